# Optimizing an MI355X kernel written in HIP

```python
import math
import jax
import jax.numpy as jnp
from jax import lax
import numpy as np

D_MODEL = 1024
BATCH = 2
SEQ = 16384
DEPTH = 2

GRID_W = 64
CTX_LEN = 256
NORM_EPS = 1e-6
LB_FLOOR = 1e-20
N_MOD = 9

DA_HEADS = 4
DA_HALF_DIM = 64
DA_V_DIM = 2 * DA_HALF_DIM
DA_QK_WIDTH = DA_HEADS * 2 * DA_HALF_DIM
DA_WIDTH = DA_HEADS * DA_V_DIM
ROPE_THETA = 10000.0
Q_BLOCK = 128

HG_HEADS = 4
HG_KEY_DIM = 64
HG_VAL_DIM = 64
HG_KEY_WIDTH = HG_HEADS * HG_KEY_DIM
HG_WIDTH = HG_HEADS * HG_VAL_DIM
HG_CHUNK = 64

POOL_WINDOWS = (2, 4, 8, 16)
POOL_GROUPS = 4
POOL_GROUP_DIM = 64
POOL_WIDTH = POOL_GROUPS * POOL_GROUP_DIM

N_BRANCH = 3
D_FF = 2816

IN_SIZES = (DA_QK_WIDTH, DA_QK_WIDTH, DA_WIDTH, HG_KEY_WIDTH, HG_KEY_WIDTH, HG_KEY_WIDTH, HG_WIDTH, HG_WIDTH, POOL_WIDTH, N_BRANCH * D_MODEL)
D_IN = sum(IN_SIZES)

kernel_name = 'hybrid_diffattn_hgrn2_pool_macaron_prefix'


def rms_norm(x, gain):
    xf = x.astype(jnp.float32)
    y = xf * lax.rsqrt(jnp.mean(xf * xf, axis=-1, keepdims=True) + NORM_EPS)
    return (y * gain.astype(jnp.float32)).astype(x.dtype)


def modulate(x, shift, scale):
    return x * (1 + scale) + shift


def swiglu(x, w1, w3, w2):
    return (jax.nn.silu(x @ w1) * (x @ w3)) @ w2


def split_columns(z):
    offsets = np.cumsum(IN_SIZES)[:-1].tolist()
    return jnp.split(z, offsets, axis=-1)


def axial_rope_tables(n_tokens):
    rows = n_tokens // GRID_W
    row = jnp.repeat(jnp.arange(rows, dtype=jnp.int32), GRID_W).astype(jnp.float32)
    col = jnp.tile(jnp.arange(GRID_W, dtype=jnp.int32), rows).astype(jnp.float32)
    axis_dim = DA_HALF_DIM // 2
    inv_freq = ROPE_THETA ** (-jnp.arange(0, axis_dim, 2, dtype=jnp.float32) / axis_dim)
    ang_r = row[:, None] * inv_freq[None, :]
    ang_c = col[:, None] * inv_freq[None, :]
    return (jnp.cos(ang_r), jnp.sin(ang_r), jnp.cos(ang_c), jnp.sin(ang_c))


def rotate_pairs(x, cos, sin):
    x1, x2 = jnp.split(x, 2, axis=-1)
    return jnp.concatenate([x1 * cos - x2 * sin, x1 * sin + x2 * cos], axis=-1)


def apply_axial_rope(x, rope):
    cos_r, sin_r, cos_c, sin_c = [t[None, :, None, None, :] for t in rope]
    xf = x.astype(jnp.float32)
    half = DA_HALF_DIM // 2
    out = jnp.concatenate([rotate_pairs(xf[..., :half], cos_r, sin_r),
                           rotate_pairs(xf[..., half:], cos_c, sin_c)], axis=-1)
    return out.astype(x.dtype)


def diff_lambda(lq1, lk1, lq2, lk2, lam_init):
    e1 = jnp.exp(jnp.sum(lq1.astype(jnp.float32) * lk1.astype(jnp.float32)))
    e2 = jnp.exp(jnp.sum(lq2.astype(jnp.float32) * lk2.astype(jnp.float32)))
    return e1 - e2 + lam_init


def diff_attend(q, k, v, lam):
    s = jnp.einsum('bqhcd,bkhcd->bhcqk', q, k).astype(jnp.float32) * (DA_HALF_DIM ** -0.5)
    p = jax.nn.softmax(s, axis=-1)
    w = p[:, :, 0] - lam * p[:, :, 1]
    return jnp.einsum('bhqk,bkhe->bqhe', w.astype(v.dtype), v)


def diff_attention_latent(q, k_all, v_all, lam):
    b, n, h, _, d = q.shape
    nb = n // Q_BLOCK
    qb = jnp.moveaxis(q.reshape(b, nb, Q_BLOCK, h, 2, d), 1, 0)
    ob = lax.map(lambda blk: diff_attend(blk, k_all, v_all, lam), qb)
    return jnp.moveaxis(ob, 0, 1).reshape(b, n, h, DA_V_DIM)


def diff_post(o, gain, lam_init):
    b, n = o.shape[:2]
    return (rms_norm(o, gain) * (1.0 - lam_init)).reshape(b, n, DA_WIDTH)


def heads_first(z, head_dim):
    b, n, _ = z.shape
    return z.reshape(b, n, -1, head_dim).transpose(0, 2, 1, 3).astype(jnp.float32)


def flip_time(a):
    return a[..., ::-1, :]


def hgrn_direction_inputs(zq, zf_fwd, zf_bwd, zi, lb):
    q = heads_first(jax.nn.silu(zq), HG_KEY_DIM)
    v = heads_first(zi, HG_VAL_DIM)
    keys, logfs = [], []
    for zf, lbd in ((zf_fwd, lb[0]), (zf_bwd, lb[1])):
        zf = heads_first(zf, HG_KEY_DIM)
        lbd = lbd.astype(jnp.float32).reshape(1, HG_HEADS, 1, HG_KEY_DIM)
        keys.append((1.0 - lbd) * jax.nn.sigmoid(-zf))
        log_lb = jnp.log(jnp.maximum(lbd, LB_FLOOR))
        logfs.append(jnp.logaddexp(log_lb, jnp.log1p(-lbd) + jax.nn.log_sigmoid(zf)))
    return (jnp.stack([q, flip_time(q)]),
            jnp.stack([keys[0], flip_time(keys[1])]),
            jnp.stack([logfs[0], flip_time(logfs[1])]),
            jnp.stack([v, flip_time(v)]))


def hgrn_chunk_scan(q, k, logf, v, s0):
    n = q.shape[-2]
    nc = n // HG_CHUNK

    def to_chunks(a):
        return jnp.moveaxis(a.reshape(a.shape[:-2] + (nc, HG_CHUNK, a.shape[-1])), -3, 0)

    in_chunk = jnp.tril(jnp.ones((HG_CHUNK, HG_CHUNK), dtype=bool))[:, :, None]

    def step(state, inp):
        qc, kc, lfc, vc = inp
        a = jnp.cumsum(lfc, axis=-2)
        a_end = a[..., -1:, :]
        o_inter = jnp.einsum('...tk,...kv->...tv', qc * jnp.exp(a), state)
        diff = a[..., :, None, :] - a[..., None, :, :]
        decay = jnp.where(in_chunk, jnp.exp(jnp.where(in_chunk, diff, 0.0)), 0.0)
        scores = jnp.einsum('...tk,...tsk,...sk->...ts', qc, decay, kc)
        o_intra = jnp.einsum('...ts,...sv->...tv', scores, vc)
        new_state = (jnp.exp(a_end[..., 0, :])[..., :, None] * state
                     + jnp.einsum('...sk,...sv->...kv', kc * jnp.exp(a_end - a), vc))
        return new_state, o_inter + o_intra

    final_state, o = lax.scan(step, s0, (to_chunks(q), to_chunks(k), to_chunks(logf), to_chunks(v)))
    o = jnp.moveaxis(o, 0, -3)
    return o.reshape(o.shape[:-3] + (n, o.shape[-1])), final_state


def hgrn_scans(zq, zff, zfb, zi, zqc, zffc, zfbc, zic, lb):
    b = zq.shape[0]
    s0 = jnp.zeros((2, b, HG_HEADS, HG_KEY_DIM, HG_VAL_DIM), jnp.float32)
    o_ctx, s_ctx = hgrn_chunk_scan(*hgrn_direction_inputs(zqc, zffc, zfbc, zic, lb), s0)
    o_lat, _ = hgrn_chunk_scan(*hgrn_direction_inputs(zq, zff, zfb, zi, lb), s_ctx)
    return o_lat, o_ctx


def hgrn_readout(o_dir, zg, gain):
    b, n, _ = zg.shape
    o = jnp.swapaxes(o_dir[0] + flip_time(o_dir[1]), 1, 2)
    o = rms_norm(o, gain).astype(zg.dtype)
    return (o * jax.nn.silu(zg.reshape(b, n, HG_HEADS, HG_VAL_DIM))).reshape(b, n, HG_WIDTH)


def hgrn_lower_bounds(logits):
    p = jax.nn.softmax(logits.astype(jnp.float32), axis=0)
    return jnp.cumsum(p, axis=0) - p[0:1]


def centred_mean_minus_self(x, window):
    b, n, ch = x.shape
    csum = jnp.concatenate([jnp.zeros((b, 1, ch), x.dtype), jnp.cumsum(x, axis=1)], axis=1)
    idx = jnp.arange(n)
    lo = jnp.clip(idx - window // 2, 0, n)
    hi = jnp.clip(idx + window // 2, 0, n)
    count = (hi - lo).astype(x.dtype)[None, :, None]
    return (csum[:, hi] - csum[:, lo]) / count - x


def pool_branch(zp, pool_w, pool_scale):
    b, n, _ = zp.shape
    groups = zp.reshape(b, n, POOL_GROUPS, POOL_GROUP_DIM).astype(jnp.float32)
    mixed = jnp.stack([centred_mean_minus_self(groups[:, :, g], w) for g, w in enumerate(POOL_WINDOWS)], axis=2)
    y = jnp.einsum('bngc,gcd->bngd', mixed.astype(zp.dtype), pool_w)
    return y.reshape(b, n, POOL_WIDTH) * pool_scale


def gated_merge(o_da, o_hg, o_pool, zgate, w_pa, w_ph, w_pp, w_o):
    b, n, _ = zgate.shape
    g = jax.nn.sigmoid(zgate.reshape(b, n, N_BRANCH, D_MODEL))
    y = g[:, :, 0] * (o_da @ w_pa) + g[:, :, 1] * (o_hg @ w_ph) + g[:, :, 2] * (o_pool @ w_pp)
    return y @ w_o


def token_mixer(u, uc, w_in, lam, lam_init, da_gain, lb, hg_gain, pool_w, pool_scale,
                w_pa, w_ph, w_pp, w_o, rope, need_ctx):
    b, n, _ = u.shape
    n_ctx = uc.shape[1]
    dq, dk, dv, hq, hff, hfb, hi, hgate, zp, zgate = split_columns(u @ w_in)
    dqc, dkc, dvc, hqc, hffc, hfbc, hic, hgatec, zpc, zgatec = split_columns(uc @ w_in)

    def da_heads(z, length):
        return z.reshape(b, length, DA_HEADS, 2, DA_HALF_DIM)

    q = apply_axial_rope(da_heads(dq, n), rope)
    k = apply_axial_rope(da_heads(dk, n), rope)
    kc = da_heads(dkc, n_ctx)
    v = dv.reshape(b, n, DA_HEADS, DA_V_DIM)
    vc = dvc.reshape(b, n_ctx, DA_HEADS, DA_V_DIM)
    o_da = diff_attention_latent(q, jnp.concatenate([k, kc], axis=1), jnp.concatenate([v, vc], axis=1), lam)
    o_hg_dir, o_hgc_dir = hgrn_scans(hq, hff, hfb, hi, hqc, hffc, hfbc, hic, lb)
    o_pool = pool_branch(zp, pool_w, pool_scale)
    mix = gated_merge(diff_post(o_da, da_gain, lam_init), hgrn_readout(o_hg_dir, hgate, hg_gain),
                      o_pool, zgate, w_pa, w_ph, w_pp, w_o)
    if not need_ctx:
        return mix, None
    o_dac = diff_attend(da_heads(dqc, n_ctx), kc, vc, lam)
    mix_c = gated_merge(diff_post(o_dac, da_gain, lam_init), hgrn_readout(o_hgc_dir, hgatec, hg_gain),
                        pool_branch(zpc, pool_w, pool_scale), zgatec, w_pa, w_ph, w_pp, w_o)
    return mix, mix_c


def setup_inputs(seed: int = 0) -> dict:
    key = jax.random.key(seed)
    ks = jax.random.split(key, 32)
    D = D_MODEL

    def nrm(k, shape, scale):
        return jax.random.normal(k, shape, jnp.float32) * scale

    return {
        'x': nrm(ks[0], (BATCH, SEQ, D), 1.0),
        'c': nrm(ks[1], (BATCH, D), 1.0),
        'ctx': nrm(ks[2], (BATCH, CTX_LEN, D), 1.0),
        'c_ctx': nrm(ks[3], (D,), 1.0),
        'w_ada': nrm(ks[4], (DEPTH, D, N_MOD * D), 0.5 * D ** -0.5),
        'b_ada': nrm(ks[5], (DEPTH, N_MOD * D), 0.02),
        'norm_ffn1': 1.0 + nrm(ks[6], (DEPTH, D), 0.02),
        'norm_mix': 1.0 + nrm(ks[7], (DEPTH, D), 0.02),
        'norm_ffn2': 1.0 + nrm(ks[8], (DEPTH, D), 0.02),
        'ffn1_w1': nrm(ks[9], (DEPTH, D, D_FF), D ** -0.5),
        'ffn1_w3': nrm(ks[10], (DEPTH, D, D_FF), D ** -0.5),
        'ffn1_w2': nrm(ks[11], (DEPTH, D_FF, D), D_FF ** -0.5),
        'ffn2_w1': nrm(ks[12], (DEPTH, D, D_FF), D ** -0.5),
        'ffn2_w3': nrm(ks[13], (DEPTH, D, D_FF), D ** -0.5),
        'ffn2_w2': nrm(ks[14], (DEPTH, D_FF, D), D_FF ** -0.5),
        'w_in': nrm(ks[15], (DEPTH, D, D_IN), D ** -0.5),
        'da_lambda_q1': nrm(ks[16], (DEPTH, DA_HALF_DIM), 0.1),
        'da_lambda_k1': nrm(ks[17], (DEPTH, DA_HALF_DIM), 0.1),
        'da_lambda_q2': nrm(ks[18], (DEPTH, DA_HALF_DIM), 0.1),
        'da_lambda_k2': nrm(ks[19], (DEPTH, DA_HALF_DIM), 0.1),
        'da_subln': 1.0 + nrm(ks[20], (DEPTH, DA_V_DIM), 0.02),
        'hg_lb_logits': nrm(ks[21], (DEPTH, 2, HG_KEY_WIDTH), 0.5),
        'hg_norm': 1.0 + nrm(ks[22], (DEPTH, HG_VAL_DIM), 0.02),
        'pool_w': nrm(ks[23], (DEPTH, POOL_GROUPS, POOL_GROUP_DIM, POOL_GROUP_DIM), POOL_GROUP_DIM ** -0.5),
        'pool_scale': 1.0 + nrm(ks[24], (DEPTH, POOL_WIDTH), 0.02),
        'w_proj_da': nrm(ks[25], (DEPTH, DA_WIDTH, D), DA_WIDTH ** -0.5),
        'w_proj_hg': nrm(ks[26], (DEPTH, HG_WIDTH, D), HG_WIDTH ** -0.5),
        'w_proj_pool': nrm(ks[27], (DEPTH, POOL_WIDTH, D), POOL_WIDTH ** -0.5),
        'w_out': nrm(ks[28], (DEPTH, D, D), D ** -0.5),
        'final_norm': 1.0 + nrm(ks[29], (D,), 0.02),
    }


def reference(x, c, ctx, c_ctx, w_ada, b_ada, norm_ffn1, norm_mix, norm_ffn2,
              ffn1_w1, ffn1_w3, ffn1_w2, ffn2_w1, ffn2_w3, ffn2_w2, w_in,
              da_lambda_q1, da_lambda_k1, da_lambda_q2, da_lambda_k2, da_subln,
              hg_lb_logits, hg_norm, pool_w, pool_scale,
              w_proj_da, w_proj_hg, w_proj_pool, w_out, final_norm):
    n = x.shape[1]
    rope = axial_rope_tables(n)
    lb_all = hgrn_lower_bounds(hg_lb_logits)
    h, hc = x, ctx
    for l in range(DEPTH):
        need_ctx = l < DEPTH - 1
        m = [t[:, None, :] for t in jnp.split(jax.nn.silu(c) @ w_ada[l] + b_ada[l], N_MOD, axis=-1)]
        mc = jnp.split(jax.nn.silu(c_ctx) @ w_ada[l] + b_ada[l], N_MOD, axis=-1)
        ffn1 = (ffn1_w1[l], ffn1_w3[l], ffn1_w2[l])
        ffn2 = (ffn2_w1[l], ffn2_w3[l], ffn2_w2[l])
        h = h + 0.5 * m[2] * swiglu(modulate(rms_norm(h, norm_ffn1[l]), m[0], m[1]), *ffn1)
        hc = hc + 0.5 * mc[2] * swiglu(modulate(rms_norm(hc, norm_ffn1[l]), mc[0], mc[1]), *ffn1)
        u = modulate(rms_norm(h, norm_mix[l]), m[3], m[4])
        uc = modulate(rms_norm(hc, norm_mix[l]), mc[3], mc[4])
        lam_init = 0.8 - 0.6 * math.exp(-0.3 * l)
        lam = diff_lambda(da_lambda_q1[l], da_lambda_k1[l], da_lambda_q2[l], da_lambda_k2[l], lam_init)
        mix, mix_c = token_mixer(u, uc, w_in[l], lam, lam_init, da_subln[l], lb_all[l], hg_norm[l],
                                 pool_w[l], pool_scale[l], w_proj_da[l], w_proj_hg[l], w_proj_pool[l],
                                 w_out[l], rope, need_ctx)
        h = h + m[5] * mix
        h = h + 0.5 * m[8] * swiglu(modulate(rms_norm(h, norm_ffn2[l]), m[6], m[7]), *ffn2)
        if need_ctx:
            hc = hc + mc[5] * mix_c
            hc = hc + 0.5 * mc[8] * swiglu(modulate(rms_norm(hc, norm_ffn2[l]), mc[6], mc[7]), *ffn2)
    return rms_norm(h, final_norm)
```

```cpp
#include <hip/hip_runtime.h>
#include <hip/hip_cooperative_groups.h>
#include <cstdio>
#include <cstdint>
namespace cg = cooperative_groups;
namespace pg8 {
#define PG8_LAS __attribute__((address_space(3)))
typedef unsigned short bf16_t;
typedef short bf16x8 __attribute__((ext_vector_type(8)));
typedef float f32x4 __attribute__((ext_vector_type(4)));
typedef unsigned u32x4 __attribute__((ext_vector_type(4)));
constexpr int BM = 256, BK = 64, HALF = 128, HTB = HALF * BK * 2  , STAGE_BYTES = 8 * HTB, NXCD = 8, WGM = 8;

__host__ __device__ __forceinline__ int lds_byte(int r, int c) { const int st = (r >> 4) * 2 + (c >> 5), rr = r & 15, cc = c & 31, ob = rr * 64 + cc * 2; return st * 1024 + (ob ^ (((ob >> 9) & 1) << 5)); }
__host__ __device__ __forceinline__ void stage_rc(int b, int& R, int& C) { const int st = b / 1024, sb = b % 1024, swz = sb ^ (((sb >> 9) & 1) << 5); R = (st >> 1) * 16 + swz / 64; C = (st & 1) * 32 + (swz % 64) / 2; }
__host__ __device__ __forceinline__ int perm32(int rho) { const int n = rho >> 4, i = rho & 15; return 8 * (i >> 2) + 4 * n + (i & 3); }

struct Unit { int pm, pn; };
struct Gemm { const bf16_t* A; const bf16_t* Bt; int M, N, K; };

struct StaticOrder {
    int nM, nN, nwg, G, c;
    __host__ __device__ void init(int M, int N, int G_, int c_) { nM = M / BM; nN = N / BM; nwg = nM * nN; G = G_; c = c_; }
    __host__ __device__ bool next(int i, Unit& u) const {
        const long L = (long)i * G + c; if (L >= nwg) return false;
        int wgid = (int)L; { const int q = nwg / NXCD, r = nwg % NXCD, xcd = wgid % NXCD, off = wgid / NXCD; wgid = (xcd < r ? xcd * (q + 1) : r * (q + 1) + (xcd - r) * q) + off; }
        const int nig = WGM * nN, gid = wgid / nig, fm = gid * WGM, gsz = (nM - fm) < WGM ? (nM - fm) : WGM;
        u.pm = fm + ((wgid % nig) % gsz); u.pn = (wgid % nig) / gsz; return true;
    }
    __device__ __forceinline__ void a_ready(const Unit&) const {}
    __device__ __forceinline__ void done(const Unit&) const {}
};

}
namespace pg8 {
template <class Epi, class Sched, bool ALIGN_EPI = false, bool SP2 = false>
__device__ __forceinline__ void gemm_phase(PG8_LAS unsigned char* lds, const Gemm g, const Sched& S, const Epi& E) {
    int tid_ = threadIdx.x; asm volatile("" : "+v"(tid_)); const int tid = tid_, wid = __builtin_amdgcn_readfirstlane(tid >> 6), lane = tid & 63, wr = wid >> 2, wc = wid & 3, fr = lane & 15, fq = lane >> 4;
    const int K = g.K, nt = K / BK;
    unsigned voffA[2], voffB[2];
#pragma unroll
    for (int i = 0; i < 2; ++i) { int R, C; stage_rc(tid * 16 + i * 8192, R, C); const int Rb = Epi::PERM ? ((R & ~31) + perm32(R & 31)) : R;
        voffA[i] = (unsigned)(R * K + C) * 2u; voffB[i] = (unsigned)(Rb * K + C) * 2u; }
    const size_t kstep = (size_t)(BK * 2);
    const size_t hstep = (size_t)HALF * K * 2;
    const size_t tstep = 2 * hstep;
    const unsigned ldsw = (unsigned)wid * 1024u;
    const int aoff = lds_byte(wr * 64 + fr, fq * 8), boff = lds_byte(wc * 32 + fr, fq * 8);
#define PG8_SA(b, h) (((b) * 2 + (h)) * HTB)
#define PG8_SB(b, h) ((4 + (b) * 2 + (h)) * HTB)
#define PG8_STAGE(bufoff, gbase, voff) do { _Pragma("unroll") for (int _i = 0; _i < 2; ++_i) \
        __builtin_amdgcn_global_load_lds((const unsigned*)((const char*)(gbase) + (voff)[_i]), (PG8_LAS unsigned*)(lds + (bufoff) + ldsw + _i * 8192), 16, 0, 0); } while (0)
#define PG8_LDA(dst, b, h) do { _Pragma("unroll") for (int m = 0; m < 4; ++m) _Pragma("unroll") for (int k = 0; k < 2; ++k) dst[m][k] = *(const PG8_LAS bf16x8*)(lds + PG8_SA(b, h) + aoff + m * 2048 + k * 1024); } while (0)
#define PG8_LDB(dst, b, h) do { _Pragma("unroll") for (int n = 0; n < 2; ++n) _Pragma("unroll") for (int k = 0; k < 2; ++k) dst[n][k] = *(const PG8_LAS bf16x8*)(lds + PG8_SB(b, h) + boff + n * 2048 + k * 1024); } while (0)
#define PG8_MMA(ai, bj, At, Bt) do { __builtin_amdgcn_s_setprio(1); _Pragma("unroll") for (int m = 0; m < 4; ++m) _Pragma("unroll") for (int n = 0; n < 2; ++n) _Pragma("unroll") for (int k = 0; k < 2; ++k) \
        acc[ai][bj][m][n] = __builtin_amdgcn_mfma_f32_16x16x32_bf16(Bt[n][k], At[m][k], acc[ai][bj][m][n], 0, 0, 0); __builtin_amdgcn_s_setprio(0); } while (0)
#define PG8_WAIT_V(n) asm volatile("s_waitcnt vmcnt(" #n ")" ::: "memory")
#define PG8_WAIT_L(n) asm volatile("s_waitcnt lgkmcnt(" #n ")" ::: "memory")
#define PG8_BAR __builtin_amdgcn_s_barrier()
#define PG8_SCHED __builtin_amdgcn_sched_barrier(0)
    Unit cur, nxt; int ui = 0;
    if (!S.next(0, cur)) return;
    f32x4 acc[2][2][4][2];
#pragma unroll
    for (int a = 0; a < 2; ++a)
#pragma unroll
        for (int b = 0; b < 2; ++b)
#pragma unroll
            for (int m = 0; m < 4; ++m)
#pragma unroll
                for (int n = 0; n < 2; ++n) acc[a][b][m][n] = (f32x4){0.f, 0.f, 0.f, 0.f};
    bf16x8 At[4][2], B0[2][2], B1[2][2];
    const char* cA = (const char*)g.A + (size_t)cur.pm * tstep; const char* cB = (const char*)g.Bt + (size_t)cur.pn * tstep;
    S.a_ready(cur);
    if constexpr (SP2) {
        PG8_STAGE(PG8_SB(0, 0), cB, voffB); PG8_STAGE(PG8_SB(0, 1), cB + hstep, voffB); PG8_STAGE(PG8_SA(0, 0), cA, voffA); PG8_STAGE(PG8_SA(0, 1), cA + hstep, voffA);
        if (wr == 1) PG8_BAR;
        PG8_WAIT_V(2); PG8_BAR;
        PG8_STAGE(PG8_SB(1, 0), cB + kstep, voffB); PG8_STAGE(PG8_SA(1, 0), cA + kstep, voffA); PG8_STAGE(PG8_SB(1, 1), cB + hstep + kstep, voffB);
        PG8_WAIT_V(6); PG8_BAR;
    } else {
        PG8_STAGE(PG8_SB(0, 0), cB, voffB); PG8_STAGE(PG8_SA(0, 0), cA, voffA); PG8_STAGE(PG8_SB(0, 1), cB + hstep, voffB); PG8_STAGE(PG8_SA(0, 1), cA + hstep, voffA);
        if (wr == 1) PG8_BAR;
        PG8_WAIT_V(4); PG8_BAR;
        PG8_STAGE(PG8_SB(1, 0), cB + kstep, voffB); PG8_STAGE(PG8_SA(1, 0), cA + kstep, voffA); PG8_STAGE(PG8_SB(1, 1), cB + hstep + kstep, voffB);
        PG8_WAIT_V(6); PG8_BAR;
    }
    for (;;) {
        const bool has_next = S.next(ui + 1, nxt);
        const char* nA = has_next ? (const char*)g.A + (size_t)nxt.pm * tstep : cA; const char* nB = has_next ? (const char*)g.Bt + (size_t)nxt.pn * tstep : cB;
        for (int t = 0; t < nt; t += 2) {
            const bool last = (t == nt - 2);
            const char* a1 = cA + (size_t)(t + 1) * kstep;
            const char* a2 = last ? nA : cA + (size_t)(t + 2) * kstep; const char* b2 = last ? nB : cB + (size_t)(t + 2) * kstep;
            const char* a3 = a2 + kstep; const char* b3 = b2 + kstep;
            if (last && has_next) S.a_ready(nxt);
            if constexpr (SP2) {
            PG8_LDB(B0, 0, 0); PG8_LDB(B1, 0, 1); PG8_SCHED; PG8_LDA(At, 0, 0); PG8_STAGE(PG8_SA(1, 1), a1 + hstep, voffA);
            PG8_WAIT_V(8); PG8_WAIT_L(0); PG8_BAR; PG8_MMA(0, 0, At, B0); PG8_MMA(0, 1, At, B1); PG8_BAR; PG8_SCHED;
            PG8_LDA(At, 0, 1); PG8_STAGE(PG8_SB(0, 0), b2, voffB); PG8_STAGE(PG8_SB(0, 1), b2 + hstep, voffB); PG8_STAGE(PG8_SA(0, 0), a2, voffA);
            PG8_WAIT_V(8); PG8_WAIT_L(0); PG8_BAR; PG8_MMA(1, 0, At, B0); PG8_MMA(1, 1, At, B1); PG8_BAR; PG8_SCHED;
            PG8_LDB(B0, 1, 0); PG8_LDB(B1, 1, 1); PG8_SCHED; PG8_LDA(At, 1, 0); PG8_STAGE(PG8_SA(0, 1), a2 + hstep, voffA);
            PG8_WAIT_V(8); PG8_WAIT_L(0); PG8_BAR; PG8_MMA(0, 0, At, B0); PG8_MMA(0, 1, At, B1); PG8_BAR; PG8_SCHED;
            PG8_LDA(At, 1, 1); PG8_STAGE(PG8_SB(1, 0), b3, voffB); PG8_STAGE(PG8_SB(1, 1), b3 + hstep, voffB); PG8_STAGE(PG8_SA(1, 0), a3, voffA);
            PG8_WAIT_V(8); PG8_WAIT_L(0); PG8_BAR; PG8_MMA(1, 0, At, B0); PG8_MMA(1, 1, At, B1); PG8_BAR; PG8_SCHED;
            } else {
            PG8_LDB(B0, 0, 0); PG8_SCHED; PG8_LDA(At, 0, 0); PG8_STAGE(PG8_SA(1, 1), a1 + hstep, voffA);
            PG8_WAIT_L(8); PG8_BAR; PG8_WAIT_L(0); PG8_MMA(0, 0, At, B0); PG8_BAR; PG8_SCHED;
            PG8_LDB(B1, 0, 1); PG8_STAGE(PG8_SB(0, 0), b2, voffB);
            PG8_BAR; PG8_WAIT_L(0); PG8_MMA(0, 1, At, B1); PG8_BAR;
            PG8_LDA(At, 0, 1); PG8_STAGE(PG8_SA(0, 0), a2, voffA);
            PG8_BAR; PG8_WAIT_L(0); PG8_MMA(1, 0, At, B0); PG8_BAR; PG8_SCHED;
            PG8_STAGE(PG8_SB(0, 1), b2 + hstep, voffB);
            PG8_WAIT_V(6); PG8_BAR; PG8_MMA(1, 1, At, B1); PG8_BAR;
            PG8_LDB(B0, 1, 0); PG8_SCHED; PG8_LDA(At, 1, 0); PG8_STAGE(PG8_SA(0, 1), a2 + hstep, voffA);
            PG8_WAIT_L(8); PG8_BAR; PG8_WAIT_L(0); PG8_MMA(0, 0, At, B0); PG8_BAR; PG8_SCHED;
            PG8_LDB(B1, 1, 1); PG8_STAGE(PG8_SB(1, 0), b3, voffB);
            PG8_BAR; PG8_WAIT_L(0); PG8_MMA(0, 1, At, B1); PG8_BAR;
            PG8_LDA(At, 1, 1); PG8_STAGE(PG8_SA(1, 0), a3, voffA);
            PG8_BAR; PG8_WAIT_L(0); PG8_MMA(1, 0, At, B0); PG8_BAR; PG8_SCHED;
            PG8_STAGE(PG8_SB(1, 1), b3 + hstep, voffB);
            PG8_WAIT_V(6); PG8_BAR; PG8_MMA(1, 1, At, B1); PG8_BAR;
            }
        }
        if constexpr (ALIGN_EPI) { if (wr == 0) PG8_BAR; }
        if constexpr (!Epi::AFTER_DRAIN) { E(acc, cur, wr, wc, fr, fq); S.done(cur); }
        if (!has_next) break;
#pragma unroll
        for (int a = 0; a < 2; ++a)
#pragma unroll
            for (int b = 0; b < 2; ++b)
#pragma unroll
                for (int m = 0; m < 4; ++m)
#pragma unroll
                    for (int n = 0; n < 2; ++n) acc[a][b][m][n] = (f32x4){0.f, 0.f, 0.f, 0.f};
        cur = nxt; cA = nA; cB = nB; ++ui;
        if constexpr (ALIGN_EPI) { if (wr == 1) PG8_BAR; }
    }
    PG8_WAIT_V(0);
    if constexpr (!ALIGN_EPI) { if (wr == 0) PG8_BAR; }
    PG8_BAR;
    if constexpr (Epi::AFTER_DRAIN) { E.fused(acc, cur, wr, wc, fr, fq, lds, wid, lane); S.done(cur); }
#undef PG8_SA
#undef PG8_SB
#undef PG8_STAGE
#undef PG8_LDA
#undef PG8_LDB
#undef PG8_MMA
#undef PG8_WAIT_V
#undef PG8_WAIT_L
#undef PG8_BAR
#undef PG8_SCHED
}
}

using pg8::bf16_t; using pg8::bf16x8; using pg8::f32x4; using pg8::u32x4; using pg8::Unit;
typedef float f32x16 __attribute__((ext_vector_type(16)));
typedef float f32x2v __attribute__((ext_vector_type(2)));
typedef __bf16 bf16x2v __attribute__((ext_vector_type(2)));
typedef unsigned u32x2 __attribute__((ext_vector_type(2)));
#define LAS __attribute__((address_space(3)))

constexpr int DM = 1024, NBATCH = 2, SEQ = 16384, CTXL = 256;
constexpr int NLAT = NBATCH * SEQ, NCTX = NBATCH * CTXL, R = NLAT + NCTX;
constexpr int DFF = 2816, KEYS = SEQ + CTXL;
constexpr float EPS = 1e-6f;
constexpr float C2 = 0.125f * 1.4426950408889634f;
constexpr int NTHR = 512;
constexpr int LDS_BYTES = 135168;
constexpr int HG_SEG = 64, HG_STEPS = KEYS / HG_SEG;

constexpr size_t WL_UP1 = 0, WL_DN1 = WL_UP1 + (size_t)5632 * 1024, WL_UP2 = WL_DN1 + (size_t)1024 * 2816, WL_DN2 = WL_UP2 + (size_t)5632 * 1024,
                 WL_IN = WL_DN2 + (size_t)1024 * 2816, WL_PA = WL_IN + (size_t)6144 * 1024, WL_PH = WL_PA + (size_t)1024 * 512, WL_PP = WL_PH + (size_t)1024 * 256,
                 WL_O = WL_PP + (size_t)1024 * 256, WL_TOTAL = WL_O + (size_t)1024 * 1024;
constexpr size_t WS_WB = 0;
constexpr size_t WS_XB = WS_WB + 2 * WL_TOTAL * 2;
constexpr size_t WS_Z = WS_XB + (size_t)R * 1024 * 2;
constexpr size_t Z_VT = 0, Z_HQ = Z_VT + (size_t)R * 512 * 2, Z_FF = Z_HQ + (size_t)R * 256 * 4, Z_FB = Z_FF + (size_t)R * 256 * 4, Z_HI = Z_FB + (size_t)R * 256 * 4,
                 Z_ZP = Z_HI + (size_t)R * 256 * 2, Z_Q = Z_ZP + (size_t)R * 256 * 2, Z_K = Z_Q + (size_t)R * 512 * 2, Z_HG = Z_K + (size_t)R * 512 * 2, Z_END = Z_HG + (size_t)R * 256 * 2;
static_assert((size_t)R * 3072 * 2 <= Z_K, "gate buffer must not reach k / odir / hgate");
static_assert((size_t)R * DFF * 2 <= Z_END, "act fits Z");
constexpr size_t WS_O = WS_Z + Z_END;
constexpr size_t O_DA = 0, O_HG = O_DA + (size_t)R * 512 * 2, O_MX = O_HG + (size_t)R * 256 * 2, O_END = O_MX + (size_t)R * 256 * 2;
constexpr size_t WS_CAR = WS_O + O_END;
constexpr size_t WS_DK = WS_CAR + (size_t)16 * HG_SEG * 4096 * 4;
constexpr size_t WS_HC = WS_DK + (size_t)16 * HG_SEG * 64 * 4;
constexpr size_t WS_MOD = WS_HC + (size_t)NCTX * 1024 * 4;
constexpr size_t WS_CS = WS_MOD + (size_t)2 * 3 * 9216 * 4;
constexpr size_t WS_LB = WS_CS + (size_t)256 * 32 * 4;
constexpr size_t WS_LAM = WS_LB + (size_t)2 * 2 * 256 * 4;
constexpr size_t WS_END = WS_LAM + 256;
static_assert(WS_END <= (size_t)512 * 1024 * 1024, "workspace");

__device__ __forceinline__ unsigned pk2(float lo, float hi) { f32x2v v = {lo, hi}; bf16x2v b = __builtin_convertvector(v, bf16x2v); return __builtin_bit_cast(unsigned, b); }
__device__ __forceinline__ float bf2f(unsigned short u) { return __builtin_bit_cast(float, (unsigned)u << 16); }
__device__ __forceinline__ float bflo(unsigned u) { return __builtin_bit_cast(float, u << 16); }
__device__ __forceinline__ float bfhi(unsigned u) { return __builtin_bit_cast(float, u & 0xffff0000u); }
__device__ __forceinline__ float ex2(float x) { return __builtin_amdgcn_exp2f(x); }
__device__ __forceinline__ float rcpf_(float x) { return __builtin_amdgcn_rcpf(x); }
__device__ __forceinline__ float sigm(float x) { return rcpf_(1.f + ex2(-1.4426950408889634f * x)); }
__device__ __forceinline__ float siluf(float x) { return x * sigm(x); }
__device__ __forceinline__ float wave_sum(float v) {
#pragma unroll
    for (int o = 1; o < 64; o <<= 1) v += __shfl_xor(v, o);
    return v;
}
#define LDS_WAIT() asm volatile("s_waitcnt lgkmcnt(0)" ::: "memory")

struct EpiUp {
    static constexpr bool PERM = true, AFTER_DRAIN = false;
    bf16_t* act;
    __device__ __forceinline__ void operator()(const f32x4 (&acc)[2][2][4][2], const Unit& u, int wr, int wc, int fr, int fq) const {
        const int row0 = u.pm * 256 + wr * 64 + fr, col0 = u.pn * 128 + wc * 32 + 8 * fq;
#pragma unroll
        for (int ai = 0; ai < 2; ++ai)
#pragma unroll
            for (int m = 0; m < 4; ++m) {
                const int row = row0 + ai * 128 + m * 16;
                const f32x4 a0 = acc[ai][0][m][0], a1 = acc[ai][0][m][1], b0 = acc[ai][1][m][0], b1 = acc[ai][1][m][1];
                u32x4 w;
                w.x = pk2(siluf(a0[0]) * b0[0], siluf(a0[1]) * b0[1]); w.y = pk2(siluf(a0[2]) * b0[2], siluf(a0[3]) * b0[3]);
                w.z = pk2(siluf(a1[0]) * b1[0], siluf(a1[1]) * b1[1]); w.w = pk2(siluf(a1[2]) * b1[2], siluf(a1[3]) * b1[3]);
                *(u32x4*)(act + (size_t)row * DFF + col0) = w;
            }
    }
};
struct EpiRes {
    static constexpr bool PERM = true, AFTER_DRAIN = false;
    const float* in_lat; const float* in_ctx; float* out_lat; float* out_ctx; const float* gate; float coef;
    __device__ __forceinline__ void operator()(const f32x4 (&acc)[2][2][4][2], const Unit& u, int wr, int wc, int fr, int fq) const {
        const int row0 = u.pm * 256 + wr * 64 + fr, col0 = u.pn * 256 + wc * 32 + 8 * fq;
        const int seg = (u.pm < 64) ? 0 : (u.pm < 128 ? 1 : 2);
        f32x4 gv[2][2];
#pragma unroll
        for (int bj = 0; bj < 2; ++bj)
#pragma unroll
            for (int n = 0; n < 2; ++n) gv[bj][n] = *(const f32x4*)(gate + seg * 9216 + col0 + bj * 128 + 4 * n) * coef;
#pragma unroll
        for (int ai = 0; ai < 2; ++ai)
#pragma unroll
            for (int m = 0; m < 4; ++m) {
                const int row = row0 + ai * 128 + m * 16;
                const float* ip; float* op;
                if (row < NLAT) { ip = in_lat + (size_t)row * DM; op = out_lat + (size_t)row * DM; }
                else { ip = in_ctx + (size_t)(row - NLAT) * DM; op = out_ctx + (size_t)(row - NLAT) * DM; }
#pragma unroll
                for (int bj = 0; bj < 2; ++bj)
#pragma unroll
                    for (int n = 0; n < 2; ++n) {
                        const int c = col0 + bj * 128 + 4 * n;
                        f32x4 v = *(const f32x4*)(ip + c);
                        v = v + gv[bj][n] * acc[ai][bj][m][n];
                        *(f32x4*)(op + c) = v;
                    }
            }
    }
};
struct EpiWin {
    static constexpr bool PERM = true, AFTER_DRAIN = false;
    unsigned char* Z; const float* cs; const float* lb; int pn_off;
    __device__ __forceinline__ void operator()(const f32x4 (&acc)[2][2][4][2], const Unit& u, int wr, int wc, int fr, int fq) const {
        const int t = u.pn + pn_off;
        const int row0 = u.pm * 256 + wr * 64 + fr, cin = wc * 32 + 8 * fq;
        if (t < 4) {
            bf16_t* dst = (bf16_t*)(Z + ((t < 2) ? Z_Q : Z_K)); const float sc = (t < 2) ? C2 : 1.f; const int cb = (t & 1) * 256;
#pragma unroll
            for (int ai = 0; ai < 2; ++ai)
#pragma unroll
                for (int m = 0; m < 4; ++m) {
                    const int row = row0 + ai * 128 + m * 16;
                    f32x4 cv = {1.f, 1.f, 1.f, 1.f}, sv = {0.f, 0.f, 0.f, 0.f};
                    if (row < NLAT) { const int ts = row & (SEQ - 1); const int pos = (wc & 1) ? (ts & 63) : (ts >> 6);
                        cv = *(const f32x4*)(cs + pos * 32 + 4 * fq); sv = *(const f32x4*)(cs + pos * 32 + 16 + 4 * fq); }
#pragma unroll
                    for (int bj = 0; bj < 2; ++bj) {
                        const f32x4 x1 = acc[ai][bj][m][0], x2 = acc[ai][bj][m][1];
                        const f32x4 o1 = (x1 * cv - x2 * sv) * sc, o2 = (x1 * sv + x2 * cv) * sc;
                        u32x4 w; w.x = pk2(o1[0], o1[1]); w.y = pk2(o1[2], o1[3]); w.z = pk2(o2[0], o2[1]); w.w = pk2(o2[2], o2[3]);
                        *(u32x4*)(dst + (size_t)row * 512 + cb + bj * 128 + cin) = w;
                    }
                }
        } else if (t <= 8) {
            float* dst = (float*)(Z + ((t == 6) ? Z_HQ : (t == 7 ? Z_FF : Z_FB)));
            const float* lbp = lb + ((t == 8) ? 256 : 0);
#pragma unroll
            for (int bj = 0; bj < 2; ++bj)
#pragma unroll
                for (int n = 0; n < 2; ++n) {
                    f32x4 lbv = *(const f32x4*)(lbp + bj * 128 + cin + 4 * n);
                    f32x4 om = 1.f - lbv;
#pragma unroll
                    for (int ai = 0; ai < 2; ++ai)
#pragma unroll
                        for (int m = 0; m < 4; ++m) {
                            const int row = row0 + ai * 128 + m * 16;
                            const f32x4 z = acc[ai][bj][m][n];
                            f32x4 sg; sg[0] = sigm(z[0]); sg[1] = sigm(z[1]); sg[2] = sigm(z[2]); sg[3] = sigm(z[3]);
                            const f32x4 o = (t == 6) ? z * sg : lbv + om * sg;
                            *(f32x4*)(dst + (size_t)row * 256 + bj * 128 + cin + 4 * n) = o;
                        }
                }
        } else {
            bf16_t* dst = (bf16_t*)(Z + ((t == 9) ? Z_HI : (t == 10 ? Z_HG : Z_ZP)));
#pragma unroll
            for (int ai = 0; ai < 2; ++ai)
#pragma unroll
                for (int m = 0; m < 4; ++m) {
                    const int row = row0 + ai * 128 + m * 16;
#pragma unroll
                    for (int bj = 0; bj < 2; ++bj) {
                        f32x4 v0 = acc[ai][bj][m][0], v1 = acc[ai][bj][m][1];
                        if (t == 10) { v0[0] = siluf(v0[0]); v0[1] = siluf(v0[1]); v0[2] = siluf(v0[2]); v0[3] = siluf(v0[3]); v1[0] = siluf(v1[0]); v1[1] = siluf(v1[1]); v1[2] = siluf(v1[2]); v1[3] = siluf(v1[3]); }
                        u32x4 w; w.x = pk2(v0[0], v0[1]); w.y = pk2(v0[2], v0[3]); w.z = pk2(v1[0], v1[1]); w.w = pk2(v1[2], v1[3]);
                        *(u32x4*)(dst + (size_t)row * 256 + bj * 128 + cin) = w;
                    }
                }
        }
    }
};
struct EpiVT {
    static constexpr bool PERM = true, AFTER_DRAIN = false;
    bf16_t* vT;
    __device__ __forceinline__ void operator()(const f32x4 (&acc)[2][2][4][2], const Unit& u, int wr, int wc, int fr, int fq) const {
        const int e0 = u.pm * 256 + wr * 64 + fr;
        int b, key0;
        if (u.pn < 64) { b = 0; key0 = u.pn * 256; } else if (u.pn < 128) { b = 1; key0 = (u.pn - 64) * 256; } else { b = u.pn - 128; key0 = SEQ; }
        const int kc = key0 + wc * 32 + 8 * fq;
#pragma unroll
        for (int ai = 0; ai < 2; ++ai)
#pragma unroll
            for (int m = 0; m < 4; ++m) {
                const int e = e0 + ai * 128 + m * 16;
#pragma unroll
                for (int bj = 0; bj < 2; ++bj) {
                    const f32x4 v0 = acc[ai][bj][m][0], v1 = acc[ai][bj][m][1];
                    u32x4 w; w.x = pk2(v0[0], v0[1]); w.y = pk2(v0[2], v0[3]); w.z = pk2(v1[0], v1[1]); w.w = pk2(v1[2], v1[3]);
                    *(u32x4*)(vT + (size_t)(b * 512 + e) * KEYS + kc + bj * 128) = w;
                }
            }
    }
};
struct EpiG {
    static constexpr bool PERM = true, AFTER_DRAIN = false;
    bf16_t* G;
    __device__ __forceinline__ void operator()(const f32x4 (&acc)[2][2][4][2], const Unit& u, int wr, int wc, int fr, int fq) const {
        const int row0 = u.pm * 256 + wr * 64 + fr, col0 = u.pn * 256 + wc * 32 + 8 * fq;
#pragma unroll
        for (int ai = 0; ai < 2; ++ai)
#pragma unroll
            for (int m = 0; m < 4; ++m) {
                const int row = row0 + ai * 128 + m * 16;
#pragma unroll
                for (int bj = 0; bj < 2; ++bj) {
                    const f32x4 v0 = acc[ai][bj][m][0], v1 = acc[ai][bj][m][1];
                    u32x4 w; w.x = pk2(sigm(v0[0]), sigm(v0[1])); w.y = pk2(sigm(v0[2]), sigm(v0[3])); w.z = pk2(sigm(v1[0]), sigm(v1[1])); w.w = pk2(sigm(v1[2]), sigm(v1[3]));
                    *(u32x4*)(G + (size_t)row * 3072 + col0 + bj * 128) = w;
                }
            }
    }
};
struct EpiProj {
    static constexpr bool PERM = true, AFTER_DRAIN = false;
    bf16_t* y; const bf16_t* G; int gi; int first;
    __device__ __forceinline__ void operator()(const f32x4 (&acc)[2][2][4][2], const Unit& u, int wr, int wc, int fr, int fq) const {
        const int row0 = u.pm * 256 + wr * 64 + fr, col0 = u.pn * 256 + wc * 32 + 8 * fq;
#pragma unroll
        for (int ai = 0; ai < 2; ++ai)
#pragma unroll
            for (int m = 0; m < 4; ++m) {
                const int row = row0 + ai * 128 + m * 16;
#pragma unroll
                for (int bj = 0; bj < 2; ++bj) {
                    const int c = col0 + bj * 128;
                    const u32x4 g = *(const u32x4*)(G + (size_t)row * 3072 + gi * 1024 + c);
                    u32x4 yo = {0u, 0u, 0u, 0u};
                    if (!first) yo = *(const u32x4*)(y + (size_t)row * 1024 + c);
                    const f32x4 v0 = acc[ai][bj][m][0], v1 = acc[ai][bj][m][1];
                    u32x4 w;
                    w.x = pk2(bflo(yo.x) + bflo(g.x) * v0[0], bfhi(yo.x) + bfhi(g.x) * v0[1]);
                    w.y = pk2(bflo(yo.y) + bflo(g.y) * v0[2], bfhi(yo.y) + bfhi(g.y) * v0[3]);
                    w.z = pk2(bflo(yo.z) + bflo(g.z) * v1[0], bfhi(yo.z) + bfhi(g.z) * v1[1]);
                    w.w = pk2(bflo(yo.w) + bflo(g.w) * v1[2], bfhi(yo.w) + bfhi(g.w) * v1[3]);
                    *(u32x4*)(y + (size_t)row * 1024 + c) = w;
                }
            }
    }
};

__device__ __forceinline__ int map_row(int mode, int n) {
    if (mode == 1) return 256 * (n >> 7) + (n & 127);
    if (mode == 2) return 256 * (n >> 7) + 128 + (n & 127);
    if (mode == 3) return (n < 1024) ? ((n & ~31) + 8 * ((n & 15) >> 2) + 4 * ((n >> 4) & 1) + (n & 3)) : n;
    return n;
}
__device__ __forceinline__ void transpose_item(const float* W, int K, int N, bf16_t* WT, int mode, LAS float* scr, int item, int lane) {
    const int nblk = N / 32, kb = item / nblk, nb = item % nblk, k0 = 64 * kb, n0 = 32 * nb;
#pragma unroll 8
    for (int i = 0; i < 32; ++i) { const int kk = 2 * i + (lane >> 5); scr[kk * 33 + (lane & 31)] = W[(size_t)(k0 + kk) * N + n0 + (lane & 31)]; }
    LDS_WAIT(); asm volatile("" ::: "memory");
    const int c = lane & 7;
#pragma unroll
    for (int j = 0; j < 4; ++j) { const int n = (lane >> 3) + 8 * j; const LAS float* s = scr + (8 * c) * 33 + n;
        u32x4 o; o.x = pk2(s[0 * 33], s[1 * 33]); o.y = pk2(s[2 * 33], s[3 * 33]); o.z = pk2(s[4 * 33], s[5 * 33]); o.w = pk2(s[6 * 33], s[7 * 33]);
        *(u32x4*)(WT + (size_t)map_row(mode, n0 + n) * K + k0 + 8 * c) = o; }
    LDS_WAIT(); asm volatile("" ::: "memory");
}

__device__ __forceinline__ void norm_phase(const float* in_lat, const float* in_ctx, const float* gain, const float* modl, int shi, int sci, bf16_t* outp, int gw, int ngw, int lane) {
    f32x4 gv[4];
#pragma unroll
    for (int j = 0; j < 4; ++j) gv[j] = *(const f32x4*)(gain + 4 * lane + 256 * j);
    for (int row = gw; row < R; row += ngw) {
        const float* ip = (row < NLAT) ? in_lat + (size_t)row * DM : in_ctx + (size_t)(row - NLAT) * DM;
        const int seg = (row < SEQ) ? 0 : (row < NLAT ? 1 : 2);
        const float* sh = modl + seg * 9216 + shi * 1024; const float* sc = modl + seg * 9216 + sci * 1024;
        f32x4 v[4]; float ss = 0.f;
#pragma unroll
        for (int j = 0; j < 4; ++j) { v[j] = *(const f32x4*)(ip + 4 * lane + 256 * j); ss += (v[j][0] * v[j][0] + v[j][1] * v[j][1]) + (v[j][2] * v[j][2] + v[j][3] * v[j][3]); }
        ss = wave_sum(ss);
        const float rstd = 1.0f / sqrtf(ss * (1.f / DM) + EPS);
#pragma unroll
        for (int j = 0; j < 4; ++j) {
            const f32x4 s4 = *(const f32x4*)(sc + 4 * lane + 256 * j), h4 = *(const f32x4*)(sh + 4 * lane + 256 * j);
            const f32x4 y = v[j] * rstd * gv[j] * (s4 + 1.f) + h4;
            u32x2 w; w.x = pk2(y[0], y[1]); w.y = pk2(y[2], y[3]);
            *(u32x2*)(outp + (size_t)row * DM + 4 * lane + 256 * j) = w;
        }
    }
}
__device__ __forceinline__ void final_norm_phase(float* out, const float* gain, int gw, int ngw, int lane) {
    f32x4 gv[4];
#pragma unroll
    for (int j = 0; j < 4; ++j) gv[j] = *(const f32x4*)(gain + 4 * lane + 256 * j);
    for (int row = gw; row < NLAT; row += ngw) {
        float* ip = out + (size_t)row * DM;
        f32x4 v[4]; float ss = 0.f;
#pragma unroll
        for (int j = 0; j < 4; ++j) { v[j] = *(const f32x4*)(ip + 4 * lane + 256 * j); ss += (v[j][0] * v[j][0] + v[j][1] * v[j][1]) + (v[j][2] * v[j][2] + v[j][3] * v[j][3]); }
        ss = wave_sum(ss);
        const float rstd = 1.0f / sqrtf(ss * (1.f / DM) + EPS);
#pragma unroll
        for (int j = 0; j < 4; ++j) *(f32x4*)(ip + 4 * lane + 256 * j) = v[j] * rstd * gv[j];
    }
}
__device__ __forceinline__ void pool_phase(const bf16_t* zp, bf16_t* mx, int gtid, int ngt) {
    for (int it = gtid; it < R * 32; it += ngt) {
        const int row = it >> 5, ch = (it & 31) * 8, g = ch >> 6, hw = 1 << g;
        int base, n;
        if (row < NLAT) { base = row & ~(SEQ - 1); n = SEQ; } else { base = NLAT + ((row - NLAT) & ~(CTXL - 1)); n = CTXL; }
        const int t = row - base, lo = (t - hw > 0) ? t - hw : 0, hi = (t + hw < n) ? t + hw : n;
        float s[8];
#pragma unroll
        for (int i = 0; i < 8; ++i) s[i] = 0.f;
        for (int j = lo; j < hi; ++j) {
            const u32x4 v = *(const u32x4*)(zp + (size_t)(base + j) * 256 + ch);
            s[0] += bflo(v.x); s[1] += bfhi(v.x); s[2] += bflo(v.y); s[3] += bfhi(v.y); s[4] += bflo(v.z); s[5] += bfhi(v.z); s[6] += bflo(v.w); s[7] += bfhi(v.w);
        }
        const float inv = 1.f / (float)(hi - lo);
        const u32x4 c = *(const u32x4*)(zp + (size_t)row * 256 + ch);
        u32x4 w;
        w.x = pk2(s[0] * inv - bflo(c.x), s[1] * inv - bfhi(c.x)); w.y = pk2(s[2] * inv - bflo(c.y), s[3] * inv - bfhi(c.y));
        w.z = pk2(s[4] * inv - bflo(c.z), s[5] * inv - bfhi(c.z)); w.w = pk2(s[6] * inv - bflo(c.w), s[7] * inv - bfhi(c.w));
        *(u32x4*)(mx + (size_t)row * 256 + ch) = w;
    }
}

__device__ __forceinline__ int hg_row(int dir, int b, int step) {
    if (step < CTXL) { const int t = dir ? (CTXL - 1 - step) : step; return NLAT + b * CTXL + t; }
    int t = step - CTXL; if (dir) t = SEQ - 1 - t; return b * SEQ + t;
}
template <bool OUT>
__device__ __forceinline__ void hg_pass(const float* hq, const float* ff, const float* fb, const bf16_t* hi, float* carry, float* dk, bf16_t* odir, int wave, int lane, int G) {
    for (int item = blockIdx.x + G * wave; item < 16 * HG_SEG; item += G * 8) {
        const int s = item / HG_SEG, j = item % HG_SEG, dir = s >> 3, b = (s >> 2) & 1, h = s & 3;
        const float* fbase = dir ? fb : ff;
        float S[64];
#pragma unroll
        for (int k = 0; k < 64; ++k) S[k] = OUT ? carry[((size_t)item * 64 + k) * 64 + lane] : 0.f;
        float dl = 1.f;
        const int st0 = j * HG_STEPS, st1 = st0 + HG_STEPS;
        size_t off = (size_t)hg_row(dir, b, st0) * 256 + h * 64 + lane;
        float iv_n = bf2f(hi[off]), fv_n = fbase[off], qv_n = OUT ? hq[off] : 0.f;
        for (int st = st0; st < st1; ++st) {
            const float iv = iv_n, fv = fv_n, qv = qv_n; const size_t offc = off;
            if (st + 1 < st1) { off = (size_t)hg_row(dir, b, st + 1) * 256 + h * 64 + lane; iv_n = bf2f(hi[off]); fv_n = fbase[off]; if (OUT) qv_n = hq[off]; }
            if (!OUT) dl *= fv;
            float o = 0.f;
            const int fvi = __builtin_bit_cast(int, fv), qvi = __builtin_bit_cast(int, qv);
#pragma unroll
            for (int k = 0; k < 64; ++k) {
                const float f = __builtin_bit_cast(float, __builtin_amdgcn_readlane(fvi, k));
                const float d = S[k] - iv;
                S[k] = __builtin_fmaf(f, d, iv);
                if (OUT) { const float q = __builtin_bit_cast(float, __builtin_amdgcn_readlane(qvi, k)); o = __builtin_fmaf(q, S[k], o); }
            }
            if (OUT) odir[(size_t)dir * R * 256 + offc] = (bf16_t)(pk2(o, 0.f) & 0xffffu);
        }
        if (!OUT) {
#pragma unroll
            for (int k = 0; k < 64; ++k) carry[((size_t)item * 64 + k) * 64 + lane] = S[k];
            dk[item * 64 + lane] = dl;
        }
    }
}
__device__ __forceinline__ void hg_carry(float* carry, const float* dk, int gtid, int ngt) {
    for (int e = gtid; e < 16 * 4096; e += ngt) {
        const int s = e >> 12, idx = e & 4095, k = idx >> 6;
        float run = 0.f;
        for (int j = 0; j < HG_SEG; ++j) {
            float* p = carry + (size_t)(s * HG_SEG + j) * 4096 + idx;
            const float tmp = *p; *p = run;
            run = __builtin_fmaf(dk[(s * HG_SEG + j) * 64 + k], run, tmp);
        }
    }
}
__device__ __forceinline__ void hg_readout(const bf16_t* odir, const bf16_t* hgs, const float* gain, bf16_t* ohg, int gw, int ngw, int lane) {
    const f32x4 gv = *(const f32x4*)(gain + ((4 * lane) & 63));
    for (int row = gw; row < R; row += ngw) {
        const size_t off = (size_t)row * 256 + 4 * lane;
        const u32x2 a = *(const u32x2*)(odir + off), bq = *(const u32x2*)(odir + (size_t)R * 256 + off), hg = *(const u32x2*)(hgs + off);
        const float o0 = bflo(a.x) + bflo(bq.x), o1 = bfhi(a.x) + bfhi(bq.x), o2 = bflo(a.y) + bflo(bq.y), o3 = bfhi(a.y) + bfhi(bq.y);
        float ss = (o0 * o0 + o1 * o1) + (o2 * o2 + o3 * o3);
        ss += __shfl_xor(ss, 1); ss += __shfl_xor(ss, 2); ss += __shfl_xor(ss, 4); ss += __shfl_xor(ss, 8);
        const float rstd = 1.0f / sqrtf(ss * (1.f / 64.f) + EPS);
        u32x2 w;
        w.x = pk2(o0 * rstd * gv[0] * bflo(hg.x), o1 * rstd * gv[1] * bfhi(hg.x));
        w.y = pk2(o2 * rstd * gv[2] * bflo(hg.y), o3 * rstd * gv[3] * bfhi(hg.y));
        *(u32x2*)(ohg + off) = w;
    }
}

constexpr int AT_KSTR = 272, AT_VSTR = 136, AT_KBYTES = 64 * AT_KSTR, AT_VBYTES = 128 * AT_VSTR, AT_STAGE = AT_KBYTES + AT_VBYTES;
static_assert(2 * AT_STAGE <= LDS_BYTES && 65536 <= 2 * AT_STAGE, "attention LDS");
__device__ __forceinline__ void attn_unit(LAS unsigned char* lds, const bf16_t* qbuf, const bf16_t* kbuf, const bf16_t* vT, bf16_t* oda, const float* gain,
                                          int b, int h, int qrow0, int kt0, int kt1, float lam, float post, int tid, int wave, int lane) {
    const int c = wave & 1, g = wave >> 1, n = lane & 31, gq = lane >> 5;
    bf16x8 qf[4];
    { const bf16_t* qp = qbuf + (size_t)(qrow0 + 32 * g + n) * 512 + h * 128 + c * 64 + 8 * gq;
#pragma unroll
      for (int s = 0; s < 4; ++s) qf[s] = *(const bf16x8*)(qp + 16 * s); }
    f32x16 O[4];
#pragma unroll
    for (int e = 0; e < 4; ++e)
#pragma unroll
        for (int r = 0; r < 16; ++r) O[e][r] = 0.f;
    float m = -1e30f, l = 0.f;
    const int kkey0 = tid >> 4, kch = tid & 15, ve0 = tid >> 3, vc = tid & 7;
    const size_t kgoff = (size_t)kkey0 * 512 + h * 128 + kch * 8;
    const unsigned klds = kkey0 * AT_KSTR + kch * 16;
    const size_t vgoff = (size_t)(b * 512 + h * 128 + ve0) * KEYS + vc * 8;
    const unsigned vlds = AT_KBYTES + ve0 * AT_VSTR + vc * 16;
    u32x4 kr0, kr1, vr0, vr1;
#define AT_LOAD(kt) do { const int kk0 = (kt) * 64; const size_t krow0 = (kk0 < SEQ) ? (size_t)b * SEQ + kk0 : (size_t)NLAT + b * CTXL + (kk0 - SEQ); \
        kr0 = *(const u32x4*)(kbuf + krow0 * 512 + kgoff); kr1 = *(const u32x4*)(kbuf + (krow0 + 32) * 512 + kgoff); \
        vr0 = *(const u32x4*)(vT + vgoff + kk0); vr1 = *(const u32x4*)(vT + vgoff + (size_t)64 * KEYS + kk0); } while (0)
#define AT_STORE(buf) do { LAS unsigned char* sb_ = lds + (buf) * AT_STAGE; \
        *(LAS u32x4*)(sb_ + klds) = kr0; *(LAS u32x4*)(sb_ + klds + 32 * AT_KSTR) = kr1; \
        *(LAS u32x2*)(sb_ + vlds) = (u32x2){vr0.x, vr0.y}; *(LAS u32x2*)(sb_ + vlds + 8) = (u32x2){vr0.z, vr0.w}; \
        *(LAS u32x2*)(sb_ + vlds + 64 * AT_VSTR) = (u32x2){vr1.x, vr1.y}; *(LAS u32x2*)(sb_ + vlds + 64 * AT_VSTR + 8) = (u32x2){vr1.z, vr1.w}; } while (0)
    AT_LOAD(kt0); AT_STORE(0); __syncthreads();
    for (int kt = kt0; kt < kt1; ++kt) {
        const int cur = (kt - kt0) & 1; const bool more = (kt + 1 < kt1);
        if (more) AT_LOAD(kt + 1);
        LAS unsigned char* sb = lds + cur * AT_STAGE;
        f32x16 S0, S1;
#pragma unroll
        for (int r = 0; r < 16; ++r) { S0[r] = 0.f; S1[r] = 0.f; }
        { LAS unsigned char* kp = sb + n * AT_KSTR + (c * 8 + gq) * 16;
#pragma unroll
          for (int s = 0; s < 4; ++s) {
              const bf16x8 a0 = *(LAS bf16x8*)(kp + s * 32), a1 = *(LAS bf16x8*)(kp + 32 * AT_KSTR + s * 32);
              S0 = __builtin_amdgcn_mfma_f32_32x32x16_bf16(a0, qf[s], S0, 0, 0, 0);
              S1 = __builtin_amdgcn_mfma_f32_32x32x16_bf16(a1, qf[s], S1, 0, 0, 0);
          } }
        float mx = S0[0];
#pragma unroll
        for (int r = 1; r < 16; ++r) mx = fmaxf(mx, S0[r]);
#pragma unroll
        for (int r = 0; r < 16; ++r) mx = fmaxf(mx, S1[r]);
        mx = fmaxf(mx, __shfl_xor(mx, 32));
        const float mn = fmaxf(m, mx), alpha = ex2(m - mn); m = mn;
        float ps = 0.f;
#pragma unroll
        for (int r = 0; r < 16; ++r) { S0[r] = ex2(S0[r] - mn); S1[r] = ex2(S1[r] - mn); ps += S0[r] + S1[r]; }
        l = l * alpha + ps;
#pragma unroll
        for (int e = 0; e < 4; ++e) O[e] = O[e] * alpha;
        LAS unsigned char* vp = sb + AT_KBYTES + n * AT_VSTR + gq * 8;
#pragma unroll
        for (int kb2 = 0; kb2 < 2; ++kb2)
#pragma unroll
            for (int s = 0; s < 2; ++s) {
                u32x4 pw;
                if (kb2 == 0) { pw.x = pk2(S0[8 * s + 0], S0[8 * s + 1]); pw.y = pk2(S0[8 * s + 2], S0[8 * s + 3]); pw.z = pk2(S0[8 * s + 4], S0[8 * s + 5]); pw.w = pk2(S0[8 * s + 6], S0[8 * s + 7]); }
                else          { pw.x = pk2(S1[8 * s + 0], S1[8 * s + 1]); pw.y = pk2(S1[8 * s + 2], S1[8 * s + 3]); pw.z = pk2(S1[8 * s + 4], S1[8 * s + 5]); pw.w = pk2(S1[8 * s + 6], S1[8 * s + 7]); }
                const bf16x8 pb = __builtin_bit_cast(bf16x8, pw);
#pragma unroll
                for (int e = 0; e < 4; ++e) {
                    const u32x2 lo = *(LAS u32x2*)(vp + e * 32 * AT_VSTR + kb2 * 64 + s * 32), hi = *(LAS u32x2*)(vp + e * 32 * AT_VSTR + kb2 * 64 + s * 32 + 16);
                    const bf16x8 a = __builtin_bit_cast(bf16x8, ((u32x4){lo.x, lo.y, hi.x, hi.y}));
                    O[e] = __builtin_amdgcn_mfma_f32_32x32x16_bf16(a, pb, O[e], 0, 0, 0);
                }
            }
        if (more) AT_STORE(cur ^ 1);
        __syncthreads();
    }
#undef AT_LOAD
#undef AT_STORE
    l += __shfl_xor(l, 32);
    const float inv = 1.f / l;
    LAS float* xch = (LAS float*)lds;
    if (c == 1) {
#pragma unroll
        for (int e = 0; e < 4; ++e)
#pragma unroll
            for (int r = 0; r < 16; ++r) xch[(g * 64 + e * 16 + r) * 64 + lane] = O[e][r] * inv;
    }
    __syncthreads();
    if (c == 0) {
        float ss = 0.f;
#pragma unroll
        for (int e = 0; e < 4; ++e)
#pragma unroll
            for (int r = 0; r < 16; ++r) { const float o = O[e][r] * inv - lam * xch[(g * 64 + e * 16 + r) * 64 + lane]; O[e][r] = o; ss += o * o; }
        ss += __shfl_xor(ss, 32);
        const float rs = post / sqrtf(ss * (1.f / 128.f) + EPS);
        bf16_t* op = oda + (size_t)(qrow0 + 32 * g + n) * 512 + h * 128;
#pragma unroll
        for (int e = 0; e < 4; ++e)
#pragma unroll
            for (int r4 = 0; r4 < 4; ++r4) {
                const int e0 = e * 32 + 8 * r4 + 4 * gq;
                const f32x4 gv = *(const f32x4*)(gain + e0);
                u32x2 w; w.x = pk2(O[e][4 * r4 + 0] * rs * gv[0], O[e][4 * r4 + 1] * rs * gv[1]); w.y = pk2(O[e][4 * r4 + 2] * rs * gv[2], O[e][4 * r4 + 3] * rs * gv[3]);
                *(u32x2*)(op + e0) = w;
            }
    }
    __syncthreads();
}

struct Args { const float* in[30]; float* out; unsigned char* ws; };
typedef const Args __attribute__((address_space(4))) Args_c;
__device__ __forceinline__ Args_c* kargs_ptr() { Args_c* p = (Args_c*)__builtin_amdgcn_kernarg_segment_ptr(); asm volatile("" : "+s"(p)); return p; }
#define GSYNC() cg::this_grid().sync()
#define KA() int tid = threadIdx.x; asm volatile("" : "+v"(tid)); int G = gridDim.x, bid = blockIdx.x; asm volatile("" : "+s"(G), "+s"(bid)); \
    const int lane = tid & 63, wave = __builtin_amdgcn_readfirstlane(tid >> 6), gw = bid * 8 + wave, ngw = G * 8, gtid = bid * NTHR + tid, ngt = G * NTHR; \
    (void)lane; (void)wave; (void)gw; (void)ngw; (void)gtid; (void)ngt; \
    Args_c* ka = kargs_ptr(); unsigned char* ws = ka->ws; (void)ws

__global__ void __launch_bounds__(NTHR, 2) fwd_kernel(Args a_unused) {
    extern __shared__ __attribute__((aligned(16))) unsigned char lds_raw[];
    LAS unsigned char* lds = (LAS unsigned char*)lds_raw;

    {
        KA();
        bf16_t* WB = (bf16_t*)(ws + WS_WB);
        LAS float* scr = (LAS float*)(lds + wave * 8448);
        constexpr int IT_L = 12416;
        for (int it = gw; it < 2 * IT_L; it += ngw) {
            const int l = it / IT_L; int r = it % IT_L;
            bf16_t* Wl = WB + (size_t)l * WL_TOTAL;
            if (r < 1408) { transpose_item(ka->in[9] + (size_t)l * 1024 * DFF, 1024, DFF, Wl + WL_UP1, 1, scr, r, lane); continue; } r -= 1408;
            if (r < 1408) { transpose_item(ka->in[10] + (size_t)l * 1024 * DFF, 1024, DFF, Wl + WL_UP1, 2, scr, r, lane); continue; } r -= 1408;
            if (r < 1408) { transpose_item(ka->in[11] + (size_t)l * DFF * 1024, DFF, 1024, Wl + WL_DN1, 0, scr, r, lane); continue; } r -= 1408;
            if (r < 1408) { transpose_item(ka->in[12] + (size_t)l * 1024 * DFF, 1024, DFF, Wl + WL_UP2, 1, scr, r, lane); continue; } r -= 1408;
            if (r < 1408) { transpose_item(ka->in[13] + (size_t)l * 1024 * DFF, 1024, DFF, Wl + WL_UP2, 2, scr, r, lane); continue; } r -= 1408;
            if (r < 1408) { transpose_item(ka->in[14] + (size_t)l * DFF * 1024, DFF, 1024, Wl + WL_DN2, 0, scr, r, lane); continue; } r -= 1408;
            if (r < 3072) { transpose_item(ka->in[15] + (size_t)l * 1024 * 6144, 1024, 6144, Wl + WL_IN, 3, scr, r, lane); continue; } r -= 3072;
            if (r < 256) { transpose_item(ka->in[25] + (size_t)l * 512 * 1024, 512, 1024, Wl + WL_PA, 0, scr, r, lane); continue; } r -= 256;
            if (r < 128) { transpose_item(ka->in[26] + (size_t)l * 256 * 1024, 256, 1024, Wl + WL_PH, 0, scr, r, lane); continue; } r -= 128;
            transpose_item(ka->in[28] + (size_t)l * 1024 * 1024, 1024, 1024, Wl + WL_O, 0, scr, r, lane);
        }
        __syncthreads();
    }
    {
        KA();
        float* MOD = (float*)(ws + WS_MOD);
        LAS float* sv = (LAS float*)lds;
        LAS float* part = (LAS float*)(lds + 12288);
        for (int i = tid; i < 3072; i += NTHR) { const int seg = i >> 10, k = i & 1023; const float x = (seg < 2) ? ka->in[1][seg * 1024 + k] : ka->in[3][k]; sv[i] = x / (1.f + __expf(-x)); }
        __syncthreads();
        for (int item = bid; item < 288; item += G) {
            const int l = item / 144, col = (item % 144) * 64 + lane;
            const float* W = ka->in[4] + (size_t)l * 1024 * 9216 + col;
            float a0 = 0.f, a1 = 0.f, a2 = 0.f;
            for (int k = wave * 128; k < wave * 128 + 128; ++k) { const float w = W[(size_t)k * 9216]; a0 = __builtin_fmaf(sv[k], w, a0); a1 = __builtin_fmaf(sv[1024 + k], w, a1); a2 = __builtin_fmaf(sv[2048 + k], w, a2); }
            part[(wave * 3 + 0) * 64 + lane] = a0; part[(wave * 3 + 1) * 64 + lane] = a1; part[(wave * 3 + 2) * 64 + lane] = a2;
            __syncthreads();
            if (tid < 192) { const int seg = tid >> 6, cl = tid & 63; float s = 0.f;
#pragma unroll
                for (int w = 0; w < 8; ++w) s += part[(w * 3 + seg) * 64 + cl];
                const int cc = (item % 144) * 64 + cl;
                MOD[(size_t)(l * 3 + seg) * 9216 + cc] = s + ka->in[5][l * 9216 + cc]; }
            __syncthreads();
        }
    }
    {
        KA();
        bf16_t* WB = (bf16_t*)(ws + WS_WB); float* CS = (float*)(ws + WS_CS); float* LBT = (float*)(ws + WS_LB); float* LAMV = (float*)(ws + WS_LAM);
        for (int idx = gtid; idx < 2 * 256 * 1024; idx += ngt) {
            const int n = idx & 1023, k = (idx >> 10) & 255, l = idx >> 18, g = k >> 6, c = k & 63;
            const float* pw = ka->in[23] + (size_t)l * 4 * 64 * 64 + (g * 64 + c) * 64;
            const float* psc = ka->in[24] + l * 256 + g * 64;
            const float* wp = ka->in[27] + (size_t)l * 256 * 1024 + (size_t)(g * 64) * 1024 + n;
            float s = 0.f;
            for (int d = 0; d < 64; ++d) s = __builtin_fmaf(pw[d] * psc[d], wp[(size_t)d * 1024], s);
            (WB + (size_t)l * WL_TOTAL + WL_PP)[(size_t)n * 256 + k] = (bf16_t)(pk2(s, 0.f) & 0xffffu);
        }
        for (int idx = gtid; idx < 4096; idx += ngt) {
            const int n = idx >> 4, j = idx & 15;
            const float invf = __builtin_exp2f(-(float)j * (13.287712379549449f / 16.f));
            const float ang = (float)n * invf;
            const double rev = (double)ang * 0.15915494309189535; const float fr = (float)(rev - __builtin_floor(rev));
            CS[n * 32 + j] = __builtin_amdgcn_cosf(fr); CS[n * 32 + 16 + j] = __builtin_amdgcn_sinf(fr);
        }
        for (int idx = gtid; idx < 1024; idx += ngt) {
            const int l = idx >> 9, dc = idx & 511;
            const float l0 = ka->in[21][dc], l1 = ka->in[21][512 + dc];
            LBT[idx] = (l == 0) ? 0.f : 1.f / (1.f + __expf(l0 - l1));
        }
        if (gtid < 2) {
            const int l = gtid; float s1 = 0.f, s2 = 0.f;
            for (int i = 0; i < 64; ++i) { s1 += ka->in[16][l * 64 + i] * ka->in[17][l * 64 + i]; s2 += ka->in[18][l * 64 + i] * ka->in[19][l * 64 + i]; }
            const float li = (l == 0) ? 0.2f : (0.8f - 0.6f * 0.7408182206817179f);
            LAMV[l * 2 + 0] = __expf(s1) - __expf(s2) + li; LAMV[l * 2 + 1] = 1.f - li;
        }
    }
    GSYNC();

#pragma unroll 1
    for (int l = 0; l < 2; ++l) {
#pragma unroll 1
        for (int f = 0; f < 2; ++f) {
            {   KA(); const bool first = (l == 0 && f == 0);
                const float* in_lat = first ? ka->in[0] : ka->out; const float* in_ctx = first ? ka->in[2] : (const float*)(ws + WS_HC);
                norm_phase(in_lat, in_ctx, ka->in[f ? 8 : 6] + l * 1024, (const float*)(ws + WS_MOD) + (size_t)l * 3 * 9216, f ? 6 : 0, f ? 7 : 1, (bf16_t*)(ws + WS_XB), gw, ngw, lane); }
            GSYNC();
            {   KA(); bf16_t* Wl = (bf16_t*)(ws + WS_WB) + (size_t)l * WL_TOTAL;
                pg8::Gemm g{(bf16_t*)(ws + WS_XB), Wl + (f ? WL_UP2 : WL_UP1), R, 5632, 1024}; pg8::StaticOrder S; S.init(R, 5632, G, bid); EpiUp E{(bf16_t*)(ws + WS_Z)};
                pg8::gemm_phase<EpiUp, pg8::StaticOrder, true, true>(lds, g, S, E); }
            GSYNC();
            {   KA(); bf16_t* Wl = (bf16_t*)(ws + WS_WB) + (size_t)l * WL_TOTAL; const bool first = (l == 0 && f == 0);
                const float* in_lat = first ? ka->in[0] : ka->out; const float* in_ctx = first ? ka->in[2] : (const float*)(ws + WS_HC);
                pg8::Gemm g{(bf16_t*)(ws + WS_Z), Wl + (f ? WL_DN2 : WL_DN1), R, 1024, DFF}; pg8::StaticOrder S; S.init(R, 1024, G, bid);
                EpiRes E{in_lat, in_ctx, ka->out, (float*)(ws + WS_HC), (const float*)(ws + WS_MOD) + (size_t)l * 3 * 9216 + (f ? 8 : 2) * 1024, 0.5f};
                pg8::gemm_phase<EpiRes, pg8::StaticOrder, true, true>(lds, g, S, E); }
            GSYNC();
            if (f == 1) break;
            {   KA();
                norm_phase(ka->out, (const float*)(ws + WS_HC), ka->in[7] + l * 1024, (const float*)(ws + WS_MOD) + (size_t)l * 3 * 9216, 3, 4, (bf16_t*)(ws + WS_XB), gw, ngw, lane); }
            GSYNC();
#pragma unroll 1
            for (int part = 0; part < 2; ++part) {
                KA(); bf16_t* Wl = (bf16_t*)(ws + WS_WB) + (size_t)l * WL_TOTAL;
                pg8::Gemm g{(bf16_t*)(ws + WS_XB), Wl + WL_IN + (size_t)(part ? 1536 : 0) * 1024, R, part ? 1536 : 1024, 1024}; pg8::StaticOrder S; S.init(R, part ? 1536 : 1024, G, bid);
                EpiWin E{ws + WS_Z, (const float*)(ws + WS_CS), (const float*)(ws + WS_LB) + l * 512, part ? 6 : 0};
                pg8::gemm_phase<EpiWin, pg8::StaticOrder, true, true>(lds, g, S, E);
            }
            {   KA(); bf16_t* Wl = (bf16_t*)(ws + WS_WB) + (size_t)l * WL_TOTAL;
                pg8::Gemm g{Wl + WL_IN + (size_t)1024 * 1024, (bf16_t*)(ws + WS_XB), 512, R, 1024}; pg8::StaticOrder S; S.init(512, R, G, bid); EpiVT E{(bf16_t*)(ws + WS_Z + Z_VT)};
                pg8::gemm_phase<EpiVT, pg8::StaticOrder, true, true>(lds, g, S, E); }
            GSYNC();
            {   KA(); pool_phase((const bf16_t*)(ws + WS_Z + Z_ZP), (bf16_t*)(ws + WS_O + O_MX), gtid, ngt); }
            {   KA();
                const float* LAMV = (const float*)(ws + WS_LAM);
                const float lam = LAMV[l * 2], post = LAMV[l * 2 + 1];
                const int nunits = 1024 + (l == 0 ? 16 : 0);
                for (int u = bid; u < nunits; u += G) {
                    int bh, qrow0, kt0, kt1;
                    if (u < 1024) { bh = u >> 7; qrow0 = (bh >> 2) * SEQ + (u & 127) * 128; kt0 = 0; kt1 = KEYS / 64; }
                    else { const int v = u - 1024; bh = v >> 1; qrow0 = NLAT + (bh >> 2) * CTXL + (v & 1) * 128; kt0 = SEQ / 64; kt1 = KEYS / 64; }
                    attn_unit(lds, (const bf16_t*)(ws + WS_Z + Z_Q), (const bf16_t*)(ws + WS_Z + Z_K), (const bf16_t*)(ws + WS_Z + Z_VT), (bf16_t*)(ws + WS_O + O_DA), ka->in[20] + l * 128,
                              bh >> 2, bh & 3, qrow0, kt0, kt1, lam, post, tid, wave, lane);
                }
            }
            GSYNC();
            {   KA(); hg_pass<false>((const float*)(ws + WS_Z + Z_HQ), (const float*)(ws + WS_Z + Z_FF), (const float*)(ws + WS_Z + Z_FB), (const bf16_t*)(ws + WS_Z + Z_HI),
                                     (float*)(ws + WS_CAR), (float*)(ws + WS_DK), (bf16_t*)(ws + WS_Z + Z_K), wave, lane, G); }
            GSYNC();
            {   KA(); hg_carry((float*)(ws + WS_CAR), (const float*)(ws + WS_DK), gtid, ngt); }
            GSYNC();
            {   KA(); hg_pass<true>((const float*)(ws + WS_Z + Z_HQ), (const float*)(ws + WS_Z + Z_FF), (const float*)(ws + WS_Z + Z_FB), (const bf16_t*)(ws + WS_Z + Z_HI),
                                    (float*)(ws + WS_CAR), (float*)(ws + WS_DK), (bf16_t*)(ws + WS_Z + Z_K), wave, lane, G); }
            GSYNC();
            {   KA(); hg_readout((const bf16_t*)(ws + WS_Z + Z_K), (const bf16_t*)(ws + WS_Z + Z_HG), ka->in[22] + l * 64, (bf16_t*)(ws + WS_O + O_HG), gw, ngw, lane); }
            GSYNC();
            {   KA(); bf16_t* Wl = (bf16_t*)(ws + WS_WB) + (size_t)l * WL_TOTAL;
                pg8::Gemm g{(bf16_t*)(ws + WS_XB), Wl + WL_IN + (size_t)3072 * 1024, R, 3072, 1024}; pg8::StaticOrder S; S.init(R, 3072, G, bid); EpiG E{(bf16_t*)(ws + WS_Z)};
                pg8::gemm_phase<EpiG, pg8::StaticOrder, true, true>(lds, g, S, E); }
            GSYNC();
#pragma unroll 1
            for (int gi = 0; gi < 3; ++gi) {
                KA(); bf16_t* Wl = (bf16_t*)(ws + WS_WB) + (size_t)l * WL_TOTAL;
                const bf16_t* A = (const bf16_t*)(ws + WS_O + ((gi == 0) ? O_DA : (gi == 1 ? O_HG : O_MX))); const int K = (gi == 0) ? 512 : 256;
                const bf16_t* Bt = Wl + ((gi == 0) ? WL_PA : (gi == 1 ? WL_PH : WL_PP));
                pg8::Gemm g{A, Bt, R, 1024, K}; pg8::StaticOrder S; S.init(R, 1024, G, bid); EpiProj E{(bf16_t*)(ws + WS_XB), (const bf16_t*)(ws + WS_Z), gi, gi == 0};
                pg8::gemm_phase<EpiProj, pg8::StaticOrder, true, true>(lds, g, S, E);
            }
            GSYNC();
            {   KA(); bf16_t* Wl = (bf16_t*)(ws + WS_WB) + (size_t)l * WL_TOTAL;
                pg8::Gemm g{(bf16_t*)(ws + WS_XB), Wl + WL_O, R, 1024, 1024}; pg8::StaticOrder S; S.init(R, 1024, G, bid);
                EpiRes E{ka->out, (const float*)(ws + WS_HC), ka->out, (float*)(ws + WS_HC), (const float*)(ws + WS_MOD) + (size_t)l * 3 * 9216 + 5 * 1024, 1.0f};
                pg8::gemm_phase<EpiRes, pg8::StaticOrder, true, true>(lds, g, S, E); }
            GSYNC();
        }
    }
    {   KA(); final_norm_phase(ka->out, ka->in[29], gw, ngw, lane); }
}

extern "C" void kernel_launch(void* const* d_in, const int* in_sizes, int n_in, void* d_out, int out_size, void* d_ws, size_t ws_size, hipStream_t stream) {
    static int grid = 0;
    if (grid == 0) {
        if (n_in != 30 || out_size != NLAT * DM || ws_size < WS_END) { fprintf(stderr, "kernel_launch: unexpected shapes (n_in %d out %d ws %zu need %zu)\n", n_in, out_size, ws_size, (size_t)WS_END); grid = -1; return; }
        int dev = 0, cus = 0, per_cu = 0;
        (void)hipGetDevice(&dev);
        (void)hipDeviceGetAttribute(&cus, hipDeviceAttributeMultiprocessorCount, dev);
        if (hipFuncSetAttribute((const void*)fwd_kernel, hipFuncAttributeMaxDynamicSharedMemorySize, LDS_BYTES) != hipSuccess) { fprintf(stderr, "kernel_launch: hipFuncSetAttribute failed\n"); grid = -1; return; }
        if (hipOccupancyMaxActiveBlocksPerMultiprocessor(&per_cu, (const void*)fwd_kernel, NTHR, LDS_BYTES) != hipSuccess || per_cu < 1) { fprintf(stderr, "kernel_launch: occupancy query failed (%d)\n", per_cu); (void)hipGetLastError(); per_cu = 1; }
        if (per_cu > 1) per_cu = 1;
        grid = cus * per_cu;
    }
    if (grid < 0) return;
    Args a{};
    for (int i = 0; i < 30; ++i) a.in[i] = (const float*)d_in[i];
    a.out = (float*)d_out; a.ws = (unsigned char*)d_ws;
    void* args[] = {&a};
    hipError_t e = hipLaunchCooperativeKernel((const void*)fwd_kernel, dim3(grid), dim3(NTHR), args, LDS_BYTES, stream);
    if (e != hipSuccess) fprintf(stderr, "cooperative launch failed: %s (grid %d)\n", hipGetErrorString(e), grid);
}
```

```cpp
#include <hip/hip_runtime.h>
#include <hip/hip_cooperative_groups.h>
#include <cstdio>
#include <cstdint>
namespace cg = cooperative_groups;
namespace pg8 {
#define PG8_LAS __attribute__((address_space(3)))
typedef unsigned short bf16_t;
typedef short bf16x8 __attribute__((ext_vector_type(8)));
typedef float f32x4 __attribute__((ext_vector_type(4)));
typedef unsigned u32x4 __attribute__((ext_vector_type(4)));
constexpr int BM = 256, BK = 64, HALF = 128, HTB = HALF * BK * 2  , STAGE_BYTES = 8 * HTB, NXCD = 8, WGM = 8;

__host__ __device__ __forceinline__ int lds_byte(int r, int c) { const int st = (r >> 4) * 2 + (c >> 5), rr = r & 15, cc = c & 31, ob = rr * 64 + cc * 2; return st * 1024 + (ob ^ (((ob >> 9) & 1) << 5)); }
__host__ __device__ __forceinline__ void stage_rc(int b, int& R, int& C) { const int st = b / 1024, sb = b % 1024, swz = sb ^ (((sb >> 9) & 1) << 5); R = (st >> 1) * 16 + swz / 64; C = (st & 1) * 32 + (swz % 64) / 2; }
__host__ __device__ __forceinline__ int perm32(int rho) { const int n = rho >> 4, i = rho & 15; return 8 * (i >> 2) + 4 * n + (i & 3); }

struct Unit { int pm, pn; };
struct Gemm { const bf16_t* A; const bf16_t* Bt; int M, N, K; };

struct StaticOrder {
    int nM, nN, nwg, G, c;
    __host__ __device__ void init(int M, int N, int G_, int c_) { nM = M / BM; nN = N / BM; nwg = nM * nN; G = G_; c = c_; }
    __host__ __device__ bool next(int i, Unit& u) const {
        const long L = (long)i * G + c; if (L >= nwg) return false;
        int wgid = (int)L; { const int q = nwg / NXCD, r = nwg % NXCD, xcd = wgid % NXCD, off = wgid / NXCD; wgid = (xcd < r ? xcd * (q + 1) : r * (q + 1) + (xcd - r) * q) + off; }
        const int nig = WGM * nN, gid = wgid / nig, fm = gid * WGM, gsz = (nM - fm) < WGM ? (nM - fm) : WGM;
        u.pm = fm + ((wgid % nig) % gsz); u.pn = (wgid % nig) / gsz; return true;
    }
    __device__ __forceinline__ void a_ready(const Unit&) const {}
    __device__ __forceinline__ void done(const Unit&) const {}
};

}
namespace pg8 {
template <class Epi, class Sched, bool ALIGN_EPI = false, bool SP2 = false>
__device__ __forceinline__ void gemm_phase(PG8_LAS unsigned char* lds, const Gemm g, const Sched& S, const Epi& E) {
    int tid_ = threadIdx.x; asm volatile("" : "+v"(tid_)); const int tid = tid_, wid = __builtin_amdgcn_readfirstlane(tid >> 6), lane = tid & 63, wr = wid >> 2, wc = wid & 3, fr = lane & 15, fq = lane >> 4;
    const int K = g.K, nt = K / BK;
    unsigned voffA[2], voffB[2];
#pragma unroll
    for (int i = 0; i < 2; ++i) { int R, C; stage_rc(tid * 16 + i * 8192, R, C); const int Rb = Epi::PERM ? ((R & ~31) + perm32(R & 31)) : R;
        voffA[i] = (unsigned)(R * K + C) * 2u; voffB[i] = (unsigned)(Rb * K + C) * 2u; }
    const size_t kstep = (size_t)(BK * 2);
    const size_t hstep = (size_t)HALF * K * 2;
    const size_t tstep = 2 * hstep;
    const unsigned ldsw = (unsigned)wid * 1024u;
    const int aoff = lds_byte(wr * 64 + fr, fq * 8), boff = lds_byte(wc * 32 + fr, fq * 8);
#define PG8_SA(b, h) (((b) * 2 + (h)) * HTB)
#define PG8_SB(b, h) ((4 + (b) * 2 + (h)) * HTB)
#define PG8_STAGE(bufoff, gbase, voff) do { _Pragma("unroll") for (int _i = 0; _i < 2; ++_i) \
        __builtin_amdgcn_global_load_lds((const unsigned*)((const char*)(gbase) + (voff)[_i]), (PG8_LAS unsigned*)(lds + (bufoff) + ldsw + _i * 8192), 16, 0, 0); } while (0)
#define PG8_LDA(dst, b, h) do { _Pragma("unroll") for (int m = 0; m < 4; ++m) _Pragma("unroll") for (int k = 0; k < 2; ++k) dst[m][k] = *(const PG8_LAS bf16x8*)(lds + PG8_SA(b, h) + aoff + m * 2048 + k * 1024); } while (0)
#define PG8_LDB(dst, b, h) do { _Pragma("unroll") for (int n = 0; n < 2; ++n) _Pragma("unroll") for (int k = 0; k < 2; ++k) dst[n][k] = *(const PG8_LAS bf16x8*)(lds + PG8_SB(b, h) + boff + n * 2048 + k * 1024); } while (0)
#define PG8_MMA(ai, bj, At, Bt) do { __builtin_amdgcn_s_setprio(1); _Pragma("unroll") for (int m = 0; m < 4; ++m) _Pragma("unroll") for (int n = 0; n < 2; ++n) _Pragma("unroll") for (int k = 0; k < 2; ++k) \
        acc[ai][bj][m][n] = __builtin_amdgcn_mfma_f32_16x16x32_bf16(Bt[n][k], At[m][k], acc[ai][bj][m][n], 0, 0, 0); __builtin_amdgcn_s_setprio(0); } while (0)
#define PG8_WAIT_V(n) asm volatile("s_waitcnt vmcnt(" #n ")" ::: "memory")
#define PG8_WAIT_L(n) asm volatile("s_waitcnt lgkmcnt(" #n ")" ::: "memory")
#define PG8_BAR __builtin_amdgcn_s_barrier()
#define PG8_SCHED __builtin_amdgcn_sched_barrier(0)
    Unit cur, nxt; int ui = 0;
    if (!S.next(0, cur)) return;
    f32x4 acc[2][2][4][2];
#pragma unroll
    for (int a = 0; a < 2; ++a)
#pragma unroll
        for (int b = 0; b < 2; ++b)
#pragma unroll
            for (int m = 0; m < 4; ++m)
#pragma unroll
                for (int n = 0; n < 2; ++n) acc[a][b][m][n] = (f32x4){0.f, 0.f, 0.f, 0.f};
    bf16x8 At[4][2], B0[2][2], B1[2][2];
    const char* cA = (const char*)g.A + (size_t)cur.pm * tstep; const char* cB = (const char*)g.Bt + (size_t)cur.pn * tstep;
    S.a_ready(cur);
    if constexpr (SP2) {
        PG8_STAGE(PG8_SB(0, 0), cB, voffB); PG8_STAGE(PG8_SB(0, 1), cB + hstep, voffB); PG8_STAGE(PG8_SA(0, 0), cA, voffA); PG8_STAGE(PG8_SA(0, 1), cA + hstep, voffA);
        if (wr == 1) PG8_BAR;
        PG8_WAIT_V(2); PG8_BAR;
        PG8_STAGE(PG8_SB(1, 0), cB + kstep, voffB); PG8_STAGE(PG8_SA(1, 0), cA + kstep, voffA); PG8_STAGE(PG8_SB(1, 1), cB + hstep + kstep, voffB);
        PG8_WAIT_V(6); PG8_BAR;
    } else {
        PG8_STAGE(PG8_SB(0, 0), cB, voffB); PG8_STAGE(PG8_SA(0, 0), cA, voffA); PG8_STAGE(PG8_SB(0, 1), cB + hstep, voffB); PG8_STAGE(PG8_SA(0, 1), cA + hstep, voffA);
        if (wr == 1) PG8_BAR;
        PG8_WAIT_V(4); PG8_BAR;
        PG8_STAGE(PG8_SB(1, 0), cB + kstep, voffB); PG8_STAGE(PG8_SA(1, 0), cA + kstep, voffA); PG8_STAGE(PG8_SB(1, 1), cB + hstep + kstep, voffB);
        PG8_WAIT_V(6); PG8_BAR;
    }
    for (;;) {
        const bool has_next = S.next(ui + 1, nxt);
        const char* nA = has_next ? (const char*)g.A + (size_t)nxt.pm * tstep : cA; const char* nB = has_next ? (const char*)g.Bt + (size_t)nxt.pn * tstep : cB;
        for (int t = 0; t < nt; t += 2) {
            const bool last = (t == nt - 2);
            const char* a1 = cA + (size_t)(t + 1) * kstep;
            const char* a2 = last ? nA : cA + (size_t)(t + 2) * kstep; const char* b2 = last ? nB : cB + (size_t)(t + 2) * kstep;
            const char* a3 = a2 + kstep; const char* b3 = b2 + kstep;
            if (last && has_next) S.a_ready(nxt);
            if constexpr (SP2) {
            PG8_LDB(B0, 0, 0); PG8_LDB(B1, 0, 1); PG8_SCHED; PG8_LDA(At, 0, 0); PG8_STAGE(PG8_SA(1, 1), a1 + hstep, voffA);
            PG8_WAIT_V(8); PG8_WAIT_L(0); PG8_BAR; PG8_MMA(0, 0, At, B0); PG8_MMA(0, 1, At, B1); PG8_BAR; PG8_SCHED;
            PG8_LDA(At, 0, 1); PG8_STAGE(PG8_SB(0, 0), b2, voffB); PG8_STAGE(PG8_SB(0, 1), b2 + hstep, voffB); PG8_STAGE(PG8_SA(0, 0), a2, voffA);
            PG8_WAIT_V(8); PG8_WAIT_L(0); PG8_BAR; PG8_MMA(1, 0, At, B0); PG8_MMA(1, 1, At, B1); PG8_BAR; PG8_SCHED;
            PG8_LDB(B0, 1, 0); PG8_LDB(B1, 1, 1); PG8_SCHED; PG8_LDA(At, 1, 0); PG8_STAGE(PG8_SA(0, 1), a2 + hstep, voffA);
            PG8_WAIT_V(8); PG8_WAIT_L(0); PG8_BAR; PG8_MMA(0, 0, At, B0); PG8_MMA(0, 1, At, B1); PG8_BAR; PG8_SCHED;
            PG8_LDA(At, 1, 1); PG8_STAGE(PG8_SB(1, 0), b3, voffB); PG8_STAGE(PG8_SB(1, 1), b3 + hstep, voffB); PG8_STAGE(PG8_SA(1, 0), a3, voffA);
            PG8_WAIT_V(8); PG8_WAIT_L(0); PG8_BAR; PG8_MMA(1, 0, At, B0); PG8_MMA(1, 1, At, B1); PG8_BAR; PG8_SCHED;
            } else {
            PG8_LDB(B0, 0, 0); PG8_SCHED; PG8_LDA(At, 0, 0); PG8_STAGE(PG8_SA(1, 1), a1 + hstep, voffA);
            PG8_WAIT_L(8); PG8_BAR; PG8_WAIT_L(0); PG8_MMA(0, 0, At, B0); PG8_BAR; PG8_SCHED;
            PG8_LDB(B1, 0, 1); PG8_STAGE(PG8_SB(0, 0), b2, voffB);
            PG8_BAR; PG8_WAIT_L(0); PG8_MMA(0, 1, At, B1); PG8_BAR;
            PG8_LDA(At, 0, 1); PG8_STAGE(PG8_SA(0, 0), a2, voffA);
            PG8_BAR; PG8_WAIT_L(0); PG8_MMA(1, 0, At, B0); PG8_BAR; PG8_SCHED;
            PG8_STAGE(PG8_SB(0, 1), b2 + hstep, voffB);
            PG8_WAIT_V(6); PG8_BAR; PG8_MMA(1, 1, At, B1); PG8_BAR;
            PG8_LDB(B0, 1, 0); PG8_SCHED; PG8_LDA(At, 1, 0); PG8_STAGE(PG8_SA(0, 1), a2 + hstep, voffA);
            PG8_WAIT_L(8); PG8_BAR; PG8_WAIT_L(0); PG8_MMA(0, 0, At, B0); PG8_BAR; PG8_SCHED;
            PG8_LDB(B1, 1, 1); PG8_STAGE(PG8_SB(1, 0), b3, voffB);
            PG8_BAR; PG8_WAIT_L(0); PG8_MMA(0, 1, At, B1); PG8_BAR;
            PG8_LDA(At, 1, 1); PG8_STAGE(PG8_SA(1, 0), a3, voffA);
            PG8_BAR; PG8_WAIT_L(0); PG8_MMA(1, 0, At, B0); PG8_BAR; PG8_SCHED;
            PG8_STAGE(PG8_SB(1, 1), b3 + hstep, voffB);
            PG8_WAIT_V(6); PG8_BAR; PG8_MMA(1, 1, At, B1); PG8_BAR;
            }
        }
        if constexpr (ALIGN_EPI) { if (wr == 0) PG8_BAR; }
        if constexpr (!Epi::AFTER_DRAIN) { E(acc, cur, wr, wc, fr, fq); S.done(cur); }
        if (!has_next) break;
#pragma unroll
        for (int a = 0; a < 2; ++a)
#pragma unroll
            for (int b = 0; b < 2; ++b)
#pragma unroll
                for (int m = 0; m < 4; ++m)
#pragma unroll
                    for (int n = 0; n < 2; ++n) acc[a][b][m][n] = (f32x4){0.f, 0.f, 0.f, 0.f};
        cur = nxt; cA = nA; cB = nB; ++ui;
        if constexpr (ALIGN_EPI) { if (wr == 1) PG8_BAR; }
    }
    PG8_WAIT_V(0);
    if constexpr (!ALIGN_EPI) { if (wr == 0) PG8_BAR; }
    PG8_BAR;
    if constexpr (Epi::AFTER_DRAIN) { E.fused(acc, cur, wr, wc, fr, fq, lds, wid, lane); S.done(cur); }
#undef PG8_SA
#undef PG8_SB
#undef PG8_STAGE
#undef PG8_LDA
#undef PG8_LDB
#undef PG8_MMA
#undef PG8_WAIT_V
#undef PG8_WAIT_L
#undef PG8_BAR
#undef PG8_SCHED
}
}

using pg8::bf16_t; using pg8::bf16x8; using pg8::f32x4; using pg8::u32x4; using pg8::Unit;
typedef float f32x16 __attribute__((ext_vector_type(16)));
typedef float f32x2v __attribute__((ext_vector_type(2)));
typedef __bf16 bf16x2v __attribute__((ext_vector_type(2)));
typedef unsigned u32x2 __attribute__((ext_vector_type(2)));
#define LAS __attribute__((address_space(3)))

constexpr int DM = 1024, NBATCH = 2, SEQ = 16384, CTXL = 256;
constexpr int NLAT = NBATCH * SEQ, NCTX = NBATCH * CTXL, R = NLAT + NCTX;
constexpr int DFF = 2816, KEYS = SEQ + CTXL;
constexpr float EPS = 1e-6f;
constexpr float C2 = 0.125f * 1.4426950408889634f;
constexpr int NTHR = 512;
constexpr int LDS_BYTES = 135168;
constexpr int HG_SEG = 128, HG_STEPS = KEYS / HG_SEG;

constexpr size_t WL_UP1 = 0, WL_DN1 = WL_UP1 + (size_t)5632 * 1024, WL_UP2 = WL_DN1 + (size_t)1024 * 2816, WL_DN2 = WL_UP2 + (size_t)5632 * 1024,
                 WL_IN = WL_DN2 + (size_t)1024 * 2816, WL_PA = WL_IN + (size_t)6144 * 1024, WL_PH = WL_PA + (size_t)1024 * 512, WL_PP = WL_PH + (size_t)1024 * 256,
                 WL_O = WL_PP + (size_t)1024 * 256, WL_TOTAL = WL_O + (size_t)1024 * 1024;
constexpr size_t WS_WB = 0;
constexpr size_t WS_XB = WS_WB + 2 * WL_TOTAL * 2;
constexpr size_t WS_Z = WS_XB + (size_t)R * 1024 * 2;
constexpr size_t Z_VT = 0, Z_HQ = Z_VT + (size_t)R * 512 * 2, Z_FF = Z_HQ + (size_t)R * 256 * 4, Z_FB = Z_FF + (size_t)R * 256 * 4, Z_HI = Z_FB + (size_t)R * 256 * 4,
                 Z_ZP = Z_HI + (size_t)R * 256 * 2, Z_Q = Z_ZP + (size_t)R * 256 * 2, Z_K = Z_Q + (size_t)R * 512 * 2, Z_HG = Z_K + (size_t)R * 512 * 2, Z_END = Z_HG + (size_t)R * 256 * 2;
static_assert((size_t)R * 3072 * 2 <= Z_K, "gate buffer must not reach k / odir / hgate");
static_assert((size_t)R * DFF * 2 <= Z_END, "act fits Z");
constexpr size_t WS_O = WS_Z + Z_END;
constexpr size_t O_DA = 0, O_HG = O_DA + (size_t)R * 512 * 2, O_MX = O_HG + (size_t)R * 256 * 2, O_END = O_MX + (size_t)R * 256 * 2;
constexpr size_t WS_CAR = WS_O + O_END;
constexpr size_t WS_DK = WS_CAR + (size_t)16 * HG_SEG * 4096 * 4;
constexpr size_t WS_HC = WS_DK + (size_t)16 * HG_SEG * 64 * 4;
constexpr size_t WS_MOD = WS_HC + (size_t)NCTX * 1024 * 4;
constexpr size_t WS_CS = WS_MOD + (size_t)2 * 3 * 9216 * 4;
constexpr size_t WS_LB = WS_CS + (size_t)256 * 32 * 4;
constexpr size_t WS_LAM = WS_LB + (size_t)2 * 2 * 256 * 4;
constexpr size_t WS_END = WS_LAM + 256;
static_assert(WS_END <= (size_t)512 * 1024 * 1024, "workspace");

__device__ __forceinline__ unsigned pk2(float lo, float hi) { f32x2v v = {lo, hi}; bf16x2v b = __builtin_convertvector(v, bf16x2v); return __builtin_bit_cast(unsigned, b); }
__device__ __forceinline__ float bf2f(unsigned short u) { return __builtin_bit_cast(float, (unsigned)u << 16); }
__device__ __forceinline__ float bflo(unsigned u) { return __builtin_bit_cast(float, u << 16); }
__device__ __forceinline__ float bfhi(unsigned u) { return __builtin_bit_cast(float, u & 0xffff0000u); }
__device__ __forceinline__ float ex2(float x) { return __builtin_amdgcn_exp2f(x); }
__device__ __forceinline__ float rcpf_(float x) { return __builtin_amdgcn_rcpf(x); }
__device__ __forceinline__ float sigm(float x) { return rcpf_(1.f + ex2(-1.4426950408889634f * x)); }
__device__ __forceinline__ float siluf(float x) { return x * sigm(x); }
__device__ __forceinline__ float wave_sum(float v) {
#pragma unroll
    for (int o = 1; o < 64; o <<= 1) v += __shfl_xor(v, o);
    return v;
}
#define LDS_WAIT() asm volatile("s_waitcnt lgkmcnt(0)" ::: "memory")

struct EpiUp {
    static constexpr bool PERM = true, AFTER_DRAIN = false;
    bf16_t* act;
    __device__ __forceinline__ void operator()(const f32x4 (&acc)[2][2][4][2], const Unit& u, int wr, int wc, int fr, int fq) const {
        const int row0 = u.pm * 256 + wr * 64 + fr, col0 = u.pn * 128 + wc * 32 + 8 * fq;
#pragma unroll
        for (int ai = 0; ai < 2; ++ai)
#pragma unroll
            for (int m = 0; m < 4; ++m) {
                const int row = row0 + ai * 128 + m * 16;
                const f32x4 a0 = acc[ai][0][m][0], a1 = acc[ai][0][m][1], b0 = acc[ai][1][m][0], b1 = acc[ai][1][m][1];
                u32x4 w;
                w.x = pk2(siluf(a0[0]) * b0[0], siluf(a0[1]) * b0[1]); w.y = pk2(siluf(a0[2]) * b0[2], siluf(a0[3]) * b0[3]);
                w.z = pk2(siluf(a1[0]) * b1[0], siluf(a1[1]) * b1[1]); w.w = pk2(siluf(a1[2]) * b1[2], siluf(a1[3]) * b1[3]);
                *(u32x4*)(act + (size_t)row * DFF + col0) = w;
            }
    }
};
struct EpiRes {
    static constexpr bool PERM = true, AFTER_DRAIN = false;
    const float* in_lat; const float* in_ctx; float* out_lat; float* out_ctx; const float* gate; float coef;
    __device__ __forceinline__ void operator()(const f32x4 (&acc)[2][2][4][2], const Unit& u, int wr, int wc, int fr, int fq) const {
        const int row0 = u.pm * 256 + wr * 64 + fr, col0 = u.pn * 256 + wc * 32 + 8 * fq;
        const int seg = (u.pm < 64) ? 0 : (u.pm < 128 ? 1 : 2);
        f32x4 gv[2][2];
#pragma unroll
        for (int bj = 0; bj < 2; ++bj)
#pragma unroll
            for (int n = 0; n < 2; ++n) gv[bj][n] = *(const f32x4*)(gate + seg * 9216 + col0 + bj * 128 + 4 * n) * coef;
#pragma unroll
        for (int ai = 0; ai < 2; ++ai)
#pragma unroll
            for (int m = 0; m < 4; ++m) {
                const int row = row0 + ai * 128 + m * 16;
                const float* ip; float* op;
                if (row < NLAT) { ip = in_lat + (size_t)row * DM; op = out_lat + (size_t)row * DM; }
                else { ip = in_ctx + (size_t)(row - NLAT) * DM; op = out_ctx + (size_t)(row - NLAT) * DM; }
#pragma unroll
                for (int bj = 0; bj < 2; ++bj)
#pragma unroll
                    for (int n = 0; n < 2; ++n) {
                        const int c = col0 + bj * 128 + 4 * n;
                        f32x4 v = *(const f32x4*)(ip + c);
                        v = v + gv[bj][n] * acc[ai][bj][m][n];
                        *(f32x4*)(op + c) = v;
                    }
            }
    }
};
struct EpiWin {
    static constexpr bool PERM = true, AFTER_DRAIN = false;
    unsigned char* Z; const float* cs; const float* lb; int pn_off;
    __device__ __forceinline__ void operator()(const f32x4 (&acc)[2][2][4][2], const Unit& u, int wr, int wc, int fr, int fq) const {
        const int t = u.pn + pn_off;
        const int row0 = u.pm * 256 + wr * 64 + fr, cin = wc * 32 + 8 * fq;
        if (t < 4) {
            bf16_t* dst = (bf16_t*)(Z + ((t < 2) ? Z_Q : Z_K)); const float sc = (t < 2) ? C2 : 1.f; const int cb = (t & 1) * 256;
#pragma unroll
            for (int ai = 0; ai < 2; ++ai)
#pragma unroll
                for (int m = 0; m < 4; ++m) {
                    const int row = row0 + ai * 128 + m * 16;
                    f32x4 cv = {1.f, 1.f, 1.f, 1.f}, sv = {0.f, 0.f, 0.f, 0.f};
                    if (row < NLAT) { const int ts = row & (SEQ - 1); const int pos = (wc & 1) ? (ts & 63) : (ts >> 6);
                        cv = *(const f32x4*)(cs + pos * 32 + 4 * fq); sv = *(const f32x4*)(cs + pos * 32 + 16 + 4 * fq); }
#pragma unroll
                    for (int bj = 0; bj < 2; ++bj) {
                        const f32x4 x1 = acc[ai][bj][m][0], x2 = acc[ai][bj][m][1];
                        const f32x4 o1 = (x1 * cv - x2 * sv) * sc, o2 = (x1 * sv + x2 * cv) * sc;
                        u32x4 w; w.x = pk2(o1[0], o1[1]); w.y = pk2(o1[2], o1[3]); w.z = pk2(o2[0], o2[1]); w.w = pk2(o2[2], o2[3]);
                        *(u32x4*)(dst + (size_t)row * 512 + cb + bj * 128 + cin) = w;
                    }
                }
        } else if (t <= 8) {
            float* dst = (float*)(Z + ((t == 6) ? Z_HQ : (t == 7 ? Z_FF : Z_FB)));
            const float* lbp = lb + ((t == 8) ? 256 : 0);
#pragma unroll
            for (int bj = 0; bj < 2; ++bj)
#pragma unroll
                for (int n = 0; n < 2; ++n) {
                    f32x4 lbv = *(const f32x4*)(lbp + bj * 128 + cin + 4 * n);
                    f32x4 om = 1.f - lbv;
#pragma unroll
                    for (int ai = 0; ai < 2; ++ai)
#pragma unroll
                        for (int m = 0; m < 4; ++m) {
                            const int row = row0 + ai * 128 + m * 16;
                            const f32x4 z = acc[ai][bj][m][n];
                            f32x4 sg; sg[0] = sigm(z[0]); sg[1] = sigm(z[1]); sg[2] = sigm(z[2]); sg[3] = sigm(z[3]);
                            const f32x4 o = (t == 6) ? z * sg : lbv + om * sg;
                            *(f32x4*)(dst + (size_t)row * 256 + bj * 128 + cin + 4 * n) = o;
                        }
                }
        } else {
            bf16_t* dst = (bf16_t*)(Z + ((t == 9) ? Z_HI : (t == 10 ? Z_HG : Z_ZP)));
#pragma unroll
            for (int ai = 0; ai < 2; ++ai)
#pragma unroll
                for (int m = 0; m < 4; ++m) {
                    const int row = row0 + ai * 128 + m * 16;
#pragma unroll
                    for (int bj = 0; bj < 2; ++bj) {
                        f32x4 v0 = acc[ai][bj][m][0], v1 = acc[ai][bj][m][1];
                        if (t == 10) { v0[0] = siluf(v0[0]); v0[1] = siluf(v0[1]); v0[2] = siluf(v0[2]); v0[3] = siluf(v0[3]); v1[0] = siluf(v1[0]); v1[1] = siluf(v1[1]); v1[2] = siluf(v1[2]); v1[3] = siluf(v1[3]); }
                        u32x4 w; w.x = pk2(v0[0], v0[1]); w.y = pk2(v0[2], v0[3]); w.z = pk2(v1[0], v1[1]); w.w = pk2(v1[2], v1[3]);
                        *(u32x4*)(dst + (size_t)row * 256 + bj * 128 + cin) = w;
                    }
                }
        }
    }
};
struct EpiVT {
    static constexpr bool PERM = true, AFTER_DRAIN = false;
    bf16_t* vT;
    __device__ __forceinline__ void operator()(const f32x4 (&acc)[2][2][4][2], const Unit& u, int wr, int wc, int fr, int fq) const {
        const int e0 = u.pm * 256 + wr * 64 + fr;
        int b, key0;
        if (u.pn < 64) { b = 0; key0 = u.pn * 256; } else if (u.pn < 128) { b = 1; key0 = (u.pn - 64) * 256; } else { b = u.pn - 128; key0 = SEQ; }
        const int kc = key0 + wc * 32 + 8 * fq;
#pragma unroll
        for (int ai = 0; ai < 2; ++ai)
#pragma unroll
            for (int m = 0; m < 4; ++m) {
                const int e = e0 + ai * 128 + m * 16;
#pragma unroll
                for (int bj = 0; bj < 2; ++bj) {
                    const f32x4 v0 = acc[ai][bj][m][0], v1 = acc[ai][bj][m][1];
                    u32x4 w; w.x = pk2(v0[0], v0[1]); w.y = pk2(v0[2], v0[3]); w.z = pk2(v1[0], v1[1]); w.w = pk2(v1[2], v1[3]);
                    *(u32x4*)(vT + (size_t)(b * 512 + e) * KEYS + kc + bj * 128) = w;
                }
            }
    }
};
struct EpiG {
    static constexpr bool PERM = true, AFTER_DRAIN = false;
    bf16_t* G;
    __device__ __forceinline__ void operator()(const f32x4 (&acc)[2][2][4][2], const Unit& u, int wr, int wc, int fr, int fq) const {
        const int row0 = u.pm * 256 + wr * 64 + fr, col0 = u.pn * 256 + wc * 32 + 8 * fq;
#pragma unroll
        for (int ai = 0; ai < 2; ++ai)
#pragma unroll
            for (int m = 0; m < 4; ++m) {
                const int row = row0 + ai * 128 + m * 16;
#pragma unroll
                for (int bj = 0; bj < 2; ++bj) {
                    const f32x4 v0 = acc[ai][bj][m][0], v1 = acc[ai][bj][m][1];
                    u32x4 w; w.x = pk2(sigm(v0[0]), sigm(v0[1])); w.y = pk2(sigm(v0[2]), sigm(v0[3])); w.z = pk2(sigm(v1[0]), sigm(v1[1])); w.w = pk2(sigm(v1[2]), sigm(v1[3]));
                    *(u32x4*)(G + (size_t)row * 3072 + col0 + bj * 128) = w;
                }
            }
    }
};
struct EpiProj {
    static constexpr bool PERM = true, AFTER_DRAIN = false;
    bf16_t* y; const bf16_t* G; int gi; int first;
    __device__ __forceinline__ void operator()(const f32x4 (&acc)[2][2][4][2], const Unit& u, int wr, int wc, int fr, int fq) const {
        const int row0 = u.pm * 256 + wr * 64 + fr, col0 = u.pn * 256 + wc * 32 + 8 * fq;
#pragma unroll
        for (int ai = 0; ai < 2; ++ai)
#pragma unroll
            for (int m = 0; m < 4; ++m) {
                const int row = row0 + ai * 128 + m * 16;
#pragma unroll
                for (int bj = 0; bj < 2; ++bj) {
                    const int c = col0 + bj * 128;
                    const u32x4 g = *(const u32x4*)(G + (size_t)row * 3072 + gi * 1024 + c);
                    u32x4 yo = {0u, 0u, 0u, 0u};
                    if (!first) yo = *(const u32x4*)(y + (size_t)row * 1024 + c);
                    const f32x4 v0 = acc[ai][bj][m][0], v1 = acc[ai][bj][m][1];
                    u32x4 w;
                    w.x = pk2(bflo(yo.x) + bflo(g.x) * v0[0], bfhi(yo.x) + bfhi(g.x) * v0[1]);
                    w.y = pk2(bflo(yo.y) + bflo(g.y) * v0[2], bfhi(yo.y) + bfhi(g.y) * v0[3]);
                    w.z = pk2(bflo(yo.z) + bflo(g.z) * v1[0], bfhi(yo.z) + bfhi(g.z) * v1[1]);
                    w.w = pk2(bflo(yo.w) + bflo(g.w) * v1[2], bfhi(yo.w) + bfhi(g.w) * v1[3]);
                    *(u32x4*)(y + (size_t)row * 1024 + c) = w;
                }
            }
    }
};

__device__ __forceinline__ int map_row(int mode, int n) {
    if (mode == 1) return 256 * (n >> 7) + (n & 127);
    if (mode == 2) return 256 * (n >> 7) + 128 + (n & 127);
    if (mode == 3) return (n < 1024) ? ((n & ~31) + 8 * ((n & 15) >> 2) + 4 * ((n >> 4) & 1) + (n & 3)) : n;
    return n;
}
__device__ __forceinline__ void transpose_item(const float* W, int K, int N, bf16_t* WT, int mode, LAS float* scr, int item, int lane) {
    const int nblk = N / 32, kb = item / nblk, nb = item % nblk, k0 = 64 * kb, n0 = 32 * nb;
#pragma unroll 8
    for (int i = 0; i < 32; ++i) { const int kk = 2 * i + (lane >> 5); scr[kk * 33 + (lane & 31)] = W[(size_t)(k0 + kk) * N + n0 + (lane & 31)]; }
    LDS_WAIT(); asm volatile("" ::: "memory");
    const int c = lane & 7;
#pragma unroll
    for (int j = 0; j < 4; ++j) { const int n = (lane >> 3) + 8 * j; const LAS float* s = scr + (8 * c) * 33 + n;
        u32x4 o; o.x = pk2(s[0 * 33], s[1 * 33]); o.y = pk2(s[2 * 33], s[3 * 33]); o.z = pk2(s[4 * 33], s[5 * 33]); o.w = pk2(s[6 * 33], s[7 * 33]);
        *(u32x4*)(WT + (size_t)map_row(mode, n0 + n) * K + k0 + 8 * c) = o; }
    LDS_WAIT(); asm volatile("" ::: "memory");
}

__device__ __forceinline__ void norm_phase(const float* in_lat, const float* in_ctx, const float* gain, const float* modl, int shi, int sci, bf16_t* outp, int gw, int ngw, int lane) {
    f32x4 gv[4];
#pragma unroll
    for (int j = 0; j < 4; ++j) gv[j] = *(const f32x4*)(gain + 4 * lane + 256 * j);
    for (int row = gw; row < R; row += ngw) {
        const float* ip = (row < NLAT) ? in_lat + (size_t)row * DM : in_ctx + (size_t)(row - NLAT) * DM;
        const int seg = (row < SEQ) ? 0 : (row < NLAT ? 1 : 2);
        const float* sh = modl + seg * 9216 + shi * 1024; const float* sc = modl + seg * 9216 + sci * 1024;
        f32x4 v[4]; float ss = 0.f;
#pragma unroll
        for (int j = 0; j < 4; ++j) { v[j] = *(const f32x4*)(ip + 4 * lane + 256 * j); ss += (v[j][0] * v[j][0] + v[j][1] * v[j][1]) + (v[j][2] * v[j][2] + v[j][3] * v[j][3]); }
        ss = wave_sum(ss);
        const float rstd = 1.0f / sqrtf(ss * (1.f / DM) + EPS);
#pragma unroll
        for (int j = 0; j < 4; ++j) {
            const f32x4 s4 = *(const f32x4*)(sc + 4 * lane + 256 * j), h4 = *(const f32x4*)(sh + 4 * lane + 256 * j);
            const f32x4 y = v[j] * rstd * gv[j] * (s4 + 1.f) + h4;
            u32x2 w; w.x = pk2(y[0], y[1]); w.y = pk2(y[2], y[3]);
            *(u32x2*)(outp + (size_t)row * DM + 4 * lane + 256 * j) = w;
        }
    }
}
__device__ __forceinline__ void final_norm_phase(float* out, const float* gain, int gw, int ngw, int lane) {
    f32x4 gv[4];
#pragma unroll
    for (int j = 0; j < 4; ++j) gv[j] = *(const f32x4*)(gain + 4 * lane + 256 * j);
    for (int row = gw; row < NLAT; row += ngw) {
        float* ip = out + (size_t)row * DM;
        f32x4 v[4]; float ss = 0.f;
#pragma unroll
        for (int j = 0; j < 4; ++j) { v[j] = *(const f32x4*)(ip + 4 * lane + 256 * j); ss += (v[j][0] * v[j][0] + v[j][1] * v[j][1]) + (v[j][2] * v[j][2] + v[j][3] * v[j][3]); }
        ss = wave_sum(ss);
        const float rstd = 1.0f / sqrtf(ss * (1.f / DM) + EPS);
#pragma unroll
        for (int j = 0; j < 4; ++j) *(f32x4*)(ip + 4 * lane + 256 * j) = v[j] * rstd * gv[j];
    }
}
__device__ __forceinline__ void pool_phase(const bf16_t* zp, bf16_t* mx, int gtid, int ngt) {
    for (int it = gtid; it < R * 32; it += ngt) {
        const int row = it >> 5, ch = (it & 31) * 8, g = ch >> 6, hw = 1 << g;
        int base, n;
        if (row < NLAT) { base = row & ~(SEQ - 1); n = SEQ; } else { base = NLAT + ((row - NLAT) & ~(CTXL - 1)); n = CTXL; }
        const int t = row - base, lo = (t - hw > 0) ? t - hw : 0, hi = (t + hw < n) ? t + hw : n;
        float s[8];
#pragma unroll
        for (int i = 0; i < 8; ++i) s[i] = 0.f;
        for (int j = lo; j < hi; ++j) {
            const u32x4 v = *(const u32x4*)(zp + (size_t)(base + j) * 256 + ch);
            s[0] += bflo(v.x); s[1] += bfhi(v.x); s[2] += bflo(v.y); s[3] += bfhi(v.y); s[4] += bflo(v.z); s[5] += bfhi(v.z); s[6] += bflo(v.w); s[7] += bfhi(v.w);
        }
        const float inv = 1.f / (float)(hi - lo);
        const u32x4 c = *(const u32x4*)(zp + (size_t)row * 256 + ch);
        u32x4 w;
        w.x = pk2(s[0] * inv - bflo(c.x), s[1] * inv - bfhi(c.x)); w.y = pk2(s[2] * inv - bflo(c.y), s[3] * inv - bfhi(c.y));
        w.z = pk2(s[4] * inv - bflo(c.z), s[5] * inv - bfhi(c.z)); w.w = pk2(s[6] * inv - bflo(c.w), s[7] * inv - bfhi(c.w));
        *(u32x4*)(mx + (size_t)row * 256 + ch) = w;
    }
}

__device__ __forceinline__ int hg_row(int dir, int b, int step) {
    if (step < CTXL) { const int t = dir ? (CTXL - 1 - step) : step; return NLAT + b * CTXL + t; }
    int t = step - CTXL; if (dir) t = SEQ - 1 - t; return b * SEQ + t;
}
template <bool OUT>
__device__ __forceinline__ void hg_pass(const float* hq, const float* ff, const float* fb, const bf16_t* hi, float* carry, float* dk, bf16_t* odir, int wave, int lane, int G) {
    for (int item = blockIdx.x + G * wave; item < 16 * HG_SEG; item += G * 8) {
        const int s = item / HG_SEG, j = item % HG_SEG, dir = s >> 3, b = (s >> 2) & 1, h = s & 3;
        const float* fbase = dir ? fb : ff;
        f32x2v S[32];
#pragma unroll
        for (int k = 0; k < 32; ++k) { S[k][0] = OUT ? carry[((size_t)item * 64 + 2 * k) * 64 + lane] : 0.f; S[k][1] = OUT ? carry[((size_t)item * 64 + 2 * k + 1) * 64 + lane] : 0.f; }
        float dl = 1.f;
        const int st0 = j * HG_STEPS, st1 = st0 + HG_STEPS;
        size_t off = (size_t)hg_row(dir, b, st0) * 256 + h * 64 + lane;
        float iv_n = bf2f(hi[off]), fv_n = fbase[off], qv_n = OUT ? hq[off] : 0.f;
        for (int st = st0; st < st1; ++st) {
            const float iv = iv_n, fv = fv_n, qv = qv_n; const size_t offc = off;
            if (st + 1 < st1) { off = (size_t)hg_row(dir, b, st + 1) * 256 + h * 64 + lane; iv_n = bf2f(hi[off]); fv_n = fbase[off]; if (OUT) qv_n = hq[off]; }
            if (!OUT) dl *= fv;
            f32x2v o2 = {0.f, 0.f};
            const f32x2v iv2 = {iv, iv};
            const int fvi = __builtin_bit_cast(int, fv), qvi = __builtin_bit_cast(int, qv);
#pragma unroll
            for (int k = 0; k < 32; ++k) {
                f32x2v f2; f2[0] = __builtin_bit_cast(float, __builtin_amdgcn_readlane(fvi, 2 * k)); f2[1] = __builtin_bit_cast(float, __builtin_amdgcn_readlane(fvi, 2 * k + 1));
                const f32x2v d2 = S[k] - iv2;
                S[k] = __builtin_elementwise_fma(f2, d2, iv2);
                if (OUT) { f32x2v q2; q2[0] = __builtin_bit_cast(float, __builtin_amdgcn_readlane(qvi, 2 * k)); q2[1] = __builtin_bit_cast(float, __builtin_amdgcn_readlane(qvi, 2 * k + 1));
                    o2 = __builtin_elementwise_fma(q2, S[k], o2); }
            }
            if (OUT) odir[(size_t)dir * R * 256 + offc] = (bf16_t)(pk2(o2[0] + o2[1], 0.f) & 0xffffu);
        }
        if (!OUT) {
#pragma unroll
            for (int k = 0; k < 32; ++k) { carry[((size_t)item * 64 + 2 * k) * 64 + lane] = S[k][0]; carry[((size_t)item * 64 + 2 * k + 1) * 64 + lane] = S[k][1]; }
            dk[item * 64 + lane] = dl;
        }
    }
}
__device__ __forceinline__ void hg_carry(float* carry, const float* dk, int gtid, int ngt) {
    for (int e = gtid; e < 16 * 4096; e += ngt) {
        const int s = e >> 12, idx = e & 4095, k = idx >> 6;
        float run = 0.f;
        for (int j0 = 0; j0 < HG_SEG; j0 += 8) {
            float t[8], d[8];
#pragma unroll
            for (int u = 0; u < 8; ++u) { t[u] = carry[(size_t)(s * HG_SEG + j0 + u) * 4096 + idx]; d[u] = dk[(s * HG_SEG + j0 + u) * 64 + k]; }
#pragma unroll
            for (int u = 0; u < 8; ++u) { carry[(size_t)(s * HG_SEG + j0 + u) * 4096 + idx] = run; run = __builtin_fmaf(d[u], run, t[u]); }
        }
    }
}
__device__ __forceinline__ void hg_readout(const bf16_t* odir, const bf16_t* hgs, const float* gain, bf16_t* ohg, int gw, int ngw, int lane) {
    const f32x4 gv = *(const f32x4*)(gain + ((4 * lane) & 63));
    for (int row = gw; row < R; row += ngw) {
        const size_t off = (size_t)row * 256 + 4 * lane;
        const u32x2 a = *(const u32x2*)(odir + off), bq = *(const u32x2*)(odir + (size_t)R * 256 + off), hg = *(const u32x2*)(hgs + off);
        const float o0 = bflo(a.x) + bflo(bq.x), o1 = bfhi(a.x) + bfhi(bq.x), o2 = bflo(a.y) + bflo(bq.y), o3 = bfhi(a.y) + bfhi(bq.y);
        float ss = (o0 * o0 + o1 * o1) + (o2 * o2 + o3 * o3);
        ss += __shfl_xor(ss, 1); ss += __shfl_xor(ss, 2); ss += __shfl_xor(ss, 4); ss += __shfl_xor(ss, 8);
        const float rstd = 1.0f / sqrtf(ss * (1.f / 64.f) + EPS);
        u32x2 w;
        w.x = pk2(o0 * rstd * gv[0] * bflo(hg.x), o1 * rstd * gv[1] * bfhi(hg.x));
        w.y = pk2(o2 * rstd * gv[2] * bflo(hg.y), o3 * rstd * gv[3] * bfhi(hg.y));
        *(u32x2*)(ohg + off) = w;
    }
}

constexpr int AT_KSTR = 272, AT_VSTR = 136, AT_KBYTES = 64 * AT_KSTR, AT_VBYTES = 128 * AT_VSTR, AT_STAGE = AT_KBYTES + AT_VBYTES;
static_assert(2 * AT_STAGE <= LDS_BYTES && 65536 <= 2 * AT_STAGE, "attention LDS");
__device__ __forceinline__ void attn_unit(LAS unsigned char* lds, const bf16_t* qbuf, const bf16_t* kbuf, const bf16_t* vT, bf16_t* oda, const float* gain,
                                          int b, int h, int qrow0, int kt0, int kt1, float lam, float post, int tid, int wave, int lane) {
    const int c = wave & 1, g = wave >> 1, n = lane & 31, gq = lane >> 5;
    bf16x8 qf[4];
    { const bf16_t* qp = qbuf + (size_t)(qrow0 + 32 * g + n) * 512 + h * 128 + c * 64 + 8 * gq;
#pragma unroll
      for (int s = 0; s < 4; ++s) qf[s] = *(const bf16x8*)(qp + 16 * s); }
    f32x16 O[4];
#pragma unroll
    for (int e = 0; e < 4; ++e)
#pragma unroll
        for (int r = 0; r < 16; ++r) O[e][r] = 0.f;
    float l = 0.f;
    const int kkey0 = tid >> 4, kch = tid & 15, ve0 = tid >> 3, vc = tid & 7;
    const size_t kgoff = (size_t)kkey0 * 512 + h * 128 + kch * 8;
    const unsigned klds = kkey0 * AT_KSTR + kch * 16;
    const size_t vgoff = (size_t)(b * 512 + h * 128 + ve0) * KEYS + vc * 8;
    const unsigned vlds = AT_KBYTES + ve0 * AT_VSTR + vc * 16;
    u32x4 kr0, kr1, vr0, vr1;
#define AT_LOAD(kt) do { const int kk0 = (kt) * 64; const size_t krow0 = (kk0 < SEQ) ? (size_t)b * SEQ + kk0 : (size_t)NLAT + b * CTXL + (kk0 - SEQ); \
        kr0 = *(const u32x4*)(kbuf + krow0 * 512 + kgoff); kr1 = *(const u32x4*)(kbuf + (krow0 + 32) * 512 + kgoff); \
        vr0 = *(const u32x4*)(vT + vgoff + kk0); vr1 = *(const u32x4*)(vT + vgoff + (size_t)64 * KEYS + kk0); } while (0)
#define AT_STORE(buf) do { LAS unsigned char* sb_ = lds + (buf) * AT_STAGE; \
        *(LAS u32x4*)(sb_ + klds) = kr0; *(LAS u32x4*)(sb_ + klds + 32 * AT_KSTR) = kr1; \
        *(LAS u32x2*)(sb_ + vlds) = (u32x2){vr0.x, vr0.y}; *(LAS u32x2*)(sb_ + vlds + 8) = (u32x2){vr0.z, vr0.w}; \
        *(LAS u32x2*)(sb_ + vlds + 64 * AT_VSTR) = (u32x2){vr1.x, vr1.y}; *(LAS u32x2*)(sb_ + vlds + 64 * AT_VSTR + 8) = (u32x2){vr1.z, vr1.w}; } while (0)
    AT_LOAD(kt0); AT_STORE(0); __syncthreads();
    f32x16 negm;
    float m_used;
    {
        f32x16 S0, S1;
#pragma unroll
        for (int r = 0; r < 16; ++r) { S0[r] = 0.f; S1[r] = 0.f; }
        LAS unsigned char* kp = lds + n * AT_KSTR + (c * 8 + gq) * 16;
#pragma unroll
        for (int s = 0; s < 4; ++s) {
            const bf16x8 a0 = *(LAS bf16x8*)(kp + s * 32), a1 = *(LAS bf16x8*)(kp + 32 * AT_KSTR + s * 32);
            S0 = __builtin_amdgcn_mfma_f32_32x32x16_bf16(a0, qf[s], S0, 0, 0, 0);
            S1 = __builtin_amdgcn_mfma_f32_32x32x16_bf16(a1, qf[s], S1, 0, 0, 0);
        }
        float mx = fmaxf(S0[0], S1[0]);
#pragma unroll
        for (int r = 1; r < 16; ++r) mx = fmaxf(fmaxf(mx, S0[r]), S1[r]);
        { auto rr = __builtin_amdgcn_permlane32_swap(__builtin_bit_cast(unsigned, mx), __builtin_bit_cast(unsigned, mx), false, false);
          mx = fmaxf(__builtin_bit_cast(float, rr[0]), __builtin_bit_cast(float, rr[1])); }
        m_used = mx;
#pragma unroll
        for (int r = 0; r < 16; ++r) negm[r] = -mx;
    }
    constexpr float THR = 8.f;
    for (int kt = kt0; kt < kt1; ++kt) {
        const int cur = (kt - kt0) & 1; const bool more = (kt + 1 < kt1);
        if (more) AT_LOAD(kt + 1);
        LAS unsigned char* sb = lds + cur * AT_STAGE;
        f32x16 S0 = negm, S1 = negm;
        { LAS unsigned char* kp = sb + n * AT_KSTR + (c * 8 + gq) * 16;
#pragma unroll
          for (int s = 0; s < 4; ++s) {
              const bf16x8 a0 = *(LAS bf16x8*)(kp + s * 32), a1 = *(LAS bf16x8*)(kp + 32 * AT_KSTR + s * 32);
              S0 = __builtin_amdgcn_mfma_f32_32x32x16_bf16(a0, qf[s], S0, 0, 0, 0);
              S1 = __builtin_amdgcn_mfma_f32_32x32x16_bf16(a1, qf[s], S1, 0, 0, 0);
          } }
        float mx = fmaxf(S0[0], S1[0]);
#pragma unroll
        for (int r = 1; r < 16; ++r) mx = fmaxf(fmaxf(mx, S0[r]), S1[r]);
        { auto rr = __builtin_amdgcn_permlane32_swap(__builtin_bit_cast(unsigned, mx), __builtin_bit_cast(unsigned, mx), false, false);
          mx = fmaxf(__builtin_bit_cast(float, rr[0]), __builtin_bit_cast(float, rr[1])); }
        if (__builtin_amdgcn_ballot_w64(mx > THR) != 0ull) {
            const float delta = fmaxf(mx, 0.f), alpha = ex2(-delta);
            m_used += delta; l *= alpha;
#pragma unroll
            for (int r = 0; r < 16; ++r) { S0[r] -= delta; S1[r] -= delta; negm[r] -= delta; }
#pragma unroll
            for (int e = 0; e < 4; ++e) O[e] = O[e] * alpha;
        }
        float ps = 0.f;
#pragma unroll
        for (int r = 0; r < 16; ++r) { S0[r] = ex2(S0[r]); S1[r] = ex2(S1[r]); ps += S0[r] + S1[r]; }
        l += ps;
        LAS unsigned char* vp = sb + AT_KBYTES + n * AT_VSTR + gq * 8;
#pragma unroll
        for (int kb2 = 0; kb2 < 2; ++kb2)
#pragma unroll
            for (int s = 0; s < 2; ++s) {
                u32x4 pw;
                if (kb2 == 0) { pw.x = pk2(S0[8 * s + 0], S0[8 * s + 1]); pw.y = pk2(S0[8 * s + 2], S0[8 * s + 3]); pw.z = pk2(S0[8 * s + 4], S0[8 * s + 5]); pw.w = pk2(S0[8 * s + 6], S0[8 * s + 7]); }
                else          { pw.x = pk2(S1[8 * s + 0], S1[8 * s + 1]); pw.y = pk2(S1[8 * s + 2], S1[8 * s + 3]); pw.z = pk2(S1[8 * s + 4], S1[8 * s + 5]); pw.w = pk2(S1[8 * s + 6], S1[8 * s + 7]); }
                const bf16x8 pb = __builtin_bit_cast(bf16x8, pw);
#pragma unroll
                for (int e = 0; e < 4; ++e) {
                    const u32x2 lo = *(LAS u32x2*)(vp + e * 32 * AT_VSTR + kb2 * 64 + s * 32), hi = *(LAS u32x2*)(vp + e * 32 * AT_VSTR + kb2 * 64 + s * 32 + 16);
                    const bf16x8 a = __builtin_bit_cast(bf16x8, ((u32x4){lo.x, lo.y, hi.x, hi.y}));
                    O[e] = __builtin_amdgcn_mfma_f32_32x32x16_bf16(a, pb, O[e], 0, 0, 0);
                }
            }
        if (more) AT_STORE(cur ^ 1);
        __syncthreads();
    }
#undef AT_LOAD
#undef AT_STORE
    l += __shfl_xor(l, 32);
    const float inv = 1.f / l;
    LAS float* xch = (LAS float*)lds;
    if (c == 1) {
#pragma unroll
        for (int e = 0; e < 4; ++e)
#pragma unroll
            for (int r = 0; r < 16; ++r) xch[(g * 64 + e * 16 + r) * 64 + lane] = O[e][r] * inv;
    }
    __syncthreads();
    if (c == 0) {
        float ss = 0.f;
#pragma unroll
        for (int e = 0; e < 4; ++e)
#pragma unroll
            for (int r = 0; r < 16; ++r) { const float o = O[e][r] * inv - lam * xch[(g * 64 + e * 16 + r) * 64 + lane]; O[e][r] = o; ss += o * o; }
        ss += __shfl_xor(ss, 32);
        const float rs = post / sqrtf(ss * (1.f / 128.f) + EPS);
        bf16_t* op = oda + (size_t)(qrow0 + 32 * g + n) * 512 + h * 128;
#pragma unroll
        for (int e = 0; e < 4; ++e)
#pragma unroll
            for (int r4 = 0; r4 < 4; ++r4) {
                const int e0 = e * 32 + 8 * r4 + 4 * gq;
                const f32x4 gv = *(const f32x4*)(gain + e0);
                u32x2 w; w.x = pk2(O[e][4 * r4 + 0] * rs * gv[0], O[e][4 * r4 + 1] * rs * gv[1]); w.y = pk2(O[e][4 * r4 + 2] * rs * gv[2], O[e][4 * r4 + 3] * rs * gv[3]);
                *(u32x2*)(op + e0) = w;
            }
    }
    __syncthreads();
}

struct Args { const float* in[30]; float* out; unsigned char* ws; };
typedef const Args __attribute__((address_space(4))) Args_c;
__device__ __forceinline__ Args_c* kargs_ptr() { Args_c* p = (Args_c*)__builtin_amdgcn_kernarg_segment_ptr(); asm volatile("" : "+s"(p)); return p; }
#define GSYNC() cg::this_grid().sync()
#ifdef PROBE_A
#define TS(cat) do { if (blockIdx.x == 0 && threadIdx.x == 0) { unsigned long long* tsb = (unsigned long long*)(kargs_ptr()->ws + WS_END); const unsigned long long now = __builtin_amdgcn_s_memrealtime(); tsb[1 + (cat)] += now - tsb[0]; tsb[0] = now; } } while (0)
#else
#define TS(cat) do {} while (0)
#endif
#define KA() int tid = threadIdx.x; asm volatile("" : "+v"(tid)); int G = gridDim.x, bid = blockIdx.x; asm volatile("" : "+s"(G), "+s"(bid)); \
    const int lane = tid & 63, wave = __builtin_amdgcn_readfirstlane(tid >> 6), gw = bid * 8 + wave, ngw = G * 8, gtid = bid * NTHR + tid, ngt = G * NTHR; \
    (void)lane; (void)wave; (void)gw; (void)ngw; (void)gtid; (void)ngt; \
    Args_c* ka = kargs_ptr(); unsigned char* ws = ka->ws; (void)ws

__global__ void __launch_bounds__(NTHR, 2) fwd_kernel(Args a_unused) {
    extern __shared__ __attribute__((aligned(16))) unsigned char lds_raw[];
    LAS unsigned char* lds = (LAS unsigned char*)lds_raw;
#ifdef PROBE_A
    if (blockIdx.x == 0 && threadIdx.x == 0) { unsigned long long* tsb = (unsigned long long*)(kargs_ptr()->ws + WS_END); for (int i = 1; i < 32; ++i) tsb[i] = 0; tsb[0] = __builtin_amdgcn_s_memrealtime(); }
#endif

    {
        KA();
        bf16_t* WB = (bf16_t*)(ws + WS_WB);
        LAS float* scr = (LAS float*)(lds + wave * 8448);
        constexpr int IT_L = 12416;
        for (int it = gw; it < 2 * IT_L; it += ngw) {
            const int l = it / IT_L; int r = it % IT_L;
            bf16_t* Wl = WB + (size_t)l * WL_TOTAL;
            if (r < 1408) { transpose_item(ka->in[9] + (size_t)l * 1024 * DFF, 1024, DFF, Wl + WL_UP1, 1, scr, r, lane); continue; } r -= 1408;
            if (r < 1408) { transpose_item(ka->in[10] + (size_t)l * 1024 * DFF, 1024, DFF, Wl + WL_UP1, 2, scr, r, lane); continue; } r -= 1408;
            if (r < 1408) { transpose_item(ka->in[11] + (size_t)l * DFF * 1024, DFF, 1024, Wl + WL_DN1, 0, scr, r, lane); continue; } r -= 1408;
            if (r < 1408) { transpose_item(ka->in[12] + (size_t)l * 1024 * DFF, 1024, DFF, Wl + WL_UP2, 1, scr, r, lane); continue; } r -= 1408;
            if (r < 1408) { transpose_item(ka->in[13] + (size_t)l * 1024 * DFF, 1024, DFF, Wl + WL_UP2, 2, scr, r, lane); continue; } r -= 1408;
            if (r < 1408) { transpose_item(ka->in[14] + (size_t)l * DFF * 1024, DFF, 1024, Wl + WL_DN2, 0, scr, r, lane); continue; } r -= 1408;
            if (r < 3072) { transpose_item(ka->in[15] + (size_t)l * 1024 * 6144, 1024, 6144, Wl + WL_IN, 3, scr, r, lane); continue; } r -= 3072;
            if (r < 256) { transpose_item(ka->in[25] + (size_t)l * 512 * 1024, 512, 1024, Wl + WL_PA, 0, scr, r, lane); continue; } r -= 256;
            if (r < 128) { transpose_item(ka->in[26] + (size_t)l * 256 * 1024, 256, 1024, Wl + WL_PH, 0, scr, r, lane); continue; } r -= 128;
            transpose_item(ka->in[28] + (size_t)l * 1024 * 1024, 1024, 1024, Wl + WL_O, 0, scr, r, lane);
        }
        __syncthreads();
    }
    {
        KA();
        float* MOD = (float*)(ws + WS_MOD);
        LAS float* sv = (LAS float*)lds;
        LAS float* part = (LAS float*)(lds + 12288);
        for (int i = tid; i < 3072; i += NTHR) { const int seg = i >> 10, k = i & 1023; const float x = (seg < 2) ? ka->in[1][seg * 1024 + k] : ka->in[3][k]; sv[i] = x / (1.f + __expf(-x)); }
        __syncthreads();
        for (int item = bid; item < 288; item += G) {
            const int l = item / 144, col = (item % 144) * 64 + lane;
            const float* W = ka->in[4] + (size_t)l * 1024 * 9216 + col;
            float a0 = 0.f, a1 = 0.f, a2 = 0.f;
            for (int k = wave * 128; k < wave * 128 + 128; ++k) { const float w = W[(size_t)k * 9216]; a0 = __builtin_fmaf(sv[k], w, a0); a1 = __builtin_fmaf(sv[1024 + k], w, a1); a2 = __builtin_fmaf(sv[2048 + k], w, a2); }
            part[(wave * 3 + 0) * 64 + lane] = a0; part[(wave * 3 + 1) * 64 + lane] = a1; part[(wave * 3 + 2) * 64 + lane] = a2;
            __syncthreads();
            if (tid < 192) { const int seg = tid >> 6, cl = tid & 63; float s = 0.f;
#pragma unroll
                for (int w = 0; w < 8; ++w) s += part[(w * 3 + seg) * 64 + cl];
                const int cc = (item % 144) * 64 + cl;
                MOD[(size_t)(l * 3 + seg) * 9216 + cc] = s + ka->in[5][l * 9216 + cc]; }
            __syncthreads();
        }
    }
    {
        KA();
        bf16_t* WB = (bf16_t*)(ws + WS_WB); float* CS = (float*)(ws + WS_CS); float* LBT = (float*)(ws + WS_LB); float* LAMV = (float*)(ws + WS_LAM);
        for (int idx = gtid; idx < 2 * 256 * 1024; idx += ngt) {
            const int n = idx & 1023, k = (idx >> 10) & 255, l = idx >> 18, g = k >> 6, c = k & 63;
            const float* pw = ka->in[23] + (size_t)l * 4 * 64 * 64 + (g * 64 + c) * 64;
            const float* psc = ka->in[24] + l * 256 + g * 64;
            const float* wp = ka->in[27] + (size_t)l * 256 * 1024 + (size_t)(g * 64) * 1024 + n;
            float s = 0.f;
            for (int d = 0; d < 64; ++d) s = __builtin_fmaf(pw[d] * psc[d], wp[(size_t)d * 1024], s);
            (WB + (size_t)l * WL_TOTAL + WL_PP)[(size_t)n * 256 + k] = (bf16_t)(pk2(s, 0.f) & 0xffffu);
        }
        for (int idx = gtid; idx < 4096; idx += ngt) {
            const int n = idx >> 4, j = idx & 15;
            const float invf = __builtin_exp2f(-(float)j * (13.287712379549449f / 16.f));
            const float ang = (float)n * invf;
            const double rev = (double)ang * 0.15915494309189535; const float fr = (float)(rev - __builtin_floor(rev));
            CS[n * 32 + j] = __builtin_amdgcn_cosf(fr); CS[n * 32 + 16 + j] = __builtin_amdgcn_sinf(fr);
        }
        for (int idx = gtid; idx < 1024; idx += ngt) {
            const int l = idx >> 9, dc = idx & 511;
            const float l0 = ka->in[21][dc], l1 = ka->in[21][512 + dc];
            LBT[idx] = (l == 0) ? 0.f : 1.f / (1.f + __expf(l0 - l1));
        }
        if (gtid < 2) {
            const int l = gtid; float s1 = 0.f, s2 = 0.f;
            for (int i = 0; i < 64; ++i) { s1 += ka->in[16][l * 64 + i] * ka->in[17][l * 64 + i]; s2 += ka->in[18][l * 64 + i] * ka->in[19][l * 64 + i]; }
            const float li = (l == 0) ? 0.2f : (0.8f - 0.6f * 0.7408182206817179f);
            LAMV[l * 2 + 0] = __expf(s1) - __expf(s2) + li; LAMV[l * 2 + 1] = 1.f - li;
        }
    }
    GSYNC();
    TS(0);

#pragma unroll 1
    for (int l = 0; l < 2; ++l) {
#pragma unroll 1
        for (int f = 0; f < 2; ++f) {
            {   KA(); const bool first = (l == 0 && f == 0);
                const float* in_lat = first ? ka->in[0] : ka->out; const float* in_ctx = first ? ka->in[2] : (const float*)(ws + WS_HC);
                norm_phase(in_lat, in_ctx, ka->in[f ? 8 : 6] + l * 1024, (const float*)(ws + WS_MOD) + (size_t)l * 3 * 9216, f ? 6 : 0, f ? 7 : 1, (bf16_t*)(ws + WS_XB), gw, ngw, lane); }
            GSYNC();
            TS(1);
            {   KA(); bf16_t* Wl = (bf16_t*)(ws + WS_WB) + (size_t)l * WL_TOTAL;
                pg8::Gemm g{(bf16_t*)(ws + WS_XB), Wl + (f ? WL_UP2 : WL_UP1), R, 5632, 1024}; pg8::StaticOrder S; S.init(R, 5632, G, bid); EpiUp E{(bf16_t*)(ws + WS_Z)};
                pg8::gemm_phase<EpiUp, pg8::StaticOrder, true, true>(lds, g, S, E); }
            GSYNC();
            TS(2);
            {   KA(); bf16_t* Wl = (bf16_t*)(ws + WS_WB) + (size_t)l * WL_TOTAL; const bool first = (l == 0 && f == 0);
                const float* in_lat = first ? ka->in[0] : ka->out; const float* in_ctx = first ? ka->in[2] : (const float*)(ws + WS_HC);
                pg8::Gemm g{(bf16_t*)(ws + WS_Z), Wl + (f ? WL_DN2 : WL_DN1), R, 1024, DFF}; pg8::StaticOrder S; S.init(R, 1024, G, bid);
                EpiRes E{in_lat, in_ctx, ka->out, (float*)(ws + WS_HC), (const float*)(ws + WS_MOD) + (size_t)l * 3 * 9216 + (f ? 8 : 2) * 1024, 0.5f};
                pg8::gemm_phase<EpiRes, pg8::StaticOrder, true, true>(lds, g, S, E); }
            GSYNC();
            TS(3);
            if (f == 1) break;
            {   KA();
                norm_phase(ka->out, (const float*)(ws + WS_HC), ka->in[7] + l * 1024, (const float*)(ws + WS_MOD) + (size_t)l * 3 * 9216, 3, 4, (bf16_t*)(ws + WS_XB), gw, ngw, lane); }
            GSYNC();
            TS(1);
#pragma unroll 1
            for (int part = 0; part < 2; ++part) {
                KA(); bf16_t* Wl = (bf16_t*)(ws + WS_WB) + (size_t)l * WL_TOTAL;
                pg8::Gemm g{(bf16_t*)(ws + WS_XB), Wl + WL_IN + (size_t)(part ? 1536 : 0) * 1024, R, part ? 1536 : 1024, 1024}; pg8::StaticOrder S; S.init(R, part ? 1536 : 1024, G, bid);
                EpiWin E{ws + WS_Z, (const float*)(ws + WS_CS), (const float*)(ws + WS_LB) + l * 512, part ? 6 : 0};
                pg8::gemm_phase<EpiWin, pg8::StaticOrder, true, true>(lds, g, S, E);
            }
            {   KA(); bf16_t* Wl = (bf16_t*)(ws + WS_WB) + (size_t)l * WL_TOTAL;
                pg8::Gemm g{Wl + WL_IN + (size_t)1024 * 1024, (bf16_t*)(ws + WS_XB), 512, R, 1024}; pg8::StaticOrder S; S.init(512, R, G, bid); EpiVT E{(bf16_t*)(ws + WS_Z + Z_VT)};
                pg8::gemm_phase<EpiVT, pg8::StaticOrder, true, true>(lds, g, S, E); }
            GSYNC();
            TS(4);
            {   KA(); pool_phase((const bf16_t*)(ws + WS_Z + Z_ZP), (bf16_t*)(ws + WS_O + O_MX), gtid, ngt); }
#ifdef REP_ATTN
            for (int rep_ = 0; rep_ < 2; ++rep_)
#endif
            {   KA();
                const float* LAMV = (const float*)(ws + WS_LAM);
                const float lam = LAMV[l * 2], post = LAMV[l * 2 + 1];
                const int nunits = 1024 + (l == 0 ? 16 : 0);
                for (int u = bid; u < nunits; u += G) {
                    int bh, qrow0, kt0, kt1;
                    if (u < 1024) { bh = u >> 7; qrow0 = (bh >> 2) * SEQ + (u & 127) * 128; kt0 = 0; kt1 = KEYS / 64; }
                    else { const int v = u - 1024; bh = v >> 1; qrow0 = NLAT + (bh >> 2) * CTXL + (v & 1) * 128; kt0 = SEQ / 64; kt1 = KEYS / 64; }
                    attn_unit(lds, (const bf16_t*)(ws + WS_Z + Z_Q), (const bf16_t*)(ws + WS_Z + Z_K), (const bf16_t*)(ws + WS_Z + Z_VT), (bf16_t*)(ws + WS_O + O_DA), ka->in[20] + l * 128,
                              bh >> 2, bh & 3, qrow0, kt0, kt1, lam, post, tid, wave, lane);
                }
            }
            GSYNC();
            TS(5);
#ifdef REP_HG
#pragma unroll 1
            for (int rep_ = 0; rep_ < 2; ++rep_) {
#else
            {
#endif
            {   KA(); hg_pass<false>((const float*)(ws + WS_Z + Z_HQ), (const float*)(ws + WS_Z + Z_FF), (const float*)(ws + WS_Z + Z_FB), (const bf16_t*)(ws + WS_Z + Z_HI),
                                     (float*)(ws + WS_CAR), (float*)(ws + WS_DK), (bf16_t*)(ws + WS_Z + Z_K), wave, lane, G); }
            GSYNC();
            TS(6);
            {   KA(); hg_carry((float*)(ws + WS_CAR), (const float*)(ws + WS_DK), gtid, ngt); }
            GSYNC();
            TS(7);
            {   KA(); hg_pass<true>((const float*)(ws + WS_Z + Z_HQ), (const float*)(ws + WS_Z + Z_FF), (const float*)(ws + WS_Z + Z_FB), (const bf16_t*)(ws + WS_Z + Z_HI),
                                    (float*)(ws + WS_CAR), (float*)(ws + WS_DK), (bf16_t*)(ws + WS_Z + Z_K), wave, lane, G); }
            GSYNC();
            TS(8);
            {   KA(); hg_readout((const bf16_t*)(ws + WS_Z + Z_K), (const bf16_t*)(ws + WS_Z + Z_HG), ka->in[22] + l * 64, (bf16_t*)(ws + WS_O + O_HG), gw, ngw, lane); }
            GSYNC();
            TS(9);
            }
            {   KA(); bf16_t* Wl = (bf16_t*)(ws + WS_WB) + (size_t)l * WL_TOTAL;
                pg8::Gemm g{(bf16_t*)(ws + WS_XB), Wl + WL_IN + (size_t)3072 * 1024, R, 3072, 1024}; pg8::StaticOrder S; S.init(R, 3072, G, bid); EpiG E{(bf16_t*)(ws + WS_Z)};
                pg8::gemm_phase<EpiG, pg8::StaticOrder, true, true>(lds, g, S, E); }
            GSYNC();
            TS(10);
#pragma unroll 1
            for (int gi = 0; gi < 3; ++gi) {
                KA(); bf16_t* Wl = (bf16_t*)(ws + WS_WB) + (size_t)l * WL_TOTAL;
                const bf16_t* A = (const bf16_t*)(ws + WS_O + ((gi == 0) ? O_DA : (gi == 1 ? O_HG : O_MX))); const int K = (gi == 0) ? 512 : 256;
                const bf16_t* Bt = Wl + ((gi == 0) ? WL_PA : (gi == 1 ? WL_PH : WL_PP));
                pg8::Gemm g{A, Bt, R, 1024, K}; pg8::StaticOrder S; S.init(R, 1024, G, bid); EpiProj E{(bf16_t*)(ws + WS_XB), (const bf16_t*)(ws + WS_Z), gi, gi == 0};
                pg8::gemm_phase<EpiProj, pg8::StaticOrder, true, true>(lds, g, S, E);
            }
            GSYNC();
            TS(11);
            {   KA(); bf16_t* Wl = (bf16_t*)(ws + WS_WB) + (size_t)l * WL_TOTAL;
                pg8::Gemm g{(bf16_t*)(ws + WS_XB), Wl + WL_O, R, 1024, 1024}; pg8::StaticOrder S; S.init(R, 1024, G, bid);
                EpiRes E{ka->out, (const float*)(ws + WS_HC), ka->out, (float*)(ws + WS_HC), (const float*)(ws + WS_MOD) + (size_t)l * 3 * 9216 + 5 * 1024, 1.0f};
                pg8::gemm_phase<EpiRes, pg8::StaticOrder, true, true>(lds, g, S, E); }
            GSYNC();
            TS(12);
        }
    }
    {   KA(); final_norm_phase(ka->out, ka->in[29], gw, ngw, lane); }
#ifdef PROBE_A
    GSYNC(); TS(1);
    if (blockIdx.x == 0) { KA(); const unsigned long long* tsb = (const unsigned long long*)(ws + WS_END);
        __syncthreads();
        const float va = (float)tsb[1 + PROBE_A] * 0.01f, vb = (float)tsb[1 + PROBE_B] * 0.01f;
        __syncthreads();
        if (tid == 0) ka->out[0] += va;
        for (int i = tid; i < 65536; i += NTHR) ka->out[(size_t)(i / 1024 + 8) * 1024 + (i & 1023)] += vb; }
#endif
}

extern "C" void kernel_launch(void* const* d_in, const int* in_sizes, int n_in, void* d_out, int out_size, void* d_ws, size_t ws_size, hipStream_t stream) {
    static int grid = 0;
    if (grid == 0) {
        if (n_in != 30 || out_size != NLAT * DM || ws_size < WS_END) { fprintf(stderr, "kernel_launch: unexpected shapes (n_in %d out %d ws %zu need %zu)\n", n_in, out_size, ws_size, (size_t)WS_END); grid = -1; return; }
        int dev = 0, cus = 0, per_cu = 0;
        (void)hipGetDevice(&dev);
        (void)hipDeviceGetAttribute(&cus, hipDeviceAttributeMultiprocessorCount, dev);
        if (hipFuncSetAttribute((const void*)fwd_kernel, hipFuncAttributeMaxDynamicSharedMemorySize, LDS_BYTES) != hipSuccess) { fprintf(stderr, "kernel_launch: hipFuncSetAttribute failed\n"); grid = -1; return; }
        if (hipOccupancyMaxActiveBlocksPerMultiprocessor(&per_cu, (const void*)fwd_kernel, NTHR, LDS_BYTES) != hipSuccess || per_cu < 1) { fprintf(stderr, "kernel_launch: occupancy query failed (%d)\n", per_cu); (void)hipGetLastError(); per_cu = 1; }
        if (per_cu > 1) per_cu = 1;
        grid = cus * per_cu;
    }
    if (grid < 0) return;
    Args a{};
    for (int i = 0; i < 30; ++i) a.in[i] = (const float*)d_in[i];
    a.out = (float*)d_out; a.ws = (unsigned char*)d_ws;
    void* args[] = {&a};
    hipError_t e = hipLaunchCooperativeKernel((const void*)fwd_kernel, dim3(grid), dim3(NTHR), args, LDS_BYTES, stream);
    if (e != hipSuccess) fprintf(stderr, "cooperative launch failed: %s (grid %d)\n", hipGetErrorString(e), grid);
}
```

```cpp
#include <hip/hip_runtime.h>
#include <hip/hip_cooperative_groups.h>
#include <cstdio>
#include <cstdint>
namespace cg = cooperative_groups;
namespace pg8 {
#define PG8_LAS __attribute__((address_space(3)))
typedef unsigned short bf16_t;
typedef short bf16x8 __attribute__((ext_vector_type(8)));
typedef float f32x4 __attribute__((ext_vector_type(4)));
typedef unsigned u32x4 __attribute__((ext_vector_type(4)));
constexpr int BM = 256, BK = 64, HALF = 128, HTB = HALF * BK * 2  , STAGE_BYTES = 8 * HTB, NXCD = 8, WGM = 8;

__host__ __device__ __forceinline__ int lds_byte(int r, int c) { const int st = (r >> 4) * 2 + (c >> 5), rr = r & 15, cc = c & 31, ob = rr * 64 + cc * 2; return st * 1024 + (ob ^ (((ob >> 9) & 1) << 5)); }
__host__ __device__ __forceinline__ void stage_rc(int b, int& R, int& C) { const int st = b / 1024, sb = b % 1024, swz = sb ^ (((sb >> 9) & 1) << 5); R = (st >> 1) * 16 + swz / 64; C = (st & 1) * 32 + (swz % 64) / 2; }
__host__ __device__ __forceinline__ int perm32(int rho) { const int n = rho >> 4, i = rho & 15; return 8 * (i >> 2) + 4 * n + (i & 3); }

struct Unit { int pm, pn; };
struct Gemm { const bf16_t* A; const bf16_t* Bt; int M, N, K; };

struct StaticOrder {
    int nM, nN, nwg, G, c;
    __host__ __device__ void init(int M, int N, int G_, int c_) { nM = M / BM; nN = N / BM; nwg = nM * nN; G = G_; c = c_; }
    __host__ __device__ bool next(int i, Unit& u) const {
        const long L = (long)i * G + c; if (L >= nwg) return false;
        int wgid = (int)L; { const int q = nwg / NXCD, r = nwg % NXCD, xcd = wgid % NXCD, off = wgid / NXCD; wgid = (xcd < r ? xcd * (q + 1) : r * (q + 1) + (xcd - r) * q) + off; }
        const int nig = WGM * nN, gid = wgid / nig, fm = gid * WGM, gsz = (nM - fm) < WGM ? (nM - fm) : WGM;
        u.pm = fm + ((wgid % nig) % gsz); u.pn = (wgid % nig) / gsz; return true;
    }
    __device__ __forceinline__ void a_ready(const Unit&) const {}
    __device__ __forceinline__ void done(const Unit&) const {}
};

}
namespace pg8 {
template <class Epi, class Sched, bool ALIGN_EPI = false, bool SP2 = false>
__device__ __forceinline__ void gemm_phase(PG8_LAS unsigned char* lds, const Gemm g, const Sched& S, const Epi& E) {
    int tid_ = threadIdx.x; asm volatile("" : "+v"(tid_)); const int tid = tid_, wid = __builtin_amdgcn_readfirstlane(tid >> 6), lane = tid & 63, wr = wid >> 2, wc = wid & 3, fr = lane & 15, fq = lane >> 4;
    const int K = g.K, nt = K / BK;
    unsigned voffA[2], voffB[2];
#pragma unroll
    for (int i = 0; i < 2; ++i) { int R, C; stage_rc(tid * 16 + i * 8192, R, C); const int Rb = Epi::PERM ? ((R & ~31) + perm32(R & 31)) : R;
        voffA[i] = (unsigned)(R * K + C) * 2u; voffB[i] = (unsigned)(Rb * K + C) * 2u; }
    const size_t kstep = (size_t)(BK * 2);
    const size_t hstep = (size_t)HALF * K * 2;
    const size_t tstep = 2 * hstep;
    const unsigned ldsw = (unsigned)wid * 1024u;
    const int aoff = lds_byte(wr * 64 + fr, fq * 8), boff = lds_byte(wc * 32 + fr, fq * 8);
#define PG8_SA(b, h) (((b) * 2 + (h)) * HTB)
#define PG8_SB(b, h) ((4 + (b) * 2 + (h)) * HTB)
#define PG8_STAGE(bufoff, gbase, voff) do { _Pragma("unroll") for (int _i = 0; _i < 2; ++_i) \
        __builtin_amdgcn_global_load_lds((const unsigned*)((const char*)(gbase) + (voff)[_i]), (PG8_LAS unsigned*)(lds + (bufoff) + ldsw + _i * 8192), 16, 0, 0); } while (0)
#define PG8_LDA(dst, b, h) do { _Pragma("unroll") for (int m = 0; m < 4; ++m) _Pragma("unroll") for (int k = 0; k < 2; ++k) dst[m][k] = *(const PG8_LAS bf16x8*)(lds + PG8_SA(b, h) + aoff + m * 2048 + k * 1024); } while (0)
#define PG8_LDB(dst, b, h) do { _Pragma("unroll") for (int n = 0; n < 2; ++n) _Pragma("unroll") for (int k = 0; k < 2; ++k) dst[n][k] = *(const PG8_LAS bf16x8*)(lds + PG8_SB(b, h) + boff + n * 2048 + k * 1024); } while (0)
#define PG8_MMA(ai, bj, At, Bt) do { __builtin_amdgcn_s_setprio(1); _Pragma("unroll") for (int m = 0; m < 4; ++m) _Pragma("unroll") for (int n = 0; n < 2; ++n) _Pragma("unroll") for (int k = 0; k < 2; ++k) \
        acc[ai][bj][m][n] = __builtin_amdgcn_mfma_f32_16x16x32_bf16(Bt[n][k], At[m][k], acc[ai][bj][m][n], 0, 0, 0); __builtin_amdgcn_s_setprio(0); } while (0)
#define PG8_WAIT_V(n) asm volatile("s_waitcnt vmcnt(" #n ")" ::: "memory")
#define PG8_WAIT_L(n) asm volatile("s_waitcnt lgkmcnt(" #n ")" ::: "memory")
#define PG8_BAR __builtin_amdgcn_s_barrier()
#define PG8_SCHED __builtin_amdgcn_sched_barrier(0)
    Unit cur, nxt; int ui = 0;
    if (!S.next(0, cur)) return;
    f32x4 acc[2][2][4][2];
#pragma unroll
    for (int a = 0; a < 2; ++a)
#pragma unroll
        for (int b = 0; b < 2; ++b)
#pragma unroll
            for (int m = 0; m < 4; ++m)
#pragma unroll
                for (int n = 0; n < 2; ++n) acc[a][b][m][n] = (f32x4){0.f, 0.f, 0.f, 0.f};
    bf16x8 At[4][2], B0[2][2], B1[2][2];
    const char* cA = (const char*)g.A + (size_t)cur.pm * tstep; const char* cB = (const char*)g.Bt + (size_t)cur.pn * tstep;
    S.a_ready(cur);
    if constexpr (SP2) {
        PG8_STAGE(PG8_SB(0, 0), cB, voffB); PG8_STAGE(PG8_SB(0, 1), cB + hstep, voffB); PG8_STAGE(PG8_SA(0, 0), cA, voffA); PG8_STAGE(PG8_SA(0, 1), cA + hstep, voffA);
        if (wr == 1) PG8_BAR;
        PG8_WAIT_V(2); PG8_BAR;
        PG8_STAGE(PG8_SB(1, 0), cB + kstep, voffB); PG8_STAGE(PG8_SA(1, 0), cA + kstep, voffA); PG8_STAGE(PG8_SB(1, 1), cB + hstep + kstep, voffB);
        PG8_WAIT_V(6); PG8_BAR;
    } else {
        PG8_STAGE(PG8_SB(0, 0), cB, voffB); PG8_STAGE(PG8_SA(0, 0), cA, voffA); PG8_STAGE(PG8_SB(0, 1), cB + hstep, voffB); PG8_STAGE(PG8_SA(0, 1), cA + hstep, voffA);
        if (wr == 1) PG8_BAR;
        PG8_WAIT_V(4); PG8_BAR;
        PG8_STAGE(PG8_SB(1, 0), cB + kstep, voffB); PG8_STAGE(PG8_SA(1, 0), cA + kstep, voffA); PG8_STAGE(PG8_SB(1, 1), cB + hstep + kstep, voffB);
        PG8_WAIT_V(6); PG8_BAR;
    }
    for (;;) {
        const bool has_next = S.next(ui + 1, nxt);
        const char* nA = has_next ? (const char*)g.A + (size_t)nxt.pm * tstep : cA; const char* nB = has_next ? (const char*)g.Bt + (size_t)nxt.pn * tstep : cB;
        for (int t = 0; t < nt; t += 2) {
            const bool last = (t == nt - 2);
            const char* a1 = cA + (size_t)(t + 1) * kstep;
            const char* a2 = last ? nA : cA + (size_t)(t + 2) * kstep; const char* b2 = last ? nB : cB + (size_t)(t + 2) * kstep;
            const char* a3 = a2 + kstep; const char* b3 = b2 + kstep;
            if (last && has_next) S.a_ready(nxt);
            if constexpr (SP2) {
            PG8_LDB(B0, 0, 0); PG8_LDB(B1, 0, 1); PG8_SCHED; PG8_LDA(At, 0, 0); PG8_STAGE(PG8_SA(1, 1), a1 + hstep, voffA);
            PG8_WAIT_V(8); PG8_WAIT_L(0); PG8_BAR; PG8_MMA(0, 0, At, B0); PG8_MMA(0, 1, At, B1); PG8_BAR; PG8_SCHED;
            PG8_LDA(At, 0, 1); PG8_STAGE(PG8_SB(0, 0), b2, voffB); PG8_STAGE(PG8_SB(0, 1), b2 + hstep, voffB); PG8_STAGE(PG8_SA(0, 0), a2, voffA);
            PG8_WAIT_V(8); PG8_WAIT_L(0); PG8_BAR; PG8_MMA(1, 0, At, B0); PG8_MMA(1, 1, At, B1); PG8_BAR; PG8_SCHED;
            PG8_LDB(B0, 1, 0); PG8_LDB(B1, 1, 1); PG8_SCHED; PG8_LDA(At, 1, 0); PG8_STAGE(PG8_SA(0, 1), a2 + hstep, voffA);
            PG8_WAIT_V(8); PG8_WAIT_L(0); PG8_BAR; PG8_MMA(0, 0, At, B0); PG8_MMA(0, 1, At, B1); PG8_BAR; PG8_SCHED;
            PG8_LDA(At, 1, 1); PG8_STAGE(PG8_SB(1, 0), b3, voffB); PG8_STAGE(PG8_SB(1, 1), b3 + hstep, voffB); PG8_STAGE(PG8_SA(1, 0), a3, voffA);
            PG8_WAIT_V(8); PG8_WAIT_L(0); PG8_BAR; PG8_MMA(1, 0, At, B0); PG8_MMA(1, 1, At, B1); PG8_BAR; PG8_SCHED;
            } else {
            PG8_LDB(B0, 0, 0); PG8_SCHED; PG8_LDA(At, 0, 0); PG8_STAGE(PG8_SA(1, 1), a1 + hstep, voffA);
            PG8_WAIT_L(8); PG8_BAR; PG8_WAIT_L(0); PG8_MMA(0, 0, At, B0); PG8_BAR; PG8_SCHED;
            PG8_LDB(B1, 0, 1); PG8_STAGE(PG8_SB(0, 0), b2, voffB);
            PG8_BAR; PG8_WAIT_L(0); PG8_MMA(0, 1, At, B1); PG8_BAR;
            PG8_LDA(At, 0, 1); PG8_STAGE(PG8_SA(0, 0), a2, voffA);
            PG8_BAR; PG8_WAIT_L(0); PG8_MMA(1, 0, At, B0); PG8_BAR; PG8_SCHED;
            PG8_STAGE(PG8_SB(0, 1), b2 + hstep, voffB);
            PG8_WAIT_V(6); PG8_BAR; PG8_MMA(1, 1, At, B1); PG8_BAR;
            PG8_LDB(B0, 1, 0); PG8_SCHED; PG8_LDA(At, 1, 0); PG8_STAGE(PG8_SA(0, 1), a2 + hstep, voffA);
            PG8_WAIT_L(8); PG8_BAR; PG8_WAIT_L(0); PG8_MMA(0, 0, At, B0); PG8_BAR; PG8_SCHED;
            PG8_LDB(B1, 1, 1); PG8_STAGE(PG8_SB(1, 0), b3, voffB);
            PG8_BAR; PG8_WAIT_L(0); PG8_MMA(0, 1, At, B1); PG8_BAR;
            PG8_LDA(At, 1, 1); PG8_STAGE(PG8_SA(1, 0), a3, voffA);
            PG8_BAR; PG8_WAIT_L(0); PG8_MMA(1, 0, At, B0); PG8_BAR; PG8_SCHED;
            PG8_STAGE(PG8_SB(1, 1), b3 + hstep, voffB);
            PG8_WAIT_V(6); PG8_BAR; PG8_MMA(1, 1, At, B1); PG8_BAR;
            }
        }
        if constexpr (ALIGN_EPI) { if (wr == 0) PG8_BAR; }
        if constexpr (!Epi::AFTER_DRAIN) { E(acc, cur, wr, wc, fr, fq); S.done(cur); }
        if (!has_next) break;
#pragma unroll
        for (int a = 0; a < 2; ++a)
#pragma unroll
            for (int b = 0; b < 2; ++b)
#pragma unroll
                for (int m = 0; m < 4; ++m)
#pragma unroll
                    for (int n = 0; n < 2; ++n) acc[a][b][m][n] = (f32x4){0.f, 0.f, 0.f, 0.f};
        cur = nxt; cA = nA; cB = nB; ++ui;
        if constexpr (ALIGN_EPI) { if (wr == 1) PG8_BAR; }
    }
    PG8_WAIT_V(0);
    if constexpr (!ALIGN_EPI) { if (wr == 0) PG8_BAR; }
    PG8_BAR;
    if constexpr (Epi::AFTER_DRAIN) { E.fused(acc, cur, wr, wc, fr, fq, lds, wid, lane); S.done(cur); }
#undef PG8_SA
#undef PG8_SB
#undef PG8_STAGE
#undef PG8_LDA
#undef PG8_LDB
#undef PG8_MMA
#undef PG8_WAIT_V
#undef PG8_WAIT_L
#undef PG8_BAR
#undef PG8_SCHED
}
}

using pg8::bf16_t; using pg8::bf16x8; using pg8::f32x4; using pg8::u32x4; using pg8::Unit;
typedef float f32x16 __attribute__((ext_vector_type(16)));
typedef float f32x2v __attribute__((ext_vector_type(2)));
typedef __bf16 bf16x2v __attribute__((ext_vector_type(2)));
typedef unsigned u32x2 __attribute__((ext_vector_type(2)));
#define LAS __attribute__((address_space(3)))

constexpr int DM = 1024, NBATCH = 2, SEQ = 16384, CTXL = 256;
constexpr int NLAT = NBATCH * SEQ, NCTX = NBATCH * CTXL, R = NLAT + NCTX;
constexpr int DFF = 2816, KEYS = SEQ + CTXL;
constexpr float EPS = 1e-6f;
constexpr float C2 = 0.125f * 1.4426950408889634f;
constexpr int NTHR = 512;
constexpr int LDS_BYTES = 135168;
constexpr int HG_SEG = 128, HG_STEPS = KEYS / HG_SEG;

constexpr size_t WL_UP1 = 0, WL_DN1 = WL_UP1 + (size_t)5632 * 1024, WL_UP2 = WL_DN1 + (size_t)1024 * 2816, WL_DN2 = WL_UP2 + (size_t)5632 * 1024,
                 WL_IN = WL_DN2 + (size_t)1024 * 2816, WL_PA = WL_IN + (size_t)6144 * 1024, WL_PH = WL_PA + (size_t)1024 * 512, WL_PP = WL_PH + (size_t)1024 * 256,
                 WL_O = WL_PP + (size_t)1024 * 256, WL_TOTAL = WL_O + (size_t)1024 * 1024;
constexpr size_t WS_WB = 0;
constexpr size_t WS_XB = WS_WB + 2 * WL_TOTAL * 2;
constexpr size_t WS_Z = WS_XB + (size_t)R * 1024 * 2;
constexpr size_t Z_VT = 0, Z_HQ = Z_VT + (size_t)R * 512 * 2, Z_FF = Z_HQ + (size_t)R * 256 * 4, Z_FB = Z_FF + (size_t)R * 256 * 4, Z_HI = Z_FB + (size_t)R * 256 * 4,
                 Z_ZP = Z_HI + (size_t)R * 256 * 2, Z_Q = Z_ZP + (size_t)R * 256 * 2, Z_K = Z_Q + (size_t)R * 512 * 2, Z_HG = Z_K + (size_t)R * 512 * 2, Z_END = Z_HG + (size_t)R * 256 * 2;
static_assert((size_t)R * 3072 * 2 <= Z_K, "gate buffer must not reach k / odir / hgate");
static_assert((size_t)R * DFF * 2 <= Z_END, "act fits Z");
constexpr size_t WS_O = WS_Z + Z_END;
constexpr size_t O_DA = 0, O_HG = O_DA + (size_t)R * 512 * 2, O_MX = O_HG + (size_t)R * 256 * 2, O_END = O_MX + (size_t)R * 256 * 2;
constexpr size_t WS_CAR = WS_O + O_END;
constexpr size_t WS_DK = WS_CAR + (size_t)16 * HG_SEG * 4096 * 4;
constexpr size_t WS_HC = WS_DK + (size_t)16 * HG_SEG * 64 * 4;
constexpr size_t WS_MOD = WS_HC + (size_t)NCTX * 1024 * 4;
constexpr size_t WS_CS = WS_MOD + (size_t)2 * 3 * 9216 * 4;
constexpr size_t WS_LB = WS_CS + (size_t)256 * 32 * 4;
constexpr size_t WS_LAM = WS_LB + (size_t)2 * 2 * 256 * 4;
constexpr size_t WS_END = WS_LAM + 256;
static_assert(WS_END <= (size_t)512 * 1024 * 1024, "workspace");

__device__ __forceinline__ unsigned pk2(float lo, float hi) { f32x2v v = {lo, hi}; bf16x2v b = __builtin_convertvector(v, bf16x2v); return __builtin_bit_cast(unsigned, b); }
__device__ __forceinline__ float bf2f(unsigned short u) { return __builtin_bit_cast(float, (unsigned)u << 16); }
__device__ __forceinline__ float bflo(unsigned u) { return __builtin_bit_cast(float, u << 16); }
__device__ __forceinline__ float bfhi(unsigned u) { return __builtin_bit_cast(float, u & 0xffff0000u); }
__device__ __forceinline__ float ex2(float x) { return __builtin_amdgcn_exp2f(x); }
__device__ __forceinline__ float rcpf_(float x) { return __builtin_amdgcn_rcpf(x); }
__device__ __forceinline__ float sigm(float x) { return rcpf_(1.f + ex2(-1.4426950408889634f * x)); }
__device__ __forceinline__ float siluf(float x) { return x * sigm(x); }
__device__ __forceinline__ float shx(float v, int o, int lane) { return __builtin_bit_cast(float, __builtin_amdgcn_ds_bpermute((lane ^ o) << 2, __builtin_bit_cast(int, v))); }
__device__ __forceinline__ float swap32(float v) { auto rr = __builtin_amdgcn_permlane32_swap(__builtin_bit_cast(unsigned, v), __builtin_bit_cast(unsigned, v), false, false);
    const float a = __builtin_bit_cast(float, rr[0]), b = __builtin_bit_cast(float, rr[1]); return (a == v) ? b : a; }
__device__ __forceinline__ float wave_sum(float v, int lane) {
#pragma unroll
    for (int o = 1; o < 64; o <<= 1) v += shx(v, o, lane);
    return v;
}
#define LDS_WAIT() asm volatile("s_waitcnt lgkmcnt(0)" ::: "memory")

struct EpiUp {
    static constexpr bool PERM = true, AFTER_DRAIN = false;
    bf16_t* act;
    __device__ __forceinline__ void operator()(const f32x4 (&acc)[2][2][4][2], const Unit& u, int wr, int wc, int fr, int fq) const {
        const int row0 = u.pm * 256 + wr * 64 + fr, col0 = u.pn * 128 + wc * 32 + 8 * fq;
#pragma unroll
        for (int ai = 0; ai < 2; ++ai)
#pragma unroll
            for (int m = 0; m < 4; ++m) {
                const int row = row0 + ai * 128 + m * 16;
                const f32x4 a0 = acc[ai][0][m][0], a1 = acc[ai][0][m][1], b0 = acc[ai][1][m][0], b1 = acc[ai][1][m][1];
                u32x4 w;
                w.x = pk2(siluf(a0[0]) * b0[0], siluf(a0[1]) * b0[1]); w.y = pk2(siluf(a0[2]) * b0[2], siluf(a0[3]) * b0[3]);
                w.z = pk2(siluf(a1[0]) * b1[0], siluf(a1[1]) * b1[1]); w.w = pk2(siluf(a1[2]) * b1[2], siluf(a1[3]) * b1[3]);
                *(u32x4*)(act + (size_t)row * DFF + col0) = w;
            }
    }
};
struct EpiRes {
    static constexpr bool PERM = true, AFTER_DRAIN = false;
    const float* in_lat; const float* in_ctx; float* out_lat; float* out_ctx; const float* gate; float coef;
    __device__ __forceinline__ void operator()(const f32x4 (&acc)[2][2][4][2], const Unit& u, int wr, int wc, int fr, int fq) const {
        const int row0 = u.pm * 256 + wr * 64 + fr, col0 = u.pn * 256 + wc * 32 + 8 * fq;
        const int seg = (u.pm < 64) ? 0 : (u.pm < 128 ? 1 : 2);
        f32x4 gv[2][2];
#pragma unroll
        for (int bj = 0; bj < 2; ++bj)
#pragma unroll
            for (int n = 0; n < 2; ++n) gv[bj][n] = *(const f32x4*)(gate + seg * 9216 + col0 + bj * 128 + 4 * n) * coef;
#pragma unroll
        for (int ai = 0; ai < 2; ++ai)
#pragma unroll
            for (int m = 0; m < 4; ++m) {
                const int row = row0 + ai * 128 + m * 16;
                const float* ip; float* op;
                if (row < NLAT) { ip = in_lat + (size_t)row * DM; op = out_lat + (size_t)row * DM; }
                else { ip = in_ctx + (size_t)(row - NLAT) * DM; op = out_ctx + (size_t)(row - NLAT) * DM; }
#pragma unroll
                for (int bj = 0; bj < 2; ++bj)
#pragma unroll
                    for (int n = 0; n < 2; ++n) {
                        const int c = col0 + bj * 128 + 4 * n;
                        f32x4 v = *(const f32x4*)(ip + c);
                        v = v + gv[bj][n] * acc[ai][bj][m][n];
                        *(f32x4*)(op + c) = v;
                    }
            }
    }
};
struct EpiWin {
    static constexpr bool PERM = true, AFTER_DRAIN = false;
    unsigned char* Z; const float* cs; const float* lb; int pn_off;
    __device__ __forceinline__ void operator()(const f32x4 (&acc)[2][2][4][2], const Unit& u, int wr, int wc, int fr, int fq) const {
        const int t = u.pn + pn_off;
        const int row0 = u.pm * 256 + wr * 64 + fr, cin = wc * 32 + 8 * fq;
        if (t < 4) {
            bf16_t* dst = (bf16_t*)(Z + ((t < 2) ? Z_Q : Z_K)); const float sc = (t < 2) ? C2 : 1.f; const int cb = (t & 1) * 256;
#pragma unroll
            for (int ai = 0; ai < 2; ++ai)
#pragma unroll
                for (int m = 0; m < 4; ++m) {
                    const int row = row0 + ai * 128 + m * 16;
                    f32x4 cv = {1.f, 1.f, 1.f, 1.f}, sv = {0.f, 0.f, 0.f, 0.f};
                    if (row < NLAT) { const int ts = row & (SEQ - 1); const int pos = (wc & 1) ? (ts & 63) : (ts >> 6);
                        cv = *(const f32x4*)(cs + pos * 32 + 4 * fq); sv = *(const f32x4*)(cs + pos * 32 + 16 + 4 * fq); }
#pragma unroll
                    for (int bj = 0; bj < 2; ++bj) {
                        const f32x4 x1 = acc[ai][bj][m][0], x2 = acc[ai][bj][m][1];
                        const f32x4 o1 = (x1 * cv - x2 * sv) * sc, o2 = (x1 * sv + x2 * cv) * sc;
                        u32x4 w; w.x = pk2(o1[0], o1[1]); w.y = pk2(o1[2], o1[3]); w.z = pk2(o2[0], o2[1]); w.w = pk2(o2[2], o2[3]);
                        *(u32x4*)(dst + (size_t)row * 512 + cb + bj * 128 + cin) = w;
                    }
                }
        } else if (t <= 8) {
            float* dst = (float*)(Z + ((t == 6) ? Z_HQ : (t == 7 ? Z_FF : Z_FB)));
            const float* lbp = lb + ((t == 8) ? 256 : 0);
#pragma unroll
            for (int bj = 0; bj < 2; ++bj)
#pragma unroll
                for (int n = 0; n < 2; ++n) {
                    f32x4 lbv = *(const f32x4*)(lbp + bj * 128 + cin + 4 * n);
                    f32x4 om = 1.f - lbv;
#pragma unroll
                    for (int ai = 0; ai < 2; ++ai)
#pragma unroll
                        for (int m = 0; m < 4; ++m) {
                            const int row = row0 + ai * 128 + m * 16;
                            const f32x4 z = acc[ai][bj][m][n];
                            f32x4 sg; sg[0] = sigm(z[0]); sg[1] = sigm(z[1]); sg[2] = sigm(z[2]); sg[3] = sigm(z[3]);
                            const f32x4 o = (t == 6) ? z * sg : lbv + om * sg;
                            *(f32x4*)(dst + (size_t)row * 256 + bj * 128 + cin + 4 * n) = o;
                        }
                }
        } else {
            bf16_t* dst = (bf16_t*)(Z + ((t == 9) ? Z_HI : (t == 10 ? Z_HG : Z_ZP)));
#pragma unroll
            for (int ai = 0; ai < 2; ++ai)
#pragma unroll
                for (int m = 0; m < 4; ++m) {
                    const int row = row0 + ai * 128 + m * 16;
#pragma unroll
                    for (int bj = 0; bj < 2; ++bj) {
                        f32x4 v0 = acc[ai][bj][m][0], v1 = acc[ai][bj][m][1];
                        if (t == 10) { v0[0] = siluf(v0[0]); v0[1] = siluf(v0[1]); v0[2] = siluf(v0[2]); v0[3] = siluf(v0[3]); v1[0] = siluf(v1[0]); v1[1] = siluf(v1[1]); v1[2] = siluf(v1[2]); v1[3] = siluf(v1[3]); }
                        u32x4 w; w.x = pk2(v0[0], v0[1]); w.y = pk2(v0[2], v0[3]); w.z = pk2(v1[0], v1[1]); w.w = pk2(v1[2], v1[3]);
                        *(u32x4*)(dst + (size_t)row * 256 + bj * 128 + cin) = w;
                    }
                }
        }
    }
};
struct EpiVT {
    static constexpr bool PERM = true, AFTER_DRAIN = false;
    bf16_t* vT;
    __device__ __forceinline__ void operator()(const f32x4 (&acc)[2][2][4][2], const Unit& u, int wr, int wc, int fr, int fq) const {
        const int e0 = u.pm * 256 + wr * 64 + fr;
        int b, key0;
        if (u.pn < 64) { b = 0; key0 = u.pn * 256; } else if (u.pn < 128) { b = 1; key0 = (u.pn - 64) * 256; } else { b = u.pn - 128; key0 = SEQ; }
        const int kc = key0 + wc * 32 + 8 * fq;
#pragma unroll
        for (int ai = 0; ai < 2; ++ai)
#pragma unroll
            for (int m = 0; m < 4; ++m) {
                const int e = e0 + ai * 128 + m * 16;
#pragma unroll
                for (int bj = 0; bj < 2; ++bj) {
                    const f32x4 v0 = acc[ai][bj][m][0], v1 = acc[ai][bj][m][1];
                    u32x4 w; w.x = pk2(v0[0], v0[1]); w.y = pk2(v0[2], v0[3]); w.z = pk2(v1[0], v1[1]); w.w = pk2(v1[2], v1[3]);
                    *(u32x4*)(vT + (size_t)(b * 512 + e) * KEYS + kc + bj * 128) = w;
                }
            }
    }
};
struct EpiG {
    static constexpr bool PERM = true, AFTER_DRAIN = false;
    bf16_t* G;
    __device__ __forceinline__ void operator()(const f32x4 (&acc)[2][2][4][2], const Unit& u, int wr, int wc, int fr, int fq) const {
        const int row0 = u.pm * 256 + wr * 64 + fr, col0 = u.pn * 256 + wc * 32 + 8 * fq;
#pragma unroll
        for (int ai = 0; ai < 2; ++ai)
#pragma unroll
            for (int m = 0; m < 4; ++m) {
                const int row = row0 + ai * 128 + m * 16;
#pragma unroll
                for (int bj = 0; bj < 2; ++bj) {
                    const f32x4 v0 = acc[ai][bj][m][0], v1 = acc[ai][bj][m][1];
                    u32x4 w; w.x = pk2(sigm(v0[0]), sigm(v0[1])); w.y = pk2(sigm(v0[2]), sigm(v0[3])); w.z = pk2(sigm(v1[0]), sigm(v1[1])); w.w = pk2(sigm(v1[2]), sigm(v1[3]));
                    *(u32x4*)(G + (size_t)row * 3072 + col0 + bj * 128) = w;
                }
            }
    }
};
struct EpiProj {
    static constexpr bool PERM = true, AFTER_DRAIN = false;
    bf16_t* y; const bf16_t* G; int gi; int first;
    __device__ __forceinline__ void operator()(const f32x4 (&acc)[2][2][4][2], const Unit& u, int wr, int wc, int fr, int fq) const {
        const int row0 = u.pm * 256 + wr * 64 + fr, col0 = u.pn * 256 + wc * 32 + 8 * fq;
#pragma unroll
        for (int ai = 0; ai < 2; ++ai)
#pragma unroll
            for (int m = 0; m < 4; ++m) {
                const int row = row0 + ai * 128 + m * 16;
#pragma unroll
                for (int bj = 0; bj < 2; ++bj) {
                    const int c = col0 + bj * 128;
                    const u32x4 g = *(const u32x4*)(G + (size_t)row * 3072 + gi * 1024 + c);
                    u32x4 yo = {0u, 0u, 0u, 0u};
                    if (!first) yo = *(const u32x4*)(y + (size_t)row * 1024 + c);
                    const f32x4 v0 = acc[ai][bj][m][0], v1 = acc[ai][bj][m][1];
                    u32x4 w;
                    w.x = pk2(bflo(yo.x) + bflo(g.x) * v0[0], bfhi(yo.x) + bfhi(g.x) * v0[1]);
                    w.y = pk2(bflo(yo.y) + bflo(g.y) * v0[2], bfhi(yo.y) + bfhi(g.y) * v0[3]);
                    w.z = pk2(bflo(yo.z) + bflo(g.z) * v1[0], bfhi(yo.z) + bfhi(g.z) * v1[1]);
                    w.w = pk2(bflo(yo.w) + bflo(g.w) * v1[2], bfhi(yo.w) + bfhi(g.w) * v1[3]);
                    *(u32x4*)(y + (size_t)row * 1024 + c) = w;
                }
            }
    }
};

__device__ __forceinline__ int map_row(int mode, int n) {
    if (mode == 1) return 256 * (n >> 7) + (n & 127);
    if (mode == 2) return 256 * (n >> 7) + 128 + (n & 127);
    if (mode == 3) return (n < 1024) ? ((n & ~31) + 8 * ((n & 15) >> 2) + 4 * ((n >> 4) & 1) + (n & 3)) : n;
    return n;
}
__device__ __forceinline__ void transpose_item(const float* W, int K, int N, bf16_t* WT, int mode, LAS float* scr, int item, int lane) {
    const int nblk = N / 32, kb = item / nblk, nb = item % nblk, k0 = 64 * kb, n0 = 32 * nb;
#pragma unroll 8
    for (int i = 0; i < 32; ++i) { const int kk = 2 * i + (lane >> 5); scr[kk * 33 + (lane & 31)] = W[(size_t)(k0 + kk) * N + n0 + (lane & 31)]; }
    LDS_WAIT(); asm volatile("" ::: "memory");
    const int c = lane & 7;
#pragma unroll
    for (int j = 0; j < 4; ++j) { const int n = (lane >> 3) + 8 * j; const LAS float* s = scr + (8 * c) * 33 + n;
        u32x4 o; o.x = pk2(s[0 * 33], s[1 * 33]); o.y = pk2(s[2 * 33], s[3 * 33]); o.z = pk2(s[4 * 33], s[5 * 33]); o.w = pk2(s[6 * 33], s[7 * 33]);
        *(u32x4*)(WT + (size_t)map_row(mode, n0 + n) * K + k0 + 8 * c) = o; }
    LDS_WAIT(); asm volatile("" ::: "memory");
}

__device__ __forceinline__ void norm_phase(const float* in_lat, const float* in_ctx, const float* gain, const float* modl, int shi, int sci, bf16_t* outp, int gw, int ngw, int lane) {
    f32x4 gv[4];
#pragma unroll
    for (int j = 0; j < 4; ++j) gv[j] = *(const f32x4*)(gain + 4 * lane + 256 * j);
    for (int row = gw; row < R; row += ngw) {
        const float* ip = (row < NLAT) ? in_lat + (size_t)row * DM : in_ctx + (size_t)(row - NLAT) * DM;
        const int seg = (row < SEQ) ? 0 : (row < NLAT ? 1 : 2);
        const float* sh = modl + seg * 9216 + shi * 1024; const float* sc = modl + seg * 9216 + sci * 1024;
        f32x4 v[4]; float ss = 0.f;
#pragma unroll
        for (int j = 0; j < 4; ++j) { v[j] = *(const f32x4*)(ip + 4 * lane + 256 * j); ss += (v[j][0] * v[j][0] + v[j][1] * v[j][1]) + (v[j][2] * v[j][2] + v[j][3] * v[j][3]); }
        ss = wave_sum(ss, lane);
        const float rstd = 1.0f / sqrtf(ss * (1.f / DM) + EPS);
#pragma unroll
        for (int j = 0; j < 4; ++j) {
            const f32x4 s4 = *(const f32x4*)(sc + 4 * lane + 256 * j), h4 = *(const f32x4*)(sh + 4 * lane + 256 * j);
            const f32x4 y = v[j] * rstd * gv[j] * (s4 + 1.f) + h4;
            u32x2 w; w.x = pk2(y[0], y[1]); w.y = pk2(y[2], y[3]);
            *(u32x2*)(outp + (size_t)row * DM + 4 * lane + 256 * j) = w;
        }
    }
}
__device__ __forceinline__ void final_norm_phase(float* out, const float* gain, int gw, int ngw, int lane) {
    f32x4 gv[4];
#pragma unroll
    for (int j = 0; j < 4; ++j) gv[j] = *(const f32x4*)(gain + 4 * lane + 256 * j);
    for (int row = gw; row < NLAT; row += ngw) {
        float* ip = out + (size_t)row * DM;
        f32x4 v[4]; float ss = 0.f;
#pragma unroll
        for (int j = 0; j < 4; ++j) { v[j] = *(const f32x4*)(ip + 4 * lane + 256 * j); ss += (v[j][0] * v[j][0] + v[j][1] * v[j][1]) + (v[j][2] * v[j][2] + v[j][3] * v[j][3]); }
        ss = wave_sum(ss, lane);
        const float rstd = 1.0f / sqrtf(ss * (1.f / DM) + EPS);
#pragma unroll
        for (int j = 0; j < 4; ++j) *(f32x4*)(ip + 4 * lane + 256 * j) = v[j] * rstd * gv[j];
    }
}
__device__ __forceinline__ void pool_phase(const bf16_t* zp, bf16_t* mx, int gtid, int ngt) {
    for (int it = gtid; it < R * 32; it += ngt) {
        const int row = it >> 5, ch = (it & 31) * 8, g = ch >> 6, hw = 1 << g;
        int base, n;
        if (row < NLAT) { base = row & ~(SEQ - 1); n = SEQ; } else { base = NLAT + ((row - NLAT) & ~(CTXL - 1)); n = CTXL; }
        const int t = row - base, lo = (t - hw > 0) ? t - hw : 0, hi = (t + hw < n) ? t + hw : n;
        float s[8];
#pragma unroll
        for (int i = 0; i < 8; ++i) s[i] = 0.f;
        for (int j = lo; j < hi; ++j) {
            const u32x4 v = *(const u32x4*)(zp + (size_t)(base + j) * 256 + ch);
            s[0] += bflo(v.x); s[1] += bfhi(v.x); s[2] += bflo(v.y); s[3] += bfhi(v.y); s[4] += bflo(v.z); s[5] += bfhi(v.z); s[6] += bflo(v.w); s[7] += bfhi(v.w);
        }
        const float inv = 1.f / (float)(hi - lo);
        const u32x4 c = *(const u32x4*)(zp + (size_t)row * 256 + ch);
        u32x4 w;
        w.x = pk2(s[0] * inv - bflo(c.x), s[1] * inv - bfhi(c.x)); w.y = pk2(s[2] * inv - bflo(c.y), s[3] * inv - bfhi(c.y));
        w.z = pk2(s[4] * inv - bflo(c.z), s[5] * inv - bfhi(c.z)); w.w = pk2(s[6] * inv - bflo(c.w), s[7] * inv - bfhi(c.w));
        *(u32x4*)(mx + (size_t)row * 256 + ch) = w;
    }
}

__device__ __forceinline__ int hg_row(int dir, int b, int step) {
    if (step < CTXL) { const int t = dir ? (CTXL - 1 - step) : step; return NLAT + b * CTXL + t; }
    int t = step - CTXL; if (dir) t = SEQ - 1 - t; return b * SEQ + t;
}
template <bool OUT>
__device__ __forceinline__ void hg_pass(const float* hq, const float* ff, const float* fb, const bf16_t* hi, float* carry, float* dk, bf16_t* odir, int wave, int lane, int G) {
    for (int item = blockIdx.x + G * wave; item < 16 * HG_SEG; item += G * 8) {
        const int s = item / HG_SEG, j = item % HG_SEG, dir = s >> 3, b = (s >> 2) & 1, h = s & 3;
        const float* fbase = dir ? fb : ff;
        f32x2v S[32];
#pragma unroll
        for (int k = 0; k < 32; ++k) { S[k][0] = OUT ? carry[((size_t)item * 64 + 2 * k) * 64 + lane] : 0.f; S[k][1] = OUT ? carry[((size_t)item * 64 + 2 * k + 1) * 64 + lane] : 0.f; }
        float dl = 1.f;
        const int st0 = j * HG_STEPS, st1 = st0 + HG_STEPS;
        constexpr int HG_PF = 8;
        float ivb[HG_PF], fvb[HG_PF], qvb[HG_PF];
#pragma unroll
        for (int u = 0; u < HG_PF; ++u) {
            const int stl = (st0 + u < st1) ? st0 + u : st1 - 1;
            const size_t off = (size_t)hg_row(dir, b, stl) * 256 + h * 64 + lane;
            ivb[u] = bf2f(hi[off]); fvb[u] = fbase[off]; qvb[u] = OUT ? hq[off] : 0.f;
        }
        for (int sb = st0; sb < st1; sb += HG_PF) {
#pragma unroll
            for (int u = 0; u < HG_PF; ++u) {
                const int st = sb + u;
                if (st < st1) {
                    const float iv = ivb[u], fv = fvb[u], qv = qvb[u];
                    const size_t offc = (size_t)hg_row(dir, b, st) * 256 + h * 64 + lane;
                    { const int stn = (st + HG_PF < st1) ? st + HG_PF : st1 - 1;
                      const size_t off = (size_t)hg_row(dir, b, stn) * 256 + h * 64 + lane;
                      ivb[u] = bf2f(hi[off]); fvb[u] = fbase[off]; if (OUT) qvb[u] = hq[off]; }
                    if (!OUT) dl *= fv;
                    f32x2v o2 = {0.f, 0.f};
                    const f32x2v iv2 = {iv, iv};
                    const int fvi = __builtin_bit_cast(int, fv), qvi = __builtin_bit_cast(int, qv);
#pragma unroll
                    for (int k = 0; k < 32; ++k) {
                        f32x2v f2; f2[0] = __builtin_bit_cast(float, __builtin_amdgcn_readlane(fvi, 2 * k)); f2[1] = __builtin_bit_cast(float, __builtin_amdgcn_readlane(fvi, 2 * k + 1));
                        const f32x2v d2 = S[k] - iv2;
                        S[k] = __builtin_elementwise_fma(f2, d2, iv2);
                        if (OUT) { f32x2v q2; q2[0] = __builtin_bit_cast(float, __builtin_amdgcn_readlane(qvi, 2 * k)); q2[1] = __builtin_bit_cast(float, __builtin_amdgcn_readlane(qvi, 2 * k + 1));
                            o2 = __builtin_elementwise_fma(q2, S[k], o2); }
                    }
                    if (OUT) odir[(size_t)dir * R * 256 + offc] = (bf16_t)(pk2(o2[0] + o2[1], 0.f) & 0xffffu);
                }
            }
        }
        if (!OUT) {
#pragma unroll
            for (int k = 0; k < 32; ++k) { carry[((size_t)item * 64 + 2 * k) * 64 + lane] = S[k][0]; carry[((size_t)item * 64 + 2 * k + 1) * 64 + lane] = S[k][1]; }
            dk[item * 64 + lane] = dl;
        }
    }
}
__device__ __forceinline__ void hg_carry(float* carry, const float* dk, int gtid, int ngt) {
    for (int e = gtid; e < 16 * 4096; e += ngt) {
        const int s = e >> 12, idx = e & 4095, k = idx >> 6;
        float run = 0.f;
        for (int j0 = 0; j0 < HG_SEG; j0 += 8) {
            float t[8], d[8];
#pragma unroll
            for (int u = 0; u < 8; ++u) { t[u] = carry[(size_t)(s * HG_SEG + j0 + u) * 4096 + idx]; d[u] = dk[(s * HG_SEG + j0 + u) * 64 + k]; }
#pragma unroll
            for (int u = 0; u < 8; ++u) { carry[(size_t)(s * HG_SEG + j0 + u) * 4096 + idx] = run; run = __builtin_fmaf(d[u], run, t[u]); }
        }
    }
}
__device__ __forceinline__ void hg_readout(const bf16_t* odir, const bf16_t* hgs, const float* gain, bf16_t* ohg, int gw, int ngw, int lane) {
    const f32x4 gv = *(const f32x4*)(gain + ((4 * lane) & 63));
    for (int row = gw; row < R; row += ngw) {
        const size_t off = (size_t)row * 256 + 4 * lane;
        const u32x2 a = *(const u32x2*)(odir + off), bq = *(const u32x2*)(odir + (size_t)R * 256 + off), hg = *(const u32x2*)(hgs + off);
        const float o0 = bflo(a.x) + bflo(bq.x), o1 = bfhi(a.x) + bfhi(bq.x), o2 = bflo(a.y) + bflo(bq.y), o3 = bfhi(a.y) + bfhi(bq.y);
        float ss = (o0 * o0 + o1 * o1) + (o2 * o2 + o3 * o3);
        ss += shx(ss, 1, lane); ss += shx(ss, 2, lane); ss += shx(ss, 4, lane); ss += shx(ss, 8, lane);
        const float rstd = 1.0f / sqrtf(ss * (1.f / 64.f) + EPS);
        u32x2 w;
        w.x = pk2(o0 * rstd * gv[0] * bflo(hg.x), o1 * rstd * gv[1] * bfhi(hg.x));
        w.y = pk2(o2 * rstd * gv[2] * bflo(hg.y), o3 * rstd * gv[3] * bfhi(hg.y));
        *(u32x2*)(ohg + off) = w;
    }
}

constexpr int AT_KSTR = 272, AT_VSTR = 136, AT_KBYTES = 64 * AT_KSTR, AT_VBYTES = 128 * AT_VSTR, AT_STAGE = AT_KBYTES + AT_VBYTES;
static_assert(2 * AT_STAGE <= LDS_BYTES && 65536 <= 2 * AT_STAGE, "attention LDS");
__device__ __forceinline__ void attn_unit(LAS unsigned char* lds, const bf16_t* qbuf, const bf16_t* kbuf, const bf16_t* vT, bf16_t* oda, const float* gain,
                                          int b, int h, int qrow0, int kt0, int kt1, float lam, float post, int tid, int wave, int lane) {
    const int c = wave & 1, g = wave >> 1, n = lane & 31, gq = lane >> 5;
    bf16x8 qf[4];
    { const bf16_t* qp = qbuf + (size_t)(qrow0 + 32 * g + n) * 512 + h * 128 + c * 64 + 8 * gq;
#pragma unroll
      for (int s = 0; s < 4; ++s) qf[s] = *(const bf16x8*)(qp + 16 * s); }
    f32x16 O[4];
#pragma unroll
    for (int e = 0; e < 4; ++e)
#pragma unroll
        for (int r = 0; r < 16; ++r) O[e][r] = 0.f;
    float l = 0.f;
    const int kkey0 = tid >> 4, kch = tid & 15, ve0 = tid >> 3, vc = tid & 7;
    const size_t kgoff = (size_t)kkey0 * 512 + h * 128 + kch * 8;
    const unsigned klds = kkey0 * AT_KSTR + kch * 16;
    const size_t vgoff = (size_t)(b * 512 + h * 128 + ve0) * KEYS + vc * 8;
    const unsigned vlds = ve0 * AT_VSTR + vc * 16;
    u32x4 kr0, kr1, vr0, vr1;
#define AT_KROW0(kt) (((kt) * 64 < SEQ) ? (size_t)b * SEQ + (kt) * 64 : (size_t)NLAT + b * CTXL + ((kt) * 64 - SEQ))
#define AT_LOADK(kt) do { const size_t krow0 = AT_KROW0(kt); kr0 = *(const u32x4*)(kbuf + krow0 * 512 + kgoff); kr1 = *(const u32x4*)(kbuf + (krow0 + 32) * 512 + kgoff); } while (0)
#define AT_LOADV(kt) do { vr0 = *(const u32x4*)(vT + vgoff + (kt) * 64); vr1 = *(const u32x4*)(vT + vgoff + (size_t)64 * KEYS + (kt) * 64); } while (0)
#define AT_STOREK(buf) do { LAS unsigned char* sb_ = lds + (buf) * AT_KBYTES; *(LAS u32x4*)(sb_ + klds) = kr0; *(LAS u32x4*)(sb_ + klds + 32 * AT_KSTR) = kr1; } while (0)
#define AT_STOREV(buf) do { LAS unsigned char* sb_ = lds + 2 * AT_KBYTES + (buf) * AT_VBYTES; \
        *(LAS u32x2*)(sb_ + vlds) = (u32x2){vr0.x, vr0.y}; *(LAS u32x2*)(sb_ + vlds + 8) = (u32x2){vr0.z, vr0.w}; \
        *(LAS u32x2*)(sb_ + vlds + 64 * AT_VSTR) = (u32x2){vr1.x, vr1.y}; *(LAS u32x2*)(sb_ + vlds + 64 * AT_VSTR + 8) = (u32x2){vr1.z, vr1.w}; } while (0)
#define AT_QK(Sa, Sb, buf) do { LAS unsigned char* kp = lds + (buf) * AT_KBYTES + n * AT_KSTR + (c * 8 + gq) * 16; \
        _Pragma("unroll") for (int s = 0; s < 4; ++s) { \
            const bf16x8 a0 = *(LAS bf16x8*)(kp + s * 32), a1 = *(LAS bf16x8*)(kp + 32 * AT_KSTR + s * 32); \
            Sa = __builtin_amdgcn_mfma_f32_32x32x16_bf16(a0, qf[s], Sa, 0, 0, 0); \
            Sb = __builtin_amdgcn_mfma_f32_32x32x16_bf16(a1, qf[s], Sb, 0, 0, 0); } } while (0)
#define AT_BAR() do { asm volatile("s_waitcnt lgkmcnt(0)" ::: "memory"); __builtin_amdgcn_s_barrier(); asm volatile("" ::: "memory"); } while (0)
    const int nt = kt1 - kt0;
    AT_LOADK(kt0); AT_LOADV(kt0); AT_STOREK(0); AT_STOREV(0);
    if (nt > 1) { AT_LOADK(kt0 + 1); AT_LOADV(kt0 + 1); }
    AT_BAR();
    f32x16 negm;
    {
        f32x16 S0, S1;
#pragma unroll
        for (int r = 0; r < 16; ++r) { S0[r] = 0.f; S1[r] = 0.f; }
        AT_QK(S0, S1, 0);
        float mx = fmaxf(S0[0], S1[0]);
#pragma unroll
        for (int r = 1; r < 16; ++r) mx = fmaxf(fmaxf(mx, S0[r]), S1[r]);
        { auto rr = __builtin_amdgcn_permlane32_swap(__builtin_bit_cast(unsigned, mx), __builtin_bit_cast(unsigned, mx), false, false);
          mx = fmaxf(__builtin_bit_cast(float, rr[0]), __builtin_bit_cast(float, rr[1])); }
#pragma unroll
        for (int r = 0; r < 16; ++r) negm[r] = -mx;
    }
    constexpr float THR = 8.f;
    for (int i = 0; i < nt; ++i) {
        const int cur = i & 1;
        if (i + 1 < nt) { AT_STOREK(cur ^ 1); AT_STOREV(cur ^ 1); }
        if (i + 2 < nt) { AT_LOADK(kt0 + i + 2); AT_LOADV(kt0 + i + 2); }
        bf16x8 kf[8];
        { LAS unsigned char* kp = lds + cur * AT_KBYTES + n * AT_KSTR + (c * 8 + gq) * 16;
#pragma unroll
          for (int s = 0; s < 4; ++s) { kf[2 * s] = *(LAS bf16x8*)(kp + s * 32); kf[2 * s + 1] = *(LAS bf16x8*)(kp + 32 * AT_KSTR + s * 32); } }
        LAS unsigned char* vp = lds + 2 * AT_KBYTES + cur * AT_VBYTES + n * AT_VSTR + gq * 8;
        u32x2 va[8][2];
#pragma unroll
        for (int ks = 0; ks < 2; ++ks)
#pragma unroll
            for (int e = 0; e < 4; ++e) { va[ks * 4 + e][0] = *(LAS u32x2*)(vp + e * 32 * AT_VSTR + ks * 32); va[ks * 4 + e][1] = *(LAS u32x2*)(vp + e * 32 * AT_VSTR + ks * 32 + 16); }
        __builtin_amdgcn_sched_barrier(0);
        f32x16 S0 = negm, S1 = negm;
#pragma unroll
        for (int s = 0; s < 4; ++s) {
            S0 = __builtin_amdgcn_mfma_f32_32x32x16_bf16(kf[2 * s], qf[s], S0, 0, 0, 0);
            S1 = __builtin_amdgcn_mfma_f32_32x32x16_bf16(kf[2 * s + 1], qf[s], S1, 0, 0, 0);
        }
        __builtin_amdgcn_sched_barrier(0);
        u32x2 vb[8][2];
#pragma unroll
        for (int ks = 0; ks < 2; ++ks)
#pragma unroll
            for (int e = 0; e < 4; ++e) { vb[ks * 4 + e][0] = *(LAS u32x2*)(vp + e * 32 * AT_VSTR + (ks + 2) * 32); vb[ks * 4 + e][1] = *(LAS u32x2*)(vp + e * 32 * AT_VSTR + (ks + 2) * 32 + 16); }
        __builtin_amdgcn_sched_barrier(0);
        float mx = fmaxf(S0[0], S1[0]);
#pragma unroll
        for (int r = 1; r < 16; ++r) mx = fmaxf(fmaxf(mx, S0[r]), S1[r]);
        { auto rr = __builtin_amdgcn_permlane32_swap(__builtin_bit_cast(unsigned, mx), __builtin_bit_cast(unsigned, mx), false, false);
          mx = fmaxf(__builtin_bit_cast(float, rr[0]), __builtin_bit_cast(float, rr[1])); }
        if (__builtin_amdgcn_ballot_w64(mx > THR) != 0ull) {
            const float delta = fmaxf(mx, 0.f), alpha = ex2(-delta);
            l *= alpha;
#pragma unroll
            for (int r = 0; r < 16; ++r) { S0[r] -= delta; S1[r] -= delta; negm[r] -= delta; }
#pragma unroll
            for (int e = 0; e < 4; ++e) O[e] = O[e] * alpha;
        }
        float ps = 0.f;
#pragma unroll
        for (int r = 0; r < 16; ++r) { S0[r] = ex2(S0[r]); S1[r] = ex2(S1[r]); ps += S0[r] + S1[r]; }
        l += ps;
        bf16x8 pb[4];
#pragma unroll
        for (int s = 0; s < 2; ++s) {
            u32x4 pw;
            pw.x = pk2(S0[8 * s + 0], S0[8 * s + 1]); pw.y = pk2(S0[8 * s + 2], S0[8 * s + 3]); pw.z = pk2(S0[8 * s + 4], S0[8 * s + 5]); pw.w = pk2(S0[8 * s + 6], S0[8 * s + 7]);
            pb[s] = __builtin_bit_cast(bf16x8, pw);
            pw.x = pk2(S1[8 * s + 0], S1[8 * s + 1]); pw.y = pk2(S1[8 * s + 2], S1[8 * s + 3]); pw.z = pk2(S1[8 * s + 4], S1[8 * s + 5]); pw.w = pk2(S1[8 * s + 6], S1[8 * s + 7]);
            pb[2 + s] = __builtin_bit_cast(bf16x8, pw);
        }
        __builtin_amdgcn_sched_barrier(0);
#pragma unroll
        for (int ks = 0; ks < 2; ++ks)
#pragma unroll
            for (int e = 0; e < 4; ++e) {
                const bf16x8 a = __builtin_bit_cast(bf16x8, ((u32x4){va[ks * 4 + e][0].x, va[ks * 4 + e][0].y, va[ks * 4 + e][1].x, va[ks * 4 + e][1].y}));
                O[e] = __builtin_amdgcn_mfma_f32_32x32x16_bf16(a, pb[ks], O[e], 0, 0, 0);
            }
#pragma unroll
        for (int ks = 0; ks < 2; ++ks)
#pragma unroll
            for (int e = 0; e < 4; ++e) {
                const bf16x8 a = __builtin_bit_cast(bf16x8, ((u32x4){vb[ks * 4 + e][0].x, vb[ks * 4 + e][0].y, vb[ks * 4 + e][1].x, vb[ks * 4 + e][1].y}));
                O[e] = __builtin_amdgcn_mfma_f32_32x32x16_bf16(a, pb[2 + ks], O[e], 0, 0, 0);
            }
        AT_BAR();
    }
#undef AT_BAR
#undef AT_KROW0
#undef AT_LOADK
#undef AT_LOADV
#undef AT_STOREK
#undef AT_STOREV
#undef AT_QK
    l += shx(l, 32, lane);
    const float inv = 1.f / l;
    LAS float* xch = (LAS float*)lds;
    if (c == 1) {
#pragma unroll
        for (int e = 0; e < 4; ++e)
#pragma unroll
            for (int r = 0; r < 16; ++r) xch[(g * 64 + e * 16 + r) * 64 + lane] = O[e][r] * inv;
    }
    __syncthreads();
    if (c == 0) {
        float ss = 0.f;
#pragma unroll
        for (int e = 0; e < 4; ++e)
#pragma unroll
            for (int r = 0; r < 16; ++r) { const float o = O[e][r] * inv - lam * xch[(g * 64 + e * 16 + r) * 64 + lane]; O[e][r] = o; ss += o * o; }
        ss += shx(ss, 32, lane);
        const float rs = post / sqrtf(ss * (1.f / 128.f) + EPS);
        bf16_t* op = oda + (size_t)(qrow0 + 32 * g + n) * 512 + h * 128;
#pragma unroll
        for (int e = 0; e < 4; ++e)
#pragma unroll
            for (int r4 = 0; r4 < 4; ++r4) {
                const int e0 = e * 32 + 8 * r4 + 4 * gq;
                const f32x4 gv = *(const f32x4*)(gain + e0);
                u32x2 w; w.x = pk2(O[e][4 * r4 + 0] * rs * gv[0], O[e][4 * r4 + 1] * rs * gv[1]); w.y = pk2(O[e][4 * r4 + 2] * rs * gv[2], O[e][4 * r4 + 3] * rs * gv[3]);
                *(u32x2*)(op + e0) = w;
            }
    }
    __syncthreads();
}
#define XB_TMO      128
#define XB_XCNT(j)  (256  + 64 * (j))
#define XB_XSUB(j)  (1280 + 64 * (j))
#define XB_XGEN(j)  (2304 + 64 * (j))
#define XB_TOP      3328
#define XB_TOPGEN   3392
#define XCD_BAR_WORDS 3456
#define XB_SPIN_CAP (1u << 18)

__device__ __forceinline__ unsigned xb_ld(unsigned* p)              { return __hip_atomic_load(p, __ATOMIC_RELAXED, __HIP_MEMORY_SCOPE_AGENT); }
__device__ __forceinline__ unsigned xb_add(unsigned* p, unsigned v) { return __hip_atomic_fetch_add(p, v, __ATOMIC_RELAXED, __HIP_MEMORY_SCOPE_AGENT); }
__device__ __forceinline__ unsigned xb_xcc_id() { return (unsigned)__builtin_amdgcn_s_getreg((3 << 11) | 20) & 0xFu; }
#define XB_SPIN(cond, bar) do { unsigned _sp = 0; while (cond) { __builtin_amdgcn_s_sleep(1); \
    if ((++_sp & 255u) == 0u) { if (xb_ld(&(bar)[XB_TMO])) break; if (_sp > XB_SPIN_CAP) { atomicAdd(&(bar)[XB_TMO], 1u); break; } } } } while (0)

struct XcdBarrier {
    unsigned* bar; unsigned x;
    volatile LAS unsigned* st;
};

__device__ __forceinline__ XcdBarrier xcd_barrier_post(unsigned* bar, volatile LAS unsigned* st) {
    XcdBarrier b; b.bar = bar; b.x = xb_xcc_id(); b.st = st;
    if (threadIdx.x == 0) (void)xb_add(&bar[XB_XCNT(b.x)], 1u);
    return b;
}
__device__ __forceinline__ void xcd_barrier_complete(unsigned* bar, unsigned x, unsigned& nloc, unsigned& nx) {
    const unsigned G = gridDim.x * gridDim.y * gridDim.z;
    unsigned sum, cnt, mine, sp = 0u;
    for (;;) {
        sum = 0u; cnt = 0u; mine = 0u;
#pragma unroll
        for (unsigned j = 0; j < 16; ++j) { const unsigned c = xb_ld(&bar[XB_XCNT(j)]); sum += c; cnt += (c > 0u) ? 1u : 0u; mine = (j == x) ? c : mine; }
        if (sum == G) break;
        __builtin_amdgcn_s_sleep(1);
        if ((++sp & 255u) == 0u) { if (xb_ld(&bar[XB_TMO])) break; if (sp > XB_SPIN_CAP) { atomicAdd(&bar[XB_TMO], 1u); break; } }
    }
    nloc = mine > 0u ? mine : 1u; nx = cnt > 0u ? cnt : 1u;
}

__device__ __forceinline__ void xcd_barrier(const XcdBarrier& b) {
    asm volatile("s_waitcnt vmcnt(0)" ::: "memory");
    __syncthreads();
    if (threadIdx.x == 0) {
        unsigned* bar = b.bar;
        __builtin_amdgcn_s_waitcnt(0);
        unsigned nloc = b.st[0], nx = b.st[1];
        if (nloc == 0u) { xcd_barrier_complete(bar, b.x, nloc, nx); b.st[0] = nloc; b.st[1] = nx; }
        const unsigned old = xb_add(&bar[XB_XSUB(b.x)], 1u);
        const unsigned gen = old / nloc;
        if (old + 1u == (gen + 1u) * nloc) {
            __builtin_amdgcn_fence(__ATOMIC_RELEASE, "agent");
            asm volatile("s_waitcnt vmcnt(0)" ::: "memory");
            const unsigned og = xb_add(&bar[XB_TOP], 1u);
            const unsigned tg = og / nx;
            if (og + 1u == (tg + 1u) * nx) xb_add(&bar[XB_TOPGEN], 1u);
            else XB_SPIN(xb_ld(&bar[XB_TOPGEN]) == tg, bar);
            __builtin_amdgcn_fence(__ATOMIC_ACQUIRE, "agent");
            xb_add(&bar[XB_XGEN(b.x)], 1u);
            asm volatile("s_waitcnt vmcnt(0)" ::: "memory");
        } else {
            XB_SPIN(xb_ld(&bar[XB_XGEN(b.x)]) == gen, bar);
            __builtin_amdgcn_fence(__ATOMIC_ACQUIRE, "agent");
            asm volatile("s_waitcnt vmcnt(0)" ::: "memory");
        }
    }
    __syncthreads();
}


struct Args { const float* in[30]; float* out; unsigned char* ws; };
typedef const Args __attribute__((address_space(4))) Args_c;
__device__ __forceinline__ Args_c* kargs_ptr() { Args_c* p = (Args_c*)__builtin_amdgcn_kernarg_segment_ptr(); asm volatile("" : "+s"(p)); return p; }
#define GSYNC_CG() cg::this_grid().sync()
constexpr size_t WS_BAR = WS_END + 4096;
constexpr size_t WS_TOTAL = WS_BAR + (size_t)XCD_BAR_WORDS * 4;
static_assert(WS_TOTAL <= (size_t)512 * 1024 * 1024, "workspace");
constexpr int LDS_BARST = LDS_BYTES - 16;
#define GSYNC() do { XcdBarrier xb_; xb_.bar = (unsigned*)(kargs_ptr()->ws + WS_BAR); xb_.x = xb_xcc_id(); xb_.st = (volatile LAS unsigned*)(lds + LDS_BARST); xcd_barrier(xb_); } while (0)
#ifdef PROBE_A
#define TS(cat) do { if (blockIdx.x == 0 && threadIdx.x == 0) { unsigned long long* tsb = (unsigned long long*)(kargs_ptr()->ws + WS_END); const unsigned long long now = __builtin_amdgcn_s_memrealtime(); tsb[1 + (cat)] += now - tsb[0]; tsb[0] = now; } } while (0)
#else
#define TS(cat) do {} while (0)
#endif
#define KA() int tid = threadIdx.x; asm volatile("" : "+v"(tid)); int G = gridDim.x, bid = blockIdx.x; asm volatile("" : "+s"(G), "+s"(bid)); \
    const int lane = tid & 63, wave = __builtin_amdgcn_readfirstlane(tid >> 6), gw = bid * 8 + wave, ngw = G * 8, gtid = bid * NTHR + tid, ngt = G * NTHR; \
    (void)lane; (void)wave; (void)gw; (void)ngw; (void)gtid; (void)ngt; \
    Args_c* ka = kargs_ptr(); unsigned char* ws = ka->ws; (void)ws

__global__ void __launch_bounds__(NTHR, 2) fwd_kernel(Args a_unused) {
    extern __shared__ __attribute__((aligned(16))) unsigned char lds_raw[];
    LAS unsigned char* lds = (LAS unsigned char*)lds_raw;
    if (threadIdx.x < 4) ((volatile LAS unsigned*)(lds + LDS_BARST))[threadIdx.x] = 0u;
    __syncthreads();
    (void)xcd_barrier_post((unsigned*)(kargs_ptr()->ws + WS_BAR), (volatile LAS unsigned*)(lds + LDS_BARST));
#ifdef PROBE_A
    if (blockIdx.x == 0 && threadIdx.x == 0) { unsigned long long* tsb = (unsigned long long*)(kargs_ptr()->ws + WS_END); for (int i = 1; i < 32; ++i) tsb[i] = 0; tsb[0] = __builtin_amdgcn_s_memrealtime(); }
#endif

    {
        KA();
        bf16_t* WB = (bf16_t*)(ws + WS_WB);
        LAS float* scr = (LAS float*)(lds + wave * 8448);
        constexpr int IT_L = 12416;
        for (int it = gw; it < 2 * IT_L; it += ngw) {
            const int l = it / IT_L; int r = it % IT_L;
            bf16_t* Wl = WB + (size_t)l * WL_TOTAL;
            if (r < 1408) { transpose_item(ka->in[9] + (size_t)l * 1024 * DFF, 1024, DFF, Wl + WL_UP1, 1, scr, r, lane); continue; } r -= 1408;
            if (r < 1408) { transpose_item(ka->in[10] + (size_t)l * 1024 * DFF, 1024, DFF, Wl + WL_UP1, 2, scr, r, lane); continue; } r -= 1408;
            if (r < 1408) { transpose_item(ka->in[11] + (size_t)l * DFF * 1024, DFF, 1024, Wl + WL_DN1, 0, scr, r, lane); continue; } r -= 1408;
            if (r < 1408) { transpose_item(ka->in[12] + (size_t)l * 1024 * DFF, 1024, DFF, Wl + WL_UP2, 1, scr, r, lane); continue; } r -= 1408;
            if (r < 1408) { transpose_item(ka->in[13] + (size_t)l * 1024 * DFF, 1024, DFF, Wl + WL_UP2, 2, scr, r, lane); continue; } r -= 1408;
            if (r < 1408) { transpose_item(ka->in[14] + (size_t)l * DFF * 1024, DFF, 1024, Wl + WL_DN2, 0, scr, r, lane); continue; } r -= 1408;
            if (r < 3072) { transpose_item(ka->in[15] + (size_t)l * 1024 * 6144, 1024, 6144, Wl + WL_IN, 3, scr, r, lane); continue; } r -= 3072;
            if (r < 256) { transpose_item(ka->in[25] + (size_t)l * 512 * 1024, 512, 1024, Wl + WL_PA, 0, scr, r, lane); continue; } r -= 256;
            if (r < 128) { transpose_item(ka->in[26] + (size_t)l * 256 * 1024, 256, 1024, Wl + WL_PH, 0, scr, r, lane); continue; } r -= 128;
            transpose_item(ka->in[28] + (size_t)l * 1024 * 1024, 1024, 1024, Wl + WL_O, 0, scr, r, lane);
        }
        __syncthreads();
    }
    {
        KA();
        float* MOD = (float*)(ws + WS_MOD);
        LAS float* sv = (LAS float*)lds;
        LAS float* part = (LAS float*)(lds + 12288);
        for (int i = tid; i < 3072; i += NTHR) { const int seg = i >> 10, k = i & 1023; const float x = (seg < 2) ? ka->in[1][seg * 1024 + k] : ka->in[3][k]; sv[i] = x / (1.f + __expf(-x)); }
        __syncthreads();
        for (int item = bid; item < 288; item += G) {
            const int l = item / 144, col = (item % 144) * 64 + lane;
            const float* W = ka->in[4] + (size_t)l * 1024 * 9216 + col;
            float a0 = 0.f, a1 = 0.f, a2 = 0.f;
            for (int k = wave * 128; k < wave * 128 + 128; ++k) { const float w = W[(size_t)k * 9216]; a0 = __builtin_fmaf(sv[k], w, a0); a1 = __builtin_fmaf(sv[1024 + k], w, a1); a2 = __builtin_fmaf(sv[2048 + k], w, a2); }
            part[(wave * 3 + 0) * 64 + lane] = a0; part[(wave * 3 + 1) * 64 + lane] = a1; part[(wave * 3 + 2) * 64 + lane] = a2;
            __syncthreads();
            if (tid < 192) { const int seg = tid >> 6, cl = tid & 63; float s = 0.f;
#pragma unroll
                for (int w = 0; w < 8; ++w) s += part[(w * 3 + seg) * 64 + cl];
                const int cc = (item % 144) * 64 + cl;
                MOD[(size_t)(l * 3 + seg) * 9216 + cc] = s + ka->in[5][l * 9216 + cc]; }
            __syncthreads();
        }
    }
    {
        KA();
        bf16_t* WB = (bf16_t*)(ws + WS_WB); float* CS = (float*)(ws + WS_CS); float* LBT = (float*)(ws + WS_LB); float* LAMV = (float*)(ws + WS_LAM);
        for (int idx = gtid; idx < 2 * 256 * 1024; idx += ngt) {
            const int n = idx & 1023, k = (idx >> 10) & 255, l = idx >> 18, g = k >> 6, c = k & 63;
            const float* pw = ka->in[23] + (size_t)l * 4 * 64 * 64 + (g * 64 + c) * 64;
            const float* psc = ka->in[24] + l * 256 + g * 64;
            const float* wp = ka->in[27] + (size_t)l * 256 * 1024 + (size_t)(g * 64) * 1024 + n;
            float s = 0.f;
            for (int d = 0; d < 64; ++d) s = __builtin_fmaf(pw[d] * psc[d], wp[(size_t)d * 1024], s);
            (WB + (size_t)l * WL_TOTAL + WL_PP)[(size_t)n * 256 + k] = (bf16_t)(pk2(s, 0.f) & 0xffffu);
        }
        for (int idx = gtid; idx < 4096; idx += ngt) {
            const int n = idx >> 4, j = idx & 15;
            const float invf = __builtin_exp2f(-(float)j * (13.287712379549449f / 16.f));
            const float ang = (float)n * invf;
            const double rev = (double)ang * 0.15915494309189535; const float fr = (float)(rev - __builtin_floor(rev));
            CS[n * 32 + j] = __builtin_amdgcn_cosf(fr); CS[n * 32 + 16 + j] = __builtin_amdgcn_sinf(fr);
        }
        for (int idx = gtid; idx < 1024; idx += ngt) {
            const int l = idx >> 9, dc = idx & 511;
            const float l0 = ka->in[21][dc], l1 = ka->in[21][512 + dc];
            LBT[idx] = (l == 0) ? 0.f : 1.f / (1.f + __expf(l0 - l1));
        }
        if (gtid < 2) {
            const int l = gtid; float s1 = 0.f, s2 = 0.f;
            for (int i = 0; i < 64; ++i) { s1 += ka->in[16][l * 64 + i] * ka->in[17][l * 64 + i]; s2 += ka->in[18][l * 64 + i] * ka->in[19][l * 64 + i]; }
            const float li = (l == 0) ? 0.2f : (0.8f - 0.6f * 0.7408182206817179f);
            LAMV[l * 2 + 0] = __expf(s1) - __expf(s2) + li; LAMV[l * 2 + 1] = 1.f - li;
        }
    }
    GSYNC_CG();
    TS(0);

#pragma unroll 1
    for (int l = 0; l < 2; ++l) {
#ifdef REP_SYNC
#pragma unroll 1
        for (int rs_ = 0; rs_ < 10; ++rs_) { GSYNC(); }
#endif
#pragma unroll 1
        for (int f = 0; f < 2; ++f) {
            {   KA(); const bool first = (l == 0 && f == 0);
                const float* in_lat = first ? ka->in[0] : ka->out; const float* in_ctx = first ? ka->in[2] : (const float*)(ws + WS_HC);
                norm_phase(in_lat, in_ctx, ka->in[f ? 8 : 6] + l * 1024, (const float*)(ws + WS_MOD) + (size_t)l * 3 * 9216, f ? 6 : 0, f ? 7 : 1, (bf16_t*)(ws + WS_XB), gw, ngw, lane); }
            GSYNC();
            TS(1);
            {   KA(); bf16_t* Wl = (bf16_t*)(ws + WS_WB) + (size_t)l * WL_TOTAL;
                pg8::Gemm g{(bf16_t*)(ws + WS_XB), Wl + (f ? WL_UP2 : WL_UP1), R, 5632, 1024}; pg8::StaticOrder S; S.init(R, 5632, G, bid); EpiUp E{(bf16_t*)(ws + WS_Z)};
                pg8::gemm_phase<EpiUp, pg8::StaticOrder, true, true>(lds, g, S, E); }
            GSYNC();
            TS(2);
            {   KA(); bf16_t* Wl = (bf16_t*)(ws + WS_WB) + (size_t)l * WL_TOTAL; const bool first = (l == 0 && f == 0);
                const float* in_lat = first ? ka->in[0] : ka->out; const float* in_ctx = first ? ka->in[2] : (const float*)(ws + WS_HC);
                pg8::Gemm g{(bf16_t*)(ws + WS_Z), Wl + (f ? WL_DN2 : WL_DN1), R, 1024, DFF}; pg8::StaticOrder S; S.init(R, 1024, G, bid);
                EpiRes E{in_lat, in_ctx, ka->out, (float*)(ws + WS_HC), (const float*)(ws + WS_MOD) + (size_t)l * 3 * 9216 + (f ? 8 : 2) * 1024, 0.5f};
                pg8::gemm_phase<EpiRes, pg8::StaticOrder, true, true>(lds, g, S, E); }
            GSYNC();
            TS(3);
            if (f == 1) break;
            {   KA();
                norm_phase(ka->out, (const float*)(ws + WS_HC), ka->in[7] + l * 1024, (const float*)(ws + WS_MOD) + (size_t)l * 3 * 9216, 3, 4, (bf16_t*)(ws + WS_XB), gw, ngw, lane); }
            GSYNC();
            TS(1);
#pragma unroll 1
            for (int part = 0; part < 2; ++part) {
                KA(); bf16_t* Wl = (bf16_t*)(ws + WS_WB) + (size_t)l * WL_TOTAL;
                pg8::Gemm g{(bf16_t*)(ws + WS_XB), Wl + WL_IN + (size_t)(part ? 1536 : 0) * 1024, R, part ? 1536 : 1024, 1024}; pg8::StaticOrder S; S.init(R, part ? 1536 : 1024, G, bid);
                EpiWin E{ws + WS_Z, (const float*)(ws + WS_CS), (const float*)(ws + WS_LB) + l * 512, part ? 6 : 0};
                pg8::gemm_phase<EpiWin, pg8::StaticOrder, true, true>(lds, g, S, E);
            }
            {   KA(); bf16_t* Wl = (bf16_t*)(ws + WS_WB) + (size_t)l * WL_TOTAL;
                pg8::Gemm g{Wl + WL_IN + (size_t)1024 * 1024, (bf16_t*)(ws + WS_XB), 512, R, 1024}; pg8::StaticOrder S; S.init(512, R, G, bid); EpiVT E{(bf16_t*)(ws + WS_Z + Z_VT)};
                pg8::gemm_phase<EpiVT, pg8::StaticOrder, true, true>(lds, g, S, E); }
            GSYNC();
            TS(4);
            {   KA(); pool_phase((const bf16_t*)(ws + WS_Z + Z_ZP), (bf16_t*)(ws + WS_O + O_MX), gtid, ngt); }
#ifdef REP_ATTN
            for (int rep_ = 0; rep_ < 2; ++rep_)
#endif
            {   KA();
                const float* LAMV = (const float*)(ws + WS_LAM);
                const float lam = LAMV[l * 2], post = LAMV[l * 2 + 1];
                const int nunits = 1024 + (l == 0 ? 16 : 0);
                for (int u = bid; u < nunits; u += G) {
                    int bh, qrow0, kt0, kt1;
                    if (u < 1024) { bh = u >> 7; qrow0 = (bh >> 2) * SEQ + (u & 127) * 128; kt0 = 0; kt1 = KEYS / 64; }
                    else { const int v = u - 1024; bh = v >> 1; qrow0 = NLAT + (bh >> 2) * CTXL + (v & 1) * 128; kt0 = SEQ / 64; kt1 = KEYS / 64; }
                    attn_unit(lds, (const bf16_t*)(ws + WS_Z + Z_Q), (const bf16_t*)(ws + WS_Z + Z_K), (const bf16_t*)(ws + WS_Z + Z_VT), (bf16_t*)(ws + WS_O + O_DA), ka->in[20] + l * 128,
                              bh >> 2, bh & 3, qrow0, kt0, kt1, lam, post, tid, wave, lane);
                }
            }
            GSYNC();
            TS(5);
#ifdef REP_HG
#pragma unroll 1
            for (int rep_ = 0; rep_ < 2; ++rep_) {
#else
            {
#endif
            {   KA(); hg_pass<false>((const float*)(ws + WS_Z + Z_HQ), (const float*)(ws + WS_Z + Z_FF), (const float*)(ws + WS_Z + Z_FB), (const bf16_t*)(ws + WS_Z + Z_HI),
                                     (float*)(ws + WS_CAR), (float*)(ws + WS_DK), (bf16_t*)(ws + WS_Z + Z_K), wave, lane, G); }
            GSYNC();
            TS(6);
            {   KA(); hg_carry((float*)(ws + WS_CAR), (const float*)(ws + WS_DK), gtid, ngt); }
            GSYNC();
            TS(7);
            {   KA(); hg_pass<true>((const float*)(ws + WS_Z + Z_HQ), (const float*)(ws + WS_Z + Z_FF), (const float*)(ws + WS_Z + Z_FB), (const bf16_t*)(ws + WS_Z + Z_HI),
                                    (float*)(ws + WS_CAR), (float*)(ws + WS_DK), (bf16_t*)(ws + WS_Z + Z_K), wave, lane, G); }
            GSYNC();
            TS(8);
            {   KA(); hg_readout((const bf16_t*)(ws + WS_Z + Z_K), (const bf16_t*)(ws + WS_Z + Z_HG), ka->in[22] + l * 64, (bf16_t*)(ws + WS_O + O_HG), gw, ngw, lane); }
            GSYNC();
            TS(9);
            }
            {   KA(); bf16_t* Wl = (bf16_t*)(ws + WS_WB) + (size_t)l * WL_TOTAL;
                pg8::Gemm g{(bf16_t*)(ws + WS_XB), Wl + WL_IN + (size_t)3072 * 1024, R, 3072, 1024}; pg8::StaticOrder S; S.init(R, 3072, G, bid); EpiG E{(bf16_t*)(ws + WS_Z)};
                pg8::gemm_phase<EpiG, pg8::StaticOrder, true, true>(lds, g, S, E); }
            GSYNC();
            TS(10);
#pragma unroll 1
            for (int gi = 0; gi < 3; ++gi) {
                KA(); bf16_t* Wl = (bf16_t*)(ws + WS_WB) + (size_t)l * WL_TOTAL;
                const bf16_t* A = (const bf16_t*)(ws + WS_O + ((gi == 0) ? O_DA : (gi == 1 ? O_HG : O_MX))); const int K = (gi == 0) ? 512 : 256;
                const bf16_t* Bt = Wl + ((gi == 0) ? WL_PA : (gi == 1 ? WL_PH : WL_PP));
                pg8::Gemm g{A, Bt, R, 1024, K}; pg8::StaticOrder S; S.init(R, 1024, G, bid); EpiProj E{(bf16_t*)(ws + WS_XB), (const bf16_t*)(ws + WS_Z), gi, gi == 0};
                pg8::gemm_phase<EpiProj, pg8::StaticOrder, true, true>(lds, g, S, E);
            }
            GSYNC();
            TS(11);
            {   KA(); bf16_t* Wl = (bf16_t*)(ws + WS_WB) + (size_t)l * WL_TOTAL;
                pg8::Gemm g{(bf16_t*)(ws + WS_XB), Wl + WL_O, R, 1024, 1024}; pg8::StaticOrder S; S.init(R, 1024, G, bid);
                EpiRes E{ka->out, (const float*)(ws + WS_HC), ka->out, (float*)(ws + WS_HC), (const float*)(ws + WS_MOD) + (size_t)l * 3 * 9216 + 5 * 1024, 1.0f};
                pg8::gemm_phase<EpiRes, pg8::StaticOrder, true, true>(lds, g, S, E); }
            GSYNC();
            TS(12);
        }
    }
    {   KA(); final_norm_phase(ka->out, ka->in[29], gw, ngw, lane); }
#ifdef PROBE_A
    GSYNC(); TS(1);
    if (blockIdx.x == 0) { KA(); const unsigned long long* tsb = (const unsigned long long*)(ws + WS_END);
        __syncthreads();
        const float va = (float)tsb[1 + PROBE_A] * 0.01f, vb = (float)tsb[1 + PROBE_B] * 0.01f;
        __syncthreads();
        if (tid == 0) ka->out[0] += va;
        for (int i = tid; i < 65536; i += NTHR) ka->out[(size_t)(i / 1024 + 8) * 1024 + (i & 1023)] += vb; }
#endif
}

extern "C" void kernel_launch(void* const* d_in, const int* in_sizes, int n_in, void* d_out, int out_size, void* d_ws, size_t ws_size, hipStream_t stream) {
    static int grid = 0;
    if (grid == 0) {
        if (n_in != 30 || out_size != NLAT * DM || ws_size < WS_TOTAL) { fprintf(stderr, "kernel_launch: unexpected shapes (n_in %d out %d ws %zu need %zu)\n", n_in, out_size, ws_size, (size_t)WS_TOTAL); grid = -1; return; }
        int dev = 0, cus = 0, per_cu = 0;
        (void)hipGetDevice(&dev);
        (void)hipDeviceGetAttribute(&cus, hipDeviceAttributeMultiprocessorCount, dev);
        if (hipFuncSetAttribute((const void*)fwd_kernel, hipFuncAttributeMaxDynamicSharedMemorySize, LDS_BYTES) != hipSuccess) { fprintf(stderr, "kernel_launch: hipFuncSetAttribute failed\n"); grid = -1; return; }
        if (hipOccupancyMaxActiveBlocksPerMultiprocessor(&per_cu, (const void*)fwd_kernel, NTHR, LDS_BYTES) != hipSuccess || per_cu < 1) { fprintf(stderr, "kernel_launch: occupancy query failed (%d)\n", per_cu); (void)hipGetLastError(); per_cu = 1; }
        if (per_cu > 1) per_cu = 1;
        grid = cus * per_cu;
    }
    if (grid < 0) return;
    if (hipMemsetAsync((unsigned char*)d_ws + WS_BAR, 0, (size_t)XCD_BAR_WORDS * 4, stream) != hipSuccess) { fprintf(stderr, "kernel_launch: memset failed\n"); return; }
    Args a{};
    for (int i = 0; i < 30; ++i) a.in[i] = (const float*)d_in[i];
    a.out = (float*)d_out; a.ws = (unsigned char*)d_ws;
    void* args[] = {&a};
    hipError_t e = hipLaunchCooperativeKernel((const void*)fwd_kernel, dim3(grid), dim3(NTHR), args, LDS_BYTES, stream);
    if (e != hipSuccess) fprintf(stderr, "cooperative launch failed: %s (grid %d)\n", hipGetErrorString(e), grid);
}
```

```cpp
#include <hip/hip_runtime.h>
#include <hip/hip_cooperative_groups.h>
#include <cstdio>
#include <cstdint>
namespace cg = cooperative_groups;
namespace pg8 {
#define PG8_LAS __attribute__((address_space(3)))
typedef unsigned short bf16_t;
typedef short bf16x8 __attribute__((ext_vector_type(8)));
typedef float f32x4 __attribute__((ext_vector_type(4)));
typedef unsigned u32x4 __attribute__((ext_vector_type(4)));
constexpr int BM = 256, BK = 64, HALF = 128, HTB = HALF * BK * 2  , STAGE_BYTES = 8 * HTB, NXCD = 8, WGM = 8;

__host__ __device__ __forceinline__ int lds_byte(int r, int c) { const int st = (r >> 4) * 2 + (c >> 5), rr = r & 15, cc = c & 31, ob = rr * 64 + cc * 2; return st * 1024 + (ob ^ (((ob >> 9) & 1) << 5)); }
__host__ __device__ __forceinline__ void stage_rc(int b, int& R, int& C) { const int st = b / 1024, sb = b % 1024, swz = sb ^ (((sb >> 9) & 1) << 5); R = (st >> 1) * 16 + swz / 64; C = (st & 1) * 32 + (swz % 64) / 2; }
__host__ __device__ __forceinline__ int perm32(int rho) { const int n = rho >> 4, i = rho & 15; return 8 * (i >> 2) + 4 * n + (i & 3); }

struct Unit { int pm, pn; int koff = 0; };
struct Gemm { const bf16_t* A; const bf16_t* Bt; int M, N, K; int ld = 0; };

struct StaticOrder {
    int nM, nN, nwg, G, c;
    __host__ __device__ void init(int M, int N, int G_, int c_) { nM = M / BM; nN = N / BM; nwg = nM * nN; G = G_; c = c_; }
    __host__ __device__ bool next(int i, Unit& u) const {
        const long L = (long)i * G + c; if (L >= nwg) return false;
        int wgid = (int)L; { const int q = nwg / NXCD, r = nwg % NXCD, xcd = wgid % NXCD, off = wgid / NXCD; wgid = (xcd < r ? xcd * (q + 1) : r * (q + 1) + (xcd - r) * q) + off; }
        const int nig = WGM * nN, gid = wgid / nig, fm = gid * WGM, gsz = (nM - fm) < WGM ? (nM - fm) : WGM;
        u.pm = fm + ((wgid % nig) % gsz); u.pn = (wgid % nig) / gsz; u.koff = 0; return true;
    }
    __device__ __forceinline__ void a_ready(const Unit&) const {}
    __device__ __forceinline__ void done(const Unit&) const {}
};

}
namespace pg8 {
template <class Epi, class Sched, bool ALIGN_EPI = false, bool SP2 = false>
__device__ __forceinline__ void gemm_phase(PG8_LAS unsigned char* lds, const Gemm g, const Sched& S, const Epi& E, int tid_in) {
    int tid_ = tid_in; asm volatile("" : "+v"(tid_)); const int tid = tid_, wid = __builtin_amdgcn_readfirstlane(tid >> 6), lane = tid & 63, wr = wid >> 2, wc = wid & 3, fr = lane & 15, fq = lane >> 4;
    const int K = g.ld ? g.ld : g.K, nt = g.K / BK;
    unsigned voffA[2], voffB[2];
#pragma unroll
    for (int i = 0; i < 2; ++i) { int R, C; stage_rc(tid * 16 + i * 8192, R, C); const int Rb = Epi::PERM ? ((R & ~31) + perm32(R & 31)) : R;
        voffA[i] = (unsigned)(R * K + C) * 2u; voffB[i] = (unsigned)(Rb * K + C) * 2u; }
    const size_t kstep = (size_t)(BK * 2);
    const size_t hstep = (size_t)HALF * K * 2;
    const size_t tstep = 2 * hstep;
    const unsigned ldsw = (unsigned)wid * 1024u;
    const int aoff = lds_byte(wr * 64 + fr, fq * 8), boff = lds_byte(wc * 32 + fr, fq * 8);
#define PG8_SA(b, h) (((b) * 2 + (h)) * HTB)
#define PG8_SB(b, h) ((4 + (b) * 2 + (h)) * HTB)
#define PG8_STAGE(bufoff, gbase, voff) do { _Pragma("unroll") for (int _i = 0; _i < 2; ++_i) \
        __builtin_amdgcn_global_load_lds((const unsigned*)((const char*)(gbase) + (voff)[_i]), (PG8_LAS unsigned*)(lds + (bufoff) + ldsw + _i * 8192), 16, 0, 0); } while (0)
#define PG8_LDA(dst, b, h) do { _Pragma("unroll") for (int m = 0; m < 4; ++m) _Pragma("unroll") for (int k = 0; k < 2; ++k) dst[m][k] = *(const PG8_LAS bf16x8*)(lds + PG8_SA(b, h) + aoff + m * 2048 + k * 1024); } while (0)
#define PG8_LDB(dst, b, h) do { _Pragma("unroll") for (int n = 0; n < 2; ++n) _Pragma("unroll") for (int k = 0; k < 2; ++k) dst[n][k] = *(const PG8_LAS bf16x8*)(lds + PG8_SB(b, h) + boff + n * 2048 + k * 1024); } while (0)
#define PG8_MMA(ai, bj, At, Bt) do { __builtin_amdgcn_s_setprio(1); _Pragma("unroll") for (int m = 0; m < 4; ++m) _Pragma("unroll") for (int n = 0; n < 2; ++n) _Pragma("unroll") for (int k = 0; k < 2; ++k) \
        acc[ai][bj][m][n] = __builtin_amdgcn_mfma_f32_16x16x32_bf16(Bt[n][k], At[m][k], acc[ai][bj][m][n], 0, 0, 0); __builtin_amdgcn_s_setprio(0); } while (0)
#define PG8_WAIT_V(n) asm volatile("s_waitcnt vmcnt(" #n ")" ::: "memory")
#define PG8_WAIT_L(n) asm volatile("s_waitcnt lgkmcnt(" #n ")" ::: "memory")
#define PG8_BAR __builtin_amdgcn_s_barrier()
#define PG8_SCHED __builtin_amdgcn_sched_barrier(0)
    Unit cur, nxt; int ui = 0;
    if (!S.next(0, cur)) return;
    f32x4 acc[2][2][4][2];
#pragma unroll
    for (int a = 0; a < 2; ++a)
#pragma unroll
        for (int b = 0; b < 2; ++b)
#pragma unroll
            for (int m = 0; m < 4; ++m)
#pragma unroll
                for (int n = 0; n < 2; ++n) acc[a][b][m][n] = (f32x4){0.f, 0.f, 0.f, 0.f};
    bf16x8 At[4][2], B0[2][2], B1[2][2];
    const char* cA = (const char*)g.A + (size_t)cur.pm * tstep + (size_t)cur.koff * 2; const char* cB = (const char*)g.Bt + (size_t)cur.pn * tstep + (size_t)cur.koff * 2;
    S.a_ready(cur);
    if constexpr (SP2) {
        PG8_STAGE(PG8_SB(0, 0), cB, voffB); PG8_STAGE(PG8_SB(0, 1), cB + hstep, voffB); PG8_STAGE(PG8_SA(0, 0), cA, voffA); PG8_STAGE(PG8_SA(0, 1), cA + hstep, voffA);
        if (wr == 1) PG8_BAR;
        PG8_WAIT_V(2); PG8_BAR;
        PG8_STAGE(PG8_SB(1, 0), cB + kstep, voffB); PG8_STAGE(PG8_SA(1, 0), cA + kstep, voffA); PG8_STAGE(PG8_SB(1, 1), cB + hstep + kstep, voffB);
        PG8_WAIT_V(6); PG8_BAR;
    } else {
        PG8_STAGE(PG8_SB(0, 0), cB, voffB); PG8_STAGE(PG8_SA(0, 0), cA, voffA); PG8_STAGE(PG8_SB(0, 1), cB + hstep, voffB); PG8_STAGE(PG8_SA(0, 1), cA + hstep, voffA);
        if (wr == 1) PG8_BAR;
        PG8_WAIT_V(4); PG8_BAR;
        PG8_STAGE(PG8_SB(1, 0), cB + kstep, voffB); PG8_STAGE(PG8_SA(1, 0), cA + kstep, voffA); PG8_STAGE(PG8_SB(1, 1), cB + hstep + kstep, voffB);
        PG8_WAIT_V(6); PG8_BAR;
    }
    for (;;) {
        const bool has_next = S.next(ui + 1, nxt);
        const char* nA = has_next ? (const char*)g.A + (size_t)nxt.pm * tstep + (size_t)nxt.koff * 2 : cA; const char* nB = has_next ? (const char*)g.Bt + (size_t)nxt.pn * tstep + (size_t)nxt.koff * 2 : cB;
        for (int t = 0; t < nt; t += 2) {
            const bool last = (t == nt - 2);
            const char* a1 = cA + (size_t)(t + 1) * kstep;
            const char* a2 = last ? nA : cA + (size_t)(t + 2) * kstep; const char* b2 = last ? nB : cB + (size_t)(t + 2) * kstep;
            const char* a3 = a2 + kstep; const char* b3 = b2 + kstep;
            if (last && has_next) S.a_ready(nxt);
            if constexpr (SP2) {
            PG8_LDB(B0, 0, 0); PG8_LDB(B1, 0, 1); PG8_SCHED; PG8_LDA(At, 0, 0); PG8_STAGE(PG8_SA(1, 1), a1 + hstep, voffA);
            PG8_WAIT_V(8); PG8_WAIT_L(0); PG8_BAR; PG8_MMA(0, 0, At, B0); PG8_MMA(0, 1, At, B1); PG8_BAR; PG8_SCHED;
            PG8_LDA(At, 0, 1); PG8_STAGE(PG8_SB(0, 0), b2, voffB); PG8_STAGE(PG8_SB(0, 1), b2 + hstep, voffB); PG8_STAGE(PG8_SA(0, 0), a2, voffA);
            PG8_WAIT_V(8); PG8_WAIT_L(0); PG8_BAR; PG8_MMA(1, 0, At, B0); PG8_MMA(1, 1, At, B1); PG8_BAR; PG8_SCHED;
            PG8_LDB(B0, 1, 0); PG8_LDB(B1, 1, 1); PG8_SCHED; PG8_LDA(At, 1, 0); PG8_STAGE(PG8_SA(0, 1), a2 + hstep, voffA);
            PG8_WAIT_V(8); PG8_WAIT_L(0); PG8_BAR; PG8_MMA(0, 0, At, B0); PG8_MMA(0, 1, At, B1); PG8_BAR; PG8_SCHED;
            PG8_LDA(At, 1, 1); PG8_STAGE(PG8_SB(1, 0), b3, voffB); PG8_STAGE(PG8_SB(1, 1), b3 + hstep, voffB); PG8_STAGE(PG8_SA(1, 0), a3, voffA);
            PG8_WAIT_V(8); PG8_WAIT_L(0); PG8_BAR; PG8_MMA(1, 0, At, B0); PG8_MMA(1, 1, At, B1); PG8_BAR; PG8_SCHED;
            } else {
            PG8_LDB(B0, 0, 0); PG8_SCHED; PG8_LDA(At, 0, 0); PG8_STAGE(PG8_SA(1, 1), a1 + hstep, voffA);
            PG8_WAIT_L(8); PG8_BAR; PG8_WAIT_L(0); PG8_MMA(0, 0, At, B0); PG8_BAR; PG8_SCHED;
            PG8_LDB(B1, 0, 1); PG8_STAGE(PG8_SB(0, 0), b2, voffB);
            PG8_BAR; PG8_WAIT_L(0); PG8_MMA(0, 1, At, B1); PG8_BAR;
            PG8_LDA(At, 0, 1); PG8_STAGE(PG8_SA(0, 0), a2, voffA);
            PG8_BAR; PG8_WAIT_L(0); PG8_MMA(1, 0, At, B0); PG8_BAR; PG8_SCHED;
            PG8_STAGE(PG8_SB(0, 1), b2 + hstep, voffB);
            PG8_WAIT_V(6); PG8_BAR; PG8_MMA(1, 1, At, B1); PG8_BAR;
            PG8_LDB(B0, 1, 0); PG8_SCHED; PG8_LDA(At, 1, 0); PG8_STAGE(PG8_SA(0, 1), a2 + hstep, voffA);
            PG8_WAIT_L(8); PG8_BAR; PG8_WAIT_L(0); PG8_MMA(0, 0, At, B0); PG8_BAR; PG8_SCHED;
            PG8_LDB(B1, 1, 1); PG8_STAGE(PG8_SB(1, 0), b3, voffB);
            PG8_BAR; PG8_WAIT_L(0); PG8_MMA(0, 1, At, B1); PG8_BAR;
            PG8_LDA(At, 1, 1); PG8_STAGE(PG8_SA(1, 0), a3, voffA);
            PG8_BAR; PG8_WAIT_L(0); PG8_MMA(1, 0, At, B0); PG8_BAR; PG8_SCHED;
            PG8_STAGE(PG8_SB(1, 1), b3 + hstep, voffB);
            PG8_WAIT_V(6); PG8_BAR; PG8_MMA(1, 1, At, B1); PG8_BAR;
            }
        }
        if constexpr (ALIGN_EPI) { if (wr == 0) PG8_BAR; }
        if constexpr (!Epi::AFTER_DRAIN) { E(acc, cur, wr, wc, fr, fq); S.done(cur); }
        if (!has_next) break;
#pragma unroll
        for (int a = 0; a < 2; ++a)
#pragma unroll
            for (int b = 0; b < 2; ++b)
#pragma unroll
                for (int m = 0; m < 4; ++m)
#pragma unroll
                    for (int n = 0; n < 2; ++n) acc[a][b][m][n] = (f32x4){0.f, 0.f, 0.f, 0.f};
        cur = nxt; cA = nA; cB = nB; ++ui;
        if constexpr (ALIGN_EPI) { if (wr == 1) PG8_BAR; }
    }
    PG8_WAIT_V(0);
    if constexpr (!ALIGN_EPI) { if (wr == 0) PG8_BAR; }
    PG8_BAR;
    if constexpr (Epi::AFTER_DRAIN) { E.fused(acc, cur, wr, wc, fr, fq, lds, wid, lane); S.done(cur); }
#undef PG8_SA
#undef PG8_SB
#undef PG8_STAGE
#undef PG8_LDA
#undef PG8_LDB
#undef PG8_MMA
#undef PG8_WAIT_V
#undef PG8_WAIT_L
#undef PG8_BAR
#undef PG8_SCHED
}
}

using pg8::bf16_t; using pg8::bf16x8; using pg8::f32x4; using pg8::u32x4; using pg8::Unit;
typedef float f32x16 __attribute__((ext_vector_type(16)));
typedef float f32x2v __attribute__((ext_vector_type(2)));
typedef __bf16 bf16x2v __attribute__((ext_vector_type(2)));
typedef unsigned u32x2 __attribute__((ext_vector_type(2)));
#define LAS __attribute__((address_space(3)))

constexpr int DM = 1024, NBATCH = 2, SEQ = 16384, CTXL = 256;
constexpr int NLAT = NBATCH * SEQ, NCTX = NBATCH * CTXL, R = NLAT + NCTX;
constexpr int DFF = 2816, KEYS = SEQ + CTXL;
constexpr float EPS = 1e-6f;
constexpr float C2 = 0.125f * 1.4426950408889634f;
constexpr int NTHR = 512;
constexpr int LDS_BYTES = 135168;
constexpr int HG_SEG = 128, HG_STEPS = KEYS / HG_SEG;

constexpr size_t WL_UP1 = 0, WL_DN1 = WL_UP1 + (size_t)5632 * 1024, WL_UP2 = WL_DN1 + (size_t)1024 * 2816, WL_DN2 = WL_UP2 + (size_t)5632 * 1024,
                 WL_IN = WL_DN2 + (size_t)1024 * 2816, WL_PA = WL_IN + (size_t)6144 * 1024, WL_PH = WL_PA + (size_t)1024 * 512, WL_PP = WL_PH + (size_t)1024 * 256,
                 WL_O = WL_PP + (size_t)1024 * 256, WL_TOTAL = WL_O + (size_t)1024 * 1024;
constexpr size_t WS_WB = 0;
constexpr size_t WS_XB = WS_WB + 2 * WL_TOTAL * 2;
constexpr size_t WS_Z = WS_XB + (size_t)R * 1024 * 2;
constexpr size_t Z_VT = 0, Z_HQ = Z_VT + (size_t)R * 512 * 2, Z_FF = Z_HQ + (size_t)R * 256 * 4, Z_FB = Z_FF + (size_t)R * 256 * 4, Z_HI = Z_FB + (size_t)R * 256 * 4,
                 Z_ZP = Z_HI + (size_t)R * 256 * 2, Z_Q = Z_ZP + (size_t)R * 256 * 2, Z_K = Z_Q + (size_t)R * 512 * 2, Z_HG = Z_K + (size_t)R * 512 * 2, Z_END = Z_HG + (size_t)R * 256 * 2;
static_assert((size_t)R * 3072 * 2 <= Z_K, "gate buffer must not reach k / odir / hgate");
static_assert((size_t)R * DFF * 2 <= Z_END, "act fits Z");
constexpr size_t WS_O = WS_Z + Z_END;
constexpr size_t O_DA = 0, O_HG = O_DA + (size_t)R * 512 * 2, O_MX = O_HG + (size_t)R * 256 * 2, O_END = O_MX + (size_t)R * 256 * 2;
constexpr size_t WS_CAR = WS_O + O_END;
constexpr size_t WS_DK = WS_CAR + (size_t)16 * HG_SEG * 4096 * 4;
constexpr size_t WS_HC = WS_DK + (size_t)16 * HG_SEG * 64 * 4;
constexpr size_t WS_MOD = WS_HC + (size_t)NCTX * 1024 * 4;
constexpr size_t WS_CS = WS_MOD + (size_t)2 * 3 * 9216 * 4;
constexpr size_t WS_LB = WS_CS + (size_t)256 * 32 * 4;
constexpr size_t WS_LAM = WS_LB + (size_t)2 * 2 * 256 * 4;
constexpr size_t WS_END = WS_LAM + 256;
static_assert(WS_END <= (size_t)512 * 1024 * 1024, "workspace");

__device__ __forceinline__ unsigned pk2(float lo, float hi) { f32x2v v = {lo, hi}; bf16x2v b = __builtin_convertvector(v, bf16x2v); return __builtin_bit_cast(unsigned, b); }
__device__ __forceinline__ float bf2f(unsigned short u) { return __builtin_bit_cast(float, (unsigned)u << 16); }
__device__ __forceinline__ float bflo(unsigned u) { return __builtin_bit_cast(float, u << 16); }
__device__ __forceinline__ float bfhi(unsigned u) { return __builtin_bit_cast(float, u & 0xffff0000u); }
__device__ __forceinline__ float ex2(float x) { return __builtin_amdgcn_exp2f(x); }
__device__ __forceinline__ float rcpf_(float x) { return __builtin_amdgcn_rcpf(x); }
__device__ __forceinline__ float sigm(float x) { return rcpf_(1.f + ex2(-1.4426950408889634f * x)); }
__device__ __forceinline__ float siluf(float x) { return x * sigm(x); }
__device__ __forceinline__ float shx(float v, int o, int lane) { return __builtin_bit_cast(float, __builtin_amdgcn_ds_bpermute((lane ^ o) << 2, __builtin_bit_cast(int, v))); }
__device__ __forceinline__ float swap32(float v) { auto rr = __builtin_amdgcn_permlane32_swap(__builtin_bit_cast(unsigned, v), __builtin_bit_cast(unsigned, v), false, false);
    const float a = __builtin_bit_cast(float, rr[0]), b = __builtin_bit_cast(float, rr[1]); return (a == v) ? b : a; }
__device__ __forceinline__ float wave_sum(float v, int lane) {
#pragma unroll
    for (int o = 1; o < 64; o <<= 1) v += shx(v, o, lane);
    return v;
}
#define LDS_WAIT() asm volatile("s_waitcnt lgkmcnt(0)" ::: "memory")

struct EpiUp {
    static constexpr bool PERM = true, AFTER_DRAIN = false;
    bf16_t* act;
    __device__ __forceinline__ void operator()(const f32x4 (&acc)[2][2][4][2], const Unit& u, int wr, int wc, int fr, int fq) const {
        const int row0 = u.pm * 256 + wr * 64 + fr, col0 = u.pn * 128 + wc * 32 + 8 * fq;
#pragma unroll
        for (int ai = 0; ai < 2; ++ai)
#pragma unroll
            for (int m = 0; m < 4; ++m) {
                const int row = row0 + ai * 128 + m * 16;
                const f32x4 a0 = acc[ai][0][m][0], a1 = acc[ai][0][m][1], b0 = acc[ai][1][m][0], b1 = acc[ai][1][m][1];
                u32x4 w;
                w.x = pk2(siluf(a0[0]) * b0[0], siluf(a0[1]) * b0[1]); w.y = pk2(siluf(a0[2]) * b0[2], siluf(a0[3]) * b0[3]);
                w.z = pk2(siluf(a1[0]) * b1[0], siluf(a1[1]) * b1[1]); w.w = pk2(siluf(a1[2]) * b1[2], siluf(a1[3]) * b1[3]);
                *(u32x4*)(act + (size_t)row * DFF + col0) = w;
            }
    }
};
struct EpiRes {
    static constexpr bool PERM = true, AFTER_DRAIN = false;
    const float* in_lat; const float* in_ctx; float* out_lat; float* out_ctx; const float* gate; float coef;
    __device__ __forceinline__ void operator()(const f32x4 (&acc)[2][2][4][2], const Unit& u, int wr, int wc, int fr, int fq) const {
        const int row0 = u.pm * 256 + wr * 64 + fr, col0 = u.pn * 256 + wc * 32 + 8 * fq;
        const int seg = (u.pm < 64) ? 0 : (u.pm < 128 ? 1 : 2);
        f32x4 gv[2][2];
#pragma unroll
        for (int bj = 0; bj < 2; ++bj)
#pragma unroll
            for (int n = 0; n < 2; ++n) gv[bj][n] = *(const f32x4*)(gate + seg * 9216 + col0 + bj * 128 + 4 * n) * coef;
#pragma unroll
        for (int ai = 0; ai < 2; ++ai)
#pragma unroll
            for (int m = 0; m < 4; ++m) {
                const int row = row0 + ai * 128 + m * 16;
                const float* ip; float* op;
                if (row < NLAT) { ip = in_lat + (size_t)row * DM; op = out_lat + (size_t)row * DM; }
                else { ip = in_ctx + (size_t)(row - NLAT) * DM; op = out_ctx + (size_t)(row - NLAT) * DM; }
#pragma unroll
                for (int bj = 0; bj < 2; ++bj)
#pragma unroll
                    for (int n = 0; n < 2; ++n) {
                        const int c = col0 + bj * 128 + 4 * n;
                        f32x4 v = *(const f32x4*)(ip + c);
                        v = v + gv[bj][n] * acc[ai][bj][m][n];
                        *(f32x4*)(op + c) = v;
                    }
            }
    }
};
struct SplitKOrder {
    int nunits, G, c, kc;
    __device__ void init(int nparts, int kc_, int G_, int c_) { nunits = nparts * 8; G = G_; c = c_; kc = kc_; }
    __device__ bool next(int i, Unit& u) const {
        const int L = i * G + c; if (L >= nunits) return false;
        const int part = L >> 3, r = L & 7; u.pm = r >> 2; u.pn = r & 3; u.koff = part * kc; return true;
    }
    __device__ __forceinline__ void a_ready(const Unit&) const {}
    __device__ __forceinline__ void done(const Unit&) const {}
};
struct EpiPart {
    static constexpr bool PERM = true, AFTER_DRAIN = false;
    float* P; const float* gate; float coef;
    __device__ __forceinline__ void operator()(const f32x4 (&acc)[2][2][4][2], const Unit& u, int wr, int wc, int fr, int fq) const {
        unsigned z_ = 0u; asm volatile("" : "+s"(z_));
        const int lane_ = (int)__builtin_amdgcn_mbcnt_hi(~0u, __builtin_amdgcn_mbcnt_lo(~0u, z_)), fr_ = lane_ & 15, fq_ = lane_ >> 4;
        const int row0 = u.pm * 256 + wr * 64 + fr_, col0 = u.pn * 256 + wc * 32 + 8 * fq_;
        float* Pp = P + (size_t)(u.koff >> 8) * NCTX * DM;
        f32x4 gv[2][2];
#pragma unroll
        for (int bj = 0; bj < 2; ++bj)
#pragma unroll
            for (int n = 0; n < 2; ++n) gv[bj][n] = *(const f32x4*)(gate + 2 * 9216 + col0 + bj * 128 + 4 * n) * coef;
#pragma unroll
        for (int ai = 0; ai < 2; ++ai)
#pragma unroll
            for (int m = 0; m < 4; ++m) {
                float* op = Pp + (size_t)(row0 + ai * 128 + m * 16) * DM;
#pragma unroll
                for (int bj = 0; bj < 2; ++bj)
#pragma unroll
                    for (int n = 0; n < 2; ++n) *(f32x4*)(op + col0 + bj * 128 + 4 * n) = gv[bj][n] * acc[ai][bj][m][n];
            }
    }
};
struct EpiWin {
    static constexpr bool PERM = true, AFTER_DRAIN = false;
    unsigned char* Z; const float* cs; const float* lb; int pn_off;
    __device__ __forceinline__ void operator()(const f32x4 (&acc)[2][2][4][2], const Unit& u, int wr, int wc, int fr, int fq) const {
        const int t = u.pn + pn_off;
        const int row0 = u.pm * 256 + wr * 64 + fr, cin = wc * 32 + 8 * fq;
        if (t < 4) {
            bf16_t* dst = (bf16_t*)(Z + ((t < 2) ? Z_Q : Z_K)); const float sc = (t < 2) ? C2 : 1.f; const int cb = (t & 1) * 256;
#pragma unroll
            for (int ai = 0; ai < 2; ++ai)
#pragma unroll
                for (int m = 0; m < 4; ++m) {
                    const int row = row0 + ai * 128 + m * 16;
                    f32x4 cv = {1.f, 1.f, 1.f, 1.f}, sv = {0.f, 0.f, 0.f, 0.f};
                    if (row < NLAT) { const int ts = row & (SEQ - 1); const int pos = (wc & 1) ? (ts & 63) : (ts >> 6);
                        cv = *(const f32x4*)(cs + pos * 32 + 4 * fq); sv = *(const f32x4*)(cs + pos * 32 + 16 + 4 * fq); }
#pragma unroll
                    for (int bj = 0; bj < 2; ++bj) {
                        const f32x4 x1 = acc[ai][bj][m][0], x2 = acc[ai][bj][m][1];
                        const f32x4 o1 = (x1 * cv - x2 * sv) * sc, o2 = (x1 * sv + x2 * cv) * sc;
                        u32x4 w; w.x = pk2(o1[0], o1[1]); w.y = pk2(o1[2], o1[3]); w.z = pk2(o2[0], o2[1]); w.w = pk2(o2[2], o2[3]);
                        *(u32x4*)(dst + (size_t)row * 512 + cb + bj * 128 + cin) = w;
                    }
                }
        } else if (t < 6) {
            bf16_t* vT = (bf16_t*)(Z + Z_VT);
#pragma unroll
            for (int ai = 0; ai < 2; ++ai)
#pragma unroll
                for (int m = 0; m < 4; ++m) {
                    const int row = row0 + ai * 128 + m * 16;
                    int b, key;
                    if (row < NLAT) { b = row >> 14; key = row & (SEQ - 1); } else { b = (row - NLAT) >> 8; key = SEQ + ((row - NLAT) & (CTXL - 1)); }
#pragma unroll
                    for (int bj = 0; bj < 2; ++bj) {
                        bf16_t* dp = vT + (size_t)(b * 512 + (t - 4) * 256 + bj * 128 + cin) * KEYS + key;
#pragma unroll
                        for (int n = 0; n < 2; ++n)
#pragma unroll
                            for (int i = 0; i < 4; i += 2) {
                                const unsigned w = pk2(acc[ai][bj][m][n][i], acc[ai][bj][m][n][i + 1]);
                                dp[(size_t)(4 * n + i) * KEYS] = (bf16_t)(w & 0xffffu); dp[(size_t)(4 * n + i + 1) * KEYS] = (bf16_t)(w >> 16);
                            }
                    }
                }
        } else if (t <= 8) {
            float* dst = (float*)(Z + ((t == 6) ? Z_HQ : (t == 7 ? Z_FF : Z_FB)));
            const float* lbp = lb + ((t == 8) ? 256 : 0);
#pragma unroll
            for (int bj = 0; bj < 2; ++bj)
#pragma unroll
                for (int n = 0; n < 2; ++n) {
                    f32x4 lbv = *(const f32x4*)(lbp + bj * 128 + cin + 4 * n);
                    f32x4 om = 1.f - lbv;
#pragma unroll
                    for (int ai = 0; ai < 2; ++ai)
#pragma unroll
                        for (int m = 0; m < 4; ++m) {
                            const int row = row0 + ai * 128 + m * 16;
                            const f32x4 z = acc[ai][bj][m][n];
                            f32x4 sg; sg[0] = sigm(z[0]); sg[1] = sigm(z[1]); sg[2] = sigm(z[2]); sg[3] = sigm(z[3]);
                            const f32x4 o = (t == 6) ? z * sg : lbv + om * sg;
                            *(f32x4*)(dst + (size_t)row * 256 + bj * 128 + cin + 4 * n) = o;
                        }
                }
        } else {
            bf16_t* dst = (bf16_t*)(Z + ((t == 9) ? Z_HI : (t == 10 ? Z_HG : Z_ZP)));
#pragma unroll
            for (int ai = 0; ai < 2; ++ai)
#pragma unroll
                for (int m = 0; m < 4; ++m) {
                    const int row = row0 + ai * 128 + m * 16;
#pragma unroll
                    for (int bj = 0; bj < 2; ++bj) {
                        f32x4 v0 = acc[ai][bj][m][0], v1 = acc[ai][bj][m][1];
                        if (t == 10) { v0[0] = siluf(v0[0]); v0[1] = siluf(v0[1]); v0[2] = siluf(v0[2]); v0[3] = siluf(v0[3]); v1[0] = siluf(v1[0]); v1[1] = siluf(v1[1]); v1[2] = siluf(v1[2]); v1[3] = siluf(v1[3]); }
                        u32x4 w; w.x = pk2(v0[0], v0[1]); w.y = pk2(v0[2], v0[3]); w.z = pk2(v1[0], v1[1]); w.w = pk2(v1[2], v1[3]);
                        *(u32x4*)(dst + (size_t)row * 256 + bj * 128 + cin) = w;
                    }
                }
        }
    }
};
struct EpiVT {
    static constexpr bool PERM = true, AFTER_DRAIN = false;
    bf16_t* vT;
    __device__ __forceinline__ void operator()(const f32x4 (&acc)[2][2][4][2], const Unit& u, int wr, int wc, int fr, int fq) const {
        const int e0 = u.pm * 256 + wr * 64 + fr;
        int b, key0;
        if (u.pn < 64) { b = 0; key0 = u.pn * 256; } else if (u.pn < 128) { b = 1; key0 = (u.pn - 64) * 256; } else { b = u.pn - 128; key0 = SEQ; }
        const int kc = key0 + wc * 32 + 8 * fq;
#pragma unroll
        for (int ai = 0; ai < 2; ++ai)
#pragma unroll
            for (int m = 0; m < 4; ++m) {
                const int e = e0 + ai * 128 + m * 16;
#pragma unroll
                for (int bj = 0; bj < 2; ++bj) {
                    const f32x4 v0 = acc[ai][bj][m][0], v1 = acc[ai][bj][m][1];
                    u32x4 w; w.x = pk2(v0[0], v0[1]); w.y = pk2(v0[2], v0[3]); w.z = pk2(v1[0], v1[1]); w.w = pk2(v1[2], v1[3]);
                    *(u32x4*)(vT + (size_t)(b * 512 + e) * KEYS + kc + bj * 128) = w;
                }
            }
    }
};
struct EpiG {
    static constexpr bool PERM = true, AFTER_DRAIN = false;
    bf16_t* G;
    __device__ __forceinline__ void operator()(const f32x4 (&acc)[2][2][4][2], const Unit& u, int wr, int wc, int fr, int fq) const {
        const int row0 = u.pm * 256 + wr * 64 + fr, col0 = u.pn * 256 + wc * 32 + 8 * fq;
#pragma unroll
        for (int ai = 0; ai < 2; ++ai)
#pragma unroll
            for (int m = 0; m < 4; ++m) {
                const int row = row0 + ai * 128 + m * 16;
#pragma unroll
                for (int bj = 0; bj < 2; ++bj) {
                    const f32x4 v0 = acc[ai][bj][m][0], v1 = acc[ai][bj][m][1];
                    u32x4 w; w.x = pk2(sigm(v0[0]), sigm(v0[1])); w.y = pk2(sigm(v0[2]), sigm(v0[3])); w.z = pk2(sigm(v1[0]), sigm(v1[1])); w.w = pk2(sigm(v1[2]), sigm(v1[3]));
                    *(u32x4*)(G + (size_t)row * 3072 + col0 + bj * 128) = w;
                }
            }
    }
};
struct EpiProj {
    static constexpr bool PERM = true, AFTER_DRAIN = false;
    bf16_t* y; const bf16_t* G; int gi; int first;
    __device__ __forceinline__ void operator()(const f32x4 (&acc)[2][2][4][2], const Unit& u, int wr, int wc, int fr, int fq) const {
        const int row0 = u.pm * 256 + wr * 64 + fr, col0 = u.pn * 256 + wc * 32 + 8 * fq;
#pragma unroll
        for (int ai = 0; ai < 2; ++ai)
#pragma unroll
            for (int m = 0; m < 4; ++m) {
                const int row = row0 + ai * 128 + m * 16;
#pragma unroll
                for (int bj = 0; bj < 2; ++bj) {
                    const int c = col0 + bj * 128;
                    const u32x4 g = *(const u32x4*)(G + (size_t)row * 3072 + gi * 1024 + c);
                    u32x4 yo = {0u, 0u, 0u, 0u};
                    if (!first) yo = *(const u32x4*)(y + (size_t)row * 1024 + c);
                    const f32x4 v0 = acc[ai][bj][m][0], v1 = acc[ai][bj][m][1];
                    u32x4 w;
                    w.x = pk2(bflo(yo.x) + bflo(g.x) * v0[0], bfhi(yo.x) + bfhi(g.x) * v0[1]);
                    w.y = pk2(bflo(yo.y) + bflo(g.y) * v0[2], bfhi(yo.y) + bfhi(g.y) * v0[3]);
                    w.z = pk2(bflo(yo.z) + bflo(g.z) * v1[0], bfhi(yo.z) + bfhi(g.z) * v1[1]);
                    w.w = pk2(bflo(yo.w) + bflo(g.w) * v1[2], bfhi(yo.w) + bfhi(g.w) * v1[3]);
                    *(u32x4*)(y + (size_t)row * 1024 + c) = w;
                }
            }
    }
};

__device__ __forceinline__ int map_row(int mode, int n) {
    if (mode == 1) return 256 * (n >> 7) + (n & 127);
    if (mode == 2) return 256 * (n >> 7) + 128 + (n & 127);
    if (mode == 3) return (n < 1024) ? ((n & ~31) + 8 * ((n & 15) >> 2) + 4 * ((n >> 4) & 1) + (n & 3)) : n;
    return n;
}
__device__ __forceinline__ void transpose_item(const float* W, int K, int N, bf16_t* WT, int mode, LAS float* scr, int item, int lane) {
    const int nblk = N / 32, kb = item / nblk, nb = item % nblk, k0 = 64 * kb, n0 = 32 * nb;
#pragma unroll 8
    for (int i = 0; i < 32; ++i) { const int kk = 2 * i + (lane >> 5); scr[kk * 33 + (lane & 31)] = W[(size_t)(k0 + kk) * N + n0 + (lane & 31)]; }
    LDS_WAIT(); asm volatile("" ::: "memory");
    const int c = lane & 7;
#pragma unroll
    for (int j = 0; j < 4; ++j) { const int n = (lane >> 3) + 8 * j; const LAS float* s = scr + (8 * c) * 33 + n;
        u32x4 o; o.x = pk2(s[0 * 33], s[1 * 33]); o.y = pk2(s[2 * 33], s[3 * 33]); o.z = pk2(s[4 * 33], s[5 * 33]); o.w = pk2(s[6 * 33], s[7 * 33]);
        *(u32x4*)(WT + (size_t)map_row(mode, n0 + n) * K + k0 + 8 * c) = o; }
    LDS_WAIT(); asm volatile("" ::: "memory");
}

__device__ __forceinline__ void norm_phase(const float* in_lat, const float* in_ctx, const float* gain, const float* modl, int shi, int sci, bf16_t* outp, int gw, int ngw, int lane,
                                           const float* part, int nparts, float* hc_out) {
    f32x4 gv[4];
#pragma unroll
    for (int j = 0; j < 4; ++j) gv[j] = *(const f32x4*)(gain + 4 * lane + 256 * j);
    for (int row = gw; row < R; row += ngw) {
        const float* ip = (row < NLAT) ? in_lat + (size_t)row * DM : in_ctx + (size_t)(row - NLAT) * DM;
        const int seg = (row < SEQ) ? 0 : (row < NLAT ? 1 : 2);
        const float* sh = modl + seg * 9216 + shi * 1024; const float* sc = modl + seg * 9216 + sci * 1024;
        f32x4 v[4]; float ss = 0.f;
#pragma unroll
        for (int j = 0; j < 4; ++j) v[j] = *(const f32x4*)(ip + 4 * lane + 256 * j);
        if (row >= NLAT && nparts > 0) {
            for (int p = 0; p < nparts; ++p) {
                const float* pp = part + ((size_t)p * NCTX + (row - NLAT)) * DM;
#pragma unroll
                for (int j = 0; j < 4; ++j) v[j] = v[j] + *(const f32x4*)(pp + 4 * lane + 256 * j);
            }
#pragma unroll
            for (int j = 0; j < 4; ++j) *(f32x4*)(hc_out + (size_t)(row - NLAT) * DM + 4 * lane + 256 * j) = v[j];
        }
#pragma unroll
        for (int j = 0; j < 4; ++j) ss += (v[j][0] * v[j][0] + v[j][1] * v[j][1]) + (v[j][2] * v[j][2] + v[j][3] * v[j][3]);
        ss = wave_sum(ss, lane);
        const float rstd = 1.0f / sqrtf(ss * (1.f / DM) + EPS);
#pragma unroll
        for (int j = 0; j < 4; ++j) {
            const f32x4 s4 = *(const f32x4*)(sc + 4 * lane + 256 * j), h4 = *(const f32x4*)(sh + 4 * lane + 256 * j);
            const f32x4 y = v[j] * rstd * gv[j] * (s4 + 1.f) + h4;
            u32x2 w; w.x = pk2(y[0], y[1]); w.y = pk2(y[2], y[3]);
            *(u32x2*)(outp + (size_t)row * DM + 4 * lane + 256 * j) = w;
        }
    }
}
__device__ __forceinline__ void final_norm_phase(float* out, const float* gain, int gw, int ngw, int lane) {
    f32x4 gv[4];
#pragma unroll
    for (int j = 0; j < 4; ++j) gv[j] = *(const f32x4*)(gain + 4 * lane + 256 * j);
    for (int row = gw; row < NLAT; row += ngw) {
        float* ip = out + (size_t)row * DM;
        f32x4 v[4]; float ss = 0.f;
#pragma unroll
        for (int j = 0; j < 4; ++j) { v[j] = *(const f32x4*)(ip + 4 * lane + 256 * j); ss += (v[j][0] * v[j][0] + v[j][1] * v[j][1]) + (v[j][2] * v[j][2] + v[j][3] * v[j][3]); }
        ss = wave_sum(ss, lane);
        const float rstd = 1.0f / sqrtf(ss * (1.f / DM) + EPS);
#pragma unroll
        for (int j = 0; j < 4; ++j) *(f32x4*)(ip + 4 * lane + 256 * j) = v[j] * rstd * gv[j];
    }
}
__device__ __forceinline__ void pool_phase(const bf16_t* zp, bf16_t* mx, int gtid, int ngt) {
    for (int it = gtid; it < R * 32; it += ngt) {
        const int row = it >> 5, ch = (it & 31) * 8, g = ch >> 6, hw = 1 << g;
        int base, n;
        if (row < NLAT) { base = row & ~(SEQ - 1); n = SEQ; } else { base = NLAT + ((row - NLAT) & ~(CTXL - 1)); n = CTXL; }
        const int t = row - base, lo = (t - hw > 0) ? t - hw : 0, hi = (t + hw < n) ? t + hw : n;
        float s[8];
#pragma unroll
        for (int i = 0; i < 8; ++i) s[i] = 0.f;
        for (int j = lo; j < hi; ++j) {
            const u32x4 v = *(const u32x4*)(zp + (size_t)(base + j) * 256 + ch);
            s[0] += bflo(v.x); s[1] += bfhi(v.x); s[2] += bflo(v.y); s[3] += bfhi(v.y); s[4] += bflo(v.z); s[5] += bfhi(v.z); s[6] += bflo(v.w); s[7] += bfhi(v.w);
        }
        const float inv = 1.f / (float)(hi - lo);
        const u32x4 c = *(const u32x4*)(zp + (size_t)row * 256 + ch);
        u32x4 w;
        w.x = pk2(s[0] * inv - bflo(c.x), s[1] * inv - bfhi(c.x)); w.y = pk2(s[2] * inv - bflo(c.y), s[3] * inv - bfhi(c.y));
        w.z = pk2(s[4] * inv - bflo(c.z), s[5] * inv - bfhi(c.z)); w.w = pk2(s[6] * inv - bflo(c.w), s[7] * inv - bfhi(c.w));
        *(u32x4*)(mx + (size_t)row * 256 + ch) = w;
    }
}

__device__ __forceinline__ int hg_row(int dir, int b, int step) {
    if (step < CTXL) { const int t = dir ? (CTXL - 1 - step) : step; return NLAT + b * CTXL + t; }
    int t = step - CTXL; if (dir) t = SEQ - 1 - t; return b * SEQ + t;
}
template <bool OUT>
__device__ __forceinline__ void hg_pass(const float* hq, const float* ff, const float* fb, const bf16_t* hi, float* carry, float* dk, bf16_t* odir, int wave, int lane, int G) {
    for (int item = blockIdx.x + G * wave; item < 16 * HG_SEG; item += G * 8) {
        const int s = item / HG_SEG, j = item % HG_SEG, dir = s >> 3, b = (s >> 2) & 1, h = s & 3;
        const float* fbase = dir ? fb : ff;
        f32x2v S[32];
#pragma unroll
        for (int k = 0; k < 32; ++k) { S[k][0] = OUT ? carry[((size_t)item * 64 + 2 * k) * 64 + lane] : 0.f; S[k][1] = OUT ? carry[((size_t)item * 64 + 2 * k + 1) * 64 + lane] : 0.f; }
        float dl = 1.f;
        const int st0 = j * HG_STEPS, st1 = st0 + HG_STEPS;
        constexpr int HG_PF = 8;
        float ivb[HG_PF], fvb[HG_PF], qvb[HG_PF];
#pragma unroll
        for (int u = 0; u < HG_PF; ++u) {
            const int stl = (st0 + u < st1) ? st0 + u : st1 - 1;
            const size_t off = (size_t)hg_row(dir, b, stl) * 256 + h * 64 + lane;
            ivb[u] = bf2f(hi[off]); fvb[u] = fbase[off]; qvb[u] = OUT ? hq[off] : 0.f;
        }
        for (int sb = st0; sb < st1; sb += HG_PF) {
#pragma unroll
            for (int u = 0; u < HG_PF; ++u) {
                const int st = sb + u;
                if (st < st1) {
                    const float iv = ivb[u], fv = fvb[u], qv = qvb[u];
                    const size_t offc = (size_t)hg_row(dir, b, st) * 256 + h * 64 + lane;
                    { const int stn = (st + HG_PF < st1) ? st + HG_PF : st1 - 1;
                      const size_t off = (size_t)hg_row(dir, b, stn) * 256 + h * 64 + lane;
                      ivb[u] = bf2f(hi[off]); fvb[u] = fbase[off]; if (OUT) qvb[u] = hq[off]; }
                    if (!OUT) dl *= fv;
                    f32x2v o2 = {0.f, 0.f};
                    const f32x2v iv2 = {iv, iv};
                    const int fvi = __builtin_bit_cast(int, fv), qvi = __builtin_bit_cast(int, qv);
#pragma unroll
                    for (int k = 0; k < 32; ++k) {
                        f32x2v f2; f2[0] = __builtin_bit_cast(float, __builtin_amdgcn_readlane(fvi, 2 * k)); f2[1] = __builtin_bit_cast(float, __builtin_amdgcn_readlane(fvi, 2 * k + 1));
                        const f32x2v d2 = S[k] - iv2;
                        S[k] = __builtin_elementwise_fma(f2, d2, iv2);
                        if (OUT) { f32x2v q2; q2[0] = __builtin_bit_cast(float, __builtin_amdgcn_readlane(qvi, 2 * k)); q2[1] = __builtin_bit_cast(float, __builtin_amdgcn_readlane(qvi, 2 * k + 1));
                            o2 = __builtin_elementwise_fma(q2, S[k], o2); }
                    }
                    if (OUT) odir[(size_t)dir * R * 256 + offc] = (bf16_t)(pk2(o2[0] + o2[1], 0.f) & 0xffffu);
                }
            }
        }
        if (!OUT) {
#pragma unroll
            for (int k = 0; k < 32; ++k) { carry[((size_t)item * 64 + 2 * k) * 64 + lane] = S[k][0]; carry[((size_t)item * 64 + 2 * k + 1) * 64 + lane] = S[k][1]; }
            dk[item * 64 + lane] = dl;
        }
    }
}
__device__ __forceinline__ void hg_carry(float* carry, const float* dk, int gtid, int ngt) {
    for (int e = gtid; e < 16 * 4096; e += ngt) {
        const int s = e >> 12, idx = e & 4095, k = idx >> 6;
        float run = 0.f;
        for (int j0 = 0; j0 < HG_SEG; j0 += 8) {
            float t[8], d[8];
#pragma unroll
            for (int u = 0; u < 8; ++u) { t[u] = carry[(size_t)(s * HG_SEG + j0 + u) * 4096 + idx]; d[u] = dk[(s * HG_SEG + j0 + u) * 64 + k]; }
#pragma unroll
            for (int u = 0; u < 8; ++u) { carry[(size_t)(s * HG_SEG + j0 + u) * 4096 + idx] = run; run = __builtin_fmaf(d[u], run, t[u]); }
        }
    }
}
__device__ __forceinline__ void hg_readout(const bf16_t* odir, const bf16_t* hgs, const float* gain, bf16_t* ohg, int gw, int ngw, int lane) {
    const f32x4 gv = *(const f32x4*)(gain + ((4 * lane) & 63));
    for (int row = gw; row < R; row += ngw) {
        const size_t off = (size_t)row * 256 + 4 * lane;
        const u32x2 a = *(const u32x2*)(odir + off), bq = *(const u32x2*)(odir + (size_t)R * 256 + off), hg = *(const u32x2*)(hgs + off);
        const float o0 = bflo(a.x) + bflo(bq.x), o1 = bfhi(a.x) + bfhi(bq.x), o2 = bflo(a.y) + bflo(bq.y), o3 = bfhi(a.y) + bfhi(bq.y);
        float ss = (o0 * o0 + o1 * o1) + (o2 * o2 + o3 * o3);
        ss += shx(ss, 1, lane); ss += shx(ss, 2, lane); ss += shx(ss, 4, lane); ss += shx(ss, 8, lane);
        const float rstd = 1.0f / sqrtf(ss * (1.f / 64.f) + EPS);
        u32x2 w;
        w.x = pk2(o0 * rstd * gv[0] * bflo(hg.x), o1 * rstd * gv[1] * bfhi(hg.x));
        w.y = pk2(o2 * rstd * gv[2] * bflo(hg.y), o3 * rstd * gv[3] * bfhi(hg.y));
        *(u32x2*)(ohg + off) = w;
    }
}

constexpr int AT_KSTR = 272, AT_VSTR = 136, AT_KBYTES = 64 * AT_KSTR, AT_VBYTES = 128 * AT_VSTR, AT_STAGE = AT_KBYTES + AT_VBYTES;
static_assert(2 * AT_STAGE <= LDS_BYTES && 65536 <= 2 * AT_STAGE, "attention LDS");
__device__ __forceinline__ void attn_unit(LAS unsigned char* lds, const bf16_t* qbuf, const bf16_t* kbuf, const bf16_t* vT, bf16_t* oda, const float* gain,
                                          int b, int h, int qrow0, int kt0, int kt1, float lam, float post, int tid, int wave, int lane) {
    const int c = wave & 1, g = wave >> 1, n = lane & 31, gq = lane >> 5;
    bf16x8 qf[4];
    { const bf16_t* qp = qbuf + (size_t)(qrow0 + 32 * g + n) * 512 + h * 128 + c * 64 + 8 * gq;
#pragma unroll
      for (int s = 0; s < 4; ++s) qf[s] = *(const bf16x8*)(qp + 16 * s); }
    f32x16 O[4];
#pragma unroll
    for (int e = 0; e < 4; ++e)
#pragma unroll
        for (int r = 0; r < 16; ++r) O[e][r] = 0.f;
    float l = 0.f;
    const int kkey0 = tid >> 4, kch = tid & 15, ve0 = tid >> 3, vc = tid & 7;
    const size_t kgoff = (size_t)kkey0 * 512 + h * 128 + kch * 8;
    const unsigned klds = kkey0 * AT_KSTR + kch * 16;
    const size_t vgoff = (size_t)(b * 512 + h * 128 + ve0) * KEYS + vc * 8;
    const unsigned vlds = ve0 * AT_VSTR + vc * 16;
    u32x4 kr0, kr1, vr0, vr1;
#define AT_KROW0(kt) (((kt) * 64 < SEQ) ? (size_t)b * SEQ + (kt) * 64 : (size_t)NLAT + b * CTXL + ((kt) * 64 - SEQ))
#define AT_LOADK(kt) do { const size_t krow0 = AT_KROW0(kt); kr0 = *(const u32x4*)(kbuf + krow0 * 512 + kgoff); kr1 = *(const u32x4*)(kbuf + (krow0 + 32) * 512 + kgoff); } while (0)
#define AT_LOADV(kt) do { vr0 = *(const u32x4*)(vT + vgoff + (kt) * 64); vr1 = *(const u32x4*)(vT + vgoff + (size_t)64 * KEYS + (kt) * 64); } while (0)
#define AT_STOREK(buf) do { LAS unsigned char* sb_ = lds + (buf) * AT_KBYTES; *(LAS u32x4*)(sb_ + klds) = kr0; *(LAS u32x4*)(sb_ + klds + 32 * AT_KSTR) = kr1; } while (0)
#define AT_STOREV(buf) do { LAS unsigned char* sb_ = lds + 2 * AT_KBYTES + (buf) * AT_VBYTES; \
        *(LAS u32x2*)(sb_ + vlds) = (u32x2){vr0.x, vr0.y}; *(LAS u32x2*)(sb_ + vlds + 8) = (u32x2){vr0.z, vr0.w}; \
        *(LAS u32x2*)(sb_ + vlds + 64 * AT_VSTR) = (u32x2){vr1.x, vr1.y}; *(LAS u32x2*)(sb_ + vlds + 64 * AT_VSTR + 8) = (u32x2){vr1.z, vr1.w}; } while (0)
#define AT_QK(Sa, Sb, buf) do { LAS unsigned char* kp = lds + (buf) * AT_KBYTES + n * AT_KSTR + (c * 8 + gq) * 16; \
        _Pragma("unroll") for (int s = 0; s < 4; ++s) { \
            const bf16x8 a0 = *(LAS bf16x8*)(kp + s * 32), a1 = *(LAS bf16x8*)(kp + 32 * AT_KSTR + s * 32); \
            Sa = __builtin_amdgcn_mfma_f32_32x32x16_bf16(a0, qf[s], Sa, 0, 0, 0); \
            Sb = __builtin_amdgcn_mfma_f32_32x32x16_bf16(a1, qf[s], Sb, 0, 0, 0); } } while (0)
#define AT_BAR() do { asm volatile("s_waitcnt lgkmcnt(0)" ::: "memory"); __builtin_amdgcn_s_barrier(); asm volatile("" ::: "memory"); } while (0)
    const int nt = kt1 - kt0;
    AT_LOADK(kt0); AT_LOADV(kt0); AT_STOREK(0); AT_STOREV(0);
    if (nt > 1) { AT_LOADK(kt0 + 1); AT_LOADV(kt0 + 1); }
    AT_BAR();
    f32x16 negm;
    {
        f32x16 S0, S1;
#pragma unroll
        for (int r = 0; r < 16; ++r) { S0[r] = 0.f; S1[r] = 0.f; }
        AT_QK(S0, S1, 0);
        float mx = fmaxf(S0[0], S1[0]);
#pragma unroll
        for (int r = 1; r < 16; ++r) mx = fmaxf(fmaxf(mx, S0[r]), S1[r]);
        { auto rr = __builtin_amdgcn_permlane32_swap(__builtin_bit_cast(unsigned, mx), __builtin_bit_cast(unsigned, mx), false, false);
          mx = fmaxf(__builtin_bit_cast(float, rr[0]), __builtin_bit_cast(float, rr[1])); }
#pragma unroll
        for (int r = 0; r < 16; ++r) negm[r] = -mx;
    }
    constexpr float THR = 8.f;
    for (int i = 0; i < nt; ++i) {
        const int cur = i & 1;
        if (i + 1 < nt) { AT_STOREK(cur ^ 1); AT_STOREV(cur ^ 1); }
        if (i + 2 < nt) { AT_LOADK(kt0 + i + 2); AT_LOADV(kt0 + i + 2); }
        bf16x8 kf[8];
        { LAS unsigned char* kp = lds + cur * AT_KBYTES + n * AT_KSTR + (c * 8 + gq) * 16;
#pragma unroll
          for (int s = 0; s < 4; ++s) { kf[2 * s] = *(LAS bf16x8*)(kp + s * 32); kf[2 * s + 1] = *(LAS bf16x8*)(kp + 32 * AT_KSTR + s * 32); } }
        LAS unsigned char* vp = lds + 2 * AT_KBYTES + cur * AT_VBYTES + n * AT_VSTR + gq * 8;
        u32x2 va[8][2];
#pragma unroll
        for (int ks = 0; ks < 2; ++ks)
#pragma unroll
            for (int e = 0; e < 4; ++e) { va[ks * 4 + e][0] = *(LAS u32x2*)(vp + e * 32 * AT_VSTR + ks * 32); va[ks * 4 + e][1] = *(LAS u32x2*)(vp + e * 32 * AT_VSTR + ks * 32 + 16); }
        __builtin_amdgcn_sched_barrier(0);
        f32x16 S0 = negm, S1 = negm;
#pragma unroll
        for (int s = 0; s < 4; ++s) {
            S0 = __builtin_amdgcn_mfma_f32_32x32x16_bf16(kf[2 * s], qf[s], S0, 0, 0, 0);
            S1 = __builtin_amdgcn_mfma_f32_32x32x16_bf16(kf[2 * s + 1], qf[s], S1, 0, 0, 0);
        }
        __builtin_amdgcn_sched_barrier(0);
        u32x2 vb[8][2];
#pragma unroll
        for (int ks = 0; ks < 2; ++ks)
#pragma unroll
            for (int e = 0; e < 4; ++e) { vb[ks * 4 + e][0] = *(LAS u32x2*)(vp + e * 32 * AT_VSTR + (ks + 2) * 32); vb[ks * 4 + e][1] = *(LAS u32x2*)(vp + e * 32 * AT_VSTR + (ks + 2) * 32 + 16); }
        __builtin_amdgcn_sched_barrier(0);
        float mx = fmaxf(S0[0], S1[0]);
#pragma unroll
        for (int r = 1; r < 16; ++r) mx = fmaxf(fmaxf(mx, S0[r]), S1[r]);
        { auto rr = __builtin_amdgcn_permlane32_swap(__builtin_bit_cast(unsigned, mx), __builtin_bit_cast(unsigned, mx), false, false);
          mx = fmaxf(__builtin_bit_cast(float, rr[0]), __builtin_bit_cast(float, rr[1])); }
        if (__builtin_amdgcn_ballot_w64(mx > THR) != 0ull) {
            const float delta = fmaxf(mx, 0.f), alpha = ex2(-delta);
            l *= alpha;
#pragma unroll
            for (int r = 0; r < 16; ++r) { S0[r] -= delta; S1[r] -= delta; negm[r] -= delta; }
#pragma unroll
            for (int e = 0; e < 4; ++e) O[e] = O[e] * alpha;
        }
        float ps = 0.f;
#pragma unroll
        for (int r = 0; r < 16; ++r) { S0[r] = ex2(S0[r]); S1[r] = ex2(S1[r]); ps += S0[r] + S1[r]; }
        l += ps;
        bf16x8 pb[4];
#pragma unroll
        for (int s = 0; s < 2; ++s) {
            u32x4 pw;
            pw.x = pk2(S0[8 * s + 0], S0[8 * s + 1]); pw.y = pk2(S0[8 * s + 2], S0[8 * s + 3]); pw.z = pk2(S0[8 * s + 4], S0[8 * s + 5]); pw.w = pk2(S0[8 * s + 6], S0[8 * s + 7]);
            pb[s] = __builtin_bit_cast(bf16x8, pw);
            pw.x = pk2(S1[8 * s + 0], S1[8 * s + 1]); pw.y = pk2(S1[8 * s + 2], S1[8 * s + 3]); pw.z = pk2(S1[8 * s + 4], S1[8 * s + 5]); pw.w = pk2(S1[8 * s + 6], S1[8 * s + 7]);
            pb[2 + s] = __builtin_bit_cast(bf16x8, pw);
        }
        __builtin_amdgcn_sched_barrier(0);
#pragma unroll
        for (int ks = 0; ks < 2; ++ks)
#pragma unroll
            for (int e = 0; e < 4; ++e) {
                const bf16x8 a = __builtin_bit_cast(bf16x8, ((u32x4){va[ks * 4 + e][0].x, va[ks * 4 + e][0].y, va[ks * 4 + e][1].x, va[ks * 4 + e][1].y}));
                O[e] = __builtin_amdgcn_mfma_f32_32x32x16_bf16(a, pb[ks], O[e], 0, 0, 0);
            }
#pragma unroll
        for (int ks = 0; ks < 2; ++ks)
#pragma unroll
            for (int e = 0; e < 4; ++e) {
                const bf16x8 a = __builtin_bit_cast(bf16x8, ((u32x4){vb[ks * 4 + e][0].x, vb[ks * 4 + e][0].y, vb[ks * 4 + e][1].x, vb[ks * 4 + e][1].y}));
                O[e] = __builtin_amdgcn_mfma_f32_32x32x16_bf16(a, pb[2 + ks], O[e], 0, 0, 0);
            }
        AT_BAR();
    }
#undef AT_BAR
#undef AT_KROW0
#undef AT_LOADK
#undef AT_LOADV
#undef AT_STOREK
#undef AT_STOREV
#undef AT_QK
    l += shx(l, 32, lane);
    const float inv = 1.f / l;
    LAS float* xch = (LAS float*)lds;
    if (c == 1) {
#pragma unroll
        for (int e = 0; e < 4; ++e)
#pragma unroll
            for (int r = 0; r < 16; ++r) xch[(g * 64 + e * 16 + r) * 64 + lane] = O[e][r] * inv;
    }
    __syncthreads();
    if (c == 0) {
        float ss = 0.f;
#pragma unroll
        for (int e = 0; e < 4; ++e)
#pragma unroll
            for (int r = 0; r < 16; ++r) { const float o = O[e][r] * inv - lam * xch[(g * 64 + e * 16 + r) * 64 + lane]; O[e][r] = o; ss += o * o; }
        ss += shx(ss, 32, lane);
        const float rs = post / sqrtf(ss * (1.f / 128.f) + EPS);
        bf16_t* op = oda + (size_t)(qrow0 + 32 * g + n) * 512 + h * 128;
#pragma unroll
        for (int e = 0; e < 4; ++e)
#pragma unroll
            for (int r4 = 0; r4 < 4; ++r4) {
                const int e0 = e * 32 + 8 * r4 + 4 * gq;
                const f32x4 gv = *(const f32x4*)(gain + e0);
                u32x2 w; w.x = pk2(O[e][4 * r4 + 0] * rs * gv[0], O[e][4 * r4 + 1] * rs * gv[1]); w.y = pk2(O[e][4 * r4 + 2] * rs * gv[2], O[e][4 * r4 + 3] * rs * gv[3]);
                *(u32x2*)(op + e0) = w;
            }
    }
    __syncthreads();
}
#define XB_TMO      128
#define XB_XCNT(j)  (256  + 64 * (j))
#define XB_XSUB(j)  (1280 + 64 * (j))
#define XB_XGEN(j)  (2304 + 64 * (j))
#define XB_TOP      3328
#define XB_TOPGEN   3392
#define XCD_BAR_WORDS 3456
#define XB_SPIN_CAP (1u << 18)

__device__ __forceinline__ unsigned xb_ld(unsigned* p)              { return __hip_atomic_load(p, __ATOMIC_RELAXED, __HIP_MEMORY_SCOPE_AGENT); }
__device__ __forceinline__ unsigned xb_add(unsigned* p, unsigned v) { return __hip_atomic_fetch_add(p, v, __ATOMIC_RELAXED, __HIP_MEMORY_SCOPE_AGENT); }
__device__ __forceinline__ unsigned xb_xcc_id() { return (unsigned)__builtin_amdgcn_s_getreg((3 << 11) | 20) & 0xFu; }
#define XB_SPIN(cond, bar) do { unsigned _sp = 0; while (cond) { __builtin_amdgcn_s_sleep(1); \
    if ((++_sp & 255u) == 0u) { if (xb_ld(&(bar)[XB_TMO])) break; if (_sp > XB_SPIN_CAP) { atomicAdd(&(bar)[XB_TMO], 1u); break; } } } } while (0)

struct XcdBarrier {
    unsigned* bar; unsigned x;
    volatile LAS unsigned* st;
};

__device__ __forceinline__ XcdBarrier xcd_barrier_post(unsigned* bar, volatile LAS unsigned* st, int tid_in) {
    XcdBarrier b; b.bar = bar; b.x = xb_xcc_id(); b.st = st;
    if (tid_in == 0) (void)xb_add(&bar[XB_XCNT(b.x)], 1u);
    return b;
}
__device__ __forceinline__ void xcd_barrier_complete(unsigned* bar, unsigned x, unsigned& nloc, unsigned& nx) {
    const unsigned G = gridDim.x * gridDim.y * gridDim.z;
    unsigned sum, cnt, mine, sp = 0u;
    for (;;) {
        sum = 0u; cnt = 0u; mine = 0u;
#pragma unroll
        for (unsigned j = 0; j < 16; ++j) { const unsigned c = xb_ld(&bar[XB_XCNT(j)]); sum += c; cnt += (c > 0u) ? 1u : 0u; mine = (j == x) ? c : mine; }
        if (sum == G) break;
        __builtin_amdgcn_s_sleep(1);
        if ((++sp & 255u) == 0u) { if (xb_ld(&bar[XB_TMO])) break; if (sp > XB_SPIN_CAP) { atomicAdd(&bar[XB_TMO], 1u); break; } }
    }
    nloc = mine > 0u ? mine : 1u; nx = cnt > 0u ? cnt : 1u;
}

__device__ __forceinline__ void xcd_barrier(const XcdBarrier& b, int tid_in) {
    asm volatile("s_waitcnt vmcnt(0)" ::: "memory");
    __syncthreads();
    if (tid_in == 0) {
        unsigned* bar = b.bar;
        __builtin_amdgcn_s_waitcnt(0);
        unsigned nloc = b.st[0], nx = b.st[1];
        if (nloc == 0u) { xcd_barrier_complete(bar, b.x, nloc, nx); b.st[0] = nloc; b.st[1] = nx; }
        const unsigned old = xb_add(&bar[XB_XSUB(b.x)], 1u);
        const unsigned gen = old / nloc;
        if (old + 1u == (gen + 1u) * nloc) {
            __builtin_amdgcn_fence(__ATOMIC_RELEASE, "agent");
            asm volatile("s_waitcnt vmcnt(0)" ::: "memory");
            const unsigned og = xb_add(&bar[XB_TOP], 1u);
            const unsigned tg = og / nx;
            if (og + 1u == (tg + 1u) * nx) xb_add(&bar[XB_TOPGEN], 1u);
            else XB_SPIN(xb_ld(&bar[XB_TOPGEN]) == tg, bar);
            __builtin_amdgcn_fence(__ATOMIC_ACQUIRE, "agent");
            xb_add(&bar[XB_XGEN(b.x)], 1u);
            asm volatile("s_waitcnt vmcnt(0)" ::: "memory");
        } else {
            XB_SPIN(xb_ld(&bar[XB_XGEN(b.x)]) == gen, bar);
            __builtin_amdgcn_fence(__ATOMIC_ACQUIRE, "agent");
            asm volatile("s_waitcnt vmcnt(0)" ::: "memory");
        }
    }
    __syncthreads();
}


struct Args { const float* in[30]; float* out; unsigned char* ws; };
typedef const Args __attribute__((address_space(4))) Args_c;
__device__ __forceinline__ Args_c* kargs_ptr() { Args_c* p = (Args_c*)__builtin_amdgcn_kernarg_segment_ptr(); asm volatile("" : "+s"(p)); return p; }
#define GSYNC_CG() cg::this_grid().sync()
constexpr size_t WS_BAR = WS_END + 4096;
constexpr size_t WS_TOTAL = WS_BAR + (size_t)XCD_BAR_WORDS * 4;
static_assert(WS_TOTAL <= (size_t)512 * 1024 * 1024, "workspace");
constexpr int LDS_BARST = LDS_BYTES - 16;
#define GSYNC() do { XcdBarrier xb_; xb_.bar = (unsigned*)(kargs_ptr()->ws + WS_BAR); xb_.x = xb_xcc_id(); xb_.st = (volatile LAS unsigned*)(lds + LDS_BARST); xcd_barrier(xb_, TIDX()); } while (0)
#ifdef PROBE_A
#define TS(cat) do { if (blockIdx.x == 0 && TIDX() == 0) { unsigned long long* tsb = (unsigned long long*)(kargs_ptr()->ws + WS_END); const unsigned long long now = __builtin_amdgcn_s_memrealtime(); tsb[1 + (cat)] += now - tsb[0]; tsb[0] = now; } } while (0)
#else
#define TS(cat) do {} while (0)
#endif
__device__ __forceinline__ int tid_from(int wave_s) { int w_ = wave_s; unsigned z_ = 0u; asm volatile("" : "+s"(w_), "+s"(z_)); return w_ * 64 + (int)__builtin_amdgcn_mbcnt_hi(~0u, __builtin_amdgcn_mbcnt_lo(~0u, z_)); }
#define TIDX() tid_from(wave_s)
#define KA() int tid = TIDX(); asm volatile("" : "+v"(tid)); int G = gridDim.x, bid = blockIdx.x; asm volatile("" : "+s"(G), "+s"(bid)); \
    const int lane = tid & 63, wave = __builtin_amdgcn_readfirstlane(tid >> 6), gw = bid * 8 + wave, ngw = G * 8, gtid = bid * NTHR + tid, ngt = G * NTHR; \
    (void)lane; (void)wave; (void)gw; (void)ngw; (void)gtid; (void)ngt; \
    Args_c* ka = kargs_ptr(); unsigned char* ws = ka->ws; (void)ws

__global__ void __launch_bounds__(NTHR, 2) fwd_kernel(Args a_unused) {
    extern __shared__ __attribute__((aligned(16))) unsigned char lds_raw[];
    LAS unsigned char* lds = (LAS unsigned char*)lds_raw;
    const int wave_s = __builtin_amdgcn_readfirstlane((int)threadIdx.x >> 6);
    if (TIDX() < 4) ((volatile LAS unsigned*)(lds + LDS_BARST))[TIDX()] = 0u;
    __syncthreads();
    (void)xcd_barrier_post((unsigned*)(kargs_ptr()->ws + WS_BAR), (volatile LAS unsigned*)(lds + LDS_BARST), TIDX());
#ifdef PROBE_A
    if (blockIdx.x == 0 && TIDX() == 0) { unsigned long long* tsb = (unsigned long long*)(kargs_ptr()->ws + WS_END); for (int i = 1; i < 32; ++i) tsb[i] = 0; tsb[0] = __builtin_amdgcn_s_memrealtime(); }
#endif

    {
        KA();
        bf16_t* WB = (bf16_t*)(ws + WS_WB);
        LAS float* scr = (LAS float*)(lds + wave * 8448);
        constexpr int IT_L = 12416;
        for (int it = gw; it < 2 * IT_L; it += ngw) {
            const int l = it / IT_L; int r = it % IT_L;
            bf16_t* Wl = WB + (size_t)l * WL_TOTAL;
            if (r < 1408) { transpose_item(ka->in[9] + (size_t)l * 1024 * DFF, 1024, DFF, Wl + WL_UP1, 1, scr, r, lane); continue; } r -= 1408;
            if (r < 1408) { transpose_item(ka->in[10] + (size_t)l * 1024 * DFF, 1024, DFF, Wl + WL_UP1, 2, scr, r, lane); continue; } r -= 1408;
            if (r < 1408) { transpose_item(ka->in[11] + (size_t)l * DFF * 1024, DFF, 1024, Wl + WL_DN1, 0, scr, r, lane); continue; } r -= 1408;
            if (r < 1408) { transpose_item(ka->in[12] + (size_t)l * 1024 * DFF, 1024, DFF, Wl + WL_UP2, 1, scr, r, lane); continue; } r -= 1408;
            if (r < 1408) { transpose_item(ka->in[13] + (size_t)l * 1024 * DFF, 1024, DFF, Wl + WL_UP2, 2, scr, r, lane); continue; } r -= 1408;
            if (r < 1408) { transpose_item(ka->in[14] + (size_t)l * DFF * 1024, DFF, 1024, Wl + WL_DN2, 0, scr, r, lane); continue; } r -= 1408;
            if (r < 3072) { transpose_item(ka->in[15] + (size_t)l * 1024 * 6144, 1024, 6144, Wl + WL_IN, 3, scr, r, lane); continue; } r -= 3072;
            if (r < 256) { transpose_item(ka->in[25] + (size_t)l * 512 * 1024, 512, 1024, Wl + WL_PA, 0, scr, r, lane); continue; } r -= 256;
            if (r < 128) { transpose_item(ka->in[26] + (size_t)l * 256 * 1024, 256, 1024, Wl + WL_PH, 0, scr, r, lane); continue; } r -= 128;
            transpose_item(ka->in[28] + (size_t)l * 1024 * 1024, 1024, 1024, Wl + WL_O, 0, scr, r, lane);
        }
        __syncthreads();
    }
    {
        KA();
        float* MOD = (float*)(ws + WS_MOD);
        LAS float* sv = (LAS float*)lds;
        LAS float* part = (LAS float*)(lds + 12288);
        for (int i = tid; i < 3072; i += NTHR) { const int seg = i >> 10, k = i & 1023; const float x = (seg < 2) ? ka->in[1][seg * 1024 + k] : ka->in[3][k]; sv[i] = x / (1.f + __expf(-x)); }
        __syncthreads();
        for (int item = bid; item < 288; item += G) {
            const int l = item / 144, col = (item % 144) * 64 + lane;
            const float* W = ka->in[4] + (size_t)l * 1024 * 9216 + col;
            float a0 = 0.f, a1 = 0.f, a2 = 0.f;
            for (int k = wave * 128; k < wave * 128 + 128; ++k) { const float w = W[(size_t)k * 9216]; a0 = __builtin_fmaf(sv[k], w, a0); a1 = __builtin_fmaf(sv[1024 + k], w, a1); a2 = __builtin_fmaf(sv[2048 + k], w, a2); }
            part[(wave * 3 + 0) * 64 + lane] = a0; part[(wave * 3 + 1) * 64 + lane] = a1; part[(wave * 3 + 2) * 64 + lane] = a2;
            __syncthreads();
            if (tid < 192) { const int seg = tid >> 6, cl = tid & 63; float s = 0.f;
#pragma unroll
                for (int w = 0; w < 8; ++w) s += part[(w * 3 + seg) * 64 + cl];
                const int cc = (item % 144) * 64 + cl;
                MOD[(size_t)(l * 3 + seg) * 9216 + cc] = s + ka->in[5][l * 9216 + cc]; }
            __syncthreads();
        }
    }
    {
        KA();
        bf16_t* WB = (bf16_t*)(ws + WS_WB); float* CS = (float*)(ws + WS_CS); float* LBT = (float*)(ws + WS_LB); float* LAMV = (float*)(ws + WS_LAM);
        for (int idx = gtid; idx < 2 * 256 * 1024; idx += ngt) {
            const int n = idx & 1023, k = (idx >> 10) & 255, l = idx >> 18, g = k >> 6, c = k & 63;
            const float* pw = ka->in[23] + (size_t)l * 4 * 64 * 64 + (g * 64 + c) * 64;
            const float* psc = ka->in[24] + l * 256 + g * 64;
            const float* wp = ka->in[27] + (size_t)l * 256 * 1024 + (size_t)(g * 64) * 1024 + n;
            float s = 0.f;
            for (int d = 0; d < 64; ++d) s = __builtin_fmaf(pw[d] * psc[d], wp[(size_t)d * 1024], s);
            (WB + (size_t)l * WL_TOTAL + WL_PP)[(size_t)n * 256 + k] = (bf16_t)(pk2(s, 0.f) & 0xffffu);
        }
        for (int idx = gtid; idx < 4096; idx += ngt) {
            const int n = idx >> 4, j = idx & 15;
            const float invf = __builtin_exp2f(-(float)j * (13.287712379549449f / 16.f));
            const float ang = (float)n * invf;
            const double rev = (double)ang * 0.15915494309189535; const float fr = (float)(rev - __builtin_floor(rev));
            CS[n * 32 + j] = __builtin_amdgcn_cosf(fr); CS[n * 32 + 16 + j] = __builtin_amdgcn_sinf(fr);
        }
        for (int idx = gtid; idx < 1024; idx += ngt) {
            const int l = idx >> 9, dc = idx & 511;
            const float l0 = ka->in[21][dc], l1 = ka->in[21][512 + dc];
            LBT[idx] = (l == 0) ? 0.f : 1.f / (1.f + __expf(l0 - l1));
        }
        for (int idx = gtid; idx < NCTX * DM / 4; idx += ngt) ((f32x4*)(ws + WS_HC))[idx] = ((const f32x4*)ka->in[2])[idx];
        if (gtid < 2) {
            const int l = gtid; float s1 = 0.f, s2 = 0.f;
            for (int i = 0; i < 64; ++i) { s1 += ka->in[16][l * 64 + i] * ka->in[17][l * 64 + i]; s2 += ka->in[18][l * 64 + i] * ka->in[19][l * 64 + i]; }
            const float li = (l == 0) ? 0.2f : (0.8f - 0.6f * 0.7408182206817179f);
            LAMV[l * 2 + 0] = __expf(s1) - __expf(s2) + li; LAMV[l * 2 + 1] = 1.f - li;
        }
    }
    GSYNC_CG();
    TS(0);

#pragma unroll 1
    for (int l = 0; l < 2; ++l) {
#ifdef REP_SYNC
#pragma unroll 1
        for (int rs_ = 0; rs_ < 10; ++rs_) { GSYNC(); }
#endif
#pragma unroll 1
        for (int f = 0; f < 2; ++f) {
            {   KA(); const bool first = (l == 0 && f == 0);
                const float* in_lat = first ? ka->in[0] : ka->out; const float* in_ctx = (const float*)(ws + WS_HC);
                norm_phase(in_lat, in_ctx, ka->in[f ? 8 : 6] + l * 1024, (const float*)(ws + WS_MOD) + (size_t)l * 3 * 9216, f ? 6 : 0, f ? 7 : 1, (bf16_t*)(ws + WS_XB), gw, ngw, lane,
                           (const float*)(ws + WS_O), first ? 0 : (f ? 4 : DFF / 256), (float*)(ws + WS_HC)); }
            GSYNC();
            TS(1);
            {   KA(); bf16_t* Wl = (bf16_t*)(ws + WS_WB) + (size_t)l * WL_TOTAL;
                pg8::Gemm g{(bf16_t*)(ws + WS_XB), Wl + (f ? WL_UP2 : WL_UP1), R, 5632, 1024}; pg8::StaticOrder S; S.init(R, 5632, G, bid); EpiUp E{(bf16_t*)(ws + WS_Z)};
                pg8::gemm_phase<EpiUp, pg8::StaticOrder, true, true>(lds, g, S, E, tid); }
            GSYNC();
            TS(2);
            {   KA(); bf16_t* Wl = (bf16_t*)(ws + WS_WB) + (size_t)l * WL_TOTAL; const bool first = (l == 0 && f == 0);
                const float* in_lat = first ? ka->in[0] : ka->out;
                pg8::Gemm g{(bf16_t*)(ws + WS_Z), Wl + (f ? WL_DN2 : WL_DN1), NLAT, 1024, DFF}; pg8::StaticOrder S; S.init(NLAT, 1024, G, bid);
                EpiRes E{in_lat, (const float*)(ws + WS_HC), ka->out, (float*)(ws + WS_HC), (const float*)(ws + WS_MOD) + (size_t)l * 3 * 9216 + (f ? 8 : 2) * 1024, 0.5f};
                pg8::gemm_phase<EpiRes, pg8::StaticOrder, true, true>(lds, g, S, E, tid); }
            {   KA(); bf16_t* Wl = (bf16_t*)(ws + WS_WB) + (size_t)l * WL_TOTAL;
                pg8::Gemm g{(bf16_t*)(ws + WS_Z) + (size_t)NLAT * DFF, Wl + (f ? WL_DN2 : WL_DN1), NCTX, 1024, 256, DFF}; SplitKOrder S; S.init(DFF / 256, 256, G, bid);
                EpiPart E{(float*)(ws + WS_O), (const float*)(ws + WS_MOD) + (size_t)l * 3 * 9216 + (f ? 8 : 2) * 1024, 0.5f};
                pg8::gemm_phase<EpiPart, SplitKOrder, true, true>(lds, g, S, E, tid); }
            GSYNC();
            TS(3);
            if (f == 1) break;
            {   KA();
                norm_phase(ka->out, (const float*)(ws + WS_HC), ka->in[7] + l * 1024, (const float*)(ws + WS_MOD) + (size_t)l * 3 * 9216, 3, 4, (bf16_t*)(ws + WS_XB), gw, ngw, lane,
                           (const float*)(ws + WS_O), DFF / 256, (float*)(ws + WS_HC)); }
            GSYNC();
            TS(1);
            {   KA(); bf16_t* Wl = (bf16_t*)(ws + WS_WB) + (size_t)l * WL_TOTAL;
                pg8::Gemm g{(bf16_t*)(ws + WS_XB), Wl + WL_IN, R, 3072, 1024}; pg8::StaticOrder S; S.init(R, 3072, G, bid);
                EpiWin E{ws + WS_Z, (const float*)(ws + WS_CS), (const float*)(ws + WS_LB) + l * 512, 0};
                pg8::gemm_phase<EpiWin, pg8::StaticOrder, true, true>(lds, g, S, E, tid); }
            GSYNC();
            TS(4);
            {   KA(); pool_phase((const bf16_t*)(ws + WS_Z + Z_ZP), (bf16_t*)(ws + WS_O + O_MX), gtid, ngt); }
#ifdef REP_ATTN
            for (int rep_ = 0; rep_ < 2; ++rep_)
#endif
            {   KA();
                const float* LAMV = (const float*)(ws + WS_LAM);
                const int nunits = 1024 + (l == 0 ? 16 : 0);
                for (int u = bid; u < nunits; u += G) {
                    int bh, qrow0, kt0, kt1;
                    if (u < 1024) { bh = u >> 7; qrow0 = (bh >> 2) * SEQ + (u & 127) * 128; kt0 = 0; kt1 = KEYS / 64; }
                    else { const int v = u - 1024; bh = v >> 1; qrow0 = NLAT + (bh >> 2) * CTXL + (v & 1) * 128; kt0 = SEQ / 64; kt1 = KEYS / 64; }
                    attn_unit(lds, (const bf16_t*)(ws + WS_Z + Z_Q), (const bf16_t*)(ws + WS_Z + Z_K), (const bf16_t*)(ws + WS_Z + Z_VT), (bf16_t*)(ws + WS_O + O_DA), ka->in[20] + l * 128,
                              bh >> 2, bh & 3, qrow0, kt0, kt1, LAMV[l * 2], LAMV[l * 2 + 1], tid, wave, lane);
                }
            }
            GSYNC();
            TS(5);
#ifdef REP_HG
#pragma unroll 1
            for (int rep_ = 0; rep_ < 2; ++rep_) {
#else
            {
#endif
            {   KA(); hg_pass<false>((const float*)(ws + WS_Z + Z_HQ), (const float*)(ws + WS_Z + Z_FF), (const float*)(ws + WS_Z + Z_FB), (const bf16_t*)(ws + WS_Z + Z_HI),
                                     (float*)(ws + WS_CAR), (float*)(ws + WS_DK), (bf16_t*)(ws + WS_Z + Z_K), wave, lane, G); }
            GSYNC();
            TS(6);
            {   KA(); hg_carry((float*)(ws + WS_CAR), (const float*)(ws + WS_DK), gtid, ngt); }
            GSYNC();
            TS(7);
            {   KA(); hg_pass<true>((const float*)(ws + WS_Z + Z_HQ), (const float*)(ws + WS_Z + Z_FF), (const float*)(ws + WS_Z + Z_FB), (const bf16_t*)(ws + WS_Z + Z_HI),
                                    (float*)(ws + WS_CAR), (float*)(ws + WS_DK), (bf16_t*)(ws + WS_Z + Z_K), wave, lane, G); }
            GSYNC();
            TS(8);
            {   KA(); hg_readout((const bf16_t*)(ws + WS_Z + Z_K), (const bf16_t*)(ws + WS_Z + Z_HG), ka->in[22] + l * 64, (bf16_t*)(ws + WS_O + O_HG), gw, ngw, lane); }
            GSYNC();
            TS(9);
            }
            {   KA(); bf16_t* Wl = (bf16_t*)(ws + WS_WB) + (size_t)l * WL_TOTAL;
                pg8::Gemm g{(bf16_t*)(ws + WS_XB), Wl + WL_IN + (size_t)3072 * 1024, R, 3072, 1024}; pg8::StaticOrder S; S.init(R, 3072, G, bid); EpiG E{(bf16_t*)(ws + WS_Z)};
                pg8::gemm_phase<EpiG, pg8::StaticOrder, true, true>(lds, g, S, E, tid); }
            GSYNC();
            TS(10);
#pragma unroll 1
            for (int gi = 0; gi < 3; ++gi) {
                KA(); bf16_t* Wl = (bf16_t*)(ws + WS_WB) + (size_t)l * WL_TOTAL;
                const bf16_t* A = (const bf16_t*)(ws + WS_O + ((gi == 0) ? O_DA : (gi == 1 ? O_HG : O_MX))); const int K = (gi == 0) ? 512 : 256;
                const bf16_t* Bt = Wl + ((gi == 0) ? WL_PA : (gi == 1 ? WL_PH : WL_PP));
                pg8::Gemm g{A, Bt, R, 1024, K}; pg8::StaticOrder S; S.init(R, 1024, G, bid); EpiProj E{(bf16_t*)(ws + WS_XB), (const bf16_t*)(ws + WS_Z), gi, gi == 0};
                pg8::gemm_phase<EpiProj, pg8::StaticOrder, true, true>(lds, g, S, E, tid);
            }
            GSYNC();
            TS(11);
            {   KA(); bf16_t* Wl = (bf16_t*)(ws + WS_WB) + (size_t)l * WL_TOTAL;
                pg8::Gemm g{(bf16_t*)(ws + WS_XB), Wl + WL_O, NLAT, 1024, 1024}; pg8::StaticOrder S; S.init(NLAT, 1024, G, bid);
                EpiRes E{ka->out, (const float*)(ws + WS_HC), ka->out, (float*)(ws + WS_HC), (const float*)(ws + WS_MOD) + (size_t)l * 3 * 9216 + 5 * 1024, 1.0f};
                pg8::gemm_phase<EpiRes, pg8::StaticOrder, true, true>(lds, g, S, E, tid); }
            {   KA(); bf16_t* Wl = (bf16_t*)(ws + WS_WB) + (size_t)l * WL_TOTAL;
                pg8::Gemm g{(bf16_t*)(ws + WS_XB) + (size_t)NLAT * 1024, Wl + WL_O, NCTX, 1024, 256, 1024}; SplitKOrder S; S.init(4, 256, G, bid);
                EpiPart E{(float*)(ws + WS_O), (const float*)(ws + WS_MOD) + (size_t)l * 3 * 9216 + 5 * 1024, 1.0f};
                pg8::gemm_phase<EpiPart, SplitKOrder, true, true>(lds, g, S, E, tid); }
            GSYNC();
            TS(12);
        }
    }
    {   KA(); final_norm_phase(ka->out, ka->in[29], gw, ngw, lane); }
#ifdef PROBE_A
    GSYNC(); TS(1);
    if (blockIdx.x == 0) { KA(); const unsigned long long* tsb = (const unsigned long long*)(ws + WS_END);
        __syncthreads();
        const float va = (float)tsb[1 + PROBE_A] * 0.01f, vb = (float)tsb[1 + PROBE_B] * 0.01f;
        __syncthreads();
        if (tid == 0) ka->out[0] += va;
        for (int i = tid; i < 65536; i += NTHR) ka->out[(size_t)(i / 1024 + 8) * 1024 + (i & 1023)] += vb; }
#endif
}

extern "C" void kernel_launch(void* const* d_in, const int* in_sizes, int n_in, void* d_out, int out_size, void* d_ws, size_t ws_size, hipStream_t stream) {
    static int grid = 0;
    if (grid == 0) {
        if (n_in != 30 || out_size != NLAT * DM || ws_size < WS_TOTAL) { fprintf(stderr, "kernel_launch: unexpected shapes (n_in %d out %d ws %zu need %zu)\n", n_in, out_size, ws_size, (size_t)WS_TOTAL); grid = -1; return; }
        int dev = 0, cus = 0, per_cu = 0;
        (void)hipGetDevice(&dev);
        (void)hipDeviceGetAttribute(&cus, hipDeviceAttributeMultiprocessorCount, dev);
        if (hipFuncSetAttribute((const void*)fwd_kernel, hipFuncAttributeMaxDynamicSharedMemorySize, LDS_BYTES) != hipSuccess) { fprintf(stderr, "kernel_launch: hipFuncSetAttribute failed\n"); grid = -1; return; }
        if (hipOccupancyMaxActiveBlocksPerMultiprocessor(&per_cu, (const void*)fwd_kernel, NTHR, LDS_BYTES) != hipSuccess || per_cu < 1) { fprintf(stderr, "kernel_launch: occupancy query failed (%d)\n", per_cu); (void)hipGetLastError(); per_cu = 1; }
        if (per_cu > 1) per_cu = 1;
        grid = cus * per_cu;
    }
    if (grid < 0) return;
    if (hipMemsetAsync((unsigned char*)d_ws + WS_BAR, 0, (size_t)XCD_BAR_WORDS * 4, stream) != hipSuccess) { fprintf(stderr, "kernel_launch: memset failed\n"); return; }
    Args a{};
    for (int i = 0; i < 30; ++i) a.in[i] = (const float*)d_in[i];
    a.out = (float*)d_out; a.ws = (unsigned char*)d_ws;
    void* args[] = {&a};
    hipError_t e = hipLaunchCooperativeKernel((const void*)fwd_kernel, dim3(grid), dim3(NTHR), args, LDS_BYTES, stream);
    if (e != hipSuccess) fprintf(stderr, "cooperative launch failed: %s (grid %d)\n", hipGetErrorString(e), grid);
}
```

```cpp
#include <hip/hip_runtime.h>
#include <hip/hip_cooperative_groups.h>
#include <cstdio>
#include <cstdint>
namespace cg = cooperative_groups;
namespace pg8 {
#define PG8_LAS __attribute__((address_space(3)))
typedef unsigned short bf16_t;
typedef short bf16x8 __attribute__((ext_vector_type(8)));
typedef float f32x4 __attribute__((ext_vector_type(4)));
typedef unsigned u32x4 __attribute__((ext_vector_type(4)));
constexpr int BM = 256, BK = 64, HALF = 128, HTB = HALF * BK * 2  , STAGE_BYTES = 8 * HTB, NXCD = 8, WGM = 8;

__host__ __device__ __forceinline__ int lds_byte(int r, int c) { const int st = (r >> 4) * 2 + (c >> 5), rr = r & 15, cc = c & 31, ob = rr * 64 + cc * 2; return st * 1024 + (ob ^ (((ob >> 9) & 1) << 5)); }
__host__ __device__ __forceinline__ void stage_rc(int b, int& R, int& C) { const int st = b / 1024, sb = b % 1024, swz = sb ^ (((sb >> 9) & 1) << 5); R = (st >> 1) * 16 + swz / 64; C = (st & 1) * 32 + (swz % 64) / 2; }
__host__ __device__ __forceinline__ int perm32(int rho) { const int n = rho >> 4, i = rho & 15; return 8 * (i >> 2) + 4 * n + (i & 3); }

struct Unit { int pm, pn; int koff = 0; };
struct Gemm { const bf16_t* A; const bf16_t* Bt; int M, N, K; int ld = 0; };

struct StaticOrder {
    int nM, nN, nwg, G, c;
    __host__ __device__ void init(int M, int N, int G_, int c_) { nM = M / BM; nN = N / BM; nwg = nM * nN; G = G_; c = c_; }
    __host__ __device__ bool next(int i, Unit& u) const {
        const long L = (long)i * G + c; if (L >= nwg) return false;
        int wgid = (int)L; { const int q = nwg / NXCD, r = nwg % NXCD, xcd = wgid % NXCD, off = wgid / NXCD; wgid = (xcd < r ? xcd * (q + 1) : r * (q + 1) + (xcd - r) * q) + off; }
        const int nig = WGM * nN, gid = wgid / nig, fm = gid * WGM, gsz = (nM - fm) < WGM ? (nM - fm) : WGM;
        u.pm = fm + ((wgid % nig) % gsz); u.pn = (wgid % nig) / gsz; u.koff = 0; return true;
    }
    __device__ __forceinline__ void a_ready(const Unit&) const {}
    __device__ __forceinline__ void done(const Unit&) const {}
};

}
namespace pg8 {
template <class Epi, class Sched, bool ALIGN_EPI = false, bool SP2 = false>
__device__ __forceinline__ void gemm_phase(PG8_LAS unsigned char* lds, const Gemm g, const Sched& S, const Epi& E, int tid_in) {
    int tid_ = tid_in; asm volatile("" : "+v"(tid_)); const int tid = tid_, wid = __builtin_amdgcn_readfirstlane(tid >> 6), lane = tid & 63, wr = wid >> 2, wc = wid & 3, fr = lane & 15, fq = lane >> 4;
    const int K = g.ld ? g.ld : g.K, nt = g.K / BK;
    unsigned voffA[2], voffB[2];
#pragma unroll
    for (int i = 0; i < 2; ++i) { int R, C; stage_rc(tid * 16 + i * 8192, R, C); const int Rb = Epi::PERM ? ((R & ~31) + perm32(R & 31)) : R;
        voffA[i] = (unsigned)(R * K + C) * 2u; voffB[i] = (unsigned)(Rb * K + C) * 2u; }
    const size_t kstep = (size_t)(BK * 2);
    const size_t hstep = (size_t)HALF * K * 2;
    const size_t tstep = 2 * hstep;
    const unsigned ldsw = (unsigned)wid * 1024u;
    const int aoff = lds_byte(wr * 64 + fr, fq * 8), boff = lds_byte(wc * 32 + fr, fq * 8);
#define PG8_SA(b, h) (((b) * 2 + (h)) * HTB)
#define PG8_SB(b, h) ((4 + (b) * 2 + (h)) * HTB)
#define PG8_STAGE(bufoff, gbase, voff) do { _Pragma("unroll") for (int _i = 0; _i < 2; ++_i) \
        __builtin_amdgcn_global_load_lds((const unsigned*)((const char*)(gbase) + (voff)[_i]), (PG8_LAS unsigned*)(lds + (bufoff) + ldsw + _i * 8192), 16, 0, 0); } while (0)
#define PG8_LDA(dst, b, h) do { _Pragma("unroll") for (int m = 0; m < 4; ++m) _Pragma("unroll") for (int k = 0; k < 2; ++k) dst[m][k] = *(const PG8_LAS bf16x8*)(lds + PG8_SA(b, h) + aoff + m * 2048 + k * 1024); } while (0)
#define PG8_LDB(dst, b, h) do { _Pragma("unroll") for (int n = 0; n < 2; ++n) _Pragma("unroll") for (int k = 0; k < 2; ++k) dst[n][k] = *(const PG8_LAS bf16x8*)(lds + PG8_SB(b, h) + boff + n * 2048 + k * 1024); } while (0)
#define PG8_MMA(ai, bj, At, Bt) do { __builtin_amdgcn_s_setprio(1); _Pragma("unroll") for (int m = 0; m < 4; ++m) _Pragma("unroll") for (int n = 0; n < 2; ++n) _Pragma("unroll") for (int k = 0; k < 2; ++k) \
        acc[ai][bj][m][n] = __builtin_amdgcn_mfma_f32_16x16x32_bf16(Bt[n][k], At[m][k], acc[ai][bj][m][n], 0, 0, 0); __builtin_amdgcn_s_setprio(0); } while (0)
#define PG8_WAIT_V(n) asm volatile("s_waitcnt vmcnt(" #n ")" ::: "memory")
#define PG8_WAIT_L(n) asm volatile("s_waitcnt lgkmcnt(" #n ")" ::: "memory")
#define PG8_BAR __builtin_amdgcn_s_barrier()
#define PG8_SCHED __builtin_amdgcn_sched_barrier(0)
    Unit cur, nxt; int ui = 0;
    if (!S.next(0, cur)) return;
    f32x4 acc[2][2][4][2];
#pragma unroll
    for (int a = 0; a < 2; ++a)
#pragma unroll
        for (int b = 0; b < 2; ++b)
#pragma unroll
            for (int m = 0; m < 4; ++m)
#pragma unroll
                for (int n = 0; n < 2; ++n) acc[a][b][m][n] = (f32x4){0.f, 0.f, 0.f, 0.f};
    bf16x8 At[4][2], B0[2][2], B1[2][2];
    const char* cA = (const char*)g.A + (size_t)cur.pm * tstep + (size_t)cur.koff * 2; const char* cB = (const char*)g.Bt + (size_t)cur.pn * tstep + (size_t)cur.koff * 2;
    S.a_ready(cur);
    if constexpr (SP2) {
        PG8_STAGE(PG8_SB(0, 0), cB, voffB); PG8_STAGE(PG8_SB(0, 1), cB + hstep, voffB); PG8_STAGE(PG8_SA(0, 0), cA, voffA); PG8_STAGE(PG8_SA(0, 1), cA + hstep, voffA);
        if (wr == 1) PG8_BAR;
        PG8_WAIT_V(2); PG8_BAR;
        PG8_STAGE(PG8_SB(1, 0), cB + kstep, voffB); PG8_STAGE(PG8_SA(1, 0), cA + kstep, voffA); PG8_STAGE(PG8_SB(1, 1), cB + hstep + kstep, voffB);
        PG8_WAIT_V(6); PG8_BAR;
    } else {
        PG8_STAGE(PG8_SB(0, 0), cB, voffB); PG8_STAGE(PG8_SA(0, 0), cA, voffA); PG8_STAGE(PG8_SB(0, 1), cB + hstep, voffB); PG8_STAGE(PG8_SA(0, 1), cA + hstep, voffA);
        if (wr == 1) PG8_BAR;
        PG8_WAIT_V(4); PG8_BAR;
        PG8_STAGE(PG8_SB(1, 0), cB + kstep, voffB); PG8_STAGE(PG8_SA(1, 0), cA + kstep, voffA); PG8_STAGE(PG8_SB(1, 1), cB + hstep + kstep, voffB);
        PG8_WAIT_V(6); PG8_BAR;
    }
    for (;;) {
        const bool has_next = S.next(ui + 1, nxt);
        const char* nA = has_next ? (const char*)g.A + (size_t)nxt.pm * tstep + (size_t)nxt.koff * 2 : cA; const char* nB = has_next ? (const char*)g.Bt + (size_t)nxt.pn * tstep + (size_t)nxt.koff * 2 : cB;
        for (int t = 0; t < nt; t += 2) {
            const bool last = (t == nt - 2);
            const char* a1 = cA + (size_t)(t + 1) * kstep;
            const char* a2 = last ? nA : cA + (size_t)(t + 2) * kstep; const char* b2 = last ? nB : cB + (size_t)(t + 2) * kstep;
            const char* a3 = a2 + kstep; const char* b3 = b2 + kstep;
            if (last && has_next) S.a_ready(nxt);
            if constexpr (SP2) {
            PG8_LDB(B0, 0, 0); PG8_LDB(B1, 0, 1); PG8_SCHED; PG8_LDA(At, 0, 0); PG8_STAGE(PG8_SA(1, 1), a1 + hstep, voffA);
            PG8_WAIT_V(8); PG8_WAIT_L(0); PG8_BAR; PG8_MMA(0, 0, At, B0); PG8_MMA(0, 1, At, B1); PG8_BAR; PG8_SCHED;
            PG8_LDA(At, 0, 1); PG8_STAGE(PG8_SB(0, 0), b2, voffB); PG8_STAGE(PG8_SB(0, 1), b2 + hstep, voffB); PG8_STAGE(PG8_SA(0, 0), a2, voffA);
            PG8_WAIT_V(8); PG8_WAIT_L(0); PG8_BAR; PG8_MMA(1, 0, At, B0); PG8_MMA(1, 1, At, B1); PG8_BAR; PG8_SCHED;
            PG8_LDB(B0, 1, 0); PG8_LDB(B1, 1, 1); PG8_SCHED; PG8_LDA(At, 1, 0); PG8_STAGE(PG8_SA(0, 1), a2 + hstep, voffA);
            PG8_WAIT_V(8); PG8_WAIT_L(0); PG8_BAR; PG8_MMA(0, 0, At, B0); PG8_MMA(0, 1, At, B1); PG8_BAR; PG8_SCHED;
            PG8_LDA(At, 1, 1); PG8_STAGE(PG8_SB(1, 0), b3, voffB); PG8_STAGE(PG8_SB(1, 1), b3 + hstep, voffB); PG8_STAGE(PG8_SA(1, 0), a3, voffA);
            PG8_WAIT_V(8); PG8_WAIT_L(0); PG8_BAR; PG8_MMA(1, 0, At, B0); PG8_MMA(1, 1, At, B1); PG8_BAR; PG8_SCHED;
            } else {
            PG8_LDB(B0, 0, 0); PG8_SCHED; PG8_LDA(At, 0, 0); PG8_STAGE(PG8_SA(1, 1), a1 + hstep, voffA);
            PG8_WAIT_L(8); PG8_BAR; PG8_WAIT_L(0); PG8_MMA(0, 0, At, B0); PG8_BAR; PG8_SCHED;
            PG8_LDB(B1, 0, 1); PG8_STAGE(PG8_SB(0, 0), b2, voffB);
            PG8_BAR; PG8_WAIT_L(0); PG8_MMA(0, 1, At, B1); PG8_BAR;
            PG8_LDA(At, 0, 1); PG8_STAGE(PG8_SA(0, 0), a2, voffA);
            PG8_BAR; PG8_WAIT_L(0); PG8_MMA(1, 0, At, B0); PG8_BAR; PG8_SCHED;
            PG8_STAGE(PG8_SB(0, 1), b2 + hstep, voffB);
            PG8_WAIT_V(6); PG8_BAR; PG8_MMA(1, 1, At, B1); PG8_BAR;
            PG8_LDB(B0, 1, 0); PG8_SCHED; PG8_LDA(At, 1, 0); PG8_STAGE(PG8_SA(0, 1), a2 + hstep, voffA);
            PG8_WAIT_L(8); PG8_BAR; PG8_WAIT_L(0); PG8_MMA(0, 0, At, B0); PG8_BAR; PG8_SCHED;
            PG8_LDB(B1, 1, 1); PG8_STAGE(PG8_SB(1, 0), b3, voffB);
            PG8_BAR; PG8_WAIT_L(0); PG8_MMA(0, 1, At, B1); PG8_BAR;
            PG8_LDA(At, 1, 1); PG8_STAGE(PG8_SA(1, 0), a3, voffA);
            PG8_BAR; PG8_WAIT_L(0); PG8_MMA(1, 0, At, B0); PG8_BAR; PG8_SCHED;
            PG8_STAGE(PG8_SB(1, 1), b3 + hstep, voffB);
            PG8_WAIT_V(6); PG8_BAR; PG8_MMA(1, 1, At, B1); PG8_BAR;
            }
        }
        if constexpr (ALIGN_EPI) { if (wr == 0) PG8_BAR; }
        if constexpr (!Epi::AFTER_DRAIN) { E(acc, cur, wr, wc, fr, fq); S.done(cur); }
        if (!has_next) break;
#pragma unroll
        for (int a = 0; a < 2; ++a)
#pragma unroll
            for (int b = 0; b < 2; ++b)
#pragma unroll
                for (int m = 0; m < 4; ++m)
#pragma unroll
                    for (int n = 0; n < 2; ++n) acc[a][b][m][n] = (f32x4){0.f, 0.f, 0.f, 0.f};
        cur = nxt; cA = nA; cB = nB; ++ui;
        if constexpr (ALIGN_EPI) { if (wr == 1) PG8_BAR; }
    }
    PG8_WAIT_V(0);
    if constexpr (!ALIGN_EPI) { if (wr == 0) PG8_BAR; }
    PG8_BAR;
    if constexpr (Epi::AFTER_DRAIN) { E.fused(acc, cur, wr, wc, fr, fq, lds, wid, lane); S.done(cur); }
#undef PG8_SA
#undef PG8_SB
#undef PG8_STAGE
#undef PG8_LDA
#undef PG8_LDB
#undef PG8_MMA
#undef PG8_WAIT_V
#undef PG8_WAIT_L
#undef PG8_BAR
#undef PG8_SCHED
}
}

using pg8::bf16_t; using pg8::bf16x8; using pg8::f32x4; using pg8::u32x4; using pg8::Unit;
typedef float f32x16 __attribute__((ext_vector_type(16)));
typedef float f32x2v __attribute__((ext_vector_type(2)));
typedef __bf16 bf16x2v __attribute__((ext_vector_type(2)));
typedef unsigned u32x2 __attribute__((ext_vector_type(2)));
#define LAS __attribute__((address_space(3)))

constexpr int DM = 1024, NBATCH = 2, SEQ = 16384, CTXL = 256;
constexpr int NLAT = NBATCH * SEQ, NCTX = NBATCH * CTXL, R = NLAT + NCTX;
constexpr int DFF = 2816, KEYS = SEQ + CTXL;
constexpr float EPS = 1e-6f;
constexpr float C2 = 0.125f * 1.4426950408889634f;
constexpr int NTHR = 512;
constexpr int LDS_BYTES = 135168;
constexpr int HG_SEG = 128, HG_STEPS = KEYS / HG_SEG;

constexpr size_t WL_UP1 = 0, WL_DN1 = WL_UP1 + (size_t)5632 * 1024, WL_UP2 = WL_DN1 + (size_t)1024 * 2816, WL_DN2 = WL_UP2 + (size_t)5632 * 1024,
                 WL_IN = WL_DN2 + (size_t)1024 * 2816, WL_PA = WL_IN + (size_t)6144 * 1024, WL_PH = WL_PA + (size_t)1024 * 512, WL_PP = WL_PH + (size_t)1024 * 256,
                 WL_O = WL_PP + (size_t)1024 * 256, WL_TOTAL = WL_O + (size_t)1024 * 1024;
constexpr size_t WS_WB = 0;
constexpr size_t WS_XB = WS_WB + 2 * WL_TOTAL * 2;
constexpr size_t WS_Z = WS_XB + (size_t)R * 1024 * 2;
constexpr size_t Z_VT = 0, Z_HQ = Z_VT + (size_t)R * 512 * 2, Z_FF = Z_HQ + (size_t)R * 256 * 4, Z_FB = Z_FF + (size_t)R * 256 * 4, Z_HI = Z_FB + (size_t)R * 256 * 4,
                 Z_ZP = Z_HI + (size_t)R * 256 * 2, Z_Q = Z_ZP + (size_t)R * 256 * 2, Z_K = Z_Q + (size_t)R * 512 * 2, Z_HG = Z_K + (size_t)R * 512 * 2, Z_END = Z_HG + (size_t)R * 256 * 2;
static_assert((size_t)R * 3072 * 2 <= Z_K, "gate buffer must not reach k / odir / hgate");
static_assert((size_t)R * DFF * 2 <= Z_END, "act fits Z");
constexpr size_t WS_O = WS_Z + Z_END;
constexpr size_t O_DA = 0, O_HG = O_DA + (size_t)R * 512 * 2, O_MX = O_HG + (size_t)R * 256 * 2, O_END = O_MX + (size_t)R * 256 * 2;
constexpr size_t WS_CAR = WS_O + O_END;
constexpr size_t WS_DK = WS_CAR + (size_t)16 * HG_SEG * 4096 * 4;
constexpr size_t WS_HC = WS_DK + (size_t)16 * HG_SEG * 64 * 4;
constexpr size_t WS_MOD = WS_HC + (size_t)NCTX * 1024 * 4;
constexpr size_t WS_CS = WS_MOD + (size_t)2 * 3 * 9216 * 4;
constexpr size_t WS_LB = WS_CS + (size_t)256 * 32 * 4;
constexpr size_t WS_LAM = WS_LB + (size_t)2 * 2 * 256 * 4;
constexpr size_t WS_END = WS_LAM + 256;
static_assert(WS_END <= (size_t)512 * 1024 * 1024, "workspace");

__device__ __forceinline__ unsigned pk2(float lo, float hi) { f32x2v v = {lo, hi}; bf16x2v b = __builtin_convertvector(v, bf16x2v); return __builtin_bit_cast(unsigned, b); }
__device__ __forceinline__ float bf2f(unsigned short u) { return __builtin_bit_cast(float, (unsigned)u << 16); }
__device__ __forceinline__ float bflo(unsigned u) { return __builtin_bit_cast(float, u << 16); }
__device__ __forceinline__ float bfhi(unsigned u) { return __builtin_bit_cast(float, u & 0xffff0000u); }
__device__ __forceinline__ float ex2(float x) { return __builtin_amdgcn_exp2f(x); }
__device__ __forceinline__ float rcpf_(float x) { return __builtin_amdgcn_rcpf(x); }
__device__ __forceinline__ float sigm(float x) { return rcpf_(1.f + ex2(-1.4426950408889634f * x)); }
__device__ __forceinline__ float siluf(float x) { return x * sigm(x); }
__device__ __forceinline__ float shx(float v, int o, int lane) { return __builtin_bit_cast(float, __builtin_amdgcn_ds_bpermute((lane ^ o) << 2, __builtin_bit_cast(int, v))); }
__device__ __forceinline__ float swap32(float v) { auto rr = __builtin_amdgcn_permlane32_swap(__builtin_bit_cast(unsigned, v), __builtin_bit_cast(unsigned, v), false, false);
    const float a = __builtin_bit_cast(float, rr[0]), b = __builtin_bit_cast(float, rr[1]); return (a == v) ? b : a; }
__device__ __forceinline__ float wave_sum(float v, int lane) {
#pragma unroll
    for (int o = 1; o < 64; o <<= 1) v += shx(v, o, lane);
    return v;
}
#define LDS_WAIT() asm volatile("s_waitcnt lgkmcnt(0)" ::: "memory")

struct EpiUp {
    static constexpr bool PERM = true, AFTER_DRAIN = false;
    bf16_t* act;
    __device__ __forceinline__ void operator()(const f32x4 (&acc)[2][2][4][2], const Unit& u, int wr, int wc, int fr, int fq) const {
        const int row0 = u.pm * 256 + wr * 64 + fr, col0 = u.pn * 128 + wc * 32 + 8 * fq;
#pragma unroll
        for (int ai = 0; ai < 2; ++ai)
#pragma unroll
            for (int m = 0; m < 4; ++m) {
                const int row = row0 + ai * 128 + m * 16;
                const f32x4 a0 = acc[ai][0][m][0], a1 = acc[ai][0][m][1], b0 = acc[ai][1][m][0], b1 = acc[ai][1][m][1];
                u32x4 w;
                w.x = pk2(siluf(a0[0]) * b0[0], siluf(a0[1]) * b0[1]); w.y = pk2(siluf(a0[2]) * b0[2], siluf(a0[3]) * b0[3]);
                w.z = pk2(siluf(a1[0]) * b1[0], siluf(a1[1]) * b1[1]); w.w = pk2(siluf(a1[2]) * b1[2], siluf(a1[3]) * b1[3]);
                *(u32x4*)(act + (size_t)row * DFF + col0) = w;
            }
    }
};
struct EpiRes {
    static constexpr bool PERM = true, AFTER_DRAIN = false;
    const float* in_lat; const float* in_ctx; float* out_lat; float* out_ctx; const float* gate; float coef;
    __device__ __forceinline__ void operator()(const f32x4 (&acc)[2][2][4][2], const Unit& u, int wr, int wc, int fr, int fq) const {
        const int row0 = u.pm * 256 + wr * 64 + fr, col0 = u.pn * 256 + wc * 32 + 8 * fq;
        const int seg = (u.pm < 64) ? 0 : (u.pm < 128 ? 1 : 2);
        f32x4 gv[2][2];
#pragma unroll
        for (int bj = 0; bj < 2; ++bj)
#pragma unroll
            for (int n = 0; n < 2; ++n) gv[bj][n] = *(const f32x4*)(gate + seg * 9216 + col0 + bj * 128 + 4 * n) * coef;
#pragma unroll
        for (int ai = 0; ai < 2; ++ai)
#pragma unroll
            for (int m = 0; m < 4; ++m) {
                const int row = row0 + ai * 128 + m * 16;
                const float* ip; float* op;
                if (row < NLAT) { ip = in_lat + (size_t)row * DM; op = out_lat + (size_t)row * DM; }
                else { ip = in_ctx + (size_t)(row - NLAT) * DM; op = out_ctx + (size_t)(row - NLAT) * DM; }
#pragma unroll
                for (int bj = 0; bj < 2; ++bj)
#pragma unroll
                    for (int n = 0; n < 2; ++n) {
                        const int c = col0 + bj * 128 + 4 * n;
                        f32x4 v = *(const f32x4*)(ip + c);
                        v = v + gv[bj][n] * acc[ai][bj][m][n];
                        *(f32x4*)(op + c) = v;
                    }
            }
    }
};
struct SplitKOrder {
    int nunits, G, c, kc;
    __device__ void init(int nparts, int kc_, int G_, int c_) { nunits = nparts * 8; G = G_; c = c_; kc = kc_; }
    __device__ bool next(int i, Unit& u) const {
        const int L = i * G + c; if (L >= nunits) return false;
        const int part = L >> 3, r = L & 7; u.pm = r >> 2; u.pn = r & 3; u.koff = part * kc; return true;
    }
    __device__ __forceinline__ void a_ready(const Unit&) const {}
    __device__ __forceinline__ void done(const Unit&) const {}
};
struct EpiPart {
    static constexpr bool PERM = true, AFTER_DRAIN = false;
    float* P; const float* gate; float coef;
    __device__ __forceinline__ void operator()(const f32x4 (&acc)[2][2][4][2], const Unit& u, int wr, int wc, int fr, int fq) const {
        unsigned z_ = 0u; asm volatile("" : "+s"(z_));
        const int lane_ = (int)__builtin_amdgcn_mbcnt_hi(~0u, __builtin_amdgcn_mbcnt_lo(~0u, z_)), fr_ = lane_ & 15, fq_ = lane_ >> 4;
        const int row0 = u.pm * 256 + wr * 64 + fr_, col0 = u.pn * 256 + wc * 32 + 8 * fq_;
        float* Pp = P + (size_t)(u.koff >> 8) * NCTX * DM;
        f32x4 gv[2][2];
#pragma unroll
        for (int bj = 0; bj < 2; ++bj)
#pragma unroll
            for (int n = 0; n < 2; ++n) gv[bj][n] = *(const f32x4*)(gate + 2 * 9216 + col0 + bj * 128 + 4 * n) * coef;
#pragma unroll
        for (int ai = 0; ai < 2; ++ai)
#pragma unroll
            for (int m = 0; m < 4; ++m) {
                float* op = Pp + (size_t)(row0 + ai * 128 + m * 16) * DM;
#pragma unroll
                for (int bj = 0; bj < 2; ++bj)
#pragma unroll
                    for (int n = 0; n < 2; ++n) *(f32x4*)(op + col0 + bj * 128 + 4 * n) = gv[bj][n] * acc[ai][bj][m][n];
            }
    }
};
struct EpiWin {
    static constexpr bool PERM = true, AFTER_DRAIN = false;
    unsigned char* Z; const float* cs; const float* lb; int pn_off;
    __device__ __forceinline__ void operator()(const f32x4 (&acc)[2][2][4][2], const Unit& u, int wr, int wc, int fr, int fq) const {
        const int t = u.pn + pn_off;
        const int row0 = u.pm * 256 + wr * 64 + fr, cin = wc * 32 + 8 * fq;
        if (t < 4) {
            bf16_t* dst = (bf16_t*)(Z + ((t < 2) ? Z_Q : Z_K)); const float sc = (t < 2) ? C2 : 1.f; const int cb = (t & 1) * 256;
#pragma unroll
            for (int ai = 0; ai < 2; ++ai)
#pragma unroll
                for (int m = 0; m < 4; ++m) {
                    const int row = row0 + ai * 128 + m * 16;
                    f32x4 cv = {1.f, 1.f, 1.f, 1.f}, sv = {0.f, 0.f, 0.f, 0.f};
                    if (row < NLAT) { const int ts = row & (SEQ - 1); const int pos = (wc & 1) ? (ts & 63) : (ts >> 6);
                        cv = *(const f32x4*)(cs + pos * 32 + 4 * fq); sv = *(const f32x4*)(cs + pos * 32 + 16 + 4 * fq); }
#pragma unroll
                    for (int bj = 0; bj < 2; ++bj) {
                        const f32x4 x1 = acc[ai][bj][m][0], x2 = acc[ai][bj][m][1];
                        const f32x4 o1 = (x1 * cv - x2 * sv) * sc, o2 = (x1 * sv + x2 * cv) * sc;
                        u32x4 w; w.x = pk2(o1[0], o1[1]); w.y = pk2(o1[2], o1[3]); w.z = pk2(o2[0], o2[1]); w.w = pk2(o2[2], o2[3]);
                        *(u32x4*)(dst + (size_t)row * 512 + cb + bj * 128 + cin) = w;
                    }
                }
        } else if (t < 6) {
            bf16_t* vT = (bf16_t*)(Z + Z_VT);
#pragma unroll
            for (int ai = 0; ai < 2; ++ai)
#pragma unroll
                for (int m = 0; m < 4; ++m) {
                    const int row = row0 + ai * 128 + m * 16;
                    int b, key;
                    if (row < NLAT) { b = row >> 14; key = row & (SEQ - 1); } else { b = (row - NLAT) >> 8; key = SEQ + ((row - NLAT) & (CTXL - 1)); }
#pragma unroll
                    for (int bj = 0; bj < 2; ++bj) {
                        bf16_t* dp = vT + (size_t)(b * 512 + (t - 4) * 256 + bj * 128 + cin) * KEYS + key;
#pragma unroll
                        for (int n = 0; n < 2; ++n)
#pragma unroll
                            for (int i = 0; i < 4; i += 2) {
                                const unsigned w = pk2(acc[ai][bj][m][n][i], acc[ai][bj][m][n][i + 1]);
                                dp[(size_t)(4 * n + i) * KEYS] = (bf16_t)(w & 0xffffu); dp[(size_t)(4 * n + i + 1) * KEYS] = (bf16_t)(w >> 16);
                            }
                    }
                }
        } else if (t <= 8) {
            float* dst = (float*)(Z + ((t == 6) ? Z_HQ : (t == 7 ? Z_FF : Z_FB)));
            const float* lbp = lb + ((t == 8) ? 256 : 0);
#pragma unroll
            for (int bj = 0; bj < 2; ++bj)
#pragma unroll
                for (int n = 0; n < 2; ++n) {
                    f32x4 lbv = *(const f32x4*)(lbp + bj * 128 + cin + 4 * n);
                    f32x4 om = 1.f - lbv;
#pragma unroll
                    for (int ai = 0; ai < 2; ++ai)
#pragma unroll
                        for (int m = 0; m < 4; ++m) {
                            const int row = row0 + ai * 128 + m * 16;
                            const f32x4 z = acc[ai][bj][m][n];
                            f32x4 sg; sg[0] = sigm(z[0]); sg[1] = sigm(z[1]); sg[2] = sigm(z[2]); sg[3] = sigm(z[3]);
                            const f32x4 o = (t == 6) ? z * sg : lbv + om * sg;
                            *(f32x4*)(dst + (size_t)row * 256 + bj * 128 + cin + 4 * n) = o;
                        }
                }
        } else {
            bf16_t* dst = (bf16_t*)(Z + ((t == 9) ? Z_HI : (t == 10 ? Z_HG : Z_ZP)));
#pragma unroll
            for (int ai = 0; ai < 2; ++ai)
#pragma unroll
                for (int m = 0; m < 4; ++m) {
                    const int row = row0 + ai * 128 + m * 16;
#pragma unroll
                    for (int bj = 0; bj < 2; ++bj) {
                        f32x4 v0 = acc[ai][bj][m][0], v1 = acc[ai][bj][m][1];
                        if (t == 10) { v0[0] = siluf(v0[0]); v0[1] = siluf(v0[1]); v0[2] = siluf(v0[2]); v0[3] = siluf(v0[3]); v1[0] = siluf(v1[0]); v1[1] = siluf(v1[1]); v1[2] = siluf(v1[2]); v1[3] = siluf(v1[3]); }
                        u32x4 w; w.x = pk2(v0[0], v0[1]); w.y = pk2(v0[2], v0[3]); w.z = pk2(v1[0], v1[1]); w.w = pk2(v1[2], v1[3]);
                        *(u32x4*)(dst + (size_t)row * 256 + bj * 128 + cin) = w;
                    }
                }
        }
    }
};
struct EpiVT {
    static constexpr bool PERM = true, AFTER_DRAIN = false;
    bf16_t* vT;
    __device__ __forceinline__ void operator()(const f32x4 (&acc)[2][2][4][2], const Unit& u, int wr, int wc, int fr, int fq) const {
        const int e0 = u.pm * 256 + wr * 64 + fr;
        int b, key0;
        if (u.pn < 64) { b = 0; key0 = u.pn * 256; } else if (u.pn < 128) { b = 1; key0 = (u.pn - 64) * 256; } else { b = u.pn - 128; key0 = SEQ; }
        const int kc = key0 + wc * 32 + 8 * fq;
#pragma unroll
        for (int ai = 0; ai < 2; ++ai)
#pragma unroll
            for (int m = 0; m < 4; ++m) {
                const int e = e0 + ai * 128 + m * 16;
#pragma unroll
                for (int bj = 0; bj < 2; ++bj) {
                    const f32x4 v0 = acc[ai][bj][m][0], v1 = acc[ai][bj][m][1];
                    u32x4 w; w.x = pk2(v0[0], v0[1]); w.y = pk2(v0[2], v0[3]); w.z = pk2(v1[0], v1[1]); w.w = pk2(v1[2], v1[3]);
                    *(u32x4*)(vT + (size_t)(b * 512 + e) * KEYS + kc + bj * 128) = w;
                }
            }
    }
};
struct EpiG {
    static constexpr bool PERM = true, AFTER_DRAIN = false;
    bf16_t* G;
    __device__ __forceinline__ void operator()(const f32x4 (&acc)[2][2][4][2], const Unit& u, int wr, int wc, int fr, int fq) const {
        const int row0 = u.pm * 256 + wr * 64 + fr, col0 = u.pn * 256 + wc * 32 + 8 * fq;
#pragma unroll
        for (int ai = 0; ai < 2; ++ai)
#pragma unroll
            for (int m = 0; m < 4; ++m) {
                const int row = row0 + ai * 128 + m * 16;
#pragma unroll
                for (int bj = 0; bj < 2; ++bj) {
                    const f32x4 v0 = acc[ai][bj][m][0], v1 = acc[ai][bj][m][1];
                    u32x4 w; w.x = pk2(sigm(v0[0]), sigm(v0[1])); w.y = pk2(sigm(v0[2]), sigm(v0[3])); w.z = pk2(sigm(v1[0]), sigm(v1[1])); w.w = pk2(sigm(v1[2]), sigm(v1[3]));
                    *(u32x4*)(G + (size_t)row * 3072 + col0 + bj * 128) = w;
                }
            }
    }
};
struct EpiProj {
    static constexpr bool PERM = true, AFTER_DRAIN = false;
    bf16_t* y; const bf16_t* G; int gi; int first;
    __device__ __forceinline__ void operator()(const f32x4 (&acc)[2][2][4][2], const Unit& u, int wr, int wc, int fr, int fq) const {
        const int row0 = u.pm * 256 + wr * 64 + fr, col0 = u.pn * 256 + wc * 32 + 8 * fq;
#pragma unroll
        for (int ai = 0; ai < 2; ++ai)
#pragma unroll
            for (int m = 0; m < 4; ++m) {
                const int row = row0 + ai * 128 + m * 16;
#pragma unroll
                for (int bj = 0; bj < 2; ++bj) {
                    const int c = col0 + bj * 128;
                    const u32x4 g = *(const u32x4*)(G + (size_t)row * 3072 + gi * 1024 + c);
                    u32x4 yo = {0u, 0u, 0u, 0u};
                    if (!first) yo = *(const u32x4*)(y + (size_t)row * 1024 + c);
                    const f32x4 v0 = acc[ai][bj][m][0], v1 = acc[ai][bj][m][1];
                    u32x4 w;
                    w.x = pk2(bflo(yo.x) + bflo(g.x) * v0[0], bfhi(yo.x) + bfhi(g.x) * v0[1]);
                    w.y = pk2(bflo(yo.y) + bflo(g.y) * v0[2], bfhi(yo.y) + bfhi(g.y) * v0[3]);
                    w.z = pk2(bflo(yo.z) + bflo(g.z) * v1[0], bfhi(yo.z) + bfhi(g.z) * v1[1]);
                    w.w = pk2(bflo(yo.w) + bflo(g.w) * v1[2], bfhi(yo.w) + bfhi(g.w) * v1[3]);
                    *(u32x4*)(y + (size_t)row * 1024 + c) = w;
                }
            }
    }
};

__device__ __forceinline__ int map_row(int mode, int n) {
    if (mode == 1) return 256 * (n >> 7) + (n & 127);
    if (mode == 2) return 256 * (n >> 7) + 128 + (n & 127);
    if (mode == 3) return (n < 1024) ? ((n & ~31) + 8 * ((n & 15) >> 2) + 4 * ((n >> 4) & 1) + (n & 3)) : n;
    return n;
}
__device__ __forceinline__ void transpose_item(const float* W, int K, int N, bf16_t* WT, int mode, LAS float* scr, int item, int lane) {
    const int nblk = N / 32, kb = item / nblk, nb = item % nblk, k0 = 64 * kb, n0 = 32 * nb;
#pragma unroll 8
    for (int i = 0; i < 32; ++i) { const int kk = 2 * i + (lane >> 5); scr[kk * 33 + (lane & 31)] = W[(size_t)(k0 + kk) * N + n0 + (lane & 31)]; }
    LDS_WAIT(); asm volatile("" ::: "memory");
    const int c = lane & 7;
#pragma unroll
    for (int j = 0; j < 4; ++j) { const int n = (lane >> 3) + 8 * j; const LAS float* s = scr + (8 * c) * 33 + n;
        u32x4 o; o.x = pk2(s[0 * 33], s[1 * 33]); o.y = pk2(s[2 * 33], s[3 * 33]); o.z = pk2(s[4 * 33], s[5 * 33]); o.w = pk2(s[6 * 33], s[7 * 33]);
        *(u32x4*)(WT + (size_t)map_row(mode, n0 + n) * K + k0 + 8 * c) = o; }
    LDS_WAIT(); asm volatile("" ::: "memory");
}

__device__ __forceinline__ void norm_phase(const float* in_lat, const float* in_ctx, const float* gain, const float* modl, int shi, int sci, bf16_t* outp, int gw, int ngw, int lane,
                                           const float* part, int nparts, float* hc_out) {
    f32x4 gv[4];
#pragma unroll
    for (int j = 0; j < 4; ++j) gv[j] = *(const f32x4*)(gain + 4 * lane + 256 * j);
    for (int row = gw; row < R; row += ngw) {
        const float* ip = (row < NLAT) ? in_lat + (size_t)row * DM : in_ctx + (size_t)(row - NLAT) * DM;
        const int seg = (row < SEQ) ? 0 : (row < NLAT ? 1 : 2);
        const float* sh = modl + seg * 9216 + shi * 1024; const float* sc = modl + seg * 9216 + sci * 1024;
        f32x4 v[4]; float ss = 0.f;
#pragma unroll
        for (int j = 0; j < 4; ++j) v[j] = *(const f32x4*)(ip + 4 * lane + 256 * j);
        if (row >= NLAT && nparts > 0) {
            for (int p = 0; p < nparts; ++p) {
                const float* pp = part + ((size_t)p * NCTX + (row - NLAT)) * DM;
#pragma unroll
                for (int j = 0; j < 4; ++j) v[j] = v[j] + *(const f32x4*)(pp + 4 * lane + 256 * j);
            }
#pragma unroll
            for (int j = 0; j < 4; ++j) *(f32x4*)(hc_out + (size_t)(row - NLAT) * DM + 4 * lane + 256 * j) = v[j];
        }
#pragma unroll
        for (int j = 0; j < 4; ++j) ss += (v[j][0] * v[j][0] + v[j][1] * v[j][1]) + (v[j][2] * v[j][2] + v[j][3] * v[j][3]);
        ss = wave_sum(ss, lane);
        const float rstd = 1.0f / sqrtf(ss * (1.f / DM) + EPS);
#pragma unroll
        for (int j = 0; j < 4; ++j) {
            const f32x4 s4 = *(const f32x4*)(sc + 4 * lane + 256 * j), h4 = *(const f32x4*)(sh + 4 * lane + 256 * j);
            const f32x4 y = v[j] * rstd * gv[j] * (s4 + 1.f) + h4;
            u32x2 w; w.x = pk2(y[0], y[1]); w.y = pk2(y[2], y[3]);
            *(u32x2*)(outp + (size_t)row * DM + 4 * lane + 256 * j) = w;
        }
    }
}
__device__ __forceinline__ void final_norm_phase(float* out, const float* gain, int gw, int ngw, int lane) {
    f32x4 gv[4];
#pragma unroll
    for (int j = 0; j < 4; ++j) gv[j] = *(const f32x4*)(gain + 4 * lane + 256 * j);
    for (int row = gw; row < NLAT; row += ngw) {
        float* ip = out + (size_t)row * DM;
        f32x4 v[4]; float ss = 0.f;
#pragma unroll
        for (int j = 0; j < 4; ++j) { v[j] = *(const f32x4*)(ip + 4 * lane + 256 * j); ss += (v[j][0] * v[j][0] + v[j][1] * v[j][1]) + (v[j][2] * v[j][2] + v[j][3] * v[j][3]); }
        ss = wave_sum(ss, lane);
        const float rstd = 1.0f / sqrtf(ss * (1.f / DM) + EPS);
#pragma unroll
        for (int j = 0; j < 4; ++j) *(f32x4*)(ip + 4 * lane + 256 * j) = v[j] * rstd * gv[j];
    }
}
__device__ __forceinline__ void pool_phase(const bf16_t* zp, bf16_t* mx, int gtid, int ngt) {
    for (int it = gtid; it < R * 32; it += ngt) {
        const int row = it >> 5, ch = (it & 31) * 8, g = ch >> 6, hw = 1 << g;
        int base, n;
        if (row < NLAT) { base = row & ~(SEQ - 1); n = SEQ; } else { base = NLAT + ((row - NLAT) & ~(CTXL - 1)); n = CTXL; }
        const int t = row - base, lo = (t - hw > 0) ? t - hw : 0, hi = (t + hw < n) ? t + hw : n;
        float s[8];
#pragma unroll
        for (int i = 0; i < 8; ++i) s[i] = 0.f;
        for (int j = lo; j < hi; ++j) {
            const u32x4 v = *(const u32x4*)(zp + (size_t)(base + j) * 256 + ch);
            s[0] += bflo(v.x); s[1] += bfhi(v.x); s[2] += bflo(v.y); s[3] += bfhi(v.y); s[4] += bflo(v.z); s[5] += bfhi(v.z); s[6] += bflo(v.w); s[7] += bfhi(v.w);
        }
        const float inv = 1.f / (float)(hi - lo);
        const u32x4 c = *(const u32x4*)(zp + (size_t)row * 256 + ch);
        u32x4 w;
        w.x = pk2(s[0] * inv - bflo(c.x), s[1] * inv - bfhi(c.x)); w.y = pk2(s[2] * inv - bflo(c.y), s[3] * inv - bfhi(c.y));
        w.z = pk2(s[4] * inv - bflo(c.z), s[5] * inv - bfhi(c.z)); w.w = pk2(s[6] * inv - bflo(c.w), s[7] * inv - bfhi(c.w));
        *(u32x4*)(mx + (size_t)row * 256 + ch) = w;
    }
}

__device__ __forceinline__ int hg_row(int dir, int b, int step) {
    if (step < CTXL) { const int t = dir ? (CTXL - 1 - step) : step; return NLAT + b * CTXL + t; }
    int t = step - CTXL; if (dir) t = SEQ - 1 - t; return b * SEQ + t;
}
template <bool OUT>
__device__ __forceinline__ void hg_pass(const float* hq, const float* ff, const float* fb, const bf16_t* hi, float* carry, float* dk, bf16_t* odir, int wave, int lane, int G) {
    for (int item = blockIdx.x + G * wave; item < 16 * HG_SEG; item += G * 8) {
        const int s = item / HG_SEG, j = item % HG_SEG, dir = s >> 3, b = (s >> 2) & 1, h = s & 3;
        const float* fbase = dir ? fb : ff;
        f32x2v S[32];
#pragma unroll
        for (int k = 0; k < 32; ++k) { S[k][0] = OUT ? carry[((size_t)item * 64 + 2 * k) * 64 + lane] : 0.f; S[k][1] = OUT ? carry[((size_t)item * 64 + 2 * k + 1) * 64 + lane] : 0.f; }
        float dl = 1.f;
        const int st0 = j * HG_STEPS, st1 = st0 + HG_STEPS;
        constexpr int HG_PF = 8;
        float ivb[HG_PF], fvb[HG_PF], qvb[HG_PF];
#pragma unroll
        for (int u = 0; u < HG_PF; ++u) {
            const int stl = (st0 + u < st1) ? st0 + u : st1 - 1;
            const size_t off = (size_t)hg_row(dir, b, stl) * 256 + h * 64 + lane;
            ivb[u] = bf2f(hi[off]); fvb[u] = fbase[off]; qvb[u] = OUT ? hq[off] : 0.f;
        }
        for (int sb = st0; sb < st1; sb += HG_PF) {
#pragma unroll
            for (int u = 0; u < HG_PF; ++u) {
                const int st = sb + u;
                if (st < st1) {
                    const float iv = ivb[u], fv = fvb[u], qv = qvb[u];
                    const size_t offc = (size_t)hg_row(dir, b, st) * 256 + h * 64 + lane;
                    { const int stn = (st + HG_PF < st1) ? st + HG_PF : st1 - 1;
                      const size_t off = (size_t)hg_row(dir, b, stn) * 256 + h * 64 + lane;
                      ivb[u] = bf2f(hi[off]); fvb[u] = fbase[off]; if (OUT) qvb[u] = hq[off]; }
                    if (!OUT) dl *= fv;
                    f32x2v o2 = {0.f, 0.f};
                    const f32x2v iv2 = {iv, iv};
                    const int fvi = __builtin_bit_cast(int, fv), qvi = __builtin_bit_cast(int, qv);
#pragma unroll
                    for (int k = 0; k < 32; ++k) {
                        f32x2v f2; f2[0] = __builtin_bit_cast(float, __builtin_amdgcn_readlane(fvi, 2 * k)); f2[1] = __builtin_bit_cast(float, __builtin_amdgcn_readlane(fvi, 2 * k + 1));
                        const f32x2v d2 = S[k] - iv2;
                        S[k] = __builtin_elementwise_fma(f2, d2, iv2);
                        if (OUT) { f32x2v q2; q2[0] = __builtin_bit_cast(float, __builtin_amdgcn_readlane(qvi, 2 * k)); q2[1] = __builtin_bit_cast(float, __builtin_amdgcn_readlane(qvi, 2 * k + 1));
                            o2 = __builtin_elementwise_fma(q2, S[k], o2); }
                    }
                    if (OUT) odir[(size_t)dir * R * 256 + offc] = (bf16_t)(pk2(o2[0] + o2[1], 0.f) & 0xffffu);
                }
            }
        }
        if (!OUT) {
#pragma unroll
            for (int k = 0; k < 32; ++k) { carry[((size_t)item * 64 + 2 * k) * 64 + lane] = S[k][0]; carry[((size_t)item * 64 + 2 * k + 1) * 64 + lane] = S[k][1]; }
            dk[item * 64 + lane] = dl;
        }
    }
}
constexpr int HGA_T = 48, HGA_STR = 112, HGA_MAT = 64 * HGA_STR, HGA_WAVE = 2 * HGA_MAT;
static_assert(8 * HGA_WAVE <= LDS_BYTES - 64 && 3 * HGA_T >= HG_STEPS, "hg pass A LDS");
__device__ __forceinline__ void hg_passA_mfma(LAS unsigned char* lds, const float* ff, const float* fb, const bf16_t* hi, float* carry, float* dk, int wave, int lane, int G) {
    LAS unsigned char* KT = lds + wave * HGA_WAVE; LAS unsigned char* VT = KT + HGA_MAT;
    const int n = lane & 31, gq = lane >> 5;
    for (int item = blockIdx.x + G * wave; item < 16 * HG_SEG; item += G * 8) {
        const int s = item / HG_SEG, j = item % HG_SEG, dir = s >> 3, b = (s >> 2) & 1, h = s & 3;
        const float* fbase = dir ? fb : ff;
        const int st0 = j * HG_STEPS, st1 = st0 + HG_STEPS;
        f32x16 acc[2][2];
#pragma unroll
        for (int kb = 0; kb < 2; ++kb)
#pragma unroll
            for (int vb = 0; vb < 2; ++vb)
#pragma unroll
                for (int r = 0; r < 16; ++r) acc[kb][vb][r] = 0.f;
        float P = 1.f;
        for (int third = 2; third >= 0; --third) {
            const int sb = st0 + third * HGA_T;
            for (int s0 = HGA_T - 8; s0 >= 0; s0 -= 8) {
                float fv[8]; unsigned short iv[8];
#pragma unroll
                for (int u = 0; u < 8; ++u) {
                    const int st = sb + s0 + u;
                    const int stc = (st < st1) ? st : st1 - 1;
                    const size_t off = (size_t)hg_row(dir, b, stc) * 256 + h * 64 + lane;
                    fv[u] = fbase[off]; iv[u] = hi[off];
                }
#pragma unroll
                for (int u = 7; u >= 0; --u) {
                    const int st = sb + s0 + u;
                    const bool ok = (st < st1);
                    const float f = ok ? fv[u] : 1.f;
                    const float kh = ok ? (1.f - f) * P : 0.f;
                    P *= f;
                    *(LAS unsigned short*)(KT + lane * HGA_STR + (s0 + u) * 2) = (unsigned short)(pk2(kh, 0.f) & 0xffffu);
                    *(LAS unsigned short*)(VT + lane * HGA_STR + (s0 + u) * 2) = ok ? iv[u] : (unsigned short)0;
                }
            }
            LDS_WAIT(); asm volatile("" ::: "memory");
#pragma unroll
            for (int q = 0; q < HGA_T / 16; ++q) {
                bf16x8 af[2], bfr[2];
#pragma unroll
                for (int kb = 0; kb < 2; ++kb) af[kb] = *(LAS bf16x8*)(KT + (kb * 32 + n) * HGA_STR + (16 * q + 8 * gq) * 2);
#pragma unroll
                for (int vb = 0; vb < 2; ++vb) bfr[vb] = *(LAS bf16x8*)(VT + (vb * 32 + n) * HGA_STR + (16 * q + 8 * gq) * 2);
#pragma unroll
                for (int kb = 0; kb < 2; ++kb)
#pragma unroll
                    for (int vb = 0; vb < 2; ++vb) acc[kb][vb] = __builtin_amdgcn_mfma_f32_32x32x16_bf16(af[kb], bfr[vb], acc[kb][vb], 0, 0, 0);
            }
            LDS_WAIT(); asm volatile("" ::: "memory");
        }
#pragma unroll
        for (int kb = 0; kb < 2; ++kb)
#pragma unroll
            for (int vb = 0; vb < 2; ++vb)
#pragma unroll
                for (int r = 0; r < 16; ++r) {
                    const int k = kb * 32 + 8 * (r >> 2) + 4 * gq + (r & 3), v = vb * 32 + n;
                    carry[((size_t)item * 64 + k) * 64 + v] = acc[kb][vb][r];
                }
        dk[item * 64 + lane] = P;
    }
}
__device__ __forceinline__ void hg_carry(float* carry, const float* dk, int gtid, int ngt) {
    for (int e = gtid; e < 16 * 4096; e += ngt) {
        const int s = e >> 12, idx = e & 4095, k = idx >> 6;
        float run = 0.f;
        for (int j0 = 0; j0 < HG_SEG; j0 += 8) {
            float t[8], d[8];
#pragma unroll
            for (int u = 0; u < 8; ++u) { t[u] = carry[(size_t)(s * HG_SEG + j0 + u) * 4096 + idx]; d[u] = dk[(s * HG_SEG + j0 + u) * 64 + k]; }
#pragma unroll
            for (int u = 0; u < 8; ++u) { carry[(size_t)(s * HG_SEG + j0 + u) * 4096 + idx] = run; run = __builtin_fmaf(d[u], run, t[u]); }
        }
    }
}
__device__ __forceinline__ void hg_readout(const bf16_t* odir, const bf16_t* hgs, const float* gain, bf16_t* ohg, int gw, int ngw, int lane) {
    const f32x4 gv = *(const f32x4*)(gain + ((4 * lane) & 63));
    for (int row = gw; row < R; row += ngw) {
        const size_t off = (size_t)row * 256 + 4 * lane;
        const u32x2 a = *(const u32x2*)(odir + off), bq = *(const u32x2*)(odir + (size_t)R * 256 + off), hg = *(const u32x2*)(hgs + off);
        const float o0 = bflo(a.x) + bflo(bq.x), o1 = bfhi(a.x) + bfhi(bq.x), o2 = bflo(a.y) + bflo(bq.y), o3 = bfhi(a.y) + bfhi(bq.y);
        float ss = (o0 * o0 + o1 * o1) + (o2 * o2 + o3 * o3);
        ss += shx(ss, 1, lane); ss += shx(ss, 2, lane); ss += shx(ss, 4, lane); ss += shx(ss, 8, lane);
        const float rstd = 1.0f / sqrtf(ss * (1.f / 64.f) + EPS);
        u32x2 w;
        w.x = pk2(o0 * rstd * gv[0] * bflo(hg.x), o1 * rstd * gv[1] * bfhi(hg.x));
        w.y = pk2(o2 * rstd * gv[2] * bflo(hg.y), o3 * rstd * gv[3] * bfhi(hg.y));
        *(u32x2*)(ohg + off) = w;
    }
}

constexpr int AT_KSTR = 272, AT_VSTR = 144, AT_KBYTES = 64 * AT_KSTR, AT_VBYTES = 128 * AT_VSTR, AT_STAGE = AT_KBYTES + AT_VBYTES;
static_assert(2 * AT_STAGE <= LDS_BYTES && 65536 <= 2 * AT_STAGE, "attention LDS");
__device__ __forceinline__ void attn_unit(LAS unsigned char* lds, const bf16_t* qbuf, const bf16_t* kbuf, const bf16_t* vT, bf16_t* oda, const float* gain,
                                          int b, int h, int qrow0, int kt0, int kt1, float lam, float post, int tid, int wave, int lane) {
    const int c = wave & 1, g = wave >> 1, n = lane & 31, gq = lane >> 5;
    bf16x8 qf[4];
    { const bf16_t* qp = qbuf + (size_t)(qrow0 + 32 * g + n) * 512 + h * 128 + c * 64 + 8 * gq;
#pragma unroll
      for (int s = 0; s < 4; ++s) qf[s] = *(const bf16x8*)(qp + 16 * s); }
    f32x16 O[4];
#pragma unroll
    for (int e = 0; e < 4; ++e)
#pragma unroll
        for (int r = 0; r < 16; ++r) O[e][r] = 0.f;
    float l = 0.f;
    const int kkey0 = tid >> 4, kch = tid & 15, ve0 = tid >> 3, vc = tid & 7;
    const size_t kgoff = (size_t)kkey0 * 512 + h * 128 + kch * 8;
    const unsigned klds = kkey0 * AT_KSTR + kch * 16;
    const size_t vgoff = (size_t)(b * 512 + h * 128 + ve0) * KEYS + vc * 8;
    const unsigned vlds = ve0 * AT_VSTR + (vc >> 1) * 32 + (vc & 1) * 8;
    u32x4 kr0, kr1, vr0, vr1;
#define AT_KROW0(kt) (((kt) * 64 < SEQ) ? (size_t)b * SEQ + (kt) * 64 : (size_t)NLAT + b * CTXL + ((kt) * 64 - SEQ))
#define AT_LOADK(kt) do { const size_t krow0 = AT_KROW0(kt); kr0 = *(const u32x4*)(kbuf + krow0 * 512 + kgoff); kr1 = *(const u32x4*)(kbuf + (krow0 + 32) * 512 + kgoff); } while (0)
#define AT_LOADV(kt) do { vr0 = *(const u32x4*)(vT + vgoff + (kt) * 64); vr1 = *(const u32x4*)(vT + vgoff + (size_t)64 * KEYS + (kt) * 64); } while (0)
#define AT_STOREK(buf) do { LAS unsigned char* sb_ = lds + (buf) * AT_KBYTES; *(LAS u32x4*)(sb_ + klds) = kr0; *(LAS u32x4*)(sb_ + klds + 32 * AT_KSTR) = kr1; } while (0)
#define AT_STOREV(buf) do { LAS unsigned char* sb_ = lds + 2 * AT_KBYTES + (buf) * AT_VBYTES; \
        *(LAS u32x2*)(sb_ + vlds) = (u32x2){vr0.x, vr0.y}; *(LAS u32x2*)(sb_ + vlds + 16) = (u32x2){vr0.z, vr0.w}; \
        *(LAS u32x2*)(sb_ + vlds + 64 * AT_VSTR) = (u32x2){vr1.x, vr1.y}; *(LAS u32x2*)(sb_ + vlds + 64 * AT_VSTR + 16) = (u32x2){vr1.z, vr1.w}; } while (0)
#define AT_QK(Sa, Sb, buf) do { LAS unsigned char* kp = lds + (buf) * AT_KBYTES + n * AT_KSTR + (c * 8 + gq) * 16; \
        _Pragma("unroll") for (int s = 0; s < 4; ++s) { \
            const bf16x8 a0 = *(LAS bf16x8*)(kp + s * 32), a1 = *(LAS bf16x8*)(kp + 32 * AT_KSTR + s * 32); \
            Sa = __builtin_amdgcn_mfma_f32_32x32x16_bf16(a0, qf[s], Sa, 0, 0, 0); \
            Sb = __builtin_amdgcn_mfma_f32_32x32x16_bf16(a1, qf[s], Sb, 0, 0, 0); } } while (0)
#define AT_BAR() do { asm volatile("s_waitcnt lgkmcnt(0)" ::: "memory"); __builtin_amdgcn_s_barrier(); asm volatile("" ::: "memory"); } while (0)
    const int nt = kt1 - kt0;
    AT_LOADK(kt0); AT_LOADV(kt0); AT_STOREK(0); AT_STOREV(0);
    if (nt > 1) { AT_LOADK(kt0 + 1); AT_LOADV(kt0 + 1); }
    AT_BAR();
    f32x16 negm;
    {
        f32x16 S0, S1;
#pragma unroll
        for (int r = 0; r < 16; ++r) { S0[r] = 0.f; S1[r] = 0.f; }
        AT_QK(S0, S1, 0);
        float mx = fmaxf(S0[0], S1[0]);
#pragma unroll
        for (int r = 1; r < 16; ++r) mx = fmaxf(fmaxf(mx, S0[r]), S1[r]);
        { auto rr = __builtin_amdgcn_permlane32_swap(__builtin_bit_cast(unsigned, mx), __builtin_bit_cast(unsigned, mx), false, false);
          mx = fmaxf(__builtin_bit_cast(float, rr[0]), __builtin_bit_cast(float, rr[1])); }
#pragma unroll
        for (int r = 0; r < 16; ++r) negm[r] = -mx;
    }
    constexpr float THR = 8.f;
    for (int i = 0; i < nt; ++i) {
        const int cur = i & 1;
        if (i + 1 < nt) { AT_STOREK(cur ^ 1); AT_STOREV(cur ^ 1); }
        if (i + 2 < nt) { AT_LOADK(kt0 + i + 2); AT_LOADV(kt0 + i + 2); }
        bf16x8 kf[8];
        { LAS unsigned char* kp = lds + cur * AT_KBYTES + n * AT_KSTR + (c * 8 + gq) * 16;
#pragma unroll
          for (int s = 0; s < 4; ++s) { kf[2 * s] = *(LAS bf16x8*)(kp + s * 32); kf[2 * s + 1] = *(LAS bf16x8*)(kp + 32 * AT_KSTR + s * 32); } }
        LAS unsigned char* vp = lds + 2 * AT_KBYTES + cur * AT_VBYTES + n * AT_VSTR + gq * 16;
        bf16x8 va[8];
#pragma unroll
        for (int ks = 0; ks < 2; ++ks)
#pragma unroll
            for (int e = 0; e < 4; ++e) va[ks * 4 + e] = *(LAS bf16x8*)(vp + e * 32 * AT_VSTR + ks * 32);
        __builtin_amdgcn_sched_barrier(0);
        f32x16 S0 = negm, S1 = negm;
#pragma unroll
        for (int s = 0; s < 4; ++s) {
            S0 = __builtin_amdgcn_mfma_f32_32x32x16_bf16(kf[2 * s], qf[s], S0, 0, 0, 0);
            S1 = __builtin_amdgcn_mfma_f32_32x32x16_bf16(kf[2 * s + 1], qf[s], S1, 0, 0, 0);
        }
        __builtin_amdgcn_sched_barrier(0);
        bf16x8 vb[8];
#pragma unroll
        for (int ks = 0; ks < 2; ++ks)
#pragma unroll
            for (int e = 0; e < 4; ++e) vb[ks * 4 + e] = *(LAS bf16x8*)(vp + e * 32 * AT_VSTR + (ks + 2) * 32);
        __builtin_amdgcn_sched_barrier(0);
        float mx = fmaxf(S0[0], S1[0]);
#pragma unroll
        for (int r = 1; r < 16; ++r) mx = fmaxf(fmaxf(mx, S0[r]), S1[r]);
        { auto rr = __builtin_amdgcn_permlane32_swap(__builtin_bit_cast(unsigned, mx), __builtin_bit_cast(unsigned, mx), false, false);
          mx = fmaxf(__builtin_bit_cast(float, rr[0]), __builtin_bit_cast(float, rr[1])); }
        if (__builtin_amdgcn_ballot_w64(mx > THR) != 0ull) {
            const float delta = fmaxf(mx, 0.f), alpha = ex2(-delta);
            l *= alpha;
#pragma unroll
            for (int r = 0; r < 16; ++r) { S0[r] -= delta; S1[r] -= delta; negm[r] -= delta; }
#pragma unroll
            for (int e = 0; e < 4; ++e) O[e] = O[e] * alpha;
        }
        float ps = 0.f;
#pragma unroll
        for (int r = 0; r < 16; ++r) { S0[r] = ex2(S0[r]); S1[r] = ex2(S1[r]); ps += S0[r] + S1[r]; }
        l += ps;
        bf16x8 pb[4];
#pragma unroll
        for (int s = 0; s < 2; ++s) {
            u32x4 pw;
            pw.x = pk2(S0[8 * s + 0], S0[8 * s + 1]); pw.y = pk2(S0[8 * s + 2], S0[8 * s + 3]); pw.z = pk2(S0[8 * s + 4], S0[8 * s + 5]); pw.w = pk2(S0[8 * s + 6], S0[8 * s + 7]);
            pb[s] = __builtin_bit_cast(bf16x8, pw);
            pw.x = pk2(S1[8 * s + 0], S1[8 * s + 1]); pw.y = pk2(S1[8 * s + 2], S1[8 * s + 3]); pw.z = pk2(S1[8 * s + 4], S1[8 * s + 5]); pw.w = pk2(S1[8 * s + 6], S1[8 * s + 7]);
            pb[2 + s] = __builtin_bit_cast(bf16x8, pw);
        }
        __builtin_amdgcn_sched_barrier(0);
#pragma unroll
        for (int ks = 0; ks < 2; ++ks)
#pragma unroll
            for (int e = 0; e < 4; ++e) {
                O[e] = __builtin_amdgcn_mfma_f32_32x32x16_bf16(va[ks * 4 + e], pb[ks], O[e], 0, 0, 0);
            }
#pragma unroll
        for (int ks = 0; ks < 2; ++ks)
#pragma unroll
            for (int e = 0; e < 4; ++e) {
                O[e] = __builtin_amdgcn_mfma_f32_32x32x16_bf16(vb[ks * 4 + e], pb[2 + ks], O[e], 0, 0, 0);
            }
        AT_BAR();
    }
#undef AT_BAR
#undef AT_KROW0
#undef AT_LOADK
#undef AT_LOADV
#undef AT_STOREK
#undef AT_STOREV
#undef AT_QK
    l += shx(l, 32, lane);
    const float inv = 1.f / l;
    LAS float* xch = (LAS float*)lds;
    if (c == 1) {
#pragma unroll
        for (int e = 0; e < 4; ++e)
#pragma unroll
            for (int r = 0; r < 16; ++r) xch[(g * 64 + e * 16 + r) * 64 + lane] = O[e][r] * inv;
    }
    __syncthreads();
    if (c == 0) {
        float ss = 0.f;
#pragma unroll
        for (int e = 0; e < 4; ++e)
#pragma unroll
            for (int r = 0; r < 16; ++r) { const float o = O[e][r] * inv - lam * xch[(g * 64 + e * 16 + r) * 64 + lane]; O[e][r] = o; ss += o * o; }
        ss += shx(ss, 32, lane);
        const float rs = post / sqrtf(ss * (1.f / 128.f) + EPS);
        bf16_t* op = oda + (size_t)(qrow0 + 32 * g + n) * 512 + h * 128;
#pragma unroll
        for (int e = 0; e < 4; ++e)
#pragma unroll
            for (int r4 = 0; r4 < 4; ++r4) {
                const int e0 = e * 32 + 8 * r4 + 4 * gq;
                const f32x4 gv = *(const f32x4*)(gain + e0);
                u32x2 w; w.x = pk2(O[e][4 * r4 + 0] * rs * gv[0], O[e][4 * r4 + 1] * rs * gv[1]); w.y = pk2(O[e][4 * r4 + 2] * rs * gv[2], O[e][4 * r4 + 3] * rs * gv[3]);
                *(u32x2*)(op + e0) = w;
            }
    }
    __syncthreads();
}
#define XB_TMO      128
#define XB_XCNT(j)  (256  + 64 * (j))
#define XB_XSUB(j)  (1280 + 64 * (j))
#define XB_XGEN(j)  (2304 + 64 * (j))
#define XB_TOP      3328
#define XB_TOPGEN   3392
#define XCD_BAR_WORDS 3456
#define XB_SPIN_CAP (1u << 18)

__device__ __forceinline__ unsigned xb_ld(unsigned* p)              { return __hip_atomic_load(p, __ATOMIC_RELAXED, __HIP_MEMORY_SCOPE_AGENT); }
__device__ __forceinline__ unsigned xb_add(unsigned* p, unsigned v) { return __hip_atomic_fetch_add(p, v, __ATOMIC_RELAXED, __HIP_MEMORY_SCOPE_AGENT); }
__device__ __forceinline__ unsigned xb_xcc_id() { return (unsigned)__builtin_amdgcn_s_getreg((3 << 11) | 20) & 0xFu; }
#define XB_SPIN(cond, bar) do { unsigned _sp = 0; while (cond) { __builtin_amdgcn_s_sleep(1); \
    if ((++_sp & 255u) == 0u) { if (xb_ld(&(bar)[XB_TMO])) break; if (_sp > XB_SPIN_CAP) { atomicAdd(&(bar)[XB_TMO], 1u); break; } } } } while (0)

struct XcdBarrier {
    unsigned* bar; unsigned x;
    volatile LAS unsigned* st;
};

__device__ __forceinline__ XcdBarrier xcd_barrier_post(unsigned* bar, volatile LAS unsigned* st, int tid_in) {
    XcdBarrier b; b.bar = bar; b.x = xb_xcc_id(); b.st = st;
    if (tid_in == 0) (void)xb_add(&bar[XB_XCNT(b.x)], 1u);
    return b;
}
__device__ __forceinline__ void xcd_barrier_complete(unsigned* bar, unsigned x, unsigned& nloc, unsigned& nx) {
    const unsigned G = gridDim.x * gridDim.y * gridDim.z;
    unsigned sum, cnt, mine, sp = 0u;
    for (;;) {
        sum = 0u; cnt = 0u; mine = 0u;
#pragma unroll
        for (unsigned j = 0; j < 16; ++j) { const unsigned c = xb_ld(&bar[XB_XCNT(j)]); sum += c; cnt += (c > 0u) ? 1u : 0u; mine = (j == x) ? c : mine; }
        if (sum == G) break;
        __builtin_amdgcn_s_sleep(1);
        if ((++sp & 255u) == 0u) { if (xb_ld(&bar[XB_TMO])) break; if (sp > XB_SPIN_CAP) { atomicAdd(&bar[XB_TMO], 1u); break; } }
    }
    nloc = mine > 0u ? mine : 1u; nx = cnt > 0u ? cnt : 1u;
}

__device__ __forceinline__ void xcd_barrier(const XcdBarrier& b, int tid_in) {
    asm volatile("s_waitcnt vmcnt(0)" ::: "memory");
    __syncthreads();
    if (tid_in == 0) {
        unsigned* bar = b.bar;
        __builtin_amdgcn_s_waitcnt(0);
        unsigned nloc = b.st[0], nx = b.st[1];
        if (nloc == 0u) { xcd_barrier_complete(bar, b.x, nloc, nx); b.st[0] = nloc; b.st[1] = nx; }
        const unsigned old = xb_add(&bar[XB_XSUB(b.x)], 1u);
        const unsigned gen = old / nloc;
        if (old + 1u == (gen + 1u) * nloc) {
            __builtin_amdgcn_fence(__ATOMIC_RELEASE, "agent");
            asm volatile("s_waitcnt vmcnt(0)" ::: "memory");
            const unsigned og = xb_add(&bar[XB_TOP], 1u);
            const unsigned tg = og / nx;
            if (og + 1u == (tg + 1u) * nx) xb_add(&bar[XB_TOPGEN], 1u);
            else XB_SPIN(xb_ld(&bar[XB_TOPGEN]) == tg, bar);
            __builtin_amdgcn_fence(__ATOMIC_ACQUIRE, "agent");
            xb_add(&bar[XB_XGEN(b.x)], 1u);
            asm volatile("s_waitcnt vmcnt(0)" ::: "memory");
        } else {
            XB_SPIN(xb_ld(&bar[XB_XGEN(b.x)]) == gen, bar);
            __builtin_amdgcn_fence(__ATOMIC_ACQUIRE, "agent");
            asm volatile("s_waitcnt vmcnt(0)" ::: "memory");
        }
    }
    __syncthreads();
}


struct Args { const float* in[30]; float* out; unsigned char* ws; };
typedef const Args __attribute__((address_space(4))) Args_c;
__device__ __forceinline__ Args_c* kargs_ptr() { Args_c* p = (Args_c*)__builtin_amdgcn_kernarg_segment_ptr(); asm volatile("" : "+s"(p)); return p; }
#define GSYNC_CG() cg::this_grid().sync()
constexpr size_t WS_BAR = WS_END + 4096;
constexpr size_t WS_TOTAL = WS_BAR + (size_t)XCD_BAR_WORDS * 4;
static_assert(WS_TOTAL <= (size_t)512 * 1024 * 1024, "workspace");
constexpr int LDS_BARST = LDS_BYTES - 16;
#define GSYNC() do { XcdBarrier xb_; xb_.bar = (unsigned*)(kargs_ptr()->ws + WS_BAR); xb_.x = xb_xcc_id(); xb_.st = (volatile LAS unsigned*)(lds + LDS_BARST); xcd_barrier(xb_, TIDX()); } while (0)
#ifdef PROBE_A
#define TS(cat) do { if (blockIdx.x == 0 && TIDX() == 0) { unsigned long long* tsb = (unsigned long long*)(kargs_ptr()->ws + WS_END); const unsigned long long now = __builtin_amdgcn_s_memrealtime(); tsb[1 + (cat)] += now - tsb[0]; tsb[0] = now; } } while (0)
#else
#define TS(cat) do {} while (0)
#endif
__device__ __forceinline__ int tid_from(int wave_s) { int w_ = wave_s; unsigned z_ = 0u; asm volatile("" : "+s"(w_), "+s"(z_)); return w_ * 64 + (int)__builtin_amdgcn_mbcnt_hi(~0u, __builtin_amdgcn_mbcnt_lo(~0u, z_)); }
#define TIDX() tid_from(wave_s)
#define KA() int tid = TIDX(); asm volatile("" : "+v"(tid)); int G = gridDim.x, bid = blockIdx.x; asm volatile("" : "+s"(G), "+s"(bid)); \
    const int lane = tid & 63, wave = __builtin_amdgcn_readfirstlane(tid >> 6), gw = bid * 8 + wave, ngw = G * 8, gtid = bid * NTHR + tid, ngt = G * NTHR; \
    (void)lane; (void)wave; (void)gw; (void)ngw; (void)gtid; (void)ngt; \
    Args_c* ka = kargs_ptr(); unsigned char* ws = ka->ws; (void)ws

__global__ void __launch_bounds__(NTHR, 2) fwd_kernel(Args a_unused) {
    extern __shared__ __attribute__((aligned(16))) unsigned char lds_raw[];
    LAS unsigned char* lds = (LAS unsigned char*)lds_raw;
    const int wave_s = __builtin_amdgcn_readfirstlane((int)threadIdx.x >> 6);
    if (TIDX() < 4) ((volatile LAS unsigned*)(lds + LDS_BARST))[TIDX()] = 0u;
    __syncthreads();
    (void)xcd_barrier_post((unsigned*)(kargs_ptr()->ws + WS_BAR), (volatile LAS unsigned*)(lds + LDS_BARST), TIDX());
#ifdef PROBE_A
    if (blockIdx.x == 0 && TIDX() == 0) { unsigned long long* tsb = (unsigned long long*)(kargs_ptr()->ws + WS_END); for (int i = 1; i < 32; ++i) tsb[i] = 0; tsb[0] = __builtin_amdgcn_s_memrealtime(); }
#endif

#ifdef REP_INIT
#pragma unroll 1
    for (int rep_ = 0; rep_ < 2; ++rep_) {
#else
    {
#endif
    {
        KA();
        bf16_t* WB = (bf16_t*)(ws + WS_WB);
        LAS float* scr = (LAS float*)(lds + wave * 8448);
        constexpr int IT_L = 12416;
        for (int it = gw; it < 2 * IT_L; it += ngw) {
            const int l = it / IT_L; int r = it % IT_L;
            bf16_t* Wl = WB + (size_t)l * WL_TOTAL;
            if (r < 1408) { transpose_item(ka->in[9] + (size_t)l * 1024 * DFF, 1024, DFF, Wl + WL_UP1, 1, scr, r, lane); continue; } r -= 1408;
            if (r < 1408) { transpose_item(ka->in[10] + (size_t)l * 1024 * DFF, 1024, DFF, Wl + WL_UP1, 2, scr, r, lane); continue; } r -= 1408;
            if (r < 1408) { transpose_item(ka->in[11] + (size_t)l * DFF * 1024, DFF, 1024, Wl + WL_DN1, 0, scr, r, lane); continue; } r -= 1408;
            if (r < 1408) { transpose_item(ka->in[12] + (size_t)l * 1024 * DFF, 1024, DFF, Wl + WL_UP2, 1, scr, r, lane); continue; } r -= 1408;
            if (r < 1408) { transpose_item(ka->in[13] + (size_t)l * 1024 * DFF, 1024, DFF, Wl + WL_UP2, 2, scr, r, lane); continue; } r -= 1408;
            if (r < 1408) { transpose_item(ka->in[14] + (size_t)l * DFF * 1024, DFF, 1024, Wl + WL_DN2, 0, scr, r, lane); continue; } r -= 1408;
            if (r < 3072) { transpose_item(ka->in[15] + (size_t)l * 1024 * 6144, 1024, 6144, Wl + WL_IN, 3, scr, r, lane); continue; } r -= 3072;
            if (r < 256) { transpose_item(ka->in[25] + (size_t)l * 512 * 1024, 512, 1024, Wl + WL_PA, 0, scr, r, lane); continue; } r -= 256;
            if (r < 128) { transpose_item(ka->in[26] + (size_t)l * 256 * 1024, 256, 1024, Wl + WL_PH, 0, scr, r, lane); continue; } r -= 128;
            transpose_item(ka->in[28] + (size_t)l * 1024 * 1024, 1024, 1024, Wl + WL_O, 0, scr, r, lane);
        }
        __syncthreads();
    }
    {
        KA();
        float* MOD = (float*)(ws + WS_MOD);
        LAS float* sv = (LAS float*)lds;
        LAS float* part = (LAS float*)(lds + 12288);
        for (int i = tid; i < 3072; i += NTHR) { const int seg = i >> 10, k = i & 1023; const float x = (seg < 2) ? ka->in[1][seg * 1024 + k] : ka->in[3][k]; sv[i] = x / (1.f + __expf(-x)); }
        __syncthreads();
        for (int item = bid; item < 288; item += G) {
            const int l = item / 144, col = (item % 144) * 64 + lane;
            const float* W = ka->in[4] + (size_t)l * 1024 * 9216 + col;
            float a0 = 0.f, a1 = 0.f, a2 = 0.f;
            for (int k = wave * 128; k < wave * 128 + 128; ++k) { const float w = W[(size_t)k * 9216]; a0 = __builtin_fmaf(sv[k], w, a0); a1 = __builtin_fmaf(sv[1024 + k], w, a1); a2 = __builtin_fmaf(sv[2048 + k], w, a2); }
            part[(wave * 3 + 0) * 64 + lane] = a0; part[(wave * 3 + 1) * 64 + lane] = a1; part[(wave * 3 + 2) * 64 + lane] = a2;
            __syncthreads();
            if (tid < 192) { const int seg = tid >> 6, cl = tid & 63; float s = 0.f;
#pragma unroll
                for (int w = 0; w < 8; ++w) s += part[(w * 3 + seg) * 64 + cl];
                const int cc = (item % 144) * 64 + cl;
                MOD[(size_t)(l * 3 + seg) * 9216 + cc] = s + ka->in[5][l * 9216 + cc]; }
            __syncthreads();
        }
    }
    {
        KA();
        bf16_t* WB = (bf16_t*)(ws + WS_WB); float* CS = (float*)(ws + WS_CS); float* LBT = (float*)(ws + WS_LB); float* LAMV = (float*)(ws + WS_LAM);
        for (int idx = gtid; idx < 2 * 256 * 1024; idx += ngt) {
            const int n = idx & 1023, k = (idx >> 10) & 255, l = idx >> 18, g = k >> 6, c = k & 63;
            const float* pw = ka->in[23] + (size_t)l * 4 * 64 * 64 + (g * 64 + c) * 64;
            const float* psc = ka->in[24] + l * 256 + g * 64;
            const float* wp = ka->in[27] + (size_t)l * 256 * 1024 + (size_t)(g * 64) * 1024 + n;
            float s = 0.f;
            for (int d = 0; d < 64; ++d) s = __builtin_fmaf(pw[d] * psc[d], wp[(size_t)d * 1024], s);
            (WB + (size_t)l * WL_TOTAL + WL_PP)[(size_t)n * 256 + k] = (bf16_t)(pk2(s, 0.f) & 0xffffu);
        }
        for (int idx = gtid; idx < 4096; idx += ngt) {
            const int n = idx >> 4, j = idx & 15;
            const float invf = __builtin_exp2f(-(float)j * (13.287712379549449f / 16.f));
            const float ang = (float)n * invf;
            const double rev = (double)ang * 0.15915494309189535; const float fr = (float)(rev - __builtin_floor(rev));
            CS[n * 32 + j] = __builtin_amdgcn_cosf(fr); CS[n * 32 + 16 + j] = __builtin_amdgcn_sinf(fr);
        }
        for (int idx = gtid; idx < 1024; idx += ngt) {
            const int l = idx >> 9, dc = idx & 511;
            const float l0 = ka->in[21][dc], l1 = ka->in[21][512 + dc];
            LBT[idx] = (l == 0) ? 0.f : 1.f / (1.f + __expf(l0 - l1));
        }
        for (int idx = gtid; idx < NCTX * DM / 4; idx += ngt) ((f32x4*)(ws + WS_HC))[idx] = ((const f32x4*)ka->in[2])[idx];
        if (gtid < 2) {
            const int l = gtid; float s1 = 0.f, s2 = 0.f;
            for (int i = 0; i < 64; ++i) { s1 += ka->in[16][l * 64 + i] * ka->in[17][l * 64 + i]; s2 += ka->in[18][l * 64 + i] * ka->in[19][l * 64 + i]; }
            const float li = (l == 0) ? 0.2f : (0.8f - 0.6f * 0.7408182206817179f);
            LAMV[l * 2 + 0] = __expf(s1) - __expf(s2) + li; LAMV[l * 2 + 1] = 1.f - li;
        }
    }
    }
    GSYNC_CG();
    TS(0);

#pragma unroll 1
    for (int l = 0; l < 2; ++l) {
#ifdef REP_SYNC
#pragma unroll 1
        for (int rs_ = 0; rs_ < 10; ++rs_) { GSYNC(); }
#endif
#pragma unroll 1
        for (int f = 0; f < 2; ++f) {
            {   KA(); const bool first = (l == 0 && f == 0);
                const float* in_lat = first ? ka->in[0] : ka->out; const float* in_ctx = (const float*)(ws + WS_HC);
                norm_phase(in_lat, in_ctx, ka->in[f ? 8 : 6] + l * 1024, (const float*)(ws + WS_MOD) + (size_t)l * 3 * 9216, f ? 6 : 0, f ? 7 : 1, (bf16_t*)(ws + WS_XB), gw, ngw, lane,
                           (const float*)(ws + WS_O), first ? 0 : (f ? 4 : DFF / 256), (float*)(ws + WS_HC)); }
            GSYNC();
            TS(1);
            {   KA(); bf16_t* Wl = (bf16_t*)(ws + WS_WB) + (size_t)l * WL_TOTAL;
                pg8::Gemm g{(bf16_t*)(ws + WS_XB), Wl + (f ? WL_UP2 : WL_UP1), R, 5632, 1024}; pg8::StaticOrder S; S.init(R, 5632, G, bid); EpiUp E{(bf16_t*)(ws + WS_Z)};
                pg8::gemm_phase<EpiUp, pg8::StaticOrder, true, true>(lds, g, S, E, tid); }
            GSYNC();
            TS(2);
            {   KA(); bf16_t* Wl = (bf16_t*)(ws + WS_WB) + (size_t)l * WL_TOTAL; const bool first = (l == 0 && f == 0);
                const float* in_lat = first ? ka->in[0] : ka->out;
                pg8::Gemm g{(bf16_t*)(ws + WS_Z), Wl + (f ? WL_DN2 : WL_DN1), NLAT, 1024, DFF}; pg8::StaticOrder S; S.init(NLAT, 1024, G, bid);
                EpiRes E{in_lat, (const float*)(ws + WS_HC), ka->out, (float*)(ws + WS_HC), (const float*)(ws + WS_MOD) + (size_t)l * 3 * 9216 + (f ? 8 : 2) * 1024, 0.5f};
                pg8::gemm_phase<EpiRes, pg8::StaticOrder, true, true>(lds, g, S, E, tid); }
            {   KA(); bf16_t* Wl = (bf16_t*)(ws + WS_WB) + (size_t)l * WL_TOTAL;
                pg8::Gemm g{(bf16_t*)(ws + WS_Z) + (size_t)NLAT * DFF, Wl + (f ? WL_DN2 : WL_DN1), NCTX, 1024, 256, DFF}; SplitKOrder S; S.init(DFF / 256, 256, G, bid);
                EpiPart E{(float*)(ws + WS_O), (const float*)(ws + WS_MOD) + (size_t)l * 3 * 9216 + (f ? 8 : 2) * 1024, 0.5f};
                pg8::gemm_phase<EpiPart, SplitKOrder, true, true>(lds, g, S, E, tid); }
            GSYNC();
            TS(3);
            if (f == 1) break;
            {   KA();
                norm_phase(ka->out, (const float*)(ws + WS_HC), ka->in[7] + l * 1024, (const float*)(ws + WS_MOD) + (size_t)l * 3 * 9216, 3, 4, (bf16_t*)(ws + WS_XB), gw, ngw, lane,
                           (const float*)(ws + WS_O), DFF / 256, (float*)(ws + WS_HC)); }
            GSYNC();
            TS(1);
            {   KA(); bf16_t* Wl = (bf16_t*)(ws + WS_WB) + (size_t)l * WL_TOTAL;
                pg8::Gemm g{(bf16_t*)(ws + WS_XB), Wl + WL_IN, R, 3072, 1024}; pg8::StaticOrder S; S.init(R, 3072, G, bid);
                EpiWin E{ws + WS_Z, (const float*)(ws + WS_CS), (const float*)(ws + WS_LB) + l * 512, 0};
                pg8::gemm_phase<EpiWin, pg8::StaticOrder, true, true>(lds, g, S, E, tid); }
            GSYNC();
            TS(4);
            {   KA(); pool_phase((const bf16_t*)(ws + WS_Z + Z_ZP), (bf16_t*)(ws + WS_O + O_MX), gtid, ngt); }
#ifdef REP_ATTN
            for (int rep_ = 0; rep_ < 2; ++rep_)
#endif
            {   KA();
                const float* LAMV = (const float*)(ws + WS_LAM);
                const int nunits = 1024 + (l == 0 ? 16 : 0);
                for (int u = bid; u < nunits; u += G) {
                    int bh, qrow0, kt0, kt1;
                    if (u < 1024) { bh = u >> 7; qrow0 = (bh >> 2) * SEQ + (u & 127) * 128; kt0 = 0; kt1 = KEYS / 64; }
                    else { const int v = u - 1024; bh = v >> 1; qrow0 = NLAT + (bh >> 2) * CTXL + (v & 1) * 128; kt0 = SEQ / 64; kt1 = KEYS / 64; }
                    attn_unit(lds, (const bf16_t*)(ws + WS_Z + Z_Q), (const bf16_t*)(ws + WS_Z + Z_K), (const bf16_t*)(ws + WS_Z + Z_VT), (bf16_t*)(ws + WS_O + O_DA), ka->in[20] + l * 128,
                              bh >> 2, bh & 3, qrow0, kt0, kt1, LAMV[l * 2], LAMV[l * 2 + 1], tid, wave, lane);
                }
            }
            GSYNC();
            TS(5);
#ifdef REP_HG
#pragma unroll 1
            for (int rep_ = 0; rep_ < 2; ++rep_) {
#else
            {
#endif
            {   KA(); hg_passA_mfma(lds, (const float*)(ws + WS_Z + Z_FF), (const float*)(ws + WS_Z + Z_FB), (const bf16_t*)(ws + WS_Z + Z_HI),
                                      (float*)(ws + WS_CAR), (float*)(ws + WS_DK), wave, lane, G); }
            GSYNC();
            TS(6);
            {   KA(); hg_carry((float*)(ws + WS_CAR), (const float*)(ws + WS_DK), gtid, ngt); }
            GSYNC();
            TS(7);
            {   KA(); hg_pass<true>((const float*)(ws + WS_Z + Z_HQ), (const float*)(ws + WS_Z + Z_FF), (const float*)(ws + WS_Z + Z_FB), (const bf16_t*)(ws + WS_Z + Z_HI),
                                    (float*)(ws + WS_CAR), (float*)(ws + WS_DK), (bf16_t*)(ws + WS_Z + Z_K), wave, lane, G); }
            GSYNC();
            TS(8);
            {   KA(); hg_readout((const bf16_t*)(ws + WS_Z + Z_K), (const bf16_t*)(ws + WS_Z + Z_HG), ka->in[22] + l * 64, (bf16_t*)(ws + WS_O + O_HG), gw, ngw, lane); }
            GSYNC();
            TS(9);
            }
            {   KA(); bf16_t* Wl = (bf16_t*)(ws + WS_WB) + (size_t)l * WL_TOTAL;
                pg8::Gemm g{(bf16_t*)(ws + WS_XB), Wl + WL_IN + (size_t)3072 * 1024, R, 3072, 1024}; pg8::StaticOrder S; S.init(R, 3072, G, bid); EpiG E{(bf16_t*)(ws + WS_Z)};
                pg8::gemm_phase<EpiG, pg8::StaticOrder, true, true>(lds, g, S, E, tid); }
            GSYNC();
            TS(10);
#pragma unroll 1
            for (int gi = 0; gi < 3; ++gi) {
                KA(); bf16_t* Wl = (bf16_t*)(ws + WS_WB) + (size_t)l * WL_TOTAL;
                const bf16_t* A = (const bf16_t*)(ws + WS_O + ((gi == 0) ? O_DA : (gi == 1 ? O_HG : O_MX))); const int K = (gi == 0) ? 512 : 256;
                const bf16_t* Bt = Wl + ((gi == 0) ? WL_PA : (gi == 1 ? WL_PH : WL_PP));
                pg8::Gemm g{A, Bt, R, 1024, K}; pg8::StaticOrder S; S.init(R, 1024, G, bid); EpiProj E{(bf16_t*)(ws + WS_XB), (const bf16_t*)(ws + WS_Z), gi, gi == 0};
                pg8::gemm_phase<EpiProj, pg8::StaticOrder, true, true>(lds, g, S, E, tid);
            }
            GSYNC();
            TS(11);
            {   KA(); bf16_t* Wl = (bf16_t*)(ws + WS_WB) + (size_t)l * WL_TOTAL;
                pg8::Gemm g{(bf16_t*)(ws + WS_XB), Wl + WL_O, NLAT, 1024, 1024}; pg8::StaticOrder S; S.init(NLAT, 1024, G, bid);
                EpiRes E{ka->out, (const float*)(ws + WS_HC), ka->out, (float*)(ws + WS_HC), (const float*)(ws + WS_MOD) + (size_t)l * 3 * 9216 + 5 * 1024, 1.0f};
                pg8::gemm_phase<EpiRes, pg8::StaticOrder, true, true>(lds, g, S, E, tid); }
            {   KA(); bf16_t* Wl = (bf16_t*)(ws + WS_WB) + (size_t)l * WL_TOTAL;
                pg8::Gemm g{(bf16_t*)(ws + WS_XB) + (size_t)NLAT * 1024, Wl + WL_O, NCTX, 1024, 256, 1024}; SplitKOrder S; S.init(4, 256, G, bid);
                EpiPart E{(float*)(ws + WS_O), (const float*)(ws + WS_MOD) + (size_t)l * 3 * 9216 + 5 * 1024, 1.0f};
                pg8::gemm_phase<EpiPart, SplitKOrder, true, true>(lds, g, S, E, tid); }
            GSYNC();
            TS(12);
        }
    }
    {   KA(); final_norm_phase(ka->out, ka->in[29], gw, ngw, lane); }
#ifdef PROBE_A
    GSYNC(); TS(1);
    if (blockIdx.x == 0) { KA(); const unsigned long long* tsb = (const unsigned long long*)(ws + WS_END);
        __syncthreads();
        const float va = (float)tsb[1 + PROBE_A] * 0.01f, vb = (float)tsb[1 + PROBE_B] * 0.01f;
        __syncthreads();
        if (tid == 0) ka->out[0] += va;
        for (int i = tid; i < 65536; i += NTHR) ka->out[(size_t)(i / 1024 + 8) * 1024 + (i & 1023)] += vb; }
#endif
}

extern "C" void kernel_launch(void* const* d_in, const int* in_sizes, int n_in, void* d_out, int out_size, void* d_ws, size_t ws_size, hipStream_t stream) {
    static int grid = 0;
    if (grid == 0) {
        if (n_in != 30 || out_size != NLAT * DM || ws_size < WS_TOTAL) { fprintf(stderr, "kernel_launch: unexpected shapes (n_in %d out %d ws %zu need %zu)\n", n_in, out_size, ws_size, (size_t)WS_TOTAL); grid = -1; return; }
        int dev = 0, cus = 0, per_cu = 0;
        (void)hipGetDevice(&dev);
        (void)hipDeviceGetAttribute(&cus, hipDeviceAttributeMultiprocessorCount, dev);
        if (hipFuncSetAttribute((const void*)fwd_kernel, hipFuncAttributeMaxDynamicSharedMemorySize, LDS_BYTES) != hipSuccess) { fprintf(stderr, "kernel_launch: hipFuncSetAttribute failed\n"); grid = -1; return; }
        if (hipOccupancyMaxActiveBlocksPerMultiprocessor(&per_cu, (const void*)fwd_kernel, NTHR, LDS_BYTES) != hipSuccess || per_cu < 1) { fprintf(stderr, "kernel_launch: occupancy query failed (%d)\n", per_cu); (void)hipGetLastError(); per_cu = 1; }
        if (per_cu > 1) per_cu = 1;
        grid = cus * per_cu;
    }
    if (grid < 0) return;
    if (hipMemsetAsync((unsigned char*)d_ws + WS_BAR, 0, (size_t)XCD_BAR_WORDS * 4, stream) != hipSuccess) { fprintf(stderr, "kernel_launch: memset failed\n"); return; }
    Args a{};
    for (int i = 0; i < 30; ++i) a.in[i] = (const float*)d_in[i];
    a.out = (float*)d_out; a.ws = (unsigned char*)d_ws;
    void* args[] = {&a};
    hipError_t e = hipLaunchCooperativeKernel((const void*)fwd_kernel, dim3(grid), dim3(NTHR), args, LDS_BYTES, stream);
    if (e != hipSuccess) fprintf(stderr, "cooperative launch failed: %s (grid %d)\n", hipGetErrorString(e), grid);
}
```

```cpp
#include <hip/hip_runtime.h>
#include <hip/hip_cooperative_groups.h>
#include <cstdio>
#include <cstdint>
namespace cg = cooperative_groups;
namespace pg8 {
#define PG8_LAS __attribute__((address_space(3)))
typedef unsigned short bf16_t;
typedef short bf16x8 __attribute__((ext_vector_type(8)));
typedef float f32x4 __attribute__((ext_vector_type(4)));
typedef unsigned u32x4 __attribute__((ext_vector_type(4)));
constexpr int BM = 256, BK = 64, HALF = 128, HTB = HALF * BK * 2  , STAGE_BYTES = 8 * HTB, NXCD = 8, WGM = 8;

__host__ __device__ __forceinline__ int lds_byte(int r, int c) { const int st = (r >> 4) * 2 + (c >> 5), rr = r & 15, cc = c & 31, ob = rr * 64 + cc * 2; return st * 1024 + (ob ^ (((ob >> 9) & 1) << 5)); }
__host__ __device__ __forceinline__ void stage_rc(int b, int& R, int& C) { const int st = b / 1024, sb = b % 1024, swz = sb ^ (((sb >> 9) & 1) << 5); R = (st >> 1) * 16 + swz / 64; C = (st & 1) * 32 + (swz % 64) / 2; }
__host__ __device__ __forceinline__ int perm32(int rho) { const int n = rho >> 4, i = rho & 15; return 8 * (i >> 2) + 4 * n + (i & 3); }

struct Unit { int pm, pn; int koff = 0; };
struct Gemm { const bf16_t* A; const bf16_t* Bt; int M, N, K; int ld = 0; };

struct StaticOrder {
    int nM, nN, nwg, G, c;
    __host__ __device__ void init(int M, int N, int G_, int c_) { nM = M / BM; nN = N / BM; nwg = nM * nN; G = G_; c = c_; }
    __host__ __device__ bool next(int i, Unit& u) const {
        const long L = (long)i * G + c; if (L >= nwg) return false;
        int wgid = (int)L; { const int q = nwg / NXCD, r = nwg % NXCD, xcd = wgid % NXCD, off = wgid / NXCD; wgid = (xcd < r ? xcd * (q + 1) : r * (q + 1) + (xcd - r) * q) + off; }
        const int nig = WGM * nN, gid = wgid / nig, fm = gid * WGM, gsz = (nM - fm) < WGM ? (nM - fm) : WGM;
        u.pm = fm + ((wgid % nig) % gsz); u.pn = (wgid % nig) / gsz; u.koff = 0; return true;
    }
    __device__ __forceinline__ void a_ready(const Unit&) const {}
    __device__ __forceinline__ void done(const Unit&) const {}
};

}
namespace pg8 {
template <class Epi, class Sched, bool ALIGN_EPI = false, bool SP2 = false>
__device__ __forceinline__ void gemm_phase(PG8_LAS unsigned char* lds, const Gemm g, const Sched& S, const Epi& E, int tid_in) {
    int tid_ = tid_in; asm volatile("" : "+v"(tid_)); const int tid = tid_, wid = __builtin_amdgcn_readfirstlane(tid >> 6), lane = tid & 63, wr = wid >> 2, wc = wid & 3, fr = lane & 15, fq = lane >> 4;
    const int K = g.ld ? g.ld : g.K, nt = g.K / BK;
    unsigned voffA[2], voffB[2];
#pragma unroll
    for (int i = 0; i < 2; ++i) { int R, C; stage_rc(tid * 16 + i * 8192, R, C); const int Rb = Epi::PERM ? ((R & ~31) + perm32(R & 31)) : R;
        voffA[i] = (unsigned)(R * K + C) * 2u; voffB[i] = (unsigned)(Rb * K + C) * 2u; }
    const size_t kstep = (size_t)(BK * 2);
    const size_t hstep = (size_t)HALF * K * 2;
    const size_t tstep = 2 * hstep;
    const unsigned ldsw = (unsigned)wid * 1024u;
    const int aoff = lds_byte(wr * 64 + fr, fq * 8), boff = lds_byte(wc * 32 + fr, fq * 8);
#define PG8_SA(b, h) (((b) * 2 + (h)) * HTB)
#define PG8_SB(b, h) ((4 + (b) * 2 + (h)) * HTB)
#define PG8_STAGE(bufoff, gbase, voff) do { _Pragma("unroll") for (int _i = 0; _i < 2; ++_i) \
        __builtin_amdgcn_global_load_lds((const unsigned*)((const char*)(gbase) + (voff)[_i]), (PG8_LAS unsigned*)(lds + (bufoff) + ldsw + _i * 8192), 16, 0, 0); } while (0)
#define PG8_LDA(dst, b, h) do { _Pragma("unroll") for (int m = 0; m < 4; ++m) _Pragma("unroll") for (int k = 0; k < 2; ++k) dst[m][k] = *(const PG8_LAS bf16x8*)(lds + PG8_SA(b, h) + aoff + m * 2048 + k * 1024); } while (0)
#define PG8_LDB(dst, b, h) do { _Pragma("unroll") for (int n = 0; n < 2; ++n) _Pragma("unroll") for (int k = 0; k < 2; ++k) dst[n][k] = *(const PG8_LAS bf16x8*)(lds + PG8_SB(b, h) + boff + n * 2048 + k * 1024); } while (0)
#define PG8_MMA(ai, bj, At, Bt) do { __builtin_amdgcn_s_setprio(1); _Pragma("unroll") for (int m = 0; m < 4; ++m) _Pragma("unroll") for (int n = 0; n < 2; ++n) _Pragma("unroll") for (int k = 0; k < 2; ++k) \
        acc[ai][bj][m][n] = __builtin_amdgcn_mfma_f32_16x16x32_bf16(Bt[n][k], At[m][k], acc[ai][bj][m][n], 0, 0, 0); __builtin_amdgcn_s_setprio(0); } while (0)
#define PG8_WAIT_V(n) asm volatile("s_waitcnt vmcnt(" #n ")" ::: "memory")
#define PG8_WAIT_L(n) asm volatile("s_waitcnt lgkmcnt(" #n ")" ::: "memory")
#define PG8_BAR __builtin_amdgcn_s_barrier()
#define PG8_SCHED __builtin_amdgcn_sched_barrier(0)
    Unit cur, nxt; int ui = 0;
    if (!S.next(0, cur)) return;
    f32x4 acc[2][2][4][2];
#pragma unroll
    for (int a = 0; a < 2; ++a)
#pragma unroll
        for (int b = 0; b < 2; ++b)
#pragma unroll
            for (int m = 0; m < 4; ++m)
#pragma unroll
                for (int n = 0; n < 2; ++n) acc[a][b][m][n] = (f32x4){0.f, 0.f, 0.f, 0.f};
    bf16x8 At[4][2], B0[2][2], B1[2][2];
    const char* cA = (const char*)g.A + (size_t)cur.pm * tstep + (size_t)cur.koff * 2; const char* cB = (const char*)g.Bt + (size_t)cur.pn * tstep + (size_t)cur.koff * 2;
    S.a_ready(cur);
    if constexpr (SP2) {
        PG8_STAGE(PG8_SB(0, 0), cB, voffB); PG8_STAGE(PG8_SB(0, 1), cB + hstep, voffB); PG8_STAGE(PG8_SA(0, 0), cA, voffA); PG8_STAGE(PG8_SA(0, 1), cA + hstep, voffA);
        if (wr == 1) PG8_BAR;
        PG8_WAIT_V(2); PG8_BAR;
        PG8_STAGE(PG8_SB(1, 0), cB + kstep, voffB); PG8_STAGE(PG8_SA(1, 0), cA + kstep, voffA); PG8_STAGE(PG8_SB(1, 1), cB + hstep + kstep, voffB);
        PG8_WAIT_V(6); PG8_BAR;
    } else {
        PG8_STAGE(PG8_SB(0, 0), cB, voffB); PG8_STAGE(PG8_SA(0, 0), cA, voffA); PG8_STAGE(PG8_SB(0, 1), cB + hstep, voffB); PG8_STAGE(PG8_SA(0, 1), cA + hstep, voffA);
        if (wr == 1) PG8_BAR;
        PG8_WAIT_V(4); PG8_BAR;
        PG8_STAGE(PG8_SB(1, 0), cB + kstep, voffB); PG8_STAGE(PG8_SA(1, 0), cA + kstep, voffA); PG8_STAGE(PG8_SB(1, 1), cB + hstep + kstep, voffB);
        PG8_WAIT_V(6); PG8_BAR;
    }
    for (;;) {
        const bool has_next = S.next(ui + 1, nxt);
        const char* nA = has_next ? (const char*)g.A + (size_t)nxt.pm * tstep + (size_t)nxt.koff * 2 : cA; const char* nB = has_next ? (const char*)g.Bt + (size_t)nxt.pn * tstep + (size_t)nxt.koff * 2 : cB;
        for (int t = 0; t < nt; t += 2) {
            const bool last = (t == nt - 2);
            const char* a1 = cA + (size_t)(t + 1) * kstep;
            const char* a2 = last ? nA : cA + (size_t)(t + 2) * kstep; const char* b2 = last ? nB : cB + (size_t)(t + 2) * kstep;
            const char* a3 = a2 + kstep; const char* b3 = b2 + kstep;
            if (last && has_next) S.a_ready(nxt);
            if constexpr (SP2) {
            PG8_LDB(B0, 0, 0); PG8_LDB(B1, 0, 1); PG8_SCHED; PG8_LDA(At, 0, 0); PG8_STAGE(PG8_SA(1, 1), a1 + hstep, voffA);
            PG8_WAIT_V(8); PG8_WAIT_L(0); PG8_BAR; PG8_MMA(0, 0, At, B0); PG8_MMA(0, 1, At, B1); PG8_BAR; PG8_SCHED;
            PG8_LDA(At, 0, 1); PG8_STAGE(PG8_SB(0, 0), b2, voffB); PG8_STAGE(PG8_SB(0, 1), b2 + hstep, voffB); PG8_STAGE(PG8_SA(0, 0), a2, voffA);
            PG8_WAIT_V(8); PG8_WAIT_L(0); PG8_BAR; PG8_MMA(1, 0, At, B0); PG8_MMA(1, 1, At, B1); PG8_BAR; PG8_SCHED;
            PG8_LDB(B0, 1, 0); PG8_LDB(B1, 1, 1); PG8_SCHED; PG8_LDA(At, 1, 0); PG8_STAGE(PG8_SA(0, 1), a2 + hstep, voffA);
            PG8_WAIT_V(8); PG8_WAIT_L(0); PG8_BAR; PG8_MMA(0, 0, At, B0); PG8_MMA(0, 1, At, B1); PG8_BAR; PG8_SCHED;
            PG8_LDA(At, 1, 1); PG8_STAGE(PG8_SB(1, 0), b3, voffB); PG8_STAGE(PG8_SB(1, 1), b3 + hstep, voffB); PG8_STAGE(PG8_SA(1, 0), a3, voffA);
            PG8_WAIT_V(8); PG8_WAIT_L(0); PG8_BAR; PG8_MMA(1, 0, At, B0); PG8_MMA(1, 1, At, B1); PG8_BAR; PG8_SCHED;
            } else {
            PG8_LDB(B0, 0, 0); PG8_SCHED; PG8_LDA(At, 0, 0); PG8_STAGE(PG8_SA(1, 1), a1 + hstep, voffA);
            PG8_WAIT_L(8); PG8_BAR; PG8_WAIT_L(0); PG8_MMA(0, 0, At, B0); PG8_BAR; PG8_SCHED;
            PG8_LDB(B1, 0, 1); PG8_STAGE(PG8_SB(0, 0), b2, voffB);
            PG8_BAR; PG8_WAIT_L(0); PG8_MMA(0, 1, At, B1); PG8_BAR;
            PG8_LDA(At, 0, 1); PG8_STAGE(PG8_SA(0, 0), a2, voffA);
            PG8_BAR; PG8_WAIT_L(0); PG8_MMA(1, 0, At, B0); PG8_BAR; PG8_SCHED;
            PG8_STAGE(PG8_SB(0, 1), b2 + hstep, voffB);
            PG8_WAIT_V(6); PG8_BAR; PG8_MMA(1, 1, At, B1); PG8_BAR;
            PG8_LDB(B0, 1, 0); PG8_SCHED; PG8_LDA(At, 1, 0); PG8_STAGE(PG8_SA(0, 1), a2 + hstep, voffA);
            PG8_WAIT_L(8); PG8_BAR; PG8_WAIT_L(0); PG8_MMA(0, 0, At, B0); PG8_BAR; PG8_SCHED;
            PG8_LDB(B1, 1, 1); PG8_STAGE(PG8_SB(1, 0), b3, voffB);
            PG8_BAR; PG8_WAIT_L(0); PG8_MMA(0, 1, At, B1); PG8_BAR;
            PG8_LDA(At, 1, 1); PG8_STAGE(PG8_SA(1, 0), a3, voffA);
            PG8_BAR; PG8_WAIT_L(0); PG8_MMA(1, 0, At, B0); PG8_BAR; PG8_SCHED;
            PG8_STAGE(PG8_SB(1, 1), b3 + hstep, voffB);
            PG8_WAIT_V(6); PG8_BAR; PG8_MMA(1, 1, At, B1); PG8_BAR;
            }
        }
        if constexpr (ALIGN_EPI) { if (wr == 0) PG8_BAR; }
        if constexpr (!Epi::AFTER_DRAIN) { E(acc, cur, wr, wc, fr, fq); S.done(cur); }
        if (!has_next) break;
#pragma unroll
        for (int a = 0; a < 2; ++a)
#pragma unroll
            for (int b = 0; b < 2; ++b)
#pragma unroll
                for (int m = 0; m < 4; ++m)
#pragma unroll
                    for (int n = 0; n < 2; ++n) acc[a][b][m][n] = (f32x4){0.f, 0.f, 0.f, 0.f};
        cur = nxt; cA = nA; cB = nB; ++ui;
        if constexpr (ALIGN_EPI) { if (wr == 1) PG8_BAR; }
    }
    PG8_WAIT_V(0);
    if constexpr (!ALIGN_EPI) { if (wr == 0) PG8_BAR; }
    PG8_BAR;
    if constexpr (Epi::AFTER_DRAIN) { E.fused(acc, cur, wr, wc, fr, fq, lds, wid, lane); S.done(cur); }
#undef PG8_SA
#undef PG8_SB
#undef PG8_STAGE
#undef PG8_LDA
#undef PG8_LDB
#undef PG8_MMA
#undef PG8_WAIT_V
#undef PG8_WAIT_L
#undef PG8_BAR
#undef PG8_SCHED
}
}

using pg8::bf16_t; using pg8::bf16x8; using pg8::f32x4; using pg8::u32x4; using pg8::Unit;
typedef float f32x16 __attribute__((ext_vector_type(16)));
typedef float f32x2v __attribute__((ext_vector_type(2)));
typedef __bf16 bf16x2v __attribute__((ext_vector_type(2)));
typedef unsigned u32x2 __attribute__((ext_vector_type(2)));
#define LAS __attribute__((address_space(3)))

constexpr int DM = 1024, NBATCH = 2, SEQ = 16384, CTXL = 256;
constexpr int NLAT = NBATCH * SEQ, NCTX = NBATCH * CTXL, R = NLAT + NCTX;
constexpr int DFF = 2816, KEYS = SEQ + CTXL;
constexpr float EPS = 1e-6f;
constexpr float C2 = 0.125f * 1.4426950408889634f;
constexpr int NTHR = 512;
constexpr int LDS_BYTES = 135168;
constexpr int HG_SEG = 128, HG_STEPS = KEYS / HG_SEG;

constexpr size_t WL_UP1 = 0, WL_DN1 = WL_UP1 + (size_t)5632 * 1024, WL_UP2 = WL_DN1 + (size_t)1024 * 2816, WL_DN2 = WL_UP2 + (size_t)5632 * 1024,
                 WL_IN = WL_DN2 + (size_t)1024 * 2816, WL_PA = WL_IN + (size_t)6144 * 1024, WL_PH = WL_PA + (size_t)1024 * 512, WL_PP = WL_PH + (size_t)1024 * 256,
                 WL_O = WL_PP + (size_t)1024 * 256, WL_TOTAL = WL_O + (size_t)1024 * 1024;
constexpr size_t WS_WB = 0;
constexpr size_t WS_XB = WS_WB + 2 * WL_TOTAL * 2;
constexpr size_t WS_Z = WS_XB + (size_t)R * 1024 * 2;
constexpr size_t Z_VT = 0, Z_HQ = Z_VT + (size_t)R * 512 * 2, Z_FF = Z_HQ + (size_t)R * 256 * 4, Z_FB = Z_FF + (size_t)R * 256 * 4, Z_HI = Z_FB + (size_t)R * 256 * 4,
                 Z_ZP = Z_HI + (size_t)R * 256 * 2, Z_Q = Z_ZP + (size_t)R * 256 * 2, Z_K = Z_Q + (size_t)R * 512 * 2, Z_HG = Z_K + (size_t)R * 512 * 2, Z_END = Z_HG + (size_t)R * 256 * 2;
static_assert((size_t)R * 3072 * 2 <= Z_K, "gate buffer must not reach k / odir / hgate");
static_assert((size_t)R * DFF * 2 <= Z_END, "act fits Z");
constexpr size_t WS_O = WS_Z + Z_END;
constexpr size_t O_DA = 0, O_HG = O_DA + (size_t)R * 512 * 2, O_MX = O_HG + (size_t)R * 256 * 2, O_END = O_MX + (size_t)R * 256 * 2;
constexpr size_t WS_CAR = WS_O + O_END;
constexpr size_t WS_DK = WS_CAR + (size_t)16 * HG_SEG * 4096 * 4;
constexpr size_t WS_HC = WS_DK + (size_t)16 * HG_SEG * 64 * 4;
constexpr size_t WS_MOD = WS_HC + (size_t)NCTX * 1024 * 4;
constexpr size_t WS_CS = WS_MOD + (size_t)2 * 3 * 9216 * 4;
constexpr size_t WS_LB = WS_CS + (size_t)256 * 32 * 4;
constexpr size_t WS_LAM = WS_LB + (size_t)2 * 2 * 256 * 4;
constexpr size_t WS_END = WS_LAM + 256;
static_assert(WS_END <= (size_t)512 * 1024 * 1024, "workspace");

__device__ __forceinline__ unsigned pk2(float lo, float hi) { f32x2v v = {lo, hi}; bf16x2v b = __builtin_convertvector(v, bf16x2v); return __builtin_bit_cast(unsigned, b); }
__device__ __forceinline__ float bf2f(unsigned short u) { return __builtin_bit_cast(float, (unsigned)u << 16); }
__device__ __forceinline__ float bflo(unsigned u) { return __builtin_bit_cast(float, u << 16); }
__device__ __forceinline__ float bfhi(unsigned u) { return __builtin_bit_cast(float, u & 0xffff0000u); }
__device__ __forceinline__ float ex2(float x) { return __builtin_amdgcn_exp2f(x); }
__device__ __forceinline__ float rcpf_(float x) { return __builtin_amdgcn_rcpf(x); }
__device__ __forceinline__ float sigm(float x) { return rcpf_(1.f + ex2(-1.4426950408889634f * x)); }
__device__ __forceinline__ float siluf(float x) { return x * sigm(x); }
__device__ __forceinline__ float shx(float v, int o, int lane) { return __builtin_bit_cast(float, __builtin_amdgcn_ds_bpermute((lane ^ o) << 2, __builtin_bit_cast(int, v))); }
__device__ __forceinline__ float swap32(float v) { auto rr = __builtin_amdgcn_permlane32_swap(__builtin_bit_cast(unsigned, v), __builtin_bit_cast(unsigned, v), false, false);
    const float a = __builtin_bit_cast(float, rr[0]), b = __builtin_bit_cast(float, rr[1]); return (a == v) ? b : a; }
__device__ __forceinline__ float wave_sum(float v, int lane) {
#pragma unroll
    for (int o = 1; o < 64; o <<= 1) v += shx(v, o, lane);
    return v;
}
#define LDS_WAIT() asm volatile("s_waitcnt lgkmcnt(0)" ::: "memory")

struct EpiUp {
    static constexpr bool PERM = true, AFTER_DRAIN = false;
    bf16_t* act;
    __device__ __forceinline__ void operator()(const f32x4 (&acc)[2][2][4][2], const Unit& u, int wr, int wc, int fr, int fq) const {
        const int row0 = u.pm * 256 + wr * 64 + fr, col0 = u.pn * 128 + wc * 32 + 8 * fq;
#pragma unroll
        for (int ai = 0; ai < 2; ++ai)
#pragma unroll
            for (int m = 0; m < 4; ++m) {
                const int row = row0 + ai * 128 + m * 16;
                const f32x4 a0 = acc[ai][0][m][0], a1 = acc[ai][0][m][1], b0 = acc[ai][1][m][0], b1 = acc[ai][1][m][1];
                u32x4 w;
                w.x = pk2(siluf(a0[0]) * b0[0], siluf(a0[1]) * b0[1]); w.y = pk2(siluf(a0[2]) * b0[2], siluf(a0[3]) * b0[3]);
                w.z = pk2(siluf(a1[0]) * b1[0], siluf(a1[1]) * b1[1]); w.w = pk2(siluf(a1[2]) * b1[2], siluf(a1[3]) * b1[3]);
                *(u32x4*)(act + (size_t)row * DFF + col0) = w;
            }
    }
};
struct EpiRes {
    static constexpr bool PERM = true, AFTER_DRAIN = false;
    const float* in_lat; const float* in_ctx; float* out_lat; float* out_ctx; const float* gate; float coef;
    __device__ __forceinline__ void operator()(const f32x4 (&acc)[2][2][4][2], const Unit& u, int wr, int wc, int fr, int fq) const {
        const int row0 = u.pm * 256 + wr * 64 + fr, col0 = u.pn * 256 + wc * 32 + 8 * fq;
        const int seg = (u.pm < 64) ? 0 : (u.pm < 128 ? 1 : 2);
        f32x4 gv[2][2];
#pragma unroll
        for (int bj = 0; bj < 2; ++bj)
#pragma unroll
            for (int n = 0; n < 2; ++n) gv[bj][n] = *(const f32x4*)(gate + seg * 9216 + col0 + bj * 128 + 4 * n) * coef;
#pragma unroll
        for (int ai = 0; ai < 2; ++ai)
#pragma unroll
            for (int m = 0; m < 4; ++m) {
                const int row = row0 + ai * 128 + m * 16;
                const float* ip; float* op;
                if (row < NLAT) { ip = in_lat + (size_t)row * DM; op = out_lat + (size_t)row * DM; }
                else { ip = in_ctx + (size_t)(row - NLAT) * DM; op = out_ctx + (size_t)(row - NLAT) * DM; }
#pragma unroll
                for (int bj = 0; bj < 2; ++bj)
#pragma unroll
                    for (int n = 0; n < 2; ++n) {
                        const int c = col0 + bj * 128 + 4 * n;
                        f32x4 v = *(const f32x4*)(ip + c);
                        v = v + gv[bj][n] * acc[ai][bj][m][n];
                        *(f32x4*)(op + c) = v;
                    }
            }
    }
};
struct SplitKOrder {
    int nunits, G, c, kc;
    __device__ void init(int nparts, int kc_, int G_, int c_) { nunits = nparts * 8; G = G_; c = c_; kc = kc_; }
    __device__ bool next(int i, Unit& u) const {
        const int L = i * G + c; if (L >= nunits) return false;
        const int part = L >> 3, r = L & 7; u.pm = r >> 2; u.pn = r & 3; u.koff = part * kc; return true;
    }
    __device__ __forceinline__ void a_ready(const Unit&) const {}
    __device__ __forceinline__ void done(const Unit&) const {}
};
struct EpiPart {
    static constexpr bool PERM = true, AFTER_DRAIN = false;
    float* P; const float* gate; float coef;
    __device__ __forceinline__ void operator()(const f32x4 (&acc)[2][2][4][2], const Unit& u, int wr, int wc, int fr, int fq) const {
        unsigned z_ = 0u; asm volatile("" : "+s"(z_));
        const int lane_ = (int)__builtin_amdgcn_mbcnt_hi(~0u, __builtin_amdgcn_mbcnt_lo(~0u, z_)), fr_ = lane_ & 15, fq_ = lane_ >> 4;
        const int row0 = u.pm * 256 + wr * 64 + fr_, col0 = u.pn * 256 + wc * 32 + 8 * fq_;
        float* Pp = P + (size_t)(u.koff >> 8) * NCTX * DM;
        f32x4 gv[2][2];
#pragma unroll
        for (int bj = 0; bj < 2; ++bj)
#pragma unroll
            for (int n = 0; n < 2; ++n) gv[bj][n] = *(const f32x4*)(gate + 2 * 9216 + col0 + bj * 128 + 4 * n) * coef;
#pragma unroll
        for (int ai = 0; ai < 2; ++ai)
#pragma unroll
            for (int m = 0; m < 4; ++m) {
                float* op = Pp + (size_t)(row0 + ai * 128 + m * 16) * DM;
#pragma unroll
                for (int bj = 0; bj < 2; ++bj)
#pragma unroll
                    for (int n = 0; n < 2; ++n) *(f32x4*)(op + col0 + bj * 128 + 4 * n) = gv[bj][n] * acc[ai][bj][m][n];
            }
    }
};
struct EpiWin {
    static constexpr bool PERM = true, AFTER_DRAIN = false;
    unsigned char* Z; const float* cs; const float* lb; int pn_off;
    __device__ __forceinline__ void operator()(const f32x4 (&acc)[2][2][4][2], const Unit& u, int wr, int wc, int fr, int fq) const {
        const int t = u.pn + pn_off;
        const int row0 = u.pm * 256 + wr * 64 + fr, cin = wc * 32 + 8 * fq;
        if (t < 4) {
            bf16_t* dst = (bf16_t*)(Z + ((t < 2) ? Z_Q : Z_K)); const float sc = (t < 2) ? C2 : 1.f; const int cb = (t & 1) * 256;
#pragma unroll
            for (int ai = 0; ai < 2; ++ai)
#pragma unroll
                for (int m = 0; m < 4; ++m) {
                    const int row = row0 + ai * 128 + m * 16;
                    f32x4 cv = {1.f, 1.f, 1.f, 1.f}, sv = {0.f, 0.f, 0.f, 0.f};
                    if (row < NLAT) { const int ts = row & (SEQ - 1); const int pos = (wc & 1) ? (ts & 63) : (ts >> 6);
                        cv = *(const f32x4*)(cs + pos * 32 + 4 * fq); sv = *(const f32x4*)(cs + pos * 32 + 16 + 4 * fq); }
#pragma unroll
                    for (int bj = 0; bj < 2; ++bj) {
                        const f32x4 x1 = acc[ai][bj][m][0], x2 = acc[ai][bj][m][1];
                        const f32x4 o1 = (x1 * cv - x2 * sv) * sc, o2 = (x1 * sv + x2 * cv) * sc;
                        u32x4 w; w.x = pk2(o1[0], o1[1]); w.y = pk2(o1[2], o1[3]); w.z = pk2(o2[0], o2[1]); w.w = pk2(o2[2], o2[3]);
                        *(u32x4*)(dst + (size_t)row * 512 + cb + bj * 128 + cin) = w;
                    }
                }
        } else if (t < 6) {
            bf16_t* vT = (bf16_t*)(Z + Z_VT);
#pragma unroll
            for (int ai = 0; ai < 2; ++ai)
#pragma unroll
                for (int m = 0; m < 4; ++m) {
                    const int row = row0 + ai * 128 + m * 16;
                    int b, key;
                    if (row < NLAT) { b = row >> 14; key = row & (SEQ - 1); } else { b = (row - NLAT) >> 8; key = SEQ + ((row - NLAT) & (CTXL - 1)); }
#pragma unroll
                    for (int bj = 0; bj < 2; ++bj) {
                        bf16_t* dp = vT + (size_t)(b * 512 + (t - 4) * 256 + bj * 128 + cin) * KEYS + key;
#pragma unroll
                        for (int n = 0; n < 2; ++n)
#pragma unroll
                            for (int i = 0; i < 4; i += 2) {
                                const unsigned w = pk2(acc[ai][bj][m][n][i], acc[ai][bj][m][n][i + 1]);
                                dp[(size_t)(4 * n + i) * KEYS] = (bf16_t)(w & 0xffffu); dp[(size_t)(4 * n + i + 1) * KEYS] = (bf16_t)(w >> 16);
                            }
                    }
                }
        } else if (t <= 8) {
            float* dst = (float*)(Z + ((t == 6) ? Z_HQ : (t == 7 ? Z_FF : Z_FB)));
            const float* lbp = lb + ((t == 8) ? 256 : 0);
#pragma unroll
            for (int bj = 0; bj < 2; ++bj)
#pragma unroll
                for (int n = 0; n < 2; ++n) {
                    f32x4 lbv = *(const f32x4*)(lbp + bj * 128 + cin + 4 * n);
                    f32x4 om = 1.f - lbv;
#pragma unroll
                    for (int ai = 0; ai < 2; ++ai)
#pragma unroll
                        for (int m = 0; m < 4; ++m) {
                            const int row = row0 + ai * 128 + m * 16;
                            const f32x4 z = acc[ai][bj][m][n];
                            f32x4 sg; sg[0] = sigm(z[0]); sg[1] = sigm(z[1]); sg[2] = sigm(z[2]); sg[3] = sigm(z[3]);
                            const f32x4 o = (t == 6) ? z * sg : lbv + om * sg;
                            *(f32x4*)(dst + (size_t)row * 256 + bj * 128 + cin + 4 * n) = o;
                        }
                }
        } else {
            bf16_t* dst = (bf16_t*)(Z + ((t == 9) ? Z_HI : (t == 10 ? Z_HG : Z_ZP)));
#pragma unroll
            for (int ai = 0; ai < 2; ++ai)
#pragma unroll
                for (int m = 0; m < 4; ++m) {
                    const int row = row0 + ai * 128 + m * 16;
#pragma unroll
                    for (int bj = 0; bj < 2; ++bj) {
                        f32x4 v0 = acc[ai][bj][m][0], v1 = acc[ai][bj][m][1];
                        if (t == 10) { v0[0] = siluf(v0[0]); v0[1] = siluf(v0[1]); v0[2] = siluf(v0[2]); v0[3] = siluf(v0[3]); v1[0] = siluf(v1[0]); v1[1] = siluf(v1[1]); v1[2] = siluf(v1[2]); v1[3] = siluf(v1[3]); }
                        u32x4 w; w.x = pk2(v0[0], v0[1]); w.y = pk2(v0[2], v0[3]); w.z = pk2(v1[0], v1[1]); w.w = pk2(v1[2], v1[3]);
                        *(u32x4*)(dst + (size_t)row * 256 + bj * 128 + cin) = w;
                    }
                }
        }
    }
};
struct EpiVT {
    static constexpr bool PERM = true, AFTER_DRAIN = false;
    bf16_t* vT;
    __device__ __forceinline__ void operator()(const f32x4 (&acc)[2][2][4][2], const Unit& u, int wr, int wc, int fr, int fq) const {
        const int e0 = u.pm * 256 + wr * 64 + fr;
        int b, key0;
        if (u.pn < 64) { b = 0; key0 = u.pn * 256; } else if (u.pn < 128) { b = 1; key0 = (u.pn - 64) * 256; } else { b = u.pn - 128; key0 = SEQ; }
        const int kc = key0 + wc * 32 + 8 * fq;
#pragma unroll
        for (int ai = 0; ai < 2; ++ai)
#pragma unroll
            for (int m = 0; m < 4; ++m) {
                const int e = e0 + ai * 128 + m * 16;
#pragma unroll
                for (int bj = 0; bj < 2; ++bj) {
                    const f32x4 v0 = acc[ai][bj][m][0], v1 = acc[ai][bj][m][1];
                    u32x4 w; w.x = pk2(v0[0], v0[1]); w.y = pk2(v0[2], v0[3]); w.z = pk2(v1[0], v1[1]); w.w = pk2(v1[2], v1[3]);
                    *(u32x4*)(vT + (size_t)(b * 512 + e) * KEYS + kc + bj * 128) = w;
                }
            }
    }
};
struct EpiG {
    static constexpr bool PERM = true, AFTER_DRAIN = false;
    bf16_t* G;
    __device__ __forceinline__ void operator()(const f32x4 (&acc)[2][2][4][2], const Unit& u, int wr, int wc, int fr, int fq) const {
        const int row0 = u.pm * 256 + wr * 64 + fr, col0 = u.pn * 256 + wc * 32 + 8 * fq;
#pragma unroll
        for (int ai = 0; ai < 2; ++ai)
#pragma unroll
            for (int m = 0; m < 4; ++m) {
                const int row = row0 + ai * 128 + m * 16;
#pragma unroll
                for (int bj = 0; bj < 2; ++bj) {
                    const f32x4 v0 = acc[ai][bj][m][0], v1 = acc[ai][bj][m][1];
                    u32x4 w; w.x = pk2(sigm(v0[0]), sigm(v0[1])); w.y = pk2(sigm(v0[2]), sigm(v0[3])); w.z = pk2(sigm(v1[0]), sigm(v1[1])); w.w = pk2(sigm(v1[2]), sigm(v1[3]));
                    *(u32x4*)(G + (size_t)row * 3072 + col0 + bj * 128) = w;
                }
            }
    }
};
struct EpiProj {
    static constexpr bool PERM = true, AFTER_DRAIN = false;
    bf16_t* y; const bf16_t* G; int gi; int first;
    __device__ __forceinline__ void operator()(const f32x4 (&acc)[2][2][4][2], const Unit& u, int wr, int wc, int fr, int fq) const {
        const int row0 = u.pm * 256 + wr * 64 + fr, col0 = u.pn * 256 + wc * 32 + 8 * fq;
#pragma unroll
        for (int ai = 0; ai < 2; ++ai)
#pragma unroll
            for (int m = 0; m < 4; ++m) {
                const int row = row0 + ai * 128 + m * 16;
#pragma unroll
                for (int bj = 0; bj < 2; ++bj) {
                    const int c = col0 + bj * 128;
                    const u32x4 g = *(const u32x4*)(G + (size_t)row * 3072 + gi * 1024 + c);
                    u32x4 yo = {0u, 0u, 0u, 0u};
                    if (!first) yo = *(const u32x4*)(y + (size_t)row * 1024 + c);
                    const f32x4 v0 = acc[ai][bj][m][0], v1 = acc[ai][bj][m][1];
                    u32x4 w;
                    w.x = pk2(bflo(yo.x) + bflo(g.x) * v0[0], bfhi(yo.x) + bfhi(g.x) * v0[1]);
                    w.y = pk2(bflo(yo.y) + bflo(g.y) * v0[2], bfhi(yo.y) + bfhi(g.y) * v0[3]);
                    w.z = pk2(bflo(yo.z) + bflo(g.z) * v1[0], bfhi(yo.z) + bfhi(g.z) * v1[1]);
                    w.w = pk2(bflo(yo.w) + bflo(g.w) * v1[2], bfhi(yo.w) + bfhi(g.w) * v1[3]);
                    *(u32x4*)(y + (size_t)row * 1024 + c) = w;
                }
            }
    }
};

__device__ __forceinline__ int map_row(int mode, int n) {
    if (mode == 1) return 256 * (n >> 7) + (n & 127);
    if (mode == 2) return 256 * (n >> 7) + 128 + (n & 127);
    if (mode == 3) return (n < 1024) ? ((n & ~31) + 8 * ((n & 15) >> 2) + 4 * ((n >> 4) & 1) + (n & 3)) : n;
    return n;
}
__device__ __forceinline__ void transpose_item(const float* W, int K, int N, bf16_t* WT, int mode, LAS float* scr, int item, int lane) {
    const int nblk = N / 32, kb = item / nblk, nb = item % nblk, k0 = 64 * kb, n0 = 32 * nb;
#pragma unroll 8
    for (int i = 0; i < 32; ++i) { const int kk = 2 * i + (lane >> 5); scr[kk * 33 + (lane & 31)] = W[(size_t)(k0 + kk) * N + n0 + (lane & 31)]; }
    LDS_WAIT(); asm volatile("" ::: "memory");
    const int c = lane & 7;
#pragma unroll
    for (int j = 0; j < 4; ++j) { const int n = (lane >> 3) + 8 * j; const LAS float* s = scr + (8 * c) * 33 + n;
        u32x4 o; o.x = pk2(s[0 * 33], s[1 * 33]); o.y = pk2(s[2 * 33], s[3 * 33]); o.z = pk2(s[4 * 33], s[5 * 33]); o.w = pk2(s[6 * 33], s[7 * 33]);
        *(u32x4*)(WT + (size_t)map_row(mode, n0 + n) * K + k0 + 8 * c) = o; }
    LDS_WAIT(); asm volatile("" ::: "memory");
}

__device__ __forceinline__ void norm_phase(const float* in_lat, const float* in_ctx, const float* gain, const float* modl, int shi, int sci, bf16_t* outp, int gw, int ngw, int lane,
                                           const float* part, int nparts, float* hc_out) {
    f32x4 gv[4];
#pragma unroll
    for (int j = 0; j < 4; ++j) gv[j] = *(const f32x4*)(gain + 4 * lane + 256 * j);
    for (int row = gw; row < R; row += ngw) {
        const float* ip = (row < NLAT) ? in_lat + (size_t)row * DM : in_ctx + (size_t)(row - NLAT) * DM;
        const int seg = (row < SEQ) ? 0 : (row < NLAT ? 1 : 2);
        const float* sh = modl + seg * 9216 + shi * 1024; const float* sc = modl + seg * 9216 + sci * 1024;
        f32x4 v[4]; float ss = 0.f;
#pragma unroll
        for (int j = 0; j < 4; ++j) v[j] = *(const f32x4*)(ip + 4 * lane + 256 * j);
        if (row >= NLAT && nparts > 0) {
            for (int p = 0; p < nparts; ++p) {
                const float* pp = part + ((size_t)p * NCTX + (row - NLAT)) * DM;
#pragma unroll
                for (int j = 0; j < 4; ++j) v[j] = v[j] + *(const f32x4*)(pp + 4 * lane + 256 * j);
            }
#pragma unroll
            for (int j = 0; j < 4; ++j) *(f32x4*)(hc_out + (size_t)(row - NLAT) * DM + 4 * lane + 256 * j) = v[j];
        }
#pragma unroll
        for (int j = 0; j < 4; ++j) ss += (v[j][0] * v[j][0] + v[j][1] * v[j][1]) + (v[j][2] * v[j][2] + v[j][3] * v[j][3]);
        ss = wave_sum(ss, lane);
        const float rstd = 1.0f / sqrtf(ss * (1.f / DM) + EPS);
#pragma unroll
        for (int j = 0; j < 4; ++j) {
            const f32x4 s4 = *(const f32x4*)(sc + 4 * lane + 256 * j), h4 = *(const f32x4*)(sh + 4 * lane + 256 * j);
            const f32x4 y = v[j] * rstd * gv[j] * (s4 + 1.f) + h4;
            u32x2 w; w.x = pk2(y[0], y[1]); w.y = pk2(y[2], y[3]);
            *(u32x2*)(outp + (size_t)row * DM + 4 * lane + 256 * j) = w;
        }
    }
}
__device__ __forceinline__ void final_norm_phase(float* out, const float* gain, int gw, int ngw, int lane) {
    f32x4 gv[4];
#pragma unroll
    for (int j = 0; j < 4; ++j) gv[j] = *(const f32x4*)(gain + 4 * lane + 256 * j);
    for (int row = gw; row < NLAT; row += ngw) {
        float* ip = out + (size_t)row * DM;
        f32x4 v[4]; float ss = 0.f;
#pragma unroll
        for (int j = 0; j < 4; ++j) { v[j] = *(const f32x4*)(ip + 4 * lane + 256 * j); ss += (v[j][0] * v[j][0] + v[j][1] * v[j][1]) + (v[j][2] * v[j][2] + v[j][3] * v[j][3]); }
        ss = wave_sum(ss, lane);
        const float rstd = 1.0f / sqrtf(ss * (1.f / DM) + EPS);
#pragma unroll
        for (int j = 0; j < 4; ++j) *(f32x4*)(ip + 4 * lane + 256 * j) = v[j] * rstd * gv[j];
    }
}
__device__ __forceinline__ void pool_phase(const bf16_t* zp, bf16_t* mx, int gtid, int ngt) {
    for (int it = gtid; it < R * 32; it += ngt) {
        const int row = it >> 5, ch = (it & 31) * 8, g = ch >> 6, hw = 1 << g;
        int base, n;
        if (row < NLAT) { base = row & ~(SEQ - 1); n = SEQ; } else { base = NLAT + ((row - NLAT) & ~(CTXL - 1)); n = CTXL; }
        const int t = row - base, lo = (t - hw > 0) ? t - hw : 0, hi = (t + hw < n) ? t + hw : n;
        float s[8];
#pragma unroll
        for (int i = 0; i < 8; ++i) s[i] = 0.f;
        for (int j = lo; j < hi; ++j) {
            const u32x4 v = *(const u32x4*)(zp + (size_t)(base + j) * 256 + ch);
            s[0] += bflo(v.x); s[1] += bfhi(v.x); s[2] += bflo(v.y); s[3] += bfhi(v.y); s[4] += bflo(v.z); s[5] += bfhi(v.z); s[6] += bflo(v.w); s[7] += bfhi(v.w);
        }
        const float inv = 1.f / (float)(hi - lo);
        const u32x4 c = *(const u32x4*)(zp + (size_t)row * 256 + ch);
        u32x4 w;
        w.x = pk2(s[0] * inv - bflo(c.x), s[1] * inv - bfhi(c.x)); w.y = pk2(s[2] * inv - bflo(c.y), s[3] * inv - bfhi(c.y));
        w.z = pk2(s[4] * inv - bflo(c.z), s[5] * inv - bfhi(c.z)); w.w = pk2(s[6] * inv - bflo(c.w), s[7] * inv - bfhi(c.w));
        *(u32x4*)(mx + (size_t)row * 256 + ch) = w;
    }
}

__device__ __forceinline__ int hg_row(int dir, int b, int step) {
    if (step < CTXL) { const int t = dir ? (CTXL - 1 - step) : step; return NLAT + b * CTXL + t; }
    int t = step - CTXL; if (dir) t = SEQ - 1 - t; return b * SEQ + t;
}
template <bool OUT>
__device__ __forceinline__ void hg_pass(const float* hq, const float* ff, const float* fb, const bf16_t* hi, float* carry, float* dk, bf16_t* odir, int wave, int lane, int G) {
    for (int item = blockIdx.x + G * wave; item < 16 * HG_SEG; item += G * 8) {
        const int s = item / HG_SEG, j = item % HG_SEG, dir = s >> 3, b = (s >> 2) & 1, h = s & 3;
        const float* fbase = dir ? fb : ff;
        f32x2v S[32];
#pragma unroll
        for (int k = 0; k < 32; ++k) { S[k][0] = OUT ? carry[((size_t)item * 64 + 2 * k) * 64 + lane] : 0.f; S[k][1] = OUT ? carry[((size_t)item * 64 + 2 * k + 1) * 64 + lane] : 0.f; }
        float dl = 1.f;
        const int st0 = j * HG_STEPS, st1 = st0 + HG_STEPS;
        constexpr int HG_PF = 8;
        float ivb[HG_PF], fvb[HG_PF], qvb[HG_PF];
#pragma unroll
        for (int u = 0; u < HG_PF; ++u) {
            const int stl = (st0 + u < st1) ? st0 + u : st1 - 1;
            const size_t off = (size_t)hg_row(dir, b, stl) * 256 + h * 64 + lane;
            ivb[u] = bf2f(hi[off]); fvb[u] = fbase[off]; qvb[u] = OUT ? hq[off] : 0.f;
        }
        for (int sb = st0; sb < st1; sb += HG_PF) {
#pragma unroll
            for (int u = 0; u < HG_PF; ++u) {
                const int st = sb + u;
                if (st < st1) {
                    const float iv = ivb[u], fv = fvb[u], qv = qvb[u];
                    const size_t offc = (size_t)hg_row(dir, b, st) * 256 + h * 64 + lane;
                    { const int stn = (st + HG_PF < st1) ? st + HG_PF : st1 - 1;
                      const size_t off = (size_t)hg_row(dir, b, stn) * 256 + h * 64 + lane;
                      ivb[u] = bf2f(hi[off]); fvb[u] = fbase[off]; if (OUT) qvb[u] = hq[off]; }
                    if (!OUT) dl *= fv;
                    f32x2v o2 = {0.f, 0.f};
                    const f32x2v iv2 = {iv, iv};
                    const int fvi = __builtin_bit_cast(int, fv), qvi = __builtin_bit_cast(int, qv);
#pragma unroll
                    for (int k = 0; k < 32; ++k) {
                        f32x2v f2; f2[0] = __builtin_bit_cast(float, __builtin_amdgcn_readlane(fvi, 2 * k)); f2[1] = __builtin_bit_cast(float, __builtin_amdgcn_readlane(fvi, 2 * k + 1));
                        const f32x2v d2 = S[k] - iv2;
                        S[k] = __builtin_elementwise_fma(f2, d2, iv2);
                        if (OUT) { f32x2v q2; q2[0] = __builtin_bit_cast(float, __builtin_amdgcn_readlane(qvi, 2 * k)); q2[1] = __builtin_bit_cast(float, __builtin_amdgcn_readlane(qvi, 2 * k + 1));
                            o2 = __builtin_elementwise_fma(q2, S[k], o2); }
                    }
                    if (OUT) odir[(size_t)dir * R * 256 + offc] = (bf16_t)(pk2(o2[0] + o2[1], 0.f) & 0xffffu);
                }
            }
        }
        if (!OUT) {
#pragma unroll
            for (int k = 0; k < 32; ++k) { carry[((size_t)item * 64 + 2 * k) * 64 + lane] = S[k][0]; carry[((size_t)item * 64 + 2 * k + 1) * 64 + lane] = S[k][1]; }
            dk[item * 64 + lane] = dl;
        }
    }
}
constexpr int HGA_T = 48, HGA_STR = 112, HGA_MAT = 64 * HGA_STR, HGA_WAVE = 2 * HGA_MAT;
static_assert(8 * HGA_WAVE <= LDS_BYTES - 64 && 3 * HGA_T >= HG_STEPS, "hg pass A LDS");
__device__ __forceinline__ void hg_passA_mfma(LAS unsigned char* lds, const float* ff, const float* fb, const bf16_t* hi, float* carry, float* dk, int wave, int lane, int G) {
    LAS unsigned char* KT = lds + wave * HGA_WAVE; LAS unsigned char* VT = KT + HGA_MAT;
    const int n = lane & 31, gq = lane >> 5;
    for (int item = blockIdx.x + G * wave; item < 16 * HG_SEG; item += G * 8) {
        const int s = item / HG_SEG, j = item % HG_SEG, dir = s >> 3, b = (s >> 2) & 1, h = s & 3;
        const float* fbase = dir ? fb : ff;
        const int st0 = j * HG_STEPS, st1 = st0 + HG_STEPS;
        f32x16 acc[2][2];
#pragma unroll
        for (int kb = 0; kb < 2; ++kb)
#pragma unroll
            for (int vb = 0; vb < 2; ++vb)
#pragma unroll
                for (int r = 0; r < 16; ++r) acc[kb][vb][r] = 0.f;
        float P = 1.f;
        for (int third = 2; third >= 0; --third) {
            const int sb = st0 + third * HGA_T;
            for (int s0 = HGA_T - 8; s0 >= 0; s0 -= 8) {
                float fv[8]; unsigned short iv[8];
#pragma unroll
                for (int u = 0; u < 8; ++u) {
                    const int st = sb + s0 + u;
                    const int stc = (st < st1) ? st : st1 - 1;
                    const size_t off = (size_t)hg_row(dir, b, stc) * 256 + h * 64 + lane;
                    fv[u] = fbase[off]; iv[u] = hi[off];
                }
#pragma unroll
                for (int u = 7; u >= 0; --u) {
                    const int st = sb + s0 + u;
                    const bool ok = (st < st1);
                    const float f = ok ? fv[u] : 1.f;
                    const float kh = ok ? (1.f - f) * P : 0.f;
                    P *= f;
                    *(LAS unsigned short*)(KT + lane * HGA_STR + (s0 + u) * 2) = (unsigned short)(pk2(kh, 0.f) & 0xffffu);
                    *(LAS unsigned short*)(VT + lane * HGA_STR + (s0 + u) * 2) = ok ? iv[u] : (unsigned short)0;
                }
            }
            LDS_WAIT(); asm volatile("" ::: "memory");
#pragma unroll
            for (int q = 0; q < HGA_T / 16; ++q) {
                bf16x8 af[2], bfr[2];
#pragma unroll
                for (int kb = 0; kb < 2; ++kb) af[kb] = *(LAS bf16x8*)(KT + (kb * 32 + n) * HGA_STR + (16 * q + 8 * gq) * 2);
#pragma unroll
                for (int vb = 0; vb < 2; ++vb) bfr[vb] = *(LAS bf16x8*)(VT + (vb * 32 + n) * HGA_STR + (16 * q + 8 * gq) * 2);
#pragma unroll
                for (int kb = 0; kb < 2; ++kb)
#pragma unroll
                    for (int vb = 0; vb < 2; ++vb) acc[kb][vb] = __builtin_amdgcn_mfma_f32_32x32x16_bf16(af[kb], bfr[vb], acc[kb][vb], 0, 0, 0);
            }
            LDS_WAIT(); asm volatile("" ::: "memory");
        }
#pragma unroll
        for (int kb = 0; kb < 2; ++kb)
#pragma unroll
            for (int vb = 0; vb < 2; ++vb)
#pragma unroll
                for (int r = 0; r < 16; ++r) {
                    const int k = kb * 32 + 8 * (r >> 2) + 4 * gq + (r & 3), v = vb * 32 + n;
                    carry[((size_t)item * 64 + k) * 64 + v] = acc[kb][vb][r];
                }
        dk[item * 64 + lane] = P;
    }
}
__device__ __forceinline__ void hg_carry(float* carry, const float* dk, int gtid, int ngt) {
    for (int e = gtid; e < 16 * 4096; e += ngt) {
        const int s = e >> 12, idx = e & 4095, k = idx >> 6;
        float run = 0.f;
        for (int j0 = 0; j0 < HG_SEG; j0 += 8) {
            float t[8], d[8];
#pragma unroll
            for (int u = 0; u < 8; ++u) { t[u] = carry[(size_t)(s * HG_SEG + j0 + u) * 4096 + idx]; d[u] = dk[(s * HG_SEG + j0 + u) * 64 + k]; }
#pragma unroll
            for (int u = 0; u < 8; ++u) { carry[(size_t)(s * HG_SEG + j0 + u) * 4096 + idx] = run; run = __builtin_fmaf(d[u], run, t[u]); }
        }
    }
}
__device__ __forceinline__ void hg_readout(const bf16_t* odir, const bf16_t* hgs, const float* gain, bf16_t* ohg, int gw, int ngw, int lane) {
    const f32x4 gv = *(const f32x4*)(gain + ((4 * lane) & 63));
    for (int row = gw; row < R; row += ngw) {
        const size_t off = (size_t)row * 256 + 4 * lane;
        const u32x2 a = *(const u32x2*)(odir + off), bq = *(const u32x2*)(odir + (size_t)R * 256 + off), hg = *(const u32x2*)(hgs + off);
        const float o0 = bflo(a.x) + bflo(bq.x), o1 = bfhi(a.x) + bfhi(bq.x), o2 = bflo(a.y) + bflo(bq.y), o3 = bfhi(a.y) + bfhi(bq.y);
        float ss = (o0 * o0 + o1 * o1) + (o2 * o2 + o3 * o3);
        ss += shx(ss, 1, lane); ss += shx(ss, 2, lane); ss += shx(ss, 4, lane); ss += shx(ss, 8, lane);
        const float rstd = 1.0f / sqrtf(ss * (1.f / 64.f) + EPS);
        u32x2 w;
        w.x = pk2(o0 * rstd * gv[0] * bflo(hg.x), o1 * rstd * gv[1] * bfhi(hg.x));
        w.y = pk2(o2 * rstd * gv[2] * bflo(hg.y), o3 * rstd * gv[3] * bfhi(hg.y));
        *(u32x2*)(ohg + off) = w;
    }
}

constexpr int AT_KSTR = 272, AT_VSTR = 144, AT_KBYTES = 64 * AT_KSTR, AT_VBYTES = 128 * AT_VSTR, AT_STAGE = AT_KBYTES + AT_VBYTES;
static_assert(2 * AT_STAGE <= LDS_BYTES && 65536 <= 2 * AT_STAGE, "attention LDS");
__device__ __forceinline__ void attn_unit(LAS unsigned char* lds, const bf16_t* qbuf, const bf16_t* kbuf, const bf16_t* vT, bf16_t* oda, const float* gain,
                                          int b, int h, int qrow0, int kt0, int kt1, float lam, float post, int tid, int wave, int lane) {
    const int c = wave & 1, g = wave >> 1, n = lane & 31, gq = lane >> 5;
    bf16x8 qf[4];
    { const bf16_t* qp = qbuf + (size_t)(qrow0 + 32 * g + n) * 512 + h * 128 + c * 64 + 8 * gq;
#pragma unroll
      for (int s = 0; s < 4; ++s) qf[s] = *(const bf16x8*)(qp + 16 * s); }
    f32x16 O[4];
#pragma unroll
    for (int e = 0; e < 4; ++e)
#pragma unroll
        for (int r = 0; r < 16; ++r) O[e][r] = 0.f;
    float l = 0.f;
    const int kkey0 = tid >> 4, kch = tid & 15, ve0 = tid >> 3, vc = tid & 7;
    const size_t kgoff = (size_t)kkey0 * 512 + h * 128 + kch * 8;
    const unsigned klds = kkey0 * AT_KSTR + kch * 16;
    const size_t vgoff = (size_t)(b * 512 + h * 128 + ve0) * KEYS + vc * 8;
    const unsigned vlds = ve0 * AT_VSTR + (vc >> 1) * 32 + (vc & 1) * 8;
    u32x4 kr0, kr1, vr0, vr1;
#define AT_KROW0(kt) (((kt) * 64 < SEQ) ? (size_t)b * SEQ + (kt) * 64 : (size_t)NLAT + b * CTXL + ((kt) * 64 - SEQ))
#define AT_LOADK(kt) do { const size_t krow0 = AT_KROW0(kt); kr0 = *(const u32x4*)(kbuf + krow0 * 512 + kgoff); kr1 = *(const u32x4*)(kbuf + (krow0 + 32) * 512 + kgoff); } while (0)
#define AT_LOADV(kt) do { vr0 = *(const u32x4*)(vT + vgoff + (kt) * 64); vr1 = *(const u32x4*)(vT + vgoff + (size_t)64 * KEYS + (kt) * 64); } while (0)
#define AT_STOREK(buf) do { LAS unsigned char* sb_ = lds + (buf) * AT_KBYTES; *(LAS u32x4*)(sb_ + klds) = kr0; *(LAS u32x4*)(sb_ + klds + 32 * AT_KSTR) = kr1; } while (0)
#define AT_STOREV(buf) do { LAS unsigned char* sb_ = lds + 2 * AT_KBYTES + (buf) * AT_VBYTES; \
        *(LAS u32x2*)(sb_ + vlds) = (u32x2){vr0.x, vr0.y}; *(LAS u32x2*)(sb_ + vlds + 16) = (u32x2){vr0.z, vr0.w}; \
        *(LAS u32x2*)(sb_ + vlds + 64 * AT_VSTR) = (u32x2){vr1.x, vr1.y}; *(LAS u32x2*)(sb_ + vlds + 64 * AT_VSTR + 16) = (u32x2){vr1.z, vr1.w}; } while (0)
#define AT_QK(Sa, Sb, buf) do { LAS unsigned char* kp = lds + (buf) * AT_KBYTES + n * AT_KSTR + (c * 8 + gq) * 16; \
        _Pragma("unroll") for (int s = 0; s < 4; ++s) { \
            const bf16x8 a0 = *(LAS bf16x8*)(kp + s * 32), a1 = *(LAS bf16x8*)(kp + 32 * AT_KSTR + s * 32); \
            Sa = __builtin_amdgcn_mfma_f32_32x32x16_bf16(a0, qf[s], Sa, 0, 0, 0); \
            Sb = __builtin_amdgcn_mfma_f32_32x32x16_bf16(a1, qf[s], Sb, 0, 0, 0); } } while (0)
#define AT_BAR() do { asm volatile("s_waitcnt lgkmcnt(0)" ::: "memory"); __builtin_amdgcn_s_barrier(); asm volatile("" ::: "memory"); } while (0)
    const int nt = kt1 - kt0;
    AT_LOADK(kt0); AT_LOADV(kt0); AT_STOREK(0); AT_STOREV(0);
    if (nt > 1) { AT_LOADK(kt0 + 1); AT_LOADV(kt0 + 1); }
    AT_BAR();
    f32x16 negm;
    {
        f32x16 S0, S1;
#pragma unroll
        for (int r = 0; r < 16; ++r) { S0[r] = 0.f; S1[r] = 0.f; }
        AT_QK(S0, S1, 0);
        float mx = fmaxf(S0[0], S1[0]);
#pragma unroll
        for (int r = 1; r < 16; ++r) mx = fmaxf(fmaxf(mx, S0[r]), S1[r]);
        { auto rr = __builtin_amdgcn_permlane32_swap(__builtin_bit_cast(unsigned, mx), __builtin_bit_cast(unsigned, mx), false, false);
          mx = fmaxf(__builtin_bit_cast(float, rr[0]), __builtin_bit_cast(float, rr[1])); }
#pragma unroll
        for (int r = 0; r < 16; ++r) negm[r] = -mx;
    }
    constexpr float THR = 8.f;
    for (int i = 0; i < nt; ++i) {
        const int cur = i & 1;
        bf16x8 kf[8];
        { LAS unsigned char* kp = lds + cur * AT_KBYTES + n * AT_KSTR + (c * 8 + gq) * 16;
#pragma unroll
          for (int s = 0; s < 4; ++s) { kf[2 * s] = *(LAS bf16x8*)(kp + s * 32); kf[2 * s + 1] = *(LAS bf16x8*)(kp + 32 * AT_KSTR + s * 32); } }
        LAS unsigned char* vp = lds + 2 * AT_KBYTES + cur * AT_VBYTES + n * AT_VSTR + gq * 16;
        bf16x8 va[8];
#pragma unroll
        for (int ks = 0; ks < 2; ++ks)
#pragma unroll
            for (int e = 0; e < 4; ++e) va[ks * 4 + e] = *(LAS bf16x8*)(vp + e * 32 * AT_VSTR + ks * 32);
        __builtin_amdgcn_sched_barrier(0);
        f32x16 S0 = negm, S1 = negm;
#pragma unroll
        for (int s = 0; s < 4; ++s) {
            S0 = __builtin_amdgcn_mfma_f32_32x32x16_bf16(kf[2 * s], qf[s], S0, 0, 0, 0);
            S1 = __builtin_amdgcn_mfma_f32_32x32x16_bf16(kf[2 * s + 1], qf[s], S1, 0, 0, 0);
        }
        __builtin_amdgcn_sched_barrier(0);
        bf16x8 vb[8];
#pragma unroll
        for (int ks = 0; ks < 2; ++ks)
#pragma unroll
            for (int e = 0; e < 4; ++e) vb[ks * 4 + e] = *(LAS bf16x8*)(vp + e * 32 * AT_VSTR + (ks + 2) * 32);
        if (i + 1 < nt) { AT_STOREK(cur ^ 1); AT_STOREV(cur ^ 1); }
        if (i + 2 < nt) { AT_LOADK(kt0 + i + 2); AT_LOADV(kt0 + i + 2); }
        __builtin_amdgcn_sched_barrier(0);
        float mx = fmaxf(S0[0], S1[0]);
#pragma unroll
        for (int r = 1; r < 16; ++r) mx = fmaxf(fmaxf(mx, S0[r]), S1[r]);
        { auto rr = __builtin_amdgcn_permlane32_swap(__builtin_bit_cast(unsigned, mx), __builtin_bit_cast(unsigned, mx), false, false);
          mx = fmaxf(__builtin_bit_cast(float, rr[0]), __builtin_bit_cast(float, rr[1])); }
        if (__builtin_amdgcn_ballot_w64(mx > THR) != 0ull) {
            const float delta = fmaxf(mx, 0.f), alpha = ex2(-delta);
            l *= alpha;
#pragma unroll
            for (int r = 0; r < 16; ++r) { S0[r] -= delta; S1[r] -= delta; negm[r] -= delta; }
#pragma unroll
            for (int e = 0; e < 4; ++e) O[e] = O[e] * alpha;
        }
        float ps = 0.f;
#pragma unroll
        for (int r = 0; r < 16; ++r) { S0[r] = ex2(S0[r]); S1[r] = ex2(S1[r]); ps += S0[r] + S1[r]; }
        l += ps;
        bf16x8 pb[4];
#pragma unroll
        for (int s = 0; s < 2; ++s) {
            u32x4 pw;
            pw.x = pk2(S0[8 * s + 0], S0[8 * s + 1]); pw.y = pk2(S0[8 * s + 2], S0[8 * s + 3]); pw.z = pk2(S0[8 * s + 4], S0[8 * s + 5]); pw.w = pk2(S0[8 * s + 6], S0[8 * s + 7]);
            pb[s] = __builtin_bit_cast(bf16x8, pw);
            pw.x = pk2(S1[8 * s + 0], S1[8 * s + 1]); pw.y = pk2(S1[8 * s + 2], S1[8 * s + 3]); pw.z = pk2(S1[8 * s + 4], S1[8 * s + 5]); pw.w = pk2(S1[8 * s + 6], S1[8 * s + 7]);
            pb[2 + s] = __builtin_bit_cast(bf16x8, pw);
        }
        __builtin_amdgcn_sched_barrier(0);
#pragma unroll
        for (int ks = 0; ks < 2; ++ks)
#pragma unroll
            for (int e = 0; e < 4; ++e) {
                O[e] = __builtin_amdgcn_mfma_f32_32x32x16_bf16(va[ks * 4 + e], pb[ks], O[e], 0, 0, 0);
            }
#pragma unroll
        for (int ks = 0; ks < 2; ++ks)
#pragma unroll
            for (int e = 0; e < 4; ++e) {
                O[e] = __builtin_amdgcn_mfma_f32_32x32x16_bf16(vb[ks * 4 + e], pb[2 + ks], O[e], 0, 0, 0);
            }
        AT_BAR();
    }
#undef AT_BAR
#undef AT_KROW0
#undef AT_LOADK
#undef AT_LOADV
#undef AT_STOREK
#undef AT_STOREV
#undef AT_QK
    l += shx(l, 32, lane);
    const float inv = 1.f / l;
    LAS float* xch = (LAS float*)lds;
    if (c == 1) {
#pragma unroll
        for (int e = 0; e < 4; ++e)
#pragma unroll
            for (int r = 0; r < 16; ++r) xch[(g * 64 + e * 16 + r) * 64 + lane] = O[e][r] * inv;
    }
    __syncthreads();
    if (c == 0) {
        float ss = 0.f;
#pragma unroll
        for (int e = 0; e < 4; ++e)
#pragma unroll
            for (int r = 0; r < 16; ++r) { const float o = O[e][r] * inv - lam * xch[(g * 64 + e * 16 + r) * 64 + lane]; O[e][r] = o; ss += o * o; }
        ss += shx(ss, 32, lane);
        const float rs = post / sqrtf(ss * (1.f / 128.f) + EPS);
        bf16_t* op = oda + (size_t)(qrow0 + 32 * g + n) * 512 + h * 128;
#pragma unroll
        for (int e = 0; e < 4; ++e)
#pragma unroll
            for (int r4 = 0; r4 < 4; ++r4) {
                const int e0 = e * 32 + 8 * r4 + 4 * gq;
                const f32x4 gv = *(const f32x4*)(gain + e0);
                u32x2 w; w.x = pk2(O[e][4 * r4 + 0] * rs * gv[0], O[e][4 * r4 + 1] * rs * gv[1]); w.y = pk2(O[e][4 * r4 + 2] * rs * gv[2], O[e][4 * r4 + 3] * rs * gv[3]);
                *(u32x2*)(op + e0) = w;
            }
    }
    __syncthreads();
}
#define XB_TMO      128
#define XB_XCNT(j)  (256  + 64 * (j))
#define XB_XSUB(j)  (1280 + 64 * (j))
#define XB_XGEN(j)  (2304 + 64 * (j))
#define XB_TOP      3328
#define XB_TOPGEN   3392
#define XCD_BAR_WORDS 3456
#define XB_SPIN_CAP (1u << 18)

__device__ __forceinline__ unsigned xb_ld(unsigned* p)              { return __hip_atomic_load(p, __ATOMIC_RELAXED, __HIP_MEMORY_SCOPE_AGENT); }
__device__ __forceinline__ unsigned xb_add(unsigned* p, unsigned v) { return __hip_atomic_fetch_add(p, v, __ATOMIC_RELAXED, __HIP_MEMORY_SCOPE_AGENT); }
__device__ __forceinline__ unsigned xb_xcc_id() { return (unsigned)__builtin_amdgcn_s_getreg((3 << 11) | 20) & 0xFu; }
#define XB_SPIN(cond, bar) do { unsigned _sp = 0; while (cond) { __builtin_amdgcn_s_sleep(1); \
    if ((++_sp & 255u) == 0u) { if (xb_ld(&(bar)[XB_TMO])) break; if (_sp > XB_SPIN_CAP) { atomicAdd(&(bar)[XB_TMO], 1u); break; } } } } while (0)

struct XcdBarrier {
    unsigned* bar; unsigned x;
    volatile LAS unsigned* st;
};

__device__ __forceinline__ XcdBarrier xcd_barrier_post(unsigned* bar, volatile LAS unsigned* st, int tid_in) {
    XcdBarrier b; b.bar = bar; b.x = xb_xcc_id(); b.st = st;
    if (tid_in == 0) (void)xb_add(&bar[XB_XCNT(b.x)], 1u);
    return b;
}
__device__ __forceinline__ void xcd_barrier_complete(unsigned* bar, unsigned x, unsigned& nloc, unsigned& nx) {
    const unsigned G = gridDim.x * gridDim.y * gridDim.z;
    unsigned sum, cnt, mine, sp = 0u;
    for (;;) {
        sum = 0u; cnt = 0u; mine = 0u;
#pragma unroll
        for (unsigned j = 0; j < 16; ++j) { const unsigned c = xb_ld(&bar[XB_XCNT(j)]); sum += c; cnt += (c > 0u) ? 1u : 0u; mine = (j == x) ? c : mine; }
        if (sum == G) break;
        __builtin_amdgcn_s_sleep(1);
        if ((++sp & 255u) == 0u) { if (xb_ld(&bar[XB_TMO])) break; if (sp > XB_SPIN_CAP) { atomicAdd(&bar[XB_TMO], 1u); break; } }
    }
    nloc = mine > 0u ? mine : 1u; nx = cnt > 0u ? cnt : 1u;
}

__device__ __forceinline__ void xcd_barrier(const XcdBarrier& b, int tid_in) {
    asm volatile("s_waitcnt vmcnt(0)" ::: "memory");
    __syncthreads();
    if (tid_in == 0) {
        unsigned* bar = b.bar;
        __builtin_amdgcn_s_waitcnt(0);
        unsigned nloc = b.st[0], nx = b.st[1];
        if (nloc == 0u) { xcd_barrier_complete(bar, b.x, nloc, nx); b.st[0] = nloc; b.st[1] = nx; }
        const unsigned old = xb_add(&bar[XB_XSUB(b.x)], 1u);
        const unsigned gen = old / nloc;
        if (old + 1u == (gen + 1u) * nloc) {
            __builtin_amdgcn_fence(__ATOMIC_RELEASE, "agent");
            asm volatile("s_waitcnt vmcnt(0)" ::: "memory");
            const unsigned og = xb_add(&bar[XB_TOP], 1u);
            const unsigned tg = og / nx;
            if (og + 1u == (tg + 1u) * nx) xb_add(&bar[XB_TOPGEN], 1u);
            else XB_SPIN(xb_ld(&bar[XB_TOPGEN]) == tg, bar);
            __builtin_amdgcn_fence(__ATOMIC_ACQUIRE, "agent");
            xb_add(&bar[XB_XGEN(b.x)], 1u);
            asm volatile("s_waitcnt vmcnt(0)" ::: "memory");
        } else {
            XB_SPIN(xb_ld(&bar[XB_XGEN(b.x)]) == gen, bar);
            __builtin_amdgcn_fence(__ATOMIC_ACQUIRE, "agent");
            asm volatile("s_waitcnt vmcnt(0)" ::: "memory");
        }
    }
    __syncthreads();
}


struct Args { const float* in[30]; float* out; unsigned char* ws; };
typedef const Args __attribute__((address_space(4))) Args_c;
__device__ __forceinline__ Args_c* kargs_ptr() { Args_c* p = (Args_c*)__builtin_amdgcn_kernarg_segment_ptr(); asm volatile("" : "+s"(p)); return p; }
#define GSYNC_CG() cg::this_grid().sync()
constexpr size_t WS_BAR = WS_END + 4096;
constexpr size_t WS_TOTAL = WS_BAR + (size_t)XCD_BAR_WORDS * 4;
static_assert(WS_TOTAL <= (size_t)512 * 1024 * 1024, "workspace");
constexpr int LDS_BARST = LDS_BYTES - 16;
#define GSYNC() do { XcdBarrier xb_; xb_.bar = (unsigned*)(kargs_ptr()->ws + WS_BAR); xb_.x = xb_xcc_id(); xb_.st = (volatile LAS unsigned*)(lds + LDS_BARST); xcd_barrier(xb_, TIDX()); } while (0)
#ifdef PROBE_A
#define TS(cat) do { if (blockIdx.x == 0 && TIDX() == 0) { unsigned long long* tsb = (unsigned long long*)(kargs_ptr()->ws + WS_END); const unsigned long long now = __builtin_amdgcn_s_memrealtime(); tsb[1 + (cat)] += now - tsb[0]; tsb[0] = now; } } while (0)
#else
#define TS(cat) do {} while (0)
#endif
__device__ __forceinline__ int tid_from(int wave_s) { int w_ = wave_s; unsigned z_ = 0u; asm volatile("" : "+s"(w_), "+s"(z_)); return w_ * 64 + (int)__builtin_amdgcn_mbcnt_hi(~0u, __builtin_amdgcn_mbcnt_lo(~0u, z_)); }
#define TIDX() tid_from(wave_s)
#define KA() int tid = TIDX(); asm volatile("" : "+v"(tid)); int G = gridDim.x, bid = blockIdx.x; asm volatile("" : "+s"(G), "+s"(bid)); \
    const int lane = tid & 63, wave = __builtin_amdgcn_readfirstlane(tid >> 6), gw = bid * 8 + wave, ngw = G * 8, gtid = bid * NTHR + tid, ngt = G * NTHR; \
    (void)lane; (void)wave; (void)gw; (void)ngw; (void)gtid; (void)ngt; \
    Args_c* ka = kargs_ptr(); unsigned char* ws = ka->ws; (void)ws

__global__ void __launch_bounds__(NTHR, 2) fwd_kernel(Args a_unused) {
    extern __shared__ __attribute__((aligned(16))) unsigned char lds_raw[];
    LAS unsigned char* lds = (LAS unsigned char*)lds_raw;
    const int wave_s = __builtin_amdgcn_readfirstlane((int)threadIdx.x >> 6);
    if (TIDX() < 4) ((volatile LAS unsigned*)(lds + LDS_BARST))[TIDX()] = 0u;
    __syncthreads();
    (void)xcd_barrier_post((unsigned*)(kargs_ptr()->ws + WS_BAR), (volatile LAS unsigned*)(lds + LDS_BARST), TIDX());
#ifdef PROBE_A
    if (blockIdx.x == 0 && TIDX() == 0) { unsigned long long* tsb = (unsigned long long*)(kargs_ptr()->ws + WS_END); for (int i = 1; i < 32; ++i) tsb[i] = 0; tsb[0] = __builtin_amdgcn_s_memrealtime(); }
#endif

#ifdef REP_INIT
#pragma unroll 1
    for (int rep_ = 0; rep_ < 2; ++rep_) {
#else
    {
#endif
    {
        KA();
        bf16_t* WB = (bf16_t*)(ws + WS_WB);
        LAS float* scr = (LAS float*)(lds + wave * 8448);
        constexpr int IT_L = 12416;
        for (int it = gw; it < 2 * IT_L; it += ngw) {
            const int l = it / IT_L; int r = it % IT_L;
            bf16_t* Wl = WB + (size_t)l * WL_TOTAL;
            if (r < 1408) { transpose_item(ka->in[9] + (size_t)l * 1024 * DFF, 1024, DFF, Wl + WL_UP1, 1, scr, r, lane); continue; } r -= 1408;
            if (r < 1408) { transpose_item(ka->in[10] + (size_t)l * 1024 * DFF, 1024, DFF, Wl + WL_UP1, 2, scr, r, lane); continue; } r -= 1408;
            if (r < 1408) { transpose_item(ka->in[11] + (size_t)l * DFF * 1024, DFF, 1024, Wl + WL_DN1, 0, scr, r, lane); continue; } r -= 1408;
            if (r < 1408) { transpose_item(ka->in[12] + (size_t)l * 1024 * DFF, 1024, DFF, Wl + WL_UP2, 1, scr, r, lane); continue; } r -= 1408;
            if (r < 1408) { transpose_item(ka->in[13] + (size_t)l * 1024 * DFF, 1024, DFF, Wl + WL_UP2, 2, scr, r, lane); continue; } r -= 1408;
            if (r < 1408) { transpose_item(ka->in[14] + (size_t)l * DFF * 1024, DFF, 1024, Wl + WL_DN2, 0, scr, r, lane); continue; } r -= 1408;
            if (r < 3072) { transpose_item(ka->in[15] + (size_t)l * 1024 * 6144, 1024, 6144, Wl + WL_IN, 3, scr, r, lane); continue; } r -= 3072;
            if (r < 256) { transpose_item(ka->in[25] + (size_t)l * 512 * 1024, 512, 1024, Wl + WL_PA, 0, scr, r, lane); continue; } r -= 256;
            if (r < 128) { transpose_item(ka->in[26] + (size_t)l * 256 * 1024, 256, 1024, Wl + WL_PH, 0, scr, r, lane); continue; } r -= 128;
            transpose_item(ka->in[28] + (size_t)l * 1024 * 1024, 1024, 1024, Wl + WL_O, 0, scr, r, lane);
        }
        __syncthreads();
    }
    {
        KA();
        float* MOD = (float*)(ws + WS_MOD);
        LAS float* sv = (LAS float*)lds;
        LAS float* part = (LAS float*)(lds + 12288);
        for (int i = tid; i < 3072; i += NTHR) { const int seg = i >> 10, k = i & 1023; const float x = (seg < 2) ? ka->in[1][seg * 1024 + k] : ka->in[3][k]; sv[i] = x / (1.f + __expf(-x)); }
        __syncthreads();
        for (int item = bid; item < 288; item += G) {
            const int l = item / 144, col = (item % 144) * 64 + lane;
            const float* W = ka->in[4] + (size_t)l * 1024 * 9216 + col;
            float a0 = 0.f, a1 = 0.f, a2 = 0.f;
            for (int k = wave * 128; k < wave * 128 + 128; ++k) { const float w = W[(size_t)k * 9216]; a0 = __builtin_fmaf(sv[k], w, a0); a1 = __builtin_fmaf(sv[1024 + k], w, a1); a2 = __builtin_fmaf(sv[2048 + k], w, a2); }
            part[(wave * 3 + 0) * 64 + lane] = a0; part[(wave * 3 + 1) * 64 + lane] = a1; part[(wave * 3 + 2) * 64 + lane] = a2;
            __syncthreads();
            if (tid < 192) { const int seg = tid >> 6, cl = tid & 63; float s = 0.f;
#pragma unroll
                for (int w = 0; w < 8; ++w) s += part[(w * 3 + seg) * 64 + cl];
                const int cc = (item % 144) * 64 + cl;
                MOD[(size_t)(l * 3 + seg) * 9216 + cc] = s + ka->in[5][l * 9216 + cc]; }
            __syncthreads();
        }
    }
    {
        KA();
        bf16_t* WB = (bf16_t*)(ws + WS_WB); float* CS = (float*)(ws + WS_CS); float* LBT = (float*)(ws + WS_LB); float* LAMV = (float*)(ws + WS_LAM);
        for (int idx = gtid; idx < 2 * 256 * 1024; idx += ngt) {
            const int n = idx & 1023, k = (idx >> 10) & 255, l = idx >> 18, g = k >> 6, c = k & 63;
            const float* pw = ka->in[23] + (size_t)l * 4 * 64 * 64 + (g * 64 + c) * 64;
            const float* psc = ka->in[24] + l * 256 + g * 64;
            const float* wp = ka->in[27] + (size_t)l * 256 * 1024 + (size_t)(g * 64) * 1024 + n;
            float s = 0.f;
            for (int d = 0; d < 64; ++d) s = __builtin_fmaf(pw[d] * psc[d], wp[(size_t)d * 1024], s);
            (WB + (size_t)l * WL_TOTAL + WL_PP)[(size_t)n * 256 + k] = (bf16_t)(pk2(s, 0.f) & 0xffffu);
        }
        for (int idx = gtid; idx < 4096; idx += ngt) {
            const int n = idx >> 4, j = idx & 15;
            const float invf = __builtin_exp2f(-(float)j * (13.287712379549449f / 16.f));
            const float ang = (float)n * invf;
            const double rev = (double)ang * 0.15915494309189535; const float fr = (float)(rev - __builtin_floor(rev));
            CS[n * 32 + j] = __builtin_amdgcn_cosf(fr); CS[n * 32 + 16 + j] = __builtin_amdgcn_sinf(fr);
        }
        for (int idx = gtid; idx < 1024; idx += ngt) {
            const int l = idx >> 9, dc = idx & 511;
            const float l0 = ka->in[21][dc], l1 = ka->in[21][512 + dc];
            LBT[idx] = (l == 0) ? 0.f : 1.f / (1.f + __expf(l0 - l1));
        }
        for (int idx = gtid; idx < NCTX * DM / 4; idx += ngt) ((f32x4*)(ws + WS_HC))[idx] = ((const f32x4*)ka->in[2])[idx];
        if (gtid < 2) {
            const int l = gtid; float s1 = 0.f, s2 = 0.f;
            for (int i = 0; i < 64; ++i) { s1 += ka->in[16][l * 64 + i] * ka->in[17][l * 64 + i]; s2 += ka->in[18][l * 64 + i] * ka->in[19][l * 64 + i]; }
            const float li = (l == 0) ? 0.2f : (0.8f - 0.6f * 0.7408182206817179f);
            LAMV[l * 2 + 0] = __expf(s1) - __expf(s2) + li; LAMV[l * 2 + 1] = 1.f - li;
        }
    }
    }
    GSYNC_CG();
    TS(0);

#pragma unroll 1
    for (int l = 0; l < 2; ++l) {
#ifdef REP_SYNC
#pragma unroll 1
        for (int rs_ = 0; rs_ < 10; ++rs_) { GSYNC(); }
#endif
#pragma unroll 1
        for (int f = 0; f < 2; ++f) {
            {   KA(); const bool first = (l == 0 && f == 0);
                const float* in_lat = first ? ka->in[0] : ka->out; const float* in_ctx = (const float*)(ws + WS_HC);
                norm_phase(in_lat, in_ctx, ka->in[f ? 8 : 6] + l * 1024, (const float*)(ws + WS_MOD) + (size_t)l * 3 * 9216, f ? 6 : 0, f ? 7 : 1, (bf16_t*)(ws + WS_XB), gw, ngw, lane,
                           (const float*)(ws + WS_O), first ? 0 : (f ? 4 : DFF / 256), (float*)(ws + WS_HC)); }
            GSYNC();
            TS(1);
            {   KA(); bf16_t* Wl = (bf16_t*)(ws + WS_WB) + (size_t)l * WL_TOTAL;
                pg8::Gemm g{(bf16_t*)(ws + WS_XB), Wl + (f ? WL_UP2 : WL_UP1), R, 5632, 1024}; pg8::StaticOrder S; S.init(R, 5632, G, bid); EpiUp E{(bf16_t*)(ws + WS_Z)};
                pg8::gemm_phase<EpiUp, pg8::StaticOrder, true, true>(lds, g, S, E, tid); }
            GSYNC();
            TS(2);
            {   KA(); bf16_t* Wl = (bf16_t*)(ws + WS_WB) + (size_t)l * WL_TOTAL; const bool first = (l == 0 && f == 0);
                const float* in_lat = first ? ka->in[0] : ka->out;
                pg8::Gemm g{(bf16_t*)(ws + WS_Z), Wl + (f ? WL_DN2 : WL_DN1), NLAT, 1024, DFF}; pg8::StaticOrder S; S.init(NLAT, 1024, G, bid);
                EpiRes E{in_lat, (const float*)(ws + WS_HC), ka->out, (float*)(ws + WS_HC), (const float*)(ws + WS_MOD) + (size_t)l * 3 * 9216 + (f ? 8 : 2) * 1024, 0.5f};
                pg8::gemm_phase<EpiRes, pg8::StaticOrder, true, true>(lds, g, S, E, tid); }
            {   KA(); bf16_t* Wl = (bf16_t*)(ws + WS_WB) + (size_t)l * WL_TOTAL;
                pg8::Gemm g{(bf16_t*)(ws + WS_Z) + (size_t)NLAT * DFF, Wl + (f ? WL_DN2 : WL_DN1), NCTX, 1024, 256, DFF}; SplitKOrder S; S.init(DFF / 256, 256, G, bid);
                EpiPart E{(float*)(ws + WS_O), (const float*)(ws + WS_MOD) + (size_t)l * 3 * 9216 + (f ? 8 : 2) * 1024, 0.5f};
                pg8::gemm_phase<EpiPart, SplitKOrder, true, true>(lds, g, S, E, tid); }
            GSYNC();
            TS(3);
            if (f == 1) break;
            {   KA();
                norm_phase(ka->out, (const float*)(ws + WS_HC), ka->in[7] + l * 1024, (const float*)(ws + WS_MOD) + (size_t)l * 3 * 9216, 3, 4, (bf16_t*)(ws + WS_XB), gw, ngw, lane,
                           (const float*)(ws + WS_O), DFF / 256, (float*)(ws + WS_HC)); }
            GSYNC();
            TS(1);
            {   KA(); bf16_t* Wl = (bf16_t*)(ws + WS_WB) + (size_t)l * WL_TOTAL;
                pg8::Gemm g{(bf16_t*)(ws + WS_XB), Wl + WL_IN, R, 3072, 1024}; pg8::StaticOrder S; S.init(R, 3072, G, bid);
                EpiWin E{ws + WS_Z, (const float*)(ws + WS_CS), (const float*)(ws + WS_LB) + l * 512, 0};
                pg8::gemm_phase<EpiWin, pg8::StaticOrder, true, true>(lds, g, S, E, tid); }
            GSYNC();
            TS(4);
            {   KA(); pool_phase((const bf16_t*)(ws + WS_Z + Z_ZP), (bf16_t*)(ws + WS_O + O_MX), gtid, ngt); }
#ifdef REP_ATTN
            for (int rep_ = 0; rep_ < 2; ++rep_)
#endif
            {   KA();
                const float* LAMV = (const float*)(ws + WS_LAM);
                const int nunits = 1024 + (l == 0 ? 16 : 0);
                for (int u = bid; u < nunits; u += G) {
                    int bh, qrow0, kt0, kt1;
                    if (u < 1024) { bh = u >> 7; qrow0 = (bh >> 2) * SEQ + (u & 127) * 128; kt0 = 0; kt1 = KEYS / 64; }
                    else { const int v = u - 1024; bh = v >> 1; qrow0 = NLAT + (bh >> 2) * CTXL + (v & 1) * 128; kt0 = SEQ / 64; kt1 = KEYS / 64; }
                    attn_unit(lds, (const bf16_t*)(ws + WS_Z + Z_Q), (const bf16_t*)(ws + WS_Z + Z_K), (const bf16_t*)(ws + WS_Z + Z_VT), (bf16_t*)(ws + WS_O + O_DA), ka->in[20] + l * 128,
                              bh >> 2, bh & 3, qrow0, kt0, kt1, LAMV[l * 2], LAMV[l * 2 + 1], tid, wave, lane);
                }
            }
            GSYNC();
            TS(5);
#ifdef REP_HG
#pragma unroll 1
            for (int rep_ = 0; rep_ < 2; ++rep_) {
#else
            {
#endif
            {   KA(); hg_passA_mfma(lds, (const float*)(ws + WS_Z + Z_FF), (const float*)(ws + WS_Z + Z_FB), (const bf16_t*)(ws + WS_Z + Z_HI),
                                      (float*)(ws + WS_CAR), (float*)(ws + WS_DK), wave, lane, G); }
            GSYNC();
            TS(6);
            {   KA(); hg_carry((float*)(ws + WS_CAR), (const float*)(ws + WS_DK), gtid, ngt); }
            GSYNC();
            TS(7);
            {   KA(); hg_pass<true>((const float*)(ws + WS_Z + Z_HQ), (const float*)(ws + WS_Z + Z_FF), (const float*)(ws + WS_Z + Z_FB), (const bf16_t*)(ws + WS_Z + Z_HI),
                                    (float*)(ws + WS_CAR), (float*)(ws + WS_DK), (bf16_t*)(ws + WS_Z + Z_K), wave, lane, G); }
            GSYNC();
            TS(8);
            {   KA(); hg_readout((const bf16_t*)(ws + WS_Z + Z_K), (const bf16_t*)(ws + WS_Z + Z_HG), ka->in[22] + l * 64, (bf16_t*)(ws + WS_O + O_HG), gw, ngw, lane); }
            GSYNC();
            TS(9);
            }
            {   KA(); bf16_t* Wl = (bf16_t*)(ws + WS_WB) + (size_t)l * WL_TOTAL;
                pg8::Gemm g{(bf16_t*)(ws + WS_XB), Wl + WL_IN + (size_t)3072 * 1024, R, 3072, 1024}; pg8::StaticOrder S; S.init(R, 3072, G, bid); EpiG E{(bf16_t*)(ws + WS_Z)};
                pg8::gemm_phase<EpiG, pg8::StaticOrder, true, true>(lds, g, S, E, tid); }
            GSYNC();
            TS(10);
#pragma unroll 1
            for (int gi = 0; gi < 3; ++gi) {
                KA(); bf16_t* Wl = (bf16_t*)(ws + WS_WB) + (size_t)l * WL_TOTAL;
                const bf16_t* A = (const bf16_t*)(ws + WS_O + ((gi == 0) ? O_DA : (gi == 1 ? O_HG : O_MX))); const int K = (gi == 0) ? 512 : 256;
                const bf16_t* Bt = Wl + ((gi == 0) ? WL_PA : (gi == 1 ? WL_PH : WL_PP));
                pg8::Gemm g{A, Bt, R, 1024, K}; pg8::StaticOrder S; S.init(R, 1024, G, bid); EpiProj E{(bf16_t*)(ws + WS_XB), (const bf16_t*)(ws + WS_Z), gi, gi == 0};
                pg8::gemm_phase<EpiProj, pg8::StaticOrder, true, true>(lds, g, S, E, tid);
            }
            GSYNC();
            TS(11);
            {   KA(); bf16_t* Wl = (bf16_t*)(ws + WS_WB) + (size_t)l * WL_TOTAL;
                pg8::Gemm g{(bf16_t*)(ws + WS_XB), Wl + WL_O, NLAT, 1024, 1024}; pg8::StaticOrder S; S.init(NLAT, 1024, G, bid);
                EpiRes E{ka->out, (const float*)(ws + WS_HC), ka->out, (float*)(ws + WS_HC), (const float*)(ws + WS_MOD) + (size_t)l * 3 * 9216 + 5 * 1024, 1.0f};
                pg8::gemm_phase<EpiRes, pg8::StaticOrder, true, true>(lds, g, S, E, tid); }
            {   KA(); bf16_t* Wl = (bf16_t*)(ws + WS_WB) + (size_t)l * WL_TOTAL;
                pg8::Gemm g{(bf16_t*)(ws + WS_XB) + (size_t)NLAT * 1024, Wl + WL_O, NCTX, 1024, 256, 1024}; SplitKOrder S; S.init(4, 256, G, bid);
                EpiPart E{(float*)(ws + WS_O), (const float*)(ws + WS_MOD) + (size_t)l * 3 * 9216 + 5 * 1024, 1.0f};
                pg8::gemm_phase<EpiPart, SplitKOrder, true, true>(lds, g, S, E, tid); }
            GSYNC();
            TS(12);
        }
    }
    {   KA(); final_norm_phase(ka->out, ka->in[29], gw, ngw, lane); }
#ifdef PROBE_A
    GSYNC(); TS(1);
    if (blockIdx.x == 0) { KA(); const unsigned long long* tsb = (const unsigned long long*)(ws + WS_END);
        __syncthreads();
        const float va = (float)tsb[1 + PROBE_A] * 0.01f, vb = (float)tsb[1 + PROBE_B] * 0.01f;
        __syncthreads();
        if (tid == 0) ka->out[0] += va;
        for (int i = tid; i < 65536; i += NTHR) ka->out[(size_t)(i / 1024 + 8) * 1024 + (i & 1023)] += vb; }
#endif
}

extern "C" void kernel_launch(void* const* d_in, const int* in_sizes, int n_in, void* d_out, int out_size, void* d_ws, size_t ws_size, hipStream_t stream) {
    static int grid = 0;
    if (grid == 0) {
        if (n_in != 30 || out_size != NLAT * DM || ws_size < WS_TOTAL) { fprintf(stderr, "kernel_launch: unexpected shapes (n_in %d out %d ws %zu need %zu)\n", n_in, out_size, ws_size, (size_t)WS_TOTAL); grid = -1; return; }
        int dev = 0, cus = 0, per_cu = 0;
        (void)hipGetDevice(&dev);
        (void)hipDeviceGetAttribute(&cus, hipDeviceAttributeMultiprocessorCount, dev);
        if (hipFuncSetAttribute((const void*)fwd_kernel, hipFuncAttributeMaxDynamicSharedMemorySize, LDS_BYTES) != hipSuccess) { fprintf(stderr, "kernel_launch: hipFuncSetAttribute failed\n"); grid = -1; return; }
        if (hipOccupancyMaxActiveBlocksPerMultiprocessor(&per_cu, (const void*)fwd_kernel, NTHR, LDS_BYTES) != hipSuccess || per_cu < 1) { fprintf(stderr, "kernel_launch: occupancy query failed (%d)\n", per_cu); (void)hipGetLastError(); per_cu = 1; }
        if (per_cu > 1) per_cu = 1;
        grid = cus * per_cu;
    }
    if (grid < 0) return;
    if (hipMemsetAsync((unsigned char*)d_ws + WS_BAR, 0, (size_t)XCD_BAR_WORDS * 4, stream) != hipSuccess) { fprintf(stderr, "kernel_launch: memset failed\n"); return; }
    Args a{};
    for (int i = 0; i < 30; ++i) a.in[i] = (const float*)d_in[i];
    a.out = (float*)d_out; a.ws = (unsigned char*)d_ws;
    void* args[] = {&a};
    hipError_t e = hipLaunchCooperativeKernel((const void*)fwd_kernel, dim3(grid), dim3(NTHR), args, LDS_BYTES, stream);
    if (e != hipSuccess) fprintf(stderr, "cooperative launch failed: %s (grid %d)\n", hipGetErrorString(e), grid);
}
```

```cpp
#include <hip/hip_runtime.h>
#include <hip/hip_cooperative_groups.h>
#include <cstdio>
#include <cstdint>
namespace cg = cooperative_groups;
namespace pg8 {
#define PG8_LAS __attribute__((address_space(3)))
typedef unsigned short bf16_t;
typedef short bf16x8 __attribute__((ext_vector_type(8)));
typedef float f32x4 __attribute__((ext_vector_type(4)));
typedef unsigned u32x4 __attribute__((ext_vector_type(4)));
constexpr int BM = 256, BK = 64, HALF = 128, HTB = HALF * BK * 2  , STAGE_BYTES = 8 * HTB, NXCD = 8, WGM = 8;

__host__ __device__ __forceinline__ int lds_byte(int r, int c) { const int st = (r >> 4) * 2 + (c >> 5), rr = r & 15, cc = c & 31, ob = rr * 64 + cc * 2; return st * 1024 + (ob ^ (((ob >> 9) & 1) << 5)); }
__host__ __device__ __forceinline__ void stage_rc(int b, int& R, int& C) { const int st = b / 1024, sb = b % 1024, swz = sb ^ (((sb >> 9) & 1) << 5); R = (st >> 1) * 16 + swz / 64; C = (st & 1) * 32 + (swz % 64) / 2; }
__host__ __device__ __forceinline__ int perm32(int rho) { const int n = rho >> 4, i = rho & 15; return 8 * (i >> 2) + 4 * n + (i & 3); }

struct Unit { int pm, pn; int koff = 0; };
struct Gemm { const bf16_t* A; const bf16_t* Bt; int M, N, K; int ld = 0; };

struct StaticOrder {
    int nM, nN, nwg, G, c;
    __host__ __device__ void init(int M, int N, int G_, int c_) { nM = M / BM; nN = N / BM; nwg = nM * nN; G = G_; c = c_; }
    __host__ __device__ bool next(int i, Unit& u) const {
        const long L = (long)i * G + c; if (L >= nwg) return false;
        int wgid = (int)L; { const int q = nwg / NXCD, r = nwg % NXCD, xcd = wgid % NXCD, off = wgid / NXCD; wgid = (xcd < r ? xcd * (q + 1) : r * (q + 1) + (xcd - r) * q) + off; }
        const int nig = WGM * nN, gid = wgid / nig, fm = gid * WGM, gsz = (nM - fm) < WGM ? (nM - fm) : WGM;
        u.pm = fm + ((wgid % nig) % gsz); u.pn = (wgid % nig) / gsz; u.koff = 0; return true;
    }
    __device__ __forceinline__ void a_ready(const Unit&) const {}
    __device__ __forceinline__ void done(const Unit&) const {}
};

}
namespace pg8 {
template <class Epi, class Sched, bool ALIGN_EPI = false, bool SP2 = false>
__device__ __forceinline__ void gemm_phase(PG8_LAS unsigned char* lds, const Gemm g, const Sched& S, const Epi& E, int tid_in) {
    int tid_ = tid_in; asm volatile("" : "+v"(tid_)); const int tid = tid_, wid = __builtin_amdgcn_readfirstlane(tid >> 6), lane = tid & 63, wr = wid >> 2, wc = wid & 3, fr = lane & 15, fq = lane >> 4;
    const int K = g.ld ? g.ld : g.K, nt = g.K / BK;
    unsigned voffA[2], voffB[2];
#pragma unroll
    for (int i = 0; i < 2; ++i) { int R, C; stage_rc(tid * 16 + i * 8192, R, C); const int Rb = Epi::PERM ? ((R & ~31) + perm32(R & 31)) : R;
        voffA[i] = (unsigned)(R * K + C) * 2u; voffB[i] = (unsigned)(Rb * K + C) * 2u; }
    const size_t kstep = (size_t)(BK * 2);
    const size_t hstep = (size_t)HALF * K * 2;
    const size_t tstep = 2 * hstep;
    const unsigned ldsw = (unsigned)wid * 1024u;
    const int aoff = lds_byte(wr * 64 + fr, fq * 8), boff = lds_byte(wc * 32 + fr, fq * 8);
#define PG8_SA(b, h) (((b) * 2 + (h)) * HTB)
#define PG8_SB(b, h) ((4 + (b) * 2 + (h)) * HTB)
#define PG8_STAGE(bufoff, gbase, voff) do { _Pragma("unroll") for (int _i = 0; _i < 2; ++_i) \
        __builtin_amdgcn_global_load_lds((const unsigned*)((const char*)(gbase) + (voff)[_i]), (PG8_LAS unsigned*)(lds + (bufoff) + ldsw + _i * 8192), 16, 0, 0); } while (0)
#define PG8_LDA(dst, b, h) do { _Pragma("unroll") for (int m = 0; m < 4; ++m) _Pragma("unroll") for (int k = 0; k < 2; ++k) dst[m][k] = *(const PG8_LAS bf16x8*)(lds + PG8_SA(b, h) + aoff + m * 2048 + k * 1024); } while (0)
#define PG8_LDB(dst, b, h) do { _Pragma("unroll") for (int n = 0; n < 2; ++n) _Pragma("unroll") for (int k = 0; k < 2; ++k) dst[n][k] = *(const PG8_LAS bf16x8*)(lds + PG8_SB(b, h) + boff + n * 2048 + k * 1024); } while (0)
#define PG8_MMA(ai, bj, At, Bt) do { __builtin_amdgcn_s_setprio(1); _Pragma("unroll") for (int m = 0; m < 4; ++m) _Pragma("unroll") for (int n = 0; n < 2; ++n) _Pragma("unroll") for (int k = 0; k < 2; ++k) \
        acc[ai][bj][m][n] = __builtin_amdgcn_mfma_f32_16x16x32_bf16(Bt[n][k], At[m][k], acc[ai][bj][m][n], 0, 0, 0); __builtin_amdgcn_s_setprio(0); } while (0)
#define PG8_WAIT_V(n) asm volatile("s_waitcnt vmcnt(" #n ")" ::: "memory")
#define PG8_WAIT_L(n) asm volatile("s_waitcnt lgkmcnt(" #n ")" ::: "memory")
#define PG8_BAR __builtin_amdgcn_s_barrier()
#define PG8_SCHED __builtin_amdgcn_sched_barrier(0)
    Unit cur, nxt; int ui = 0;
    if (!S.next(0, cur)) return;
    f32x4 acc[2][2][4][2];
#pragma unroll
    for (int a = 0; a < 2; ++a)
#pragma unroll
        for (int b = 0; b < 2; ++b)
#pragma unroll
            for (int m = 0; m < 4; ++m)
#pragma unroll
                for (int n = 0; n < 2; ++n) acc[a][b][m][n] = (f32x4){0.f, 0.f, 0.f, 0.f};
    bf16x8 At[4][2], B0[2][2], B1[2][2];
    const char* cA = (const char*)g.A + (size_t)cur.pm * tstep + (size_t)cur.koff * 2; const char* cB = (const char*)g.Bt + (size_t)cur.pn * tstep + (size_t)cur.koff * 2;
    S.a_ready(cur);
    if constexpr (SP2) {
        PG8_STAGE(PG8_SB(0, 0), cB, voffB); PG8_STAGE(PG8_SB(0, 1), cB + hstep, voffB); PG8_STAGE(PG8_SA(0, 0), cA, voffA); PG8_STAGE(PG8_SA(0, 1), cA + hstep, voffA);
        if (wr == 1) PG8_BAR;
        PG8_WAIT_V(2); PG8_BAR;
        PG8_STAGE(PG8_SB(1, 0), cB + kstep, voffB); PG8_STAGE(PG8_SA(1, 0), cA + kstep, voffA); PG8_STAGE(PG8_SB(1, 1), cB + hstep + kstep, voffB);
        PG8_WAIT_V(6); PG8_BAR;
    } else {
        PG8_STAGE(PG8_SB(0, 0), cB, voffB); PG8_STAGE(PG8_SA(0, 0), cA, voffA); PG8_STAGE(PG8_SB(0, 1), cB + hstep, voffB); PG8_STAGE(PG8_SA(0, 1), cA + hstep, voffA);
        if (wr == 1) PG8_BAR;
        PG8_WAIT_V(4); PG8_BAR;
        PG8_STAGE(PG8_SB(1, 0), cB + kstep, voffB); PG8_STAGE(PG8_SA(1, 0), cA + kstep, voffA); PG8_STAGE(PG8_SB(1, 1), cB + hstep + kstep, voffB);
        PG8_WAIT_V(6); PG8_BAR;
    }
    for (;;) {
        const bool has_next = S.next(ui + 1, nxt);
        const char* nA = has_next ? (const char*)g.A + (size_t)nxt.pm * tstep + (size_t)nxt.koff * 2 : cA; const char* nB = has_next ? (const char*)g.Bt + (size_t)nxt.pn * tstep + (size_t)nxt.koff * 2 : cB;
        for (int t = 0; t < nt; t += 2) {
            const bool last = (t == nt - 2);
            const char* a1 = cA + (size_t)(t + 1) * kstep;
            const char* a2 = last ? nA : cA + (size_t)(t + 2) * kstep; const char* b2 = last ? nB : cB + (size_t)(t + 2) * kstep;
            const char* a3 = a2 + kstep; const char* b3 = b2 + kstep;
            if (last && has_next) S.a_ready(nxt);
            if constexpr (SP2) {
            PG8_LDB(B0, 0, 0); PG8_LDB(B1, 0, 1); PG8_SCHED; PG8_LDA(At, 0, 0); PG8_STAGE(PG8_SA(1, 1), a1 + hstep, voffA);
            PG8_WAIT_V(8); PG8_WAIT_L(0); PG8_BAR; PG8_MMA(0, 0, At, B0); PG8_MMA(0, 1, At, B1); PG8_BAR; PG8_SCHED;
            PG8_LDA(At, 0, 1); PG8_STAGE(PG8_SB(0, 0), b2, voffB); PG8_STAGE(PG8_SB(0, 1), b2 + hstep, voffB); PG8_STAGE(PG8_SA(0, 0), a2, voffA);
            PG8_WAIT_V(8); PG8_WAIT_L(0); PG8_BAR; PG8_MMA(1, 0, At, B0); PG8_MMA(1, 1, At, B1); PG8_BAR; PG8_SCHED;
            PG8_LDB(B0, 1, 0); PG8_LDB(B1, 1, 1); PG8_SCHED; PG8_LDA(At, 1, 0); PG8_STAGE(PG8_SA(0, 1), a2 + hstep, voffA);
            PG8_WAIT_V(8); PG8_WAIT_L(0); PG8_BAR; PG8_MMA(0, 0, At, B0); PG8_MMA(0, 1, At, B1); PG8_BAR; PG8_SCHED;
            PG8_LDA(At, 1, 1); PG8_STAGE(PG8_SB(1, 0), b3, voffB); PG8_STAGE(PG8_SB(1, 1), b3 + hstep, voffB); PG8_STAGE(PG8_SA(1, 0), a3, voffA);
            PG8_WAIT_V(8); PG8_WAIT_L(0); PG8_BAR; PG8_MMA(1, 0, At, B0); PG8_MMA(1, 1, At, B1); PG8_BAR; PG8_SCHED;
            } else {
            PG8_LDB(B0, 0, 0); PG8_SCHED; PG8_LDA(At, 0, 0); PG8_STAGE(PG8_SA(1, 1), a1 + hstep, voffA);
            PG8_WAIT_L(8); PG8_BAR; PG8_WAIT_L(0); PG8_MMA(0, 0, At, B0); PG8_BAR; PG8_SCHED;
            PG8_LDB(B1, 0, 1); PG8_STAGE(PG8_SB(0, 0), b2, voffB);
            PG8_BAR; PG8_WAIT_L(0); PG8_MMA(0, 1, At, B1); PG8_BAR;
            PG8_LDA(At, 0, 1); PG8_STAGE(PG8_SA(0, 0), a2, voffA);
            PG8_BAR; PG8_WAIT_L(0); PG8_MMA(1, 0, At, B0); PG8_BAR; PG8_SCHED;
            PG8_STAGE(PG8_SB(0, 1), b2 + hstep, voffB);
            PG8_WAIT_V(6); PG8_BAR; PG8_MMA(1, 1, At, B1); PG8_BAR;
            PG8_LDB(B0, 1, 0); PG8_SCHED; PG8_LDA(At, 1, 0); PG8_STAGE(PG8_SA(0, 1), a2 + hstep, voffA);
            PG8_WAIT_L(8); PG8_BAR; PG8_WAIT_L(0); PG8_MMA(0, 0, At, B0); PG8_BAR; PG8_SCHED;
            PG8_LDB(B1, 1, 1); PG8_STAGE(PG8_SB(1, 0), b3, voffB);
            PG8_BAR; PG8_WAIT_L(0); PG8_MMA(0, 1, At, B1); PG8_BAR;
            PG8_LDA(At, 1, 1); PG8_STAGE(PG8_SA(1, 0), a3, voffA);
            PG8_BAR; PG8_WAIT_L(0); PG8_MMA(1, 0, At, B0); PG8_BAR; PG8_SCHED;
            PG8_STAGE(PG8_SB(1, 1), b3 + hstep, voffB);
            PG8_WAIT_V(6); PG8_BAR; PG8_MMA(1, 1, At, B1); PG8_BAR;
            }
        }
        if constexpr (ALIGN_EPI) { if (wr == 0) PG8_BAR; }
        if constexpr (!Epi::AFTER_DRAIN) { E(acc, cur, wr, wc, fr, fq); S.done(cur); }
        if (!has_next) break;
#pragma unroll
        for (int a = 0; a < 2; ++a)
#pragma unroll
            for (int b = 0; b < 2; ++b)
#pragma unroll
                for (int m = 0; m < 4; ++m)
#pragma unroll
                    for (int n = 0; n < 2; ++n) acc[a][b][m][n] = (f32x4){0.f, 0.f, 0.f, 0.f};
        cur = nxt; cA = nA; cB = nB; ++ui;
        if constexpr (ALIGN_EPI) { if (wr == 1) PG8_BAR; }
    }
    PG8_WAIT_V(0);
    if constexpr (!ALIGN_EPI) { if (wr == 0) PG8_BAR; }
    PG8_BAR;
    if constexpr (Epi::AFTER_DRAIN) { E.fused(acc, cur, wr, wc, fr, fq, lds, wid, lane); S.done(cur); }
#undef PG8_SA
#undef PG8_SB
#undef PG8_STAGE
#undef PG8_LDA
#undef PG8_LDB
#undef PG8_MMA
#undef PG8_WAIT_V
#undef PG8_WAIT_L
#undef PG8_BAR
#undef PG8_SCHED
}
}

using pg8::bf16_t; using pg8::bf16x8; using pg8::f32x4; using pg8::u32x4; using pg8::Unit;
typedef float f32x16 __attribute__((ext_vector_type(16)));
typedef float f32x2v __attribute__((ext_vector_type(2)));
typedef __bf16 bf16x2v __attribute__((ext_vector_type(2)));
typedef unsigned u32x2 __attribute__((ext_vector_type(2)));
#define LAS __attribute__((address_space(3)))

constexpr int DM = 1024, NBATCH = 2, SEQ = 16384, CTXL = 256;
constexpr int NLAT = NBATCH * SEQ, NCTX = NBATCH * CTXL, R = NLAT + NCTX;
constexpr int DFF = 2816, KEYS = SEQ + CTXL;
constexpr float EPS = 1e-6f;
constexpr float C2 = 0.125f * 1.4426950408889634f;
constexpr int NTHR = 512;
constexpr int LDS_BYTES = 135168;
constexpr int HG_SEG = 128, HG_STEPS = KEYS / HG_SEG;

constexpr size_t WL_UP1 = 0, WL_DN1 = WL_UP1 + (size_t)5632 * 1024, WL_UP2 = WL_DN1 + (size_t)1024 * 2816, WL_DN2 = WL_UP2 + (size_t)5632 * 1024,
                 WL_IN = WL_DN2 + (size_t)1024 * 2816, WL_PA = WL_IN + (size_t)6144 * 1024, WL_PH = WL_PA + (size_t)1024 * 512, WL_PP = WL_PH + (size_t)1024 * 256,
                 WL_O = WL_PP + (size_t)1024 * 256, WL_TOTAL = WL_O + (size_t)1024 * 1024;
constexpr size_t WS_WB = 0;
constexpr size_t WS_XB = WS_WB + 2 * WL_TOTAL * 2;
constexpr size_t WS_Z = WS_XB + (size_t)R * 1024 * 2;
constexpr size_t Z_VT = 0, Z_HQ = Z_VT + (size_t)R * 512 * 2, Z_FF = Z_HQ + (size_t)R * 256 * 4, Z_FB = Z_FF + (size_t)R * 256 * 4, Z_HI = Z_FB + (size_t)R * 256 * 4,
                 Z_ZP = Z_HI + (size_t)R * 256 * 2, Z_Q = Z_ZP + (size_t)R * 256 * 2, Z_K = Z_Q + (size_t)R * 512 * 2, Z_HG = Z_K + (size_t)R * 512 * 2, Z_END = Z_HG + (size_t)R * 256 * 2;
static_assert((size_t)R * 3072 * 2 <= Z_K, "gate buffer must not reach k / odir / hgate");
static_assert((size_t)R * DFF * 2 <= Z_END, "act fits Z");
constexpr size_t WS_O = WS_Z + Z_END;
constexpr size_t O_DA = 0, O_HG = O_DA + (size_t)R * 512 * 2, O_MX = O_HG + (size_t)R * 256 * 2, O_END = O_MX + (size_t)R * 256 * 2;
constexpr size_t WS_CAR = WS_O + O_END;
constexpr size_t WS_DK = WS_CAR + (size_t)16 * HG_SEG * 4096 * 4;
constexpr size_t WS_HC = WS_DK + (size_t)16 * HG_SEG * 64 * 4;
constexpr size_t WS_MOD = WS_HC + (size_t)NCTX * 1024 * 4;
constexpr size_t WS_CS = WS_MOD + (size_t)2 * 3 * 9216 * 4;
constexpr size_t WS_LB = WS_CS + (size_t)256 * 32 * 4;
constexpr size_t WS_LAM = WS_LB + (size_t)2 * 2 * 256 * 4;
constexpr size_t WS_END = WS_LAM + 256;
static_assert(WS_END <= (size_t)512 * 1024 * 1024, "workspace");

__device__ __forceinline__ unsigned pk2(float lo, float hi) { f32x2v v = {lo, hi}; bf16x2v b = __builtin_convertvector(v, bf16x2v); return __builtin_bit_cast(unsigned, b); }
__device__ __forceinline__ float bf2f(unsigned short u) { return __builtin_bit_cast(float, (unsigned)u << 16); }
__device__ __forceinline__ float bflo(unsigned u) { return __builtin_bit_cast(float, u << 16); }
__device__ __forceinline__ float bfhi(unsigned u) { return __builtin_bit_cast(float, u & 0xffff0000u); }
__device__ __forceinline__ float ex2(float x) { return __builtin_amdgcn_exp2f(x); }
__device__ __forceinline__ float rcpf_(float x) { return __builtin_amdgcn_rcpf(x); }
__device__ __forceinline__ float sigm(float x) { return rcpf_(1.f + ex2(-1.4426950408889634f * x)); }
__device__ __forceinline__ float siluf(float x) { return x * sigm(x); }
__device__ __forceinline__ float shx(float v, int o, int lane) { return __builtin_bit_cast(float, __builtin_amdgcn_ds_bpermute((lane ^ o) << 2, __builtin_bit_cast(int, v))); }
__device__ __forceinline__ float swap32(float v) { auto rr = __builtin_amdgcn_permlane32_swap(__builtin_bit_cast(unsigned, v), __builtin_bit_cast(unsigned, v), false, false);
    const float a = __builtin_bit_cast(float, rr[0]), b = __builtin_bit_cast(float, rr[1]); return (a == v) ? b : a; }
__device__ __forceinline__ float wave_sum(float v, int lane) {
#pragma unroll
    for (int o = 1; o < 64; o <<= 1) v += shx(v, o, lane);
    return v;
}
#define LDS_WAIT() asm volatile("s_waitcnt lgkmcnt(0)" ::: "memory")

struct EpiUp {
    static constexpr bool PERM = true, AFTER_DRAIN = false;
    bf16_t* act;
    __device__ __forceinline__ void operator()(const f32x4 (&acc)[2][2][4][2], const Unit& u, int wr, int wc, int fr, int fq) const {
        const int row0 = u.pm * 256 + wr * 64 + fr, col0 = u.pn * 128 + wc * 32 + 8 * fq;
#pragma unroll
        for (int ai = 0; ai < 2; ++ai)
#pragma unroll
            for (int m = 0; m < 4; ++m) {
                const int row = row0 + ai * 128 + m * 16;
                const f32x4 a0 = acc[ai][0][m][0], a1 = acc[ai][0][m][1], b0 = acc[ai][1][m][0], b1 = acc[ai][1][m][1];
                u32x4 w;
                w.x = pk2(siluf(a0[0]) * b0[0], siluf(a0[1]) * b0[1]); w.y = pk2(siluf(a0[2]) * b0[2], siluf(a0[3]) * b0[3]);
                w.z = pk2(siluf(a1[0]) * b1[0], siluf(a1[1]) * b1[1]); w.w = pk2(siluf(a1[2]) * b1[2], siluf(a1[3]) * b1[3]);
                *(u32x4*)(act + (size_t)row * DFF + col0) = w;
            }
    }
};
struct EpiRes {
    static constexpr bool PERM = true, AFTER_DRAIN = false;
    const float* in_lat; const float* in_ctx; float* out_lat; float* out_ctx; const float* gate; float coef;
    __device__ __forceinline__ void operator()(const f32x4 (&acc)[2][2][4][2], const Unit& u, int wr, int wc, int fr, int fq) const {
        const int row0 = u.pm * 256 + wr * 64 + fr, col0 = u.pn * 256 + wc * 32 + 8 * fq;
        const int seg = (u.pm < 64) ? 0 : (u.pm < 128 ? 1 : 2);
        f32x4 gv[2][2];
#pragma unroll
        for (int bj = 0; bj < 2; ++bj)
#pragma unroll
            for (int n = 0; n < 2; ++n) gv[bj][n] = *(const f32x4*)(gate + seg * 9216 + col0 + bj * 128 + 4 * n) * coef;
#pragma unroll
        for (int ai = 0; ai < 2; ++ai)
#pragma unroll
            for (int m = 0; m < 4; ++m) {
                const int row = row0 + ai * 128 + m * 16;
                const float* ip; float* op;
                if (row < NLAT) { ip = in_lat + (size_t)row * DM; op = out_lat + (size_t)row * DM; }
                else { ip = in_ctx + (size_t)(row - NLAT) * DM; op = out_ctx + (size_t)(row - NLAT) * DM; }
#pragma unroll
                for (int bj = 0; bj < 2; ++bj)
#pragma unroll
                    for (int n = 0; n < 2; ++n) {
                        const int c = col0 + bj * 128 + 4 * n;
                        f32x4 v = *(const f32x4*)(ip + c);
                        v = v + gv[bj][n] * acc[ai][bj][m][n];
                        *(f32x4*)(op + c) = v;
                    }
            }
    }
};
struct SplitKOrder {
    int nunits, G, c, kc;
    __device__ void init(int nparts, int kc_, int G_, int c_) { nunits = nparts * 8; G = G_; c = c_; kc = kc_; }
    __device__ bool next(int i, Unit& u) const {
        const int L = i * G + c; if (L >= nunits) return false;
        const int part = L >> 3, r = L & 7; u.pm = r >> 2; u.pn = r & 3; u.koff = part * kc; return true;
    }
    __device__ __forceinline__ void a_ready(const Unit&) const {}
    __device__ __forceinline__ void done(const Unit&) const {}
};
struct EpiPart {
    static constexpr bool PERM = true, AFTER_DRAIN = false;
    float* P; const float* gate; float coef;
    __device__ __forceinline__ void operator()(const f32x4 (&acc)[2][2][4][2], const Unit& u, int wr, int wc, int fr, int fq) const {
        unsigned z_ = 0u; asm volatile("" : "+s"(z_));
        const int lane_ = (int)__builtin_amdgcn_mbcnt_hi(~0u, __builtin_amdgcn_mbcnt_lo(~0u, z_)), fr_ = lane_ & 15, fq_ = lane_ >> 4;
        const int row0 = u.pm * 256 + wr * 64 + fr_, col0 = u.pn * 256 + wc * 32 + 8 * fq_;
        float* Pp = P + (size_t)(u.koff >> 8) * NCTX * DM;
        f32x4 gv[2][2];
#pragma unroll
        for (int bj = 0; bj < 2; ++bj)
#pragma unroll
            for (int n = 0; n < 2; ++n) gv[bj][n] = *(const f32x4*)(gate + 2 * 9216 + col0 + bj * 128 + 4 * n) * coef;
#pragma unroll
        for (int ai = 0; ai < 2; ++ai)
#pragma unroll
            for (int m = 0; m < 4; ++m) {
                float* op = Pp + (size_t)(row0 + ai * 128 + m * 16) * DM;
#pragma unroll
                for (int bj = 0; bj < 2; ++bj)
#pragma unroll
                    for (int n = 0; n < 2; ++n) *(f32x4*)(op + col0 + bj * 128 + 4 * n) = gv[bj][n] * acc[ai][bj][m][n];
            }
    }
};
struct EpiWin {
    static constexpr bool PERM = true, AFTER_DRAIN = false;
    unsigned char* Z; const float* cs; const float* lb; int pn_off;
    __device__ __forceinline__ void operator()(const f32x4 (&acc)[2][2][4][2], const Unit& u, int wr, int wc, int fr, int fq) const {
        const int t = u.pn + pn_off;
        const int row0 = u.pm * 256 + wr * 64 + fr, cin = wc * 32 + 8 * fq;
        if (t < 4) {
            bf16_t* dst = (bf16_t*)(Z + ((t < 2) ? Z_Q : Z_K)); const float sc = (t < 2) ? C2 : 1.f; const int cb = (t & 1) * 256;
#pragma unroll
            for (int ai = 0; ai < 2; ++ai)
#pragma unroll
                for (int m = 0; m < 4; ++m) {
                    const int row = row0 + ai * 128 + m * 16;
                    f32x4 cv = {1.f, 1.f, 1.f, 1.f}, sv = {0.f, 0.f, 0.f, 0.f};
                    if (row < NLAT) { const int ts = row & (SEQ - 1); const int pos = (wc & 1) ? (ts & 63) : (ts >> 6);
                        cv = *(const f32x4*)(cs + pos * 32 + 4 * fq); sv = *(const f32x4*)(cs + pos * 32 + 16 + 4 * fq); }
#pragma unroll
                    for (int bj = 0; bj < 2; ++bj) {
                        const f32x4 x1 = acc[ai][bj][m][0], x2 = acc[ai][bj][m][1];
                        const f32x4 o1 = (x1 * cv - x2 * sv) * sc, o2 = (x1 * sv + x2 * cv) * sc;
                        u32x4 w; w.x = pk2(o1[0], o1[1]); w.y = pk2(o1[2], o1[3]); w.z = pk2(o2[0], o2[1]); w.w = pk2(o2[2], o2[3]);
                        *(u32x4*)(dst + (size_t)row * 512 + cb + bj * 128 + cin) = w;
                    }
                }
        } else if (t < 6) {
            bf16_t* vT = (bf16_t*)(Z + Z_VT);
#pragma unroll
            for (int ai = 0; ai < 2; ++ai)
#pragma unroll
                for (int m = 0; m < 4; ++m) {
                    const int row = row0 + ai * 128 + m * 16;
                    int b, key;
                    if (row < NLAT) { b = row >> 14; key = row & (SEQ - 1); } else { b = (row - NLAT) >> 8; key = SEQ + ((row - NLAT) & (CTXL - 1)); }
#pragma unroll
                    for (int bj = 0; bj < 2; ++bj) {
                        bf16_t* dp = vT + (size_t)(b * 512 + (t - 4) * 256 + bj * 128 + cin) * KEYS + key;
#pragma unroll
                        for (int n = 0; n < 2; ++n)
#pragma unroll
                            for (int i = 0; i < 4; i += 2) {
                                const unsigned w = pk2(acc[ai][bj][m][n][i], acc[ai][bj][m][n][i + 1]);
                                dp[(size_t)(4 * n + i) * KEYS] = (bf16_t)(w & 0xffffu); dp[(size_t)(4 * n + i + 1) * KEYS] = (bf16_t)(w >> 16);
                            }
                    }
                }
        } else if (t <= 8) {
            float* dst = (float*)(Z + ((t == 6) ? Z_HQ : (t == 7 ? Z_FF : Z_FB)));
            const float* lbp = lb + ((t == 8) ? 256 : 0);
#pragma unroll
            for (int bj = 0; bj < 2; ++bj)
#pragma unroll
                for (int n = 0; n < 2; ++n) {
                    f32x4 lbv = *(const f32x4*)(lbp + bj * 128 + cin + 4 * n);
                    f32x4 om = 1.f - lbv;
#pragma unroll
                    for (int ai = 0; ai < 2; ++ai)
#pragma unroll
                        for (int m = 0; m < 4; ++m) {
                            const int row = row0 + ai * 128 + m * 16;
                            const f32x4 z = acc[ai][bj][m][n];
                            f32x4 sg; sg[0] = sigm(z[0]); sg[1] = sigm(z[1]); sg[2] = sigm(z[2]); sg[3] = sigm(z[3]);
                            const f32x4 o = (t == 6) ? z * sg : lbv + om * sg;
                            *(f32x4*)(dst + (size_t)row * 256 + bj * 128 + cin + 4 * n) = o;
                        }
                }
        } else {
            bf16_t* dst = (bf16_t*)(Z + ((t == 9) ? Z_HI : (t == 10 ? Z_HG : Z_ZP)));
#pragma unroll
            for (int ai = 0; ai < 2; ++ai)
#pragma unroll
                for (int m = 0; m < 4; ++m) {
                    const int row = row0 + ai * 128 + m * 16;
#pragma unroll
                    for (int bj = 0; bj < 2; ++bj) {
                        f32x4 v0 = acc[ai][bj][m][0], v1 = acc[ai][bj][m][1];
                        if (t == 10) { v0[0] = siluf(v0[0]); v0[1] = siluf(v0[1]); v0[2] = siluf(v0[2]); v0[3] = siluf(v0[3]); v1[0] = siluf(v1[0]); v1[1] = siluf(v1[1]); v1[2] = siluf(v1[2]); v1[3] = siluf(v1[3]); }
                        u32x4 w; w.x = pk2(v0[0], v0[1]); w.y = pk2(v0[2], v0[3]); w.z = pk2(v1[0], v1[1]); w.w = pk2(v1[2], v1[3]);
                        *(u32x4*)(dst + (size_t)row * 256 + bj * 128 + cin) = w;
                    }
                }
        }
    }
};
struct EpiVT {
    static constexpr bool PERM = true, AFTER_DRAIN = false;
    bf16_t* vT;
    __device__ __forceinline__ void operator()(const f32x4 (&acc)[2][2][4][2], const Unit& u, int wr, int wc, int fr, int fq) const {
        const int e0 = u.pm * 256 + wr * 64 + fr;
        int b, key0;
        if (u.pn < 64) { b = 0; key0 = u.pn * 256; } else if (u.pn < 128) { b = 1; key0 = (u.pn - 64) * 256; } else { b = u.pn - 128; key0 = SEQ; }
        const int kc = key0 + wc * 32 + 8 * fq;
#pragma unroll
        for (int ai = 0; ai < 2; ++ai)
#pragma unroll
            for (int m = 0; m < 4; ++m) {
                const int e = e0 + ai * 128 + m * 16;
#pragma unroll
                for (int bj = 0; bj < 2; ++bj) {
                    const f32x4 v0 = acc[ai][bj][m][0], v1 = acc[ai][bj][m][1];
                    u32x4 w; w.x = pk2(v0[0], v0[1]); w.y = pk2(v0[2], v0[3]); w.z = pk2(v1[0], v1[1]); w.w = pk2(v1[2], v1[3]);
                    *(u32x4*)(vT + (size_t)(b * 512 + e) * KEYS + kc + bj * 128) = w;
                }
            }
    }
};
struct EpiG {
    static constexpr bool PERM = true, AFTER_DRAIN = false;
    bf16_t* G;
    __device__ __forceinline__ void operator()(const f32x4 (&acc)[2][2][4][2], const Unit& u, int wr, int wc, int fr, int fq) const {
        const int row0 = u.pm * 256 + wr * 64 + fr, col0 = u.pn * 256 + wc * 32 + 8 * fq;
#pragma unroll
        for (int ai = 0; ai < 2; ++ai)
#pragma unroll
            for (int m = 0; m < 4; ++m) {
                const int row = row0 + ai * 128 + m * 16;
#pragma unroll
                for (int bj = 0; bj < 2; ++bj) {
                    const f32x4 v0 = acc[ai][bj][m][0], v1 = acc[ai][bj][m][1];
                    u32x4 w; w.x = pk2(sigm(v0[0]), sigm(v0[1])); w.y = pk2(sigm(v0[2]), sigm(v0[3])); w.z = pk2(sigm(v1[0]), sigm(v1[1])); w.w = pk2(sigm(v1[2]), sigm(v1[3]));
                    *(u32x4*)(G + (size_t)row * 3072 + col0 + bj * 128) = w;
                }
            }
    }
};
struct EpiProj {
    static constexpr bool PERM = true, AFTER_DRAIN = false;
    bf16_t* y; const bf16_t* G; int gi; int first;
    __device__ __forceinline__ void operator()(const f32x4 (&acc)[2][2][4][2], const Unit& u, int wr, int wc, int fr, int fq) const {
        const int row0 = u.pm * 256 + wr * 64 + fr, col0 = u.pn * 256 + wc * 32 + 8 * fq;
#pragma unroll
        for (int ai = 0; ai < 2; ++ai)
#pragma unroll
            for (int m = 0; m < 4; ++m) {
                const int row = row0 + ai * 128 + m * 16;
#pragma unroll
                for (int bj = 0; bj < 2; ++bj) {
                    const int c = col0 + bj * 128;
                    const u32x4 g = *(const u32x4*)(G + (size_t)row * 3072 + gi * 1024 + c);
                    u32x4 yo = {0u, 0u, 0u, 0u};
                    if (!first) yo = *(const u32x4*)(y + (size_t)row * 1024 + c);
                    const f32x4 v0 = acc[ai][bj][m][0], v1 = acc[ai][bj][m][1];
                    u32x4 w;
                    w.x = pk2(bflo(yo.x) + bflo(g.x) * v0[0], bfhi(yo.x) + bfhi(g.x) * v0[1]);
                    w.y = pk2(bflo(yo.y) + bflo(g.y) * v0[2], bfhi(yo.y) + bfhi(g.y) * v0[3]);
                    w.z = pk2(bflo(yo.z) + bflo(g.z) * v1[0], bfhi(yo.z) + bfhi(g.z) * v1[1]);
                    w.w = pk2(bflo(yo.w) + bflo(g.w) * v1[2], bfhi(yo.w) + bfhi(g.w) * v1[3]);
                    *(u32x4*)(y + (size_t)row * 1024 + c) = w;
                }
            }
    }
};

__device__ __forceinline__ int map_row(int mode, int n) {
    if (mode == 1) return 256 * (n >> 7) + (n & 127);
    if (mode == 2) return 256 * (n >> 7) + 128 + (n & 127);
    if (mode == 3) return (n < 1024) ? ((n & ~31) + 8 * ((n & 15) >> 2) + 4 * ((n >> 4) & 1) + (n & 3)) : n;
    return n;
}
__device__ __forceinline__ void transpose_item(const float* W, int K, int N, bf16_t* WT, int mode, LAS float* scr, int item, int lane) {
    const int nblk = N / 32, kb = item / nblk, nb = item % nblk, k0 = 64 * kb, n0 = 32 * nb;
#pragma unroll 8
    for (int i = 0; i < 32; ++i) { const int kk = 2 * i + (lane >> 5); scr[kk * 33 + (lane & 31)] = W[(size_t)(k0 + kk) * N + n0 + (lane & 31)]; }
    LDS_WAIT(); asm volatile("" ::: "memory");
    const int c = lane & 7;
#pragma unroll
    for (int j = 0; j < 4; ++j) { const int n = (lane >> 3) + 8 * j; const LAS float* s = scr + (8 * c) * 33 + n;
        u32x4 o; o.x = pk2(s[0 * 33], s[1 * 33]); o.y = pk2(s[2 * 33], s[3 * 33]); o.z = pk2(s[4 * 33], s[5 * 33]); o.w = pk2(s[6 * 33], s[7 * 33]);
        *(u32x4*)(WT + (size_t)map_row(mode, n0 + n) * K + k0 + 8 * c) = o; }
    LDS_WAIT(); asm volatile("" ::: "memory");
}

__device__ __forceinline__ void norm_phase(const float* in_lat, const float* in_ctx, const float* gain, const float* modl, int shi, int sci, bf16_t* outp, int gw, int ngw, int lane,
                                           const float* part, int nparts, float* hc_out) {
    f32x4 gv[4];
#pragma unroll
    for (int j = 0; j < 4; ++j) gv[j] = *(const f32x4*)(gain + 4 * lane + 256 * j);
    for (int row = gw; row < R; row += ngw) {
        const float* ip = (row < NLAT) ? in_lat + (size_t)row * DM : in_ctx + (size_t)(row - NLAT) * DM;
        const int seg = (row < SEQ) ? 0 : (row < NLAT ? 1 : 2);
        const float* sh = modl + seg * 9216 + shi * 1024; const float* sc = modl + seg * 9216 + sci * 1024;
        f32x4 v[4]; float ss = 0.f;
#pragma unroll
        for (int j = 0; j < 4; ++j) v[j] = *(const f32x4*)(ip + 4 * lane + 256 * j);
        if (row >= NLAT && nparts > 0) {
            for (int p = 0; p < nparts; ++p) {
                const float* pp = part + ((size_t)p * NCTX + (row - NLAT)) * DM;
#pragma unroll
                for (int j = 0; j < 4; ++j) v[j] = v[j] + *(const f32x4*)(pp + 4 * lane + 256 * j);
            }
#pragma unroll
            for (int j = 0; j < 4; ++j) *(f32x4*)(hc_out + (size_t)(row - NLAT) * DM + 4 * lane + 256 * j) = v[j];
        }
#pragma unroll
        for (int j = 0; j < 4; ++j) ss += (v[j][0] * v[j][0] + v[j][1] * v[j][1]) + (v[j][2] * v[j][2] + v[j][3] * v[j][3]);
        ss = wave_sum(ss, lane);
        const float rstd = 1.0f / sqrtf(ss * (1.f / DM) + EPS);
#pragma unroll
        for (int j = 0; j < 4; ++j) {
            const f32x4 s4 = *(const f32x4*)(sc + 4 * lane + 256 * j), h4 = *(const f32x4*)(sh + 4 * lane + 256 * j);
            const f32x4 y = v[j] * rstd * gv[j] * (s4 + 1.f) + h4;
            u32x2 w; w.x = pk2(y[0], y[1]); w.y = pk2(y[2], y[3]);
            *(u32x2*)(outp + (size_t)row * DM + 4 * lane + 256 * j) = w;
        }
    }
}
__device__ __forceinline__ void final_norm_phase(float* out, const float* gain, int gw, int ngw, int lane) {
    f32x4 gv[4];
#pragma unroll
    for (int j = 0; j < 4; ++j) gv[j] = *(const f32x4*)(gain + 4 * lane + 256 * j);
    for (int row = gw; row < NLAT; row += ngw) {
        float* ip = out + (size_t)row * DM;
        f32x4 v[4]; float ss = 0.f;
#pragma unroll
        for (int j = 0; j < 4; ++j) { v[j] = *(const f32x4*)(ip + 4 * lane + 256 * j); ss += (v[j][0] * v[j][0] + v[j][1] * v[j][1]) + (v[j][2] * v[j][2] + v[j][3] * v[j][3]); }
        ss = wave_sum(ss, lane);
        const float rstd = 1.0f / sqrtf(ss * (1.f / DM) + EPS);
#pragma unroll
        for (int j = 0; j < 4; ++j) *(f32x4*)(ip + 4 * lane + 256 * j) = v[j] * rstd * gv[j];
    }
}
__device__ __forceinline__ void pool_phase(const bf16_t* zp, bf16_t* mx, int gtid, int ngt) {
    for (int it = gtid; it < R * 32; it += ngt) {
        const int row = it >> 5, ch = (it & 31) * 8, g = ch >> 6, hw = 1 << g;
        int base, n;
        if (row < NLAT) { base = row & ~(SEQ - 1); n = SEQ; } else { base = NLAT + ((row - NLAT) & ~(CTXL - 1)); n = CTXL; }
        const int t = row - base, lo = (t - hw > 0) ? t - hw : 0, hi = (t + hw < n) ? t + hw : n;
        float s[8];
#pragma unroll
        for (int i = 0; i < 8; ++i) s[i] = 0.f;
        for (int j = lo; j < hi; ++j) {
            const u32x4 v = *(const u32x4*)(zp + (size_t)(base + j) * 256 + ch);
            s[0] += bflo(v.x); s[1] += bfhi(v.x); s[2] += bflo(v.y); s[3] += bfhi(v.y); s[4] += bflo(v.z); s[5] += bfhi(v.z); s[6] += bflo(v.w); s[7] += bfhi(v.w);
        }
        const float inv = 1.f / (float)(hi - lo);
        const u32x4 c = *(const u32x4*)(zp + (size_t)row * 256 + ch);
        u32x4 w;
        w.x = pk2(s[0] * inv - bflo(c.x), s[1] * inv - bfhi(c.x)); w.y = pk2(s[2] * inv - bflo(c.y), s[3] * inv - bfhi(c.y));
        w.z = pk2(s[4] * inv - bflo(c.z), s[5] * inv - bfhi(c.z)); w.w = pk2(s[6] * inv - bflo(c.w), s[7] * inv - bfhi(c.w));
        *(u32x4*)(mx + (size_t)row * 256 + ch) = w;
    }
}

__device__ __forceinline__ int hg_row(int dir, int b, int step) {
    if (step < CTXL) { const int t = dir ? (CTXL - 1 - step) : step; return NLAT + b * CTXL + t; }
    int t = step - CTXL; if (dir) t = SEQ - 1 - t; return b * SEQ + t;
}
template <bool OUT>
__device__ __forceinline__ void hg_pass(const float* hq, const float* ff, const float* fb, const bf16_t* hi, float* carry, float* dk, bf16_t* odir, int wave, int lane, int G) {
    for (int item = blockIdx.x + G * wave; item < 16 * HG_SEG; item += G * 8) {
        const int s = item / HG_SEG, j = item % HG_SEG, dir = s >> 3, b = (s >> 2) & 1, h = s & 3;
        const float* fbase = dir ? fb : ff;
        f32x2v S[32];
#pragma unroll
        for (int k = 0; k < 32; ++k) { S[k][0] = OUT ? carry[((size_t)item * 64 + 2 * k) * 64 + lane] : 0.f; S[k][1] = OUT ? carry[((size_t)item * 64 + 2 * k + 1) * 64 + lane] : 0.f; }
        float dl = 1.f;
        const int st0 = j * HG_STEPS, st1 = st0 + HG_STEPS;
        constexpr int HG_PF = 8;
        float ivb[HG_PF], fvb[HG_PF], qvb[HG_PF];
#pragma unroll
        for (int u = 0; u < HG_PF; ++u) {
            const int stl = (st0 + u < st1) ? st0 + u : st1 - 1;
            const size_t off = (size_t)hg_row(dir, b, stl) * 256 + h * 64 + lane;
            ivb[u] = bf2f(hi[off]); fvb[u] = fbase[off]; qvb[u] = OUT ? hq[off] : 0.f;
        }
        for (int sb = st0; sb < st1; sb += HG_PF) {
#pragma unroll
            for (int u = 0; u < HG_PF; ++u) {
                const int st = sb + u;
                if (st < st1) {
                    const float iv = ivb[u], fv = fvb[u], qv = qvb[u];
                    const size_t offc = (size_t)hg_row(dir, b, st) * 256 + h * 64 + lane;
                    { const int stn = (st + HG_PF < st1) ? st + HG_PF : st1 - 1;
                      const size_t off = (size_t)hg_row(dir, b, stn) * 256 + h * 64 + lane;
                      ivb[u] = bf2f(hi[off]); fvb[u] = fbase[off]; if (OUT) qvb[u] = hq[off]; }
                    if (!OUT) dl *= fv;
                    f32x2v o2 = {0.f, 0.f};
                    const f32x2v iv2 = {iv, iv};
                    const int fvi = __builtin_bit_cast(int, fv), qvi = __builtin_bit_cast(int, qv);
#pragma unroll
                    for (int k = 0; k < 32; ++k) {
                        f32x2v f2; f2[0] = __builtin_bit_cast(float, __builtin_amdgcn_readlane(fvi, 2 * k)); f2[1] = __builtin_bit_cast(float, __builtin_amdgcn_readlane(fvi, 2 * k + 1));
                        const f32x2v d2 = S[k] - iv2;
                        S[k] = __builtin_elementwise_fma(f2, d2, iv2);
                        if (OUT) { f32x2v q2; q2[0] = __builtin_bit_cast(float, __builtin_amdgcn_readlane(qvi, 2 * k)); q2[1] = __builtin_bit_cast(float, __builtin_amdgcn_readlane(qvi, 2 * k + 1));
                            o2 = __builtin_elementwise_fma(q2, S[k], o2); }
                    }
                    if (OUT) odir[(size_t)dir * R * 256 + offc] = (bf16_t)(pk2(o2[0] + o2[1], 0.f) & 0xffffu);
                }
            }
        }
        if (!OUT) {
#pragma unroll
            for (int k = 0; k < 32; ++k) { carry[((size_t)item * 64 + 2 * k) * 64 + lane] = S[k][0]; carry[((size_t)item * 64 + 2 * k + 1) * 64 + lane] = S[k][1]; }
            dk[item * 64 + lane] = dl;
        }
    }
}
constexpr int HGA_T = 48, HGA_STR = 112, HGA_MAT = 64 * HGA_STR, HGA_WAVE = 2 * HGA_MAT;
static_assert(8 * HGA_WAVE <= LDS_BYTES - 64 && 3 * HGA_T >= HG_STEPS, "hg pass A LDS");
__device__ __forceinline__ void hg_passA_mfma(LAS unsigned char* lds, const float* ff, const float* fb, const bf16_t* hi, float* carry, float* dk, int wave, int lane, int G) {
    LAS unsigned char* KT = lds + wave * HGA_WAVE; LAS unsigned char* VT = KT + HGA_MAT;
    const int n = lane & 31, gq = lane >> 5;
    for (int item = blockIdx.x + G * wave; item < 16 * HG_SEG; item += G * 8) {
        const int s = item / HG_SEG, j = item % HG_SEG, dir = s >> 3, b = (s >> 2) & 1, h = s & 3;
        const float* fbase = dir ? fb : ff;
        const int st0 = j * HG_STEPS, st1 = st0 + HG_STEPS;
        f32x16 acc[2][2];
#pragma unroll
        for (int kb = 0; kb < 2; ++kb)
#pragma unroll
            for (int vb = 0; vb < 2; ++vb)
#pragma unroll
                for (int r = 0; r < 16; ++r) acc[kb][vb][r] = 0.f;
        float P = 1.f;
        for (int third = 2; third >= 0; --third) {
            const int sb = st0 + third * HGA_T;
            for (int s0 = HGA_T - 8; s0 >= 0; s0 -= 8) {
                float fv[8]; unsigned short iv[8];
#pragma unroll
                for (int u = 0; u < 8; ++u) {
                    const int st = sb + s0 + u;
                    const int stc = (st < st1) ? st : st1 - 1;
                    const size_t off = (size_t)hg_row(dir, b, stc) * 256 + h * 64 + lane;
                    fv[u] = fbase[off]; iv[u] = hi[off];
                }
#pragma unroll
                for (int u = 7; u >= 0; --u) {
                    const int st = sb + s0 + u;
                    const bool ok = (st < st1);
                    const float f = ok ? fv[u] : 1.f;
                    const float kh = ok ? (1.f - f) * P : 0.f;
                    P *= f;
                    *(LAS unsigned short*)(KT + lane * HGA_STR + (s0 + u) * 2) = (unsigned short)(pk2(kh, 0.f) & 0xffffu);
                    *(LAS unsigned short*)(VT + lane * HGA_STR + (s0 + u) * 2) = ok ? iv[u] : (unsigned short)0;
                }
            }
            LDS_WAIT(); asm volatile("" ::: "memory");
#pragma unroll
            for (int q = 0; q < HGA_T / 16; ++q) {
                bf16x8 af[2], bfr[2];
#pragma unroll
                for (int kb = 0; kb < 2; ++kb) af[kb] = *(LAS bf16x8*)(KT + (kb * 32 + n) * HGA_STR + (16 * q + 8 * gq) * 2);
#pragma unroll
                for (int vb = 0; vb < 2; ++vb) bfr[vb] = *(LAS bf16x8*)(VT + (vb * 32 + n) * HGA_STR + (16 * q + 8 * gq) * 2);
#pragma unroll
                for (int kb = 0; kb < 2; ++kb)
#pragma unroll
                    for (int vb = 0; vb < 2; ++vb) acc[kb][vb] = __builtin_amdgcn_mfma_f32_32x32x16_bf16(af[kb], bfr[vb], acc[kb][vb], 0, 0, 0);
            }
            LDS_WAIT(); asm volatile("" ::: "memory");
        }
#pragma unroll
        for (int kb = 0; kb < 2; ++kb)
#pragma unroll
            for (int vb = 0; vb < 2; ++vb)
#pragma unroll
                for (int r = 0; r < 16; ++r) {
                    const int k = kb * 32 + 8 * (r >> 2) + 4 * gq + (r & 3), v = vb * 32 + n;
                    carry[((size_t)item * 64 + k) * 64 + v] = acc[kb][vb][r];
                }
        dk[item * 64 + lane] = P;
    }
}
constexpr int HGB_QSTR = 144, HGB_TSTR = 48, HGB_Q = 0, HGB_K = HGB_Q + 16 * HGB_QSTR, HGB_KH = HGB_K + 16 * HGB_QSTR, HGB_IT = HGB_KH + 64 * HGB_TSTR, HGB_DC = HGB_IT + 64 * HGB_TSTR, HGB_WAVE = HGB_DC + 256;
static_assert(8 * HGB_WAVE <= LDS_BYTES - 64, "hg pass B LDS");
__device__ __forceinline__ bf16x8 hgb_pack8(const f32x16& t, int r0) {
    u32x4 w; w.x = pk2(t[r0 + 0], t[r0 + 1]); w.y = pk2(t[r0 + 2], t[r0 + 3]); w.z = pk2(t[r0 + 4], t[r0 + 5]); w.w = pk2(t[r0 + 6], t[r0 + 7]); return __builtin_bit_cast(bf16x8, w);
}
__device__ __forceinline__ void hg_passB_mfma(LAS unsigned char* lds, const float* hq, const float* ff, const float* fb, const bf16_t* hi, const float* carry, bf16_t* odir, int wave, int lane, int G) {
    LAS unsigned char* W = lds + wave * HGB_WAVE;
    const int n = lane & 31, gq = lane >> 5, n16 = n & 15;
    const int kpos = (lane & ~15) + (lane & 3) + ((lane >> 3) & 1) * 4 + ((lane >> 2) & 1) * 8;
    for (int item = blockIdx.x + G * wave; item < 16 * HG_SEG; item += G * 8) {
        const int s = item / HG_SEG, j = item % HG_SEG, dir = s >> 3, b = (s >> 2) & 1, h = s & 3;
        const float* fbase = dir ? fb : ff;
        const int st0 = j * HG_STEPS, st1 = st0 + HG_STEPS;
        f32x16 S[2][2];
#pragma unroll
        for (int kb = 0; kb < 2; ++kb)
#pragma unroll
            for (int vb = 0; vb < 2; ++vb)
#pragma unroll
                for (int r = 0; r < 16; ++r) S[kb][vb][r] = carry[((size_t)item * 64 + kb * 32 + 8 * (r >> 2) + 4 * gq + (r & 3)) * 64 + vb * 32 + n];
        for (int c0 = st0; c0 < st1; c0 += 16) {
            float fv[16], qv[16]; unsigned short iv[16];
#pragma unroll
            for (int t = 0; t < 16; ++t) {
                const int st = c0 + t; const int stc = (st < st1) ? st : st1 - 1;
                const size_t off = (size_t)hg_row(dir, b, stc) * 256 + h * 64 + lane;
                fv[t] = fbase[off]; qv[t] = hq[off]; iv[t] = hi[off];
            }
            float P = 1.f; float kt[16];
#pragma unroll
            for (int t = 0; t < 16; ++t) {
                const bool ok = (c0 + t < st1);
                const float f = ok ? fv[t] : 1.f, q = ok ? qv[t] : 0.f;
                P *= f;
                const float Pc = fmaxf(P, 1e-30f);
                kt[t] = ok ? (1.f - f) * rcpf_(Pc) : 0.f;
                *(LAS unsigned short*)(W + HGB_Q + t * HGB_QSTR + kpos * 2) = (unsigned short)(pk2(q * Pc, 0.f) & 0xffffu);
                *(LAS unsigned short*)(W + HGB_K + t * HGB_QSTR + kpos * 2) = (unsigned short)(pk2(kt[t], 0.f) & 0xffffu);
                *(LAS unsigned short*)(W + HGB_IT + lane * HGB_TSTR + t * 2) = ok ? iv[t] : (unsigned short)0;
            }
            const float P15 = fmaxf(P, 1e-30f);
#pragma unroll
            for (int t = 0; t < 16; ++t) *(LAS unsigned short*)(W + HGB_KH + lane * HGB_TSTR + t * 2) = (unsigned short)(pk2(kt[t] * P15, 0.f) & 0xffffu);
            *(LAS float*)(W + HGB_DC + lane * 4) = P;
            LDS_WAIT(); asm volatile("" ::: "memory");
            bf16x8 qb[4];
#pragma unroll
            for (int u = 0; u < 4; ++u) qb[u] = *(LAS bf16x8*)(W + HGB_Q + n16 * HGB_QSTR + (16 * u + 8 * gq) * 2);
            f32x16 OT[2], AT;
#pragma unroll
            for (int r = 0; r < 16; ++r) { OT[0][r] = 0.f; OT[1][r] = 0.f; AT[r] = 0.f; }
#pragma unroll
            for (int u = 0; u < 4; ++u) {
                const bf16x8 ka = *(LAS bf16x8*)(W + HGB_K + n16 * HGB_QSTR + (16 * u + 8 * gq) * 2);
                AT = __builtin_amdgcn_mfma_f32_32x32x16_bf16(ka, qb[u], AT, 0, 0, 0);
#pragma unroll
                for (int vb = 0; vb < 2; ++vb)
                    OT[vb] = __builtin_amdgcn_mfma_f32_32x32x16_bf16(hgb_pack8(S[u >> 1][vb], 8 * (u & 1)), qb[u], OT[vb], 0, 0, 0);
            }
#pragma unroll
            for (int r = 0; r < 8; ++r) { const int srow = 8 * (r >> 2) + 4 * gq + (r & 3); if (srow > n) AT[r] = 0.f; }
            const bf16x8 ab = hgb_pack8(AT, 0);
#pragma unroll
            for (int vb = 0; vb < 2; ++vb) {
                const u32x2 lo = *(LAS u32x2*)(W + HGB_IT + (vb * 32 + n) * HGB_TSTR + (4 * gq) * 2), hi2 = *(LAS u32x2*)(W + HGB_IT + (vb * 32 + n) * HGB_TSTR + (8 + 4 * gq) * 2);
                const bf16x8 ia = __builtin_bit_cast(bf16x8, ((u32x4){lo.x, lo.y, hi2.x, hi2.y}));
                OT[vb] = __builtin_amdgcn_mfma_f32_32x32x16_bf16(ia, ab, OT[vb], 0, 0, 0);
            }
            if (n < 16 && c0 + n < st1) {
                bf16_t* op = odir + (size_t)dir * R * 256 + (size_t)hg_row(dir, b, c0 + n) * 256 + h * 64;
#pragma unroll
                for (int vb = 0; vb < 2; ++vb)
#pragma unroll
                    for (int r4 = 0; r4 < 4; ++r4) {
                        u32x2 w; w.x = pk2(OT[vb][4 * r4 + 0], OT[vb][4 * r4 + 1]); w.y = pk2(OT[vb][4 * r4 + 2], OT[vb][4 * r4 + 3]);
                        *(u32x2*)(op + vb * 32 + 8 * r4 + 4 * gq) = w;
                    }
            }
#pragma unroll
            for (int kb = 0; kb < 2; ++kb) {
                f32x4 dc[4];
#pragma unroll
                for (int r4 = 0; r4 < 4; ++r4) dc[r4] = *(LAS f32x4*)(W + HGB_DC + (kb * 32 + 8 * r4 + 4 * gq) * 4);
                const bf16x8 kh = *(LAS bf16x8*)(W + HGB_KH + (kb * 32 + n) * HGB_TSTR + (8 * gq) * 2);
#pragma unroll
                for (int vb = 0; vb < 2; ++vb) {
#pragma unroll
                    for (int r = 0; r < 16; ++r) S[kb][vb][r] *= dc[r >> 2][r & 3];
                    const bf16x8 ib = *(LAS bf16x8*)(W + HGB_IT + (vb * 32 + n) * HGB_TSTR + (8 * gq) * 2);
                    S[kb][vb] = __builtin_amdgcn_mfma_f32_32x32x16_bf16(kh, ib, S[kb][vb], 0, 0, 0);
                }
            }
            LDS_WAIT(); asm volatile("" ::: "memory");
        }
    }
}
__device__ __forceinline__ void hg_carry(float* carry, const float* dk, int gtid, int ngt) {
    for (int e = gtid; e < 16 * 4096; e += ngt) {
        const int s = e >> 12, idx = e & 4095, k = idx >> 6;
        float run = 0.f;
        for (int j0 = 0; j0 < HG_SEG; j0 += 8) {
            float t[8], d[8];
#pragma unroll
            for (int u = 0; u < 8; ++u) { t[u] = carry[(size_t)(s * HG_SEG + j0 + u) * 4096 + idx]; d[u] = dk[(s * HG_SEG + j0 + u) * 64 + k]; }
#pragma unroll
            for (int u = 0; u < 8; ++u) { carry[(size_t)(s * HG_SEG + j0 + u) * 4096 + idx] = run; run = __builtin_fmaf(d[u], run, t[u]); }
        }
    }
}
__device__ __forceinline__ void hg_readout(const bf16_t* odir, const bf16_t* hgs, const float* gain, bf16_t* ohg, int gw, int ngw, int lane) {
    const f32x4 gv = *(const f32x4*)(gain + ((4 * lane) & 63));
    for (int row = gw; row < R; row += ngw) {
        const size_t off = (size_t)row * 256 + 4 * lane;
        const u32x2 a = *(const u32x2*)(odir + off), bq = *(const u32x2*)(odir + (size_t)R * 256 + off), hg = *(const u32x2*)(hgs + off);
        const float o0 = bflo(a.x) + bflo(bq.x), o1 = bfhi(a.x) + bfhi(bq.x), o2 = bflo(a.y) + bflo(bq.y), o3 = bfhi(a.y) + bfhi(bq.y);
        float ss = (o0 * o0 + o1 * o1) + (o2 * o2 + o3 * o3);
        ss += shx(ss, 1, lane); ss += shx(ss, 2, lane); ss += shx(ss, 4, lane); ss += shx(ss, 8, lane);
        const float rstd = 1.0f / sqrtf(ss * (1.f / 64.f) + EPS);
        u32x2 w;
        w.x = pk2(o0 * rstd * gv[0] * bflo(hg.x), o1 * rstd * gv[1] * bfhi(hg.x));
        w.y = pk2(o2 * rstd * gv[2] * bflo(hg.y), o3 * rstd * gv[3] * bfhi(hg.y));
        *(u32x2*)(ohg + off) = w;
    }
}

constexpr int AT_KSTR = 272, AT_VSTR = 144, AT_KBYTES = 64 * AT_KSTR, AT_VBYTES = 128 * AT_VSTR, AT_STAGE = AT_KBYTES + AT_VBYTES;
static_assert(2 * AT_STAGE <= LDS_BYTES && 65536 <= 2 * AT_STAGE, "attention LDS");
__device__ __forceinline__ void attn_unit(LAS unsigned char* lds, const bf16_t* qbuf, const bf16_t* kbuf, const bf16_t* vT, bf16_t* oda, const float* gain,
                                          int b, int h, int qrow0, int kt0, int kt1, float lam, float post, int tid, int wave, int lane) {
    const int c = wave & 1, g = wave >> 1, n = lane & 31, gq = lane >> 5;
    bf16x8 qf[4];
    { const bf16_t* qp = qbuf + (size_t)(qrow0 + 32 * g + n) * 512 + h * 128 + c * 64 + 8 * gq;
#pragma unroll
      for (int s = 0; s < 4; ++s) qf[s] = *(const bf16x8*)(qp + 16 * s); }
    f32x16 O[4];
#pragma unroll
    for (int e = 0; e < 4; ++e)
#pragma unroll
        for (int r = 0; r < 16; ++r) O[e][r] = 0.f;
    float l = 0.f;
    const int kkey0 = tid >> 4, kch = tid & 15, ve0 = tid >> 3, vc = tid & 7;
    const size_t kgoff = (size_t)kkey0 * 512 + h * 128 + kch * 8;
    const unsigned klds = kkey0 * AT_KSTR + kch * 16;
    const size_t vgoff = (size_t)(b * 512 + h * 128 + ve0) * KEYS + vc * 8;
    const unsigned vlds = ve0 * AT_VSTR + (vc >> 1) * 32 + (vc & 1) * 8;
    u32x4 kr0, kr1, vr0, vr1;
#define AT_KROW0(kt) (((kt) * 64 < SEQ) ? (size_t)b * SEQ + (kt) * 64 : (size_t)NLAT + b * CTXL + ((kt) * 64 - SEQ))
#define AT_LOADK(kt) do { const size_t krow0 = AT_KROW0(kt); kr0 = *(const u32x4*)(kbuf + krow0 * 512 + kgoff); kr1 = *(const u32x4*)(kbuf + (krow0 + 32) * 512 + kgoff); } while (0)
#define AT_LOADV(kt) do { vr0 = *(const u32x4*)(vT + vgoff + (kt) * 64); vr1 = *(const u32x4*)(vT + vgoff + (size_t)64 * KEYS + (kt) * 64); } while (0)
#define AT_STOREK(buf) do { LAS unsigned char* sb_ = lds + (buf) * AT_KBYTES; *(LAS u32x4*)(sb_ + klds) = kr0; *(LAS u32x4*)(sb_ + klds + 32 * AT_KSTR) = kr1; } while (0)
#define AT_STOREV(buf) do { LAS unsigned char* sb_ = lds + 2 * AT_KBYTES + (buf) * AT_VBYTES; \
        *(LAS u32x2*)(sb_ + vlds) = (u32x2){vr0.x, vr0.y}; *(LAS u32x2*)(sb_ + vlds + 16) = (u32x2){vr0.z, vr0.w}; \
        *(LAS u32x2*)(sb_ + vlds + 64 * AT_VSTR) = (u32x2){vr1.x, vr1.y}; *(LAS u32x2*)(sb_ + vlds + 64 * AT_VSTR + 16) = (u32x2){vr1.z, vr1.w}; } while (0)
#define AT_QK(Sa, Sb, buf) do { LAS unsigned char* kp = lds + (buf) * AT_KBYTES + n * AT_KSTR + (c * 8 + gq) * 16; \
        _Pragma("unroll") for (int s = 0; s < 4; ++s) { \
            const bf16x8 a0 = *(LAS bf16x8*)(kp + s * 32), a1 = *(LAS bf16x8*)(kp + 32 * AT_KSTR + s * 32); \
            Sa = __builtin_amdgcn_mfma_f32_32x32x16_bf16(a0, qf[s], Sa, 0, 0, 0); \
            Sb = __builtin_amdgcn_mfma_f32_32x32x16_bf16(a1, qf[s], Sb, 0, 0, 0); } } while (0)
#define AT_BAR() do { asm volatile("s_waitcnt lgkmcnt(0)" ::: "memory"); __builtin_amdgcn_s_barrier(); asm volatile("" ::: "memory"); } while (0)
    const int nt = kt1 - kt0;
    AT_LOADK(kt0); AT_LOADV(kt0); AT_STOREK(0); AT_STOREV(0);
    if (nt > 1) { AT_LOADK(kt0 + 1); AT_LOADV(kt0 + 1); }
    AT_BAR();
    f32x16 negm;
    {
        f32x16 S0, S1;
#pragma unroll
        for (int r = 0; r < 16; ++r) { S0[r] = 0.f; S1[r] = 0.f; }
        AT_QK(S0, S1, 0);
        float mx = fmaxf(S0[0], S1[0]);
#pragma unroll
        for (int r = 1; r < 16; ++r) mx = fmaxf(fmaxf(mx, S0[r]), S1[r]);
        { auto rr = __builtin_amdgcn_permlane32_swap(__builtin_bit_cast(unsigned, mx), __builtin_bit_cast(unsigned, mx), false, false);
          mx = fmaxf(__builtin_bit_cast(float, rr[0]), __builtin_bit_cast(float, rr[1])); }
#pragma unroll
        for (int r = 0; r < 16; ++r) negm[r] = -mx;
    }
    constexpr float THR = 8.f;
    for (int i = 0; i < nt; ++i) {
        const int cur = i & 1;
        bf16x8 kf[8];
        { LAS unsigned char* kp = lds + cur * AT_KBYTES + n * AT_KSTR + (c * 8 + gq) * 16;
#pragma unroll
          for (int s = 0; s < 4; ++s) { kf[2 * s] = *(LAS bf16x8*)(kp + s * 32); kf[2 * s + 1] = *(LAS bf16x8*)(kp + 32 * AT_KSTR + s * 32); } }
        LAS unsigned char* vp = lds + 2 * AT_KBYTES + cur * AT_VBYTES + n * AT_VSTR + gq * 16;
        bf16x8 va[8];
#pragma unroll
        for (int ks = 0; ks < 2; ++ks)
#pragma unroll
            for (int e = 0; e < 4; ++e) va[ks * 4 + e] = *(LAS bf16x8*)(vp + e * 32 * AT_VSTR + ks * 32);
        __builtin_amdgcn_sched_barrier(0);
        f32x16 S0 = negm, S1 = negm;
#pragma unroll
        for (int s = 0; s < 4; ++s) {
            S0 = __builtin_amdgcn_mfma_f32_32x32x16_bf16(kf[2 * s], qf[s], S0, 0, 0, 0);
            S1 = __builtin_amdgcn_mfma_f32_32x32x16_bf16(kf[2 * s + 1], qf[s], S1, 0, 0, 0);
        }
        __builtin_amdgcn_sched_barrier(0);
        bf16x8 vb[8];
#pragma unroll
        for (int ks = 0; ks < 2; ++ks)
#pragma unroll
            for (int e = 0; e < 4; ++e) vb[ks * 4 + e] = *(LAS bf16x8*)(vp + e * 32 * AT_VSTR + (ks + 2) * 32);
        if (i + 1 < nt) { AT_STOREK(cur ^ 1); AT_STOREV(cur ^ 1); }
        if (i + 2 < nt) { AT_LOADK(kt0 + i + 2); AT_LOADV(kt0 + i + 2); }
        __builtin_amdgcn_sched_barrier(0);
        float mx = fmaxf(S0[0], S1[0]);
#pragma unroll
        for (int r = 1; r < 16; ++r) mx = fmaxf(fmaxf(mx, S0[r]), S1[r]);
        { auto rr = __builtin_amdgcn_permlane32_swap(__builtin_bit_cast(unsigned, mx), __builtin_bit_cast(unsigned, mx), false, false);
          mx = fmaxf(__builtin_bit_cast(float, rr[0]), __builtin_bit_cast(float, rr[1])); }
        if (__builtin_amdgcn_ballot_w64(mx > THR) != 0ull) {
            const float delta = fmaxf(mx, 0.f), alpha = ex2(-delta);
            l *= alpha;
#pragma unroll
            for (int r = 0; r < 16; ++r) { S0[r] -= delta; S1[r] -= delta; negm[r] -= delta; }
#pragma unroll
            for (int e = 0; e < 4; ++e) O[e] = O[e] * alpha;
        }
        float ps = 0.f;
#pragma unroll
        for (int r = 0; r < 16; ++r) { S0[r] = ex2(S0[r]); S1[r] = ex2(S1[r]); ps += S0[r] + S1[r]; }
        l += ps;
        bf16x8 pb[4];
#pragma unroll
        for (int s = 0; s < 2; ++s) {
            u32x4 pw;
            pw.x = pk2(S0[8 * s + 0], S0[8 * s + 1]); pw.y = pk2(S0[8 * s + 2], S0[8 * s + 3]); pw.z = pk2(S0[8 * s + 4], S0[8 * s + 5]); pw.w = pk2(S0[8 * s + 6], S0[8 * s + 7]);
            pb[s] = __builtin_bit_cast(bf16x8, pw);
            pw.x = pk2(S1[8 * s + 0], S1[8 * s + 1]); pw.y = pk2(S1[8 * s + 2], S1[8 * s + 3]); pw.z = pk2(S1[8 * s + 4], S1[8 * s + 5]); pw.w = pk2(S1[8 * s + 6], S1[8 * s + 7]);
            pb[2 + s] = __builtin_bit_cast(bf16x8, pw);
        }
        __builtin_amdgcn_sched_barrier(0);
#pragma unroll
        for (int ks = 0; ks < 2; ++ks)
#pragma unroll
            for (int e = 0; e < 4; ++e) {
                O[e] = __builtin_amdgcn_mfma_f32_32x32x16_bf16(va[ks * 4 + e], pb[ks], O[e], 0, 0, 0);
            }
#pragma unroll
        for (int ks = 0; ks < 2; ++ks)
#pragma unroll
            for (int e = 0; e < 4; ++e) {
                O[e] = __builtin_amdgcn_mfma_f32_32x32x16_bf16(vb[ks * 4 + e], pb[2 + ks], O[e], 0, 0, 0);
            }
        AT_BAR();
    }
#undef AT_BAR
#undef AT_KROW0
#undef AT_LOADK
#undef AT_LOADV
#undef AT_STOREK
#undef AT_STOREV
#undef AT_QK
    l += shx(l, 32, lane);
    const float inv = 1.f / l;
    LAS float* xch = (LAS float*)lds;
    if (c == 1) {
#pragma unroll
        for (int e = 0; e < 4; ++e)
#pragma unroll
            for (int r = 0; r < 16; ++r) xch[(g * 64 + e * 16 + r) * 64 + lane] = O[e][r] * inv;
    }
    __syncthreads();
    if (c == 0) {
        float ss = 0.f;
#pragma unroll
        for (int e = 0; e < 4; ++e)
#pragma unroll
            for (int r = 0; r < 16; ++r) { const float o = O[e][r] * inv - lam * xch[(g * 64 + e * 16 + r) * 64 + lane]; O[e][r] = o; ss += o * o; }
        ss += shx(ss, 32, lane);
        const float rs = post / sqrtf(ss * (1.f / 128.f) + EPS);
        bf16_t* op = oda + (size_t)(qrow0 + 32 * g + n) * 512 + h * 128;
#pragma unroll
        for (int e = 0; e < 4; ++e)
#pragma unroll
            for (int r4 = 0; r4 < 4; ++r4) {
                const int e0 = e * 32 + 8 * r4 + 4 * gq;
                const f32x4 gv = *(const f32x4*)(gain + e0);
                u32x2 w; w.x = pk2(O[e][4 * r4 + 0] * rs * gv[0], O[e][4 * r4 + 1] * rs * gv[1]); w.y = pk2(O[e][4 * r4 + 2] * rs * gv[2], O[e][4 * r4 + 3] * rs * gv[3]);
                *(u32x2*)(op + e0) = w;
            }
    }
    __syncthreads();
}
#define XB_TMO      128
#define XB_XCNT(j)  (256  + 64 * (j))
#define XB_XSUB(j)  (1280 + 64 * (j))
#define XB_XGEN(j)  (2304 + 64 * (j))
#define XB_TOP      3328
#define XB_TOPGEN   3392
#define XCD_BAR_WORDS 3456
#define XB_SPIN_CAP (1u << 18)

__device__ __forceinline__ unsigned xb_ld(unsigned* p)              { return __hip_atomic_load(p, __ATOMIC_RELAXED, __HIP_MEMORY_SCOPE_AGENT); }
__device__ __forceinline__ unsigned xb_add(unsigned* p, unsigned v) { return __hip_atomic_fetch_add(p, v, __ATOMIC_RELAXED, __HIP_MEMORY_SCOPE_AGENT); }
__device__ __forceinline__ unsigned xb_xcc_id() { return (unsigned)__builtin_amdgcn_s_getreg((3 << 11) | 20) & 0xFu; }
#define XB_SPIN(cond, bar) do { unsigned _sp = 0; while (cond) { __builtin_amdgcn_s_sleep(1); \
    if ((++_sp & 255u) == 0u) { if (xb_ld(&(bar)[XB_TMO])) break; if (_sp > XB_SPIN_CAP) { atomicAdd(&(bar)[XB_TMO], 1u); break; } } } } while (0)

struct XcdBarrier {
    unsigned* bar; unsigned x;
    volatile LAS unsigned* st;
};

__device__ __forceinline__ XcdBarrier xcd_barrier_post(unsigned* bar, volatile LAS unsigned* st, int tid_in) {
    XcdBarrier b; b.bar = bar; b.x = xb_xcc_id(); b.st = st;
    if (tid_in == 0) (void)xb_add(&bar[XB_XCNT(b.x)], 1u);
    return b;
}
__device__ __forceinline__ void xcd_barrier_complete(unsigned* bar, unsigned x, unsigned& nloc, unsigned& nx) {
    const unsigned G = gridDim.x * gridDim.y * gridDim.z;
    unsigned sum, cnt, mine, sp = 0u;
    for (;;) {
        sum = 0u; cnt = 0u; mine = 0u;
#pragma unroll
        for (unsigned j = 0; j < 16; ++j) { const unsigned c = xb_ld(&bar[XB_XCNT(j)]); sum += c; cnt += (c > 0u) ? 1u : 0u; mine = (j == x) ? c : mine; }
        if (sum == G) break;
        __builtin_amdgcn_s_sleep(1);
        if ((++sp & 255u) == 0u) { if (xb_ld(&bar[XB_TMO])) break; if (sp > XB_SPIN_CAP) { atomicAdd(&bar[XB_TMO], 1u); break; } }
    }
    nloc = mine > 0u ? mine : 1u; nx = cnt > 0u ? cnt : 1u;
}

__device__ __forceinline__ void xcd_barrier(const XcdBarrier& b, int tid_in) {
    asm volatile("s_waitcnt vmcnt(0)" ::: "memory");
    __syncthreads();
    if (tid_in == 0) {
        unsigned* bar = b.bar;
        __builtin_amdgcn_s_waitcnt(0);
        unsigned nloc = b.st[0], nx = b.st[1];
        if (nloc == 0u) { xcd_barrier_complete(bar, b.x, nloc, nx); b.st[0] = nloc; b.st[1] = nx; }
        const unsigned old = xb_add(&bar[XB_XSUB(b.x)], 1u);
        const unsigned gen = old / nloc;
        if (old + 1u == (gen + 1u) * nloc) {
            __builtin_amdgcn_fence(__ATOMIC_RELEASE, "agent");
            asm volatile("s_waitcnt vmcnt(0)" ::: "memory");
            const unsigned og = xb_add(&bar[XB_TOP], 1u);
            const unsigned tg = og / nx;
            if (og + 1u == (tg + 1u) * nx) xb_add(&bar[XB_TOPGEN], 1u);
            else XB_SPIN(xb_ld(&bar[XB_TOPGEN]) == tg, bar);
            __builtin_amdgcn_fence(__ATOMIC_ACQUIRE, "agent");
            xb_add(&bar[XB_XGEN(b.x)], 1u);
            asm volatile("s_waitcnt vmcnt(0)" ::: "memory");
        } else {
            XB_SPIN(xb_ld(&bar[XB_XGEN(b.x)]) == gen, bar);
            __builtin_amdgcn_fence(__ATOMIC_ACQUIRE, "agent");
            asm volatile("s_waitcnt vmcnt(0)" ::: "memory");
        }
    }
    __syncthreads();
}


struct Args { const float* in[30]; float* out; unsigned char* ws; };
typedef const Args __attribute__((address_space(4))) Args_c;
__device__ __forceinline__ Args_c* kargs_ptr() { Args_c* p = (Args_c*)__builtin_amdgcn_kernarg_segment_ptr(); asm volatile("" : "+s"(p)); return p; }
#define GSYNC_CG() cg::this_grid().sync()
constexpr size_t WS_BAR = WS_END + 4096;
constexpr size_t WS_TOTAL = WS_BAR + (size_t)XCD_BAR_WORDS * 4;
static_assert(WS_TOTAL <= (size_t)512 * 1024 * 1024, "workspace");
constexpr int LDS_BARST = LDS_BYTES - 16;
#define GSYNC() do { XcdBarrier xb_; xb_.bar = (unsigned*)(kargs_ptr()->ws + WS_BAR); xb_.x = xb_xcc_id(); xb_.st = (volatile LAS unsigned*)(lds + LDS_BARST); xcd_barrier(xb_, TIDX()); } while (0)
#ifdef PROBE_A
#define TS(cat) do { if (blockIdx.x == 0 && TIDX() == 0) { unsigned long long* tsb = (unsigned long long*)(kargs_ptr()->ws + WS_END); const unsigned long long now = __builtin_amdgcn_s_memrealtime(); tsb[1 + (cat)] += now - tsb[0]; tsb[0] = now; } } while (0)
#else
#define TS(cat) do {} while (0)
#endif
__device__ __forceinline__ int tid_from(int wave_s) { int w_ = wave_s; unsigned z_ = 0u; asm volatile("" : "+s"(w_), "+s"(z_)); return w_ * 64 + (int)__builtin_amdgcn_mbcnt_hi(~0u, __builtin_amdgcn_mbcnt_lo(~0u, z_)); }
#define TIDX() tid_from(wave_s)
#define KA() int tid = TIDX(); asm volatile("" : "+v"(tid)); int G = gridDim.x, bid = blockIdx.x; asm volatile("" : "+s"(G), "+s"(bid)); \
    const int lane = tid & 63, wave = __builtin_amdgcn_readfirstlane(tid >> 6), gw = bid * 8 + wave, ngw = G * 8, gtid = bid * NTHR + tid, ngt = G * NTHR; \
    (void)lane; (void)wave; (void)gw; (void)ngw; (void)gtid; (void)ngt; \
    Args_c* ka = kargs_ptr(); unsigned char* ws = ka->ws; (void)ws

__global__ void __launch_bounds__(NTHR, 2) fwd_kernel(Args a_unused) {
    extern __shared__ __attribute__((aligned(16))) unsigned char lds_raw[];
    LAS unsigned char* lds = (LAS unsigned char*)lds_raw;
    const int wave_s = __builtin_amdgcn_readfirstlane((int)threadIdx.x >> 6);
    if (TIDX() < 4) ((volatile LAS unsigned*)(lds + LDS_BARST))[TIDX()] = 0u;
    __syncthreads();
    (void)xcd_barrier_post((unsigned*)(kargs_ptr()->ws + WS_BAR), (volatile LAS unsigned*)(lds + LDS_BARST), TIDX());
#ifdef PROBE_A
    if (blockIdx.x == 0 && TIDX() == 0) { unsigned long long* tsb = (unsigned long long*)(kargs_ptr()->ws + WS_END); for (int i = 1; i < 32; ++i) tsb[i] = 0; tsb[0] = __builtin_amdgcn_s_memrealtime(); }
#endif

#ifdef REP_INIT
#pragma unroll 1
    for (int rep_ = 0; rep_ < 2; ++rep_) {
#else
    {
#endif
    {
        KA();
        bf16_t* WB = (bf16_t*)(ws + WS_WB);
        LAS float* scr = (LAS float*)(lds + wave * 8448);
        constexpr int IT_L = 12416;
        for (int it = gw; it < 2 * IT_L; it += ngw) {
            const int l = it / IT_L; int r = it % IT_L;
            bf16_t* Wl = WB + (size_t)l * WL_TOTAL;
            if (r < 1408) { transpose_item(ka->in[9] + (size_t)l * 1024 * DFF, 1024, DFF, Wl + WL_UP1, 1, scr, r, lane); continue; } r -= 1408;
            if (r < 1408) { transpose_item(ka->in[10] + (size_t)l * 1024 * DFF, 1024, DFF, Wl + WL_UP1, 2, scr, r, lane); continue; } r -= 1408;
            if (r < 1408) { transpose_item(ka->in[11] + (size_t)l * DFF * 1024, DFF, 1024, Wl + WL_DN1, 0, scr, r, lane); continue; } r -= 1408;
            if (r < 1408) { transpose_item(ka->in[12] + (size_t)l * 1024 * DFF, 1024, DFF, Wl + WL_UP2, 1, scr, r, lane); continue; } r -= 1408;
            if (r < 1408) { transpose_item(ka->in[13] + (size_t)l * 1024 * DFF, 1024, DFF, Wl + WL_UP2, 2, scr, r, lane); continue; } r -= 1408;
            if (r < 1408) { transpose_item(ka->in[14] + (size_t)l * DFF * 1024, DFF, 1024, Wl + WL_DN2, 0, scr, r, lane); continue; } r -= 1408;
            if (r < 3072) { transpose_item(ka->in[15] + (size_t)l * 1024 * 6144, 1024, 6144, Wl + WL_IN, 3, scr, r, lane); continue; } r -= 3072;
            if (r < 256) { transpose_item(ka->in[25] + (size_t)l * 512 * 1024, 512, 1024, Wl + WL_PA, 0, scr, r, lane); continue; } r -= 256;
            if (r < 128) { transpose_item(ka->in[26] + (size_t)l * 256 * 1024, 256, 1024, Wl + WL_PH, 0, scr, r, lane); continue; } r -= 128;
            transpose_item(ka->in[28] + (size_t)l * 1024 * 1024, 1024, 1024, Wl + WL_O, 0, scr, r, lane);
        }
        __syncthreads();
    }
    {
        KA();
        float* MOD = (float*)(ws + WS_MOD);
        LAS float* sv = (LAS float*)lds;
        LAS float* part = (LAS float*)(lds + 12288);
        for (int i = tid; i < 3072; i += NTHR) { const int seg = i >> 10, k = i & 1023; const float x = (seg < 2) ? ka->in[1][seg * 1024 + k] : ka->in[3][k]; sv[i] = x / (1.f + __expf(-x)); }
        __syncthreads();
        for (int item = bid; item < 288; item += G) {
            const int l = item / 144, col = (item % 144) * 64 + lane;
            const float* W = ka->in[4] + (size_t)l * 1024 * 9216 + col;
            float a0 = 0.f, a1 = 0.f, a2 = 0.f;
            for (int k = wave * 128; k < wave * 128 + 128; ++k) { const float w = W[(size_t)k * 9216]; a0 = __builtin_fmaf(sv[k], w, a0); a1 = __builtin_fmaf(sv[1024 + k], w, a1); a2 = __builtin_fmaf(sv[2048 + k], w, a2); }
            part[(wave * 3 + 0) * 64 + lane] = a0; part[(wave * 3 + 1) * 64 + lane] = a1; part[(wave * 3 + 2) * 64 + lane] = a2;
            __syncthreads();
            if (tid < 192) { const int seg = tid >> 6, cl = tid & 63; float s = 0.f;
#pragma unroll
                for (int w = 0; w < 8; ++w) s += part[(w * 3 + seg) * 64 + cl];
                const int cc = (item % 144) * 64 + cl;
                MOD[(size_t)(l * 3 + seg) * 9216 + cc] = s + ka->in[5][l * 9216 + cc]; }
            __syncthreads();
        }
    }
    {
        KA();
        bf16_t* WB = (bf16_t*)(ws + WS_WB); float* CS = (float*)(ws + WS_CS); float* LBT = (float*)(ws + WS_LB); float* LAMV = (float*)(ws + WS_LAM);
        for (int idx = gtid; idx < 2 * 256 * 1024; idx += ngt) {
            const int n = idx & 1023, k = (idx >> 10) & 255, l = idx >> 18, g = k >> 6, c = k & 63;
            const float* pw = ka->in[23] + (size_t)l * 4 * 64 * 64 + (g * 64 + c) * 64;
            const float* psc = ka->in[24] + l * 256 + g * 64;
            const float* wp = ka->in[27] + (size_t)l * 256 * 1024 + (size_t)(g * 64) * 1024 + n;
            float s = 0.f;
            for (int d = 0; d < 64; ++d) s = __builtin_fmaf(pw[d] * psc[d], wp[(size_t)d * 1024], s);
            (WB + (size_t)l * WL_TOTAL + WL_PP)[(size_t)n * 256 + k] = (bf16_t)(pk2(s, 0.f) & 0xffffu);
        }
        for (int idx = gtid; idx < 4096; idx += ngt) {
            const int n = idx >> 4, j = idx & 15;
            const float invf = __builtin_exp2f(-(float)j * (13.287712379549449f / 16.f));
            const float ang = (float)n * invf;
            const double rev = (double)ang * 0.15915494309189535; const float fr = (float)(rev - __builtin_floor(rev));
            CS[n * 32 + j] = __builtin_amdgcn_cosf(fr); CS[n * 32 + 16 + j] = __builtin_amdgcn_sinf(fr);
        }
        for (int idx = gtid; idx < 1024; idx += ngt) {
            const int l = idx >> 9, dc = idx & 511;
            const float l0 = ka->in[21][dc], l1 = ka->in[21][512 + dc];
            LBT[idx] = (l == 0) ? 0.f : 1.f / (1.f + __expf(l0 - l1));
        }
        for (int idx = gtid; idx < NCTX * DM / 4; idx += ngt) ((f32x4*)(ws + WS_HC))[idx] = ((const f32x4*)ka->in[2])[idx];
        if (gtid < 2) {
            const int l = gtid; float s1 = 0.f, s2 = 0.f;
            for (int i = 0; i < 64; ++i) { s1 += ka->in[16][l * 64 + i] * ka->in[17][l * 64 + i]; s2 += ka->in[18][l * 64 + i] * ka->in[19][l * 64 + i]; }
            const float li = (l == 0) ? 0.2f : (0.8f - 0.6f * 0.7408182206817179f);
            LAMV[l * 2 + 0] = __expf(s1) - __expf(s2) + li; LAMV[l * 2 + 1] = 1.f - li;
        }
    }
    }
    GSYNC_CG();
    TS(0);

#pragma unroll 1
    for (int l = 0; l < 2; ++l) {
#ifdef REP_SYNC
#pragma unroll 1
        for (int rs_ = 0; rs_ < 10; ++rs_) { GSYNC(); }
#endif
#pragma unroll 1
        for (int f = 0; f < 2; ++f) {
            {   KA(); const bool first = (l == 0 && f == 0);
                const float* in_lat = first ? ka->in[0] : ka->out; const float* in_ctx = (const float*)(ws + WS_HC);
                norm_phase(in_lat, in_ctx, ka->in[f ? 8 : 6] + l * 1024, (const float*)(ws + WS_MOD) + (size_t)l * 3 * 9216, f ? 6 : 0, f ? 7 : 1, (bf16_t*)(ws + WS_XB), gw, ngw, lane,
                           (const float*)(ws + WS_O), first ? 0 : (f ? 4 : DFF / 256), (float*)(ws + WS_HC)); }
            GSYNC();
            TS(1);
            {   KA(); bf16_t* Wl = (bf16_t*)(ws + WS_WB) + (size_t)l * WL_TOTAL;
                pg8::Gemm g{(bf16_t*)(ws + WS_XB), Wl + (f ? WL_UP2 : WL_UP1), R, 5632, 1024}; pg8::StaticOrder S; S.init(R, 5632, G, bid); EpiUp E{(bf16_t*)(ws + WS_Z)};
                pg8::gemm_phase<EpiUp, pg8::StaticOrder, true, true>(lds, g, S, E, tid); }
            GSYNC();
            TS(2);
            {   KA(); bf16_t* Wl = (bf16_t*)(ws + WS_WB) + (size_t)l * WL_TOTAL; const bool first = (l == 0 && f == 0);
                const float* in_lat = first ? ka->in[0] : ka->out;
                pg8::Gemm g{(bf16_t*)(ws + WS_Z), Wl + (f ? WL_DN2 : WL_DN1), NLAT, 1024, DFF}; pg8::StaticOrder S; S.init(NLAT, 1024, G, bid);
                EpiRes E{in_lat, (const float*)(ws + WS_HC), ka->out, (float*)(ws + WS_HC), (const float*)(ws + WS_MOD) + (size_t)l * 3 * 9216 + (f ? 8 : 2) * 1024, 0.5f};
                pg8::gemm_phase<EpiRes, pg8::StaticOrder, true, true>(lds, g, S, E, tid); }
            {   KA(); bf16_t* Wl = (bf16_t*)(ws + WS_WB) + (size_t)l * WL_TOTAL;
                pg8::Gemm g{(bf16_t*)(ws + WS_Z) + (size_t)NLAT * DFF, Wl + (f ? WL_DN2 : WL_DN1), NCTX, 1024, 256, DFF}; SplitKOrder S; S.init(DFF / 256, 256, G, bid);
                EpiPart E{(float*)(ws + WS_O), (const float*)(ws + WS_MOD) + (size_t)l * 3 * 9216 + (f ? 8 : 2) * 1024, 0.5f};
                pg8::gemm_phase<EpiPart, SplitKOrder, true, true>(lds, g, S, E, tid); }
            GSYNC();
            TS(3);
            if (f == 1) break;
            {   KA();
                norm_phase(ka->out, (const float*)(ws + WS_HC), ka->in[7] + l * 1024, (const float*)(ws + WS_MOD) + (size_t)l * 3 * 9216, 3, 4, (bf16_t*)(ws + WS_XB), gw, ngw, lane,
                           (const float*)(ws + WS_O), DFF / 256, (float*)(ws + WS_HC)); }
            GSYNC();
            TS(1);
            {   KA(); bf16_t* Wl = (bf16_t*)(ws + WS_WB) + (size_t)l * WL_TOTAL;
                pg8::Gemm g{(bf16_t*)(ws + WS_XB), Wl + WL_IN, R, 3072, 1024}; pg8::StaticOrder S; S.init(R, 3072, G, bid);
                EpiWin E{ws + WS_Z, (const float*)(ws + WS_CS), (const float*)(ws + WS_LB) + l * 512, 0};
                pg8::gemm_phase<EpiWin, pg8::StaticOrder, true, true>(lds, g, S, E, tid); }
            GSYNC();
            TS(4);
            {   KA(); pool_phase((const bf16_t*)(ws + WS_Z + Z_ZP), (bf16_t*)(ws + WS_O + O_MX), gtid, ngt); }
#ifdef REP_ATTN
            for (int rep_ = 0; rep_ < 2; ++rep_)
#endif
            {   KA();
                const float* LAMV = (const float*)(ws + WS_LAM);
                const int nunits = 1024 + (l == 0 ? 16 : 0);
                for (int u = bid; u < nunits; u += G) {
                    int bh, qrow0, kt0, kt1;
                    if (u < 1024) { bh = u >> 7; qrow0 = (bh >> 2) * SEQ + (u & 127) * 128; kt0 = 0; kt1 = KEYS / 64; }
                    else { const int v = u - 1024; bh = v >> 1; qrow0 = NLAT + (bh >> 2) * CTXL + (v & 1) * 128; kt0 = SEQ / 64; kt1 = KEYS / 64; }
                    attn_unit(lds, (const bf16_t*)(ws + WS_Z + Z_Q), (const bf16_t*)(ws + WS_Z + Z_K), (const bf16_t*)(ws + WS_Z + Z_VT), (bf16_t*)(ws + WS_O + O_DA), ka->in[20] + l * 128,
                              bh >> 2, bh & 3, qrow0, kt0, kt1, LAMV[l * 2], LAMV[l * 2 + 1], tid, wave, lane);
                }
            }
            GSYNC();
            TS(5);
#ifdef REP_HG
#pragma unroll 1
            for (int rep_ = 0; rep_ < 2; ++rep_) {
#else
            {
#endif
            {   KA(); hg_passA_mfma(lds, (const float*)(ws + WS_Z + Z_FF), (const float*)(ws + WS_Z + Z_FB), (const bf16_t*)(ws + WS_Z + Z_HI),
                                      (float*)(ws + WS_CAR), (float*)(ws + WS_DK), wave, lane, G); }
            GSYNC();
            TS(6);
            {   KA(); hg_carry((float*)(ws + WS_CAR), (const float*)(ws + WS_DK), gtid, ngt); }
            GSYNC();
            TS(7);
            {   KA(); hg_passB_mfma(lds, (const float*)(ws + WS_Z + Z_HQ), (const float*)(ws + WS_Z + Z_FF), (const float*)(ws + WS_Z + Z_FB), (const bf16_t*)(ws + WS_Z + Z_HI),
                                      (const float*)(ws + WS_CAR), (bf16_t*)(ws + WS_Z + Z_K), wave, lane, G); }
            GSYNC();
            TS(8);
            {   KA(); hg_readout((const bf16_t*)(ws + WS_Z + Z_K), (const bf16_t*)(ws + WS_Z + Z_HG), ka->in[22] + l * 64, (bf16_t*)(ws + WS_O + O_HG), gw, ngw, lane); }
            GSYNC();
            TS(9);
            }
            {   KA(); bf16_t* Wl = (bf16_t*)(ws + WS_WB) + (size_t)l * WL_TOTAL;
                pg8::Gemm g{(bf16_t*)(ws + WS_XB), Wl + WL_IN + (size_t)3072 * 1024, R, 3072, 1024}; pg8::StaticOrder S; S.init(R, 3072, G, bid); EpiG E{(bf16_t*)(ws + WS_Z)};
                pg8::gemm_phase<EpiG, pg8::StaticOrder, true, true>(lds, g, S, E, tid); }
            GSYNC();
            TS(10);
#pragma unroll 1
            for (int gi = 0; gi < 3; ++gi) {
                KA(); bf16_t* Wl = (bf16_t*)(ws + WS_WB) + (size_t)l * WL_TOTAL;
                const bf16_t* A = (const bf16_t*)(ws + WS_O + ((gi == 0) ? O_DA : (gi == 1 ? O_HG : O_MX))); const int K = (gi == 0) ? 512 : 256;
                const bf16_t* Bt = Wl + ((gi == 0) ? WL_PA : (gi == 1 ? WL_PH : WL_PP));
                pg8::Gemm g{A, Bt, R, 1024, K}; pg8::StaticOrder S; S.init(R, 1024, G, bid); EpiProj E{(bf16_t*)(ws + WS_XB), (const bf16_t*)(ws + WS_Z), gi, gi == 0};
                pg8::gemm_phase<EpiProj, pg8::StaticOrder, true, true>(lds, g, S, E, tid);
            }
            GSYNC();
            TS(11);
            {   KA(); bf16_t* Wl = (bf16_t*)(ws + WS_WB) + (size_t)l * WL_TOTAL;
                pg8::Gemm g{(bf16_t*)(ws + WS_XB), Wl + WL_O, NLAT, 1024, 1024}; pg8::StaticOrder S; S.init(NLAT, 1024, G, bid);
                EpiRes E{ka->out, (const float*)(ws + WS_HC), ka->out, (float*)(ws + WS_HC), (const float*)(ws + WS_MOD) + (size_t)l * 3 * 9216 + 5 * 1024, 1.0f};
                pg8::gemm_phase<EpiRes, pg8::StaticOrder, true, true>(lds, g, S, E, tid); }
            {   KA(); bf16_t* Wl = (bf16_t*)(ws + WS_WB) + (size_t)l * WL_TOTAL;
                pg8::Gemm g{(bf16_t*)(ws + WS_XB) + (size_t)NLAT * 1024, Wl + WL_O, NCTX, 1024, 256, 1024}; SplitKOrder S; S.init(4, 256, G, bid);
                EpiPart E{(float*)(ws + WS_O), (const float*)(ws + WS_MOD) + (size_t)l * 3 * 9216 + 5 * 1024, 1.0f};
                pg8::gemm_phase<EpiPart, SplitKOrder, true, true>(lds, g, S, E, tid); }
            GSYNC();
            TS(12);
        }
    }
    {   KA(); final_norm_phase(ka->out, ka->in[29], gw, ngw, lane); }
#ifdef PROBE_A
    GSYNC(); TS(1);
    if (blockIdx.x == 0) { KA(); const unsigned long long* tsb = (const unsigned long long*)(ws + WS_END);
        __syncthreads();
        const float va = (float)tsb[1 + PROBE_A] * 0.01f, vb = (float)tsb[1 + PROBE_B] * 0.01f;
        __syncthreads();
        if (tid == 0) ka->out[0] += va;
        for (int i = tid; i < 65536; i += NTHR) ka->out[(size_t)(i / 1024 + 8) * 1024 + (i & 1023)] += vb; }
#endif
}

extern "C" void kernel_launch(void* const* d_in, const int* in_sizes, int n_in, void* d_out, int out_size, void* d_ws, size_t ws_size, hipStream_t stream) {
    static int grid = 0;
    if (grid == 0) {
        if (n_in != 30 || out_size != NLAT * DM || ws_size < WS_TOTAL) { fprintf(stderr, "kernel_launch: unexpected shapes (n_in %d out %d ws %zu need %zu)\n", n_in, out_size, ws_size, (size_t)WS_TOTAL); grid = -1; return; }
        int dev = 0, cus = 0, per_cu = 0;
        (void)hipGetDevice(&dev);
        (void)hipDeviceGetAttribute(&cus, hipDeviceAttributeMultiprocessorCount, dev);
        if (hipFuncSetAttribute((const void*)fwd_kernel, hipFuncAttributeMaxDynamicSharedMemorySize, LDS_BYTES) != hipSuccess) { fprintf(stderr, "kernel_launch: hipFuncSetAttribute failed\n"); grid = -1; return; }
        if (hipOccupancyMaxActiveBlocksPerMultiprocessor(&per_cu, (const void*)fwd_kernel, NTHR, LDS_BYTES) != hipSuccess || per_cu < 1) { fprintf(stderr, "kernel_launch: occupancy query failed (%d)\n", per_cu); (void)hipGetLastError(); per_cu = 1; }
        if (per_cu > 1) per_cu = 1;
        grid = cus * per_cu;
    }
    if (grid < 0) return;
    if (hipMemsetAsync((unsigned char*)d_ws + WS_BAR, 0, (size_t)XCD_BAR_WORDS * 4, stream) != hipSuccess) { fprintf(stderr, "kernel_launch: memset failed\n"); return; }
    Args a{};
    for (int i = 0; i < 30; ++i) a.in[i] = (const float*)d_in[i];
    a.out = (float*)d_out; a.ws = (unsigned char*)d_ws;
    void* args[] = {&a};
    hipError_t e = hipLaunchCooperativeKernel((const void*)fwd_kernel, dim3(grid), dim3(NTHR), args, LDS_BYTES, stream);
    if (e != hipSuccess) fprintf(stderr, "cooperative launch failed: %s (grid %d)\n", hipGetErrorString(e), grid);
}
```

```cpp
#include <hip/hip_runtime.h>
#include <hip/hip_cooperative_groups.h>
#include <cstdio>
#include <cstdint>
namespace cg = cooperative_groups;
namespace pg8 {
#define PG8_LAS __attribute__((address_space(3)))
typedef unsigned short bf16_t;
typedef short bf16x8 __attribute__((ext_vector_type(8)));
typedef float f32x4 __attribute__((ext_vector_type(4)));
typedef unsigned u32x4 __attribute__((ext_vector_type(4)));
constexpr int BM = 256, BK = 64, HALF = 128, HTB = HALF * BK * 2  , STAGE_BYTES = 8 * HTB, NXCD = 8, WGM = 8;

__host__ __device__ __forceinline__ int lds_byte(int r, int c) { const int st = (r >> 4) * 2 + (c >> 5), rr = r & 15, cc = c & 31, ob = rr * 64 + cc * 2; return st * 1024 + (ob ^ (((ob >> 9) & 1) << 5)); }
__host__ __device__ __forceinline__ void stage_rc(int b, int& R, int& C) { const int st = b / 1024, sb = b % 1024, swz = sb ^ (((sb >> 9) & 1) << 5); R = (st >> 1) * 16 + swz / 64; C = (st & 1) * 32 + (swz % 64) / 2; }
__host__ __device__ __forceinline__ int perm32(int rho) { const int n = rho >> 4, i = rho & 15; return 8 * (i >> 2) + 4 * n + (i & 3); }

struct Unit { int pm, pn; int koff = 0; };
struct Gemm { const bf16_t* A; const bf16_t* Bt; int M, N, K; int ld = 0; };

struct StaticOrder {
    int nM, nN, nwg, G, c;
    __host__ __device__ void init(int M, int N, int G_, int c_) { nM = M / BM; nN = N / BM; nwg = nM * nN; G = G_; c = c_; }
    __host__ __device__ bool next(int i, Unit& u) const {
        const long L = (long)i * G + c; if (L >= nwg) return false;
        int wgid = (int)L; { const int q = nwg / NXCD, r = nwg % NXCD, xcd = wgid % NXCD, off = wgid / NXCD; wgid = (xcd < r ? xcd * (q + 1) : r * (q + 1) + (xcd - r) * q) + off; }
        const int nig = WGM * nN, gid = wgid / nig, fm = gid * WGM, gsz = (nM - fm) < WGM ? (nM - fm) : WGM;
        u.pm = fm + ((wgid % nig) % gsz); u.pn = (wgid % nig) / gsz; u.koff = 0; return true;
    }
    __device__ __forceinline__ void a_ready(const Unit&) const {}
    __device__ __forceinline__ void done(const Unit&) const {}
};

}
namespace pg8 {
template <class Epi, class Sched, bool ALIGN_EPI = false, bool SP2 = false>
__device__ __forceinline__ void gemm_phase(PG8_LAS unsigned char* lds, const Gemm g, const Sched& S, const Epi& E, int tid_in) {
    int tid_ = tid_in; asm volatile("" : "+v"(tid_)); const int tid = tid_, wid = __builtin_amdgcn_readfirstlane(tid >> 6), lane = tid & 63, wr = wid >> 2, wc = wid & 3, fr = lane & 15, fq = lane >> 4;
    const int K = g.ld ? g.ld : g.K, nt = g.K / BK;
    unsigned voffA[2], voffB[2];
#pragma unroll
    for (int i = 0; i < 2; ++i) { int R, C; stage_rc(tid * 16 + i * 8192, R, C); const int Rb = Epi::PERM ? ((R & ~31) + perm32(R & 31)) : R;
        voffA[i] = (unsigned)(R * K + C) * 2u; voffB[i] = (unsigned)(Rb * K + C) * 2u; }
    const size_t kstep = (size_t)(BK * 2);
    const size_t hstep = (size_t)HALF * K * 2;
    const size_t tstep = 2 * hstep;
    const unsigned ldsw = (unsigned)wid * 1024u;
    const int aoff = lds_byte(wr * 64 + fr, fq * 8), boff = lds_byte(wc * 32 + fr, fq * 8);
#define PG8_SA(b, h) (((b) * 2 + (h)) * HTB)
#define PG8_SB(b, h) ((4 + (b) * 2 + (h)) * HTB)
#define PG8_STAGE(bufoff, gbase, voff) do { _Pragma("unroll") for (int _i = 0; _i < 2; ++_i) \
        __builtin_amdgcn_global_load_lds((const unsigned*)((const char*)(gbase) + (voff)[_i]), (PG8_LAS unsigned*)(lds + (bufoff) + ldsw + _i * 8192), 16, 0, 0); } while (0)
#define PG8_LDA(dst, b, h) do { _Pragma("unroll") for (int m = 0; m < 4; ++m) _Pragma("unroll") for (int k = 0; k < 2; ++k) dst[m][k] = *(const PG8_LAS bf16x8*)(lds + PG8_SA(b, h) + aoff + m * 2048 + k * 1024); } while (0)
#define PG8_LDB(dst, b, h) do { _Pragma("unroll") for (int n = 0; n < 2; ++n) _Pragma("unroll") for (int k = 0; k < 2; ++k) dst[n][k] = *(const PG8_LAS bf16x8*)(lds + PG8_SB(b, h) + boff + n * 2048 + k * 1024); } while (0)
#define PG8_MMA(ai, bj, At, Bt) do { __builtin_amdgcn_s_setprio(1); _Pragma("unroll") for (int m = 0; m < 4; ++m) _Pragma("unroll") for (int n = 0; n < 2; ++n) _Pragma("unroll") for (int k = 0; k < 2; ++k) \
        acc[ai][bj][m][n] = __builtin_amdgcn_mfma_f32_16x16x32_bf16(Bt[n][k], At[m][k], acc[ai][bj][m][n], 0, 0, 0); __builtin_amdgcn_s_setprio(0); } while (0)
#define PG8_WAIT_V(n) asm volatile("s_waitcnt vmcnt(" #n ")" ::: "memory")
#define PG8_WAIT_L(n) asm volatile("s_waitcnt lgkmcnt(" #n ")" ::: "memory")
#define PG8_BAR __builtin_amdgcn_s_barrier()
#define PG8_SCHED __builtin_amdgcn_sched_barrier(0)
    Unit cur, nxt; int ui = 0;
    if (!S.next(0, cur)) return;
    f32x4 acc[2][2][4][2];
#pragma unroll
    for (int a = 0; a < 2; ++a)
#pragma unroll
        for (int b = 0; b < 2; ++b)
#pragma unroll
            for (int m = 0; m < 4; ++m)
#pragma unroll
                for (int n = 0; n < 2; ++n) acc[a][b][m][n] = (f32x4){0.f, 0.f, 0.f, 0.f};
    bf16x8 At[4][2], B0[2][2], B1[2][2];
    const char* cA = (const char*)g.A + (size_t)cur.pm * tstep + (size_t)cur.koff * 2; const char* cB = (const char*)g.Bt + (size_t)cur.pn * tstep + (size_t)cur.koff * 2;
    S.a_ready(cur);
    if constexpr (SP2) {
        PG8_STAGE(PG8_SB(0, 0), cB, voffB); PG8_STAGE(PG8_SB(0, 1), cB + hstep, voffB); PG8_STAGE(PG8_SA(0, 0), cA, voffA); PG8_STAGE(PG8_SA(0, 1), cA + hstep, voffA);
        if (wr == 1) PG8_BAR;
        PG8_WAIT_V(2); PG8_BAR;
        PG8_STAGE(PG8_SB(1, 0), cB + kstep, voffB); PG8_STAGE(PG8_SA(1, 0), cA + kstep, voffA); PG8_STAGE(PG8_SB(1, 1), cB + hstep + kstep, voffB);
        PG8_WAIT_V(6); PG8_BAR;
    } else {
        PG8_STAGE(PG8_SB(0, 0), cB, voffB); PG8_STAGE(PG8_SA(0, 0), cA, voffA); PG8_STAGE(PG8_SB(0, 1), cB + hstep, voffB); PG8_STAGE(PG8_SA(0, 1), cA + hstep, voffA);
        if (wr == 1) PG8_BAR;
        PG8_WAIT_V(4); PG8_BAR;
        PG8_STAGE(PG8_SB(1, 0), cB + kstep, voffB); PG8_STAGE(PG8_SA(1, 0), cA + kstep, voffA); PG8_STAGE(PG8_SB(1, 1), cB + hstep + kstep, voffB);
        PG8_WAIT_V(6); PG8_BAR;
    }
    for (;;) {
        const bool has_next = S.next(ui + 1, nxt);
        const char* nA = has_next ? (const char*)g.A + (size_t)nxt.pm * tstep + (size_t)nxt.koff * 2 : cA; const char* nB = has_next ? (const char*)g.Bt + (size_t)nxt.pn * tstep + (size_t)nxt.koff * 2 : cB;
        for (int t = 0; t < nt; t += 2) {
            const bool last = (t == nt - 2);
            const char* a1 = cA + (size_t)(t + 1) * kstep;
            const char* a2 = last ? nA : cA + (size_t)(t + 2) * kstep; const char* b2 = last ? nB : cB + (size_t)(t + 2) * kstep;
            const char* a3 = a2 + kstep; const char* b3 = b2 + kstep;
            if (last && has_next) S.a_ready(nxt);
            if constexpr (SP2) {
            PG8_LDB(B0, 0, 0); PG8_LDB(B1, 0, 1); PG8_SCHED; PG8_LDA(At, 0, 0); PG8_STAGE(PG8_SA(1, 1), a1 + hstep, voffA);
            PG8_WAIT_V(8); PG8_WAIT_L(0); PG8_BAR; PG8_MMA(0, 0, At, B0); PG8_MMA(0, 1, At, B1); PG8_BAR; PG8_SCHED;
            PG8_LDA(At, 0, 1); PG8_STAGE(PG8_SB(0, 0), b2, voffB); PG8_STAGE(PG8_SB(0, 1), b2 + hstep, voffB); PG8_STAGE(PG8_SA(0, 0), a2, voffA);
            PG8_WAIT_V(8); PG8_WAIT_L(0); PG8_BAR; PG8_MMA(1, 0, At, B0); PG8_MMA(1, 1, At, B1); PG8_BAR; PG8_SCHED;
            PG8_LDB(B0, 1, 0); PG8_LDB(B1, 1, 1); PG8_SCHED; PG8_LDA(At, 1, 0); PG8_STAGE(PG8_SA(0, 1), a2 + hstep, voffA);
            PG8_WAIT_V(8); PG8_WAIT_L(0); PG8_BAR; PG8_MMA(0, 0, At, B0); PG8_MMA(0, 1, At, B1); PG8_BAR; PG8_SCHED;
            PG8_LDA(At, 1, 1); PG8_STAGE(PG8_SB(1, 0), b3, voffB); PG8_STAGE(PG8_SB(1, 1), b3 + hstep, voffB); PG8_STAGE(PG8_SA(1, 0), a3, voffA);
            PG8_WAIT_V(8); PG8_WAIT_L(0); PG8_BAR; PG8_MMA(1, 0, At, B0); PG8_MMA(1, 1, At, B1); PG8_BAR; PG8_SCHED;
            } else {
            PG8_LDB(B0, 0, 0); PG8_SCHED; PG8_LDA(At, 0, 0); PG8_STAGE(PG8_SA(1, 1), a1 + hstep, voffA);
            PG8_WAIT_L(8); PG8_BAR; PG8_WAIT_L(0); PG8_MMA(0, 0, At, B0); PG8_BAR; PG8_SCHED;
            PG8_LDB(B1, 0, 1); PG8_STAGE(PG8_SB(0, 0), b2, voffB);
            PG8_BAR; PG8_WAIT_L(0); PG8_MMA(0, 1, At, B1); PG8_BAR;
            PG8_LDA(At, 0, 1); PG8_STAGE(PG8_SA(0, 0), a2, voffA);
            PG8_BAR; PG8_WAIT_L(0); PG8_MMA(1, 0, At, B0); PG8_BAR; PG8_SCHED;
            PG8_STAGE(PG8_SB(0, 1), b2 + hstep, voffB);
            PG8_WAIT_V(6); PG8_BAR; PG8_MMA(1, 1, At, B1); PG8_BAR;
            PG8_LDB(B0, 1, 0); PG8_SCHED; PG8_LDA(At, 1, 0); PG8_STAGE(PG8_SA(0, 1), a2 + hstep, voffA);
            PG8_WAIT_L(8); PG8_BAR; PG8_WAIT_L(0); PG8_MMA(0, 0, At, B0); PG8_BAR; PG8_SCHED;
            PG8_LDB(B1, 1, 1); PG8_STAGE(PG8_SB(1, 0), b3, voffB);
            PG8_BAR; PG8_WAIT_L(0); PG8_MMA(0, 1, At, B1); PG8_BAR;
            PG8_LDA(At, 1, 1); PG8_STAGE(PG8_SA(1, 0), a3, voffA);
            PG8_BAR; PG8_WAIT_L(0); PG8_MMA(1, 0, At, B0); PG8_BAR; PG8_SCHED;
            PG8_STAGE(PG8_SB(1, 1), b3 + hstep, voffB);
            PG8_WAIT_V(6); PG8_BAR; PG8_MMA(1, 1, At, B1); PG8_BAR;
            }
        }
        if constexpr (ALIGN_EPI) { if (wr == 0) PG8_BAR; }
        if constexpr (!Epi::AFTER_DRAIN) { E(acc, cur, wr, wc, fr, fq); S.done(cur); }
        if (!has_next) break;
#pragma unroll
        for (int a = 0; a < 2; ++a)
#pragma unroll
            for (int b = 0; b < 2; ++b)
#pragma unroll
                for (int m = 0; m < 4; ++m)
#pragma unroll
                    for (int n = 0; n < 2; ++n) acc[a][b][m][n] = (f32x4){0.f, 0.f, 0.f, 0.f};
        cur = nxt; cA = nA; cB = nB; ++ui;
        if constexpr (ALIGN_EPI) { if (wr == 1) PG8_BAR; }
    }
    PG8_WAIT_V(0);
    if constexpr (!ALIGN_EPI) { if (wr == 0) PG8_BAR; }
    PG8_BAR;
    if constexpr (Epi::AFTER_DRAIN) { E.fused(acc, cur, wr, wc, fr, fq, lds, wid, lane); S.done(cur); }
#undef PG8_SA
#undef PG8_SB
#undef PG8_STAGE
#undef PG8_LDA
#undef PG8_LDB
#undef PG8_MMA
#undef PG8_WAIT_V
#undef PG8_WAIT_L
#undef PG8_BAR
#undef PG8_SCHED
}
}

using pg8::bf16_t; using pg8::bf16x8; using pg8::f32x4; using pg8::u32x4; using pg8::Unit;
typedef float f32x16 __attribute__((ext_vector_type(16)));
typedef float f32x2v __attribute__((ext_vector_type(2)));
typedef __bf16 bf16x2v __attribute__((ext_vector_type(2)));
typedef unsigned u32x2 __attribute__((ext_vector_type(2)));
#define LAS __attribute__((address_space(3)))

constexpr int DM = 1024, NBATCH = 2, SEQ = 16384, CTXL = 256;
constexpr int NLAT = NBATCH * SEQ, NCTX = NBATCH * CTXL, R = NLAT + NCTX;
constexpr int DFF = 2816, KEYS = SEQ + CTXL;
constexpr float EPS = 1e-6f;
constexpr float C2 = 0.125f * 1.4426950408889634f;
constexpr int NTHR = 512;
constexpr int LDS_BYTES = 135168;
constexpr int HG_SEG = 128, HG_STEPS = KEYS / HG_SEG;

constexpr size_t WL_UP1 = 0, WL_DN1 = WL_UP1 + (size_t)5632 * 1024, WL_UP2 = WL_DN1 + (size_t)1024 * 2816, WL_DN2 = WL_UP2 + (size_t)5632 * 1024,
                 WL_IN = WL_DN2 + (size_t)1024 * 2816, WL_PA = WL_IN + (size_t)6144 * 1024, WL_PH = WL_PA + (size_t)1024 * 512, WL_PP = WL_PH + (size_t)1024 * 256,
                 WL_O = WL_PP + (size_t)1024 * 256, WL_TOTAL = WL_O + (size_t)1024 * 1024;
constexpr size_t WS_WB = 0;
constexpr size_t WS_XB = WS_WB + 2 * WL_TOTAL * 2;
constexpr size_t WS_Z = WS_XB + (size_t)R * 1024 * 2;
constexpr size_t Z_VT = 0, Z_HQ = Z_VT + (size_t)R * 512 * 2, Z_FF = Z_HQ + (size_t)R * 256 * 4, Z_FB = Z_FF + (size_t)R * 256 * 4, Z_HI = Z_FB + (size_t)R * 256 * 4,
                 Z_ZP = Z_HI + (size_t)R * 256 * 2, Z_Q = Z_ZP + (size_t)R * 256 * 2, Z_K = Z_Q + (size_t)R * 512 * 2, Z_HG = Z_K + (size_t)R * 512 * 2, Z_END = Z_HG + (size_t)R * 256 * 2;
static_assert((size_t)R * 3072 * 2 <= Z_K, "gate buffer must not reach k / odir / hgate");
static_assert((size_t)R * DFF * 2 <= Z_END, "act fits Z");
constexpr size_t WS_O = WS_Z + Z_END;
constexpr size_t O_DA = 0, O_HG = O_DA + (size_t)R * 512 * 2, O_MX = O_HG + (size_t)R * 256 * 2, O_END = O_MX + (size_t)R * 256 * 2;
constexpr size_t WS_CAR = WS_O + O_END;
constexpr size_t WS_DK = WS_CAR + (size_t)16 * HG_SEG * 4096 * 4;
constexpr size_t WS_HC = WS_DK + (size_t)16 * HG_SEG * 64 * 4;
constexpr size_t WS_MOD = WS_HC + (size_t)NCTX * 1024 * 4;
constexpr size_t WS_CS = WS_MOD + (size_t)2 * 3 * 9216 * 4;
constexpr size_t WS_LB = WS_CS + (size_t)256 * 32 * 4;
constexpr size_t WS_LAM = WS_LB + (size_t)2 * 2 * 256 * 4;
constexpr size_t WS_END = WS_LAM + 256;
static_assert(WS_END <= (size_t)512 * 1024 * 1024, "workspace");

__device__ __forceinline__ unsigned pk2(float lo, float hi) { f32x2v v = {lo, hi}; bf16x2v b = __builtin_convertvector(v, bf16x2v); return __builtin_bit_cast(unsigned, b); }
__device__ __forceinline__ float bf2f(unsigned short u) { return __builtin_bit_cast(float, (unsigned)u << 16); }
__device__ __forceinline__ float bflo(unsigned u) { return __builtin_bit_cast(float, u << 16); }
__device__ __forceinline__ float bfhi(unsigned u) { return __builtin_bit_cast(float, u & 0xffff0000u); }
__device__ __forceinline__ float ex2(float x) { return __builtin_amdgcn_exp2f(x); }
__device__ __forceinline__ float rcpf_(float x) { return __builtin_amdgcn_rcpf(x); }
__device__ __forceinline__ float sigm(float x) { return rcpf_(1.f + ex2(-1.4426950408889634f * x)); }
__device__ __forceinline__ float siluf(float x) { return x * sigm(x); }
__device__ __forceinline__ float shx(float v, int o, int lane) { return __builtin_bit_cast(float, __builtin_amdgcn_ds_bpermute((lane ^ o) << 2, __builtin_bit_cast(int, v))); }
__device__ __forceinline__ float swap32(float v) { auto rr = __builtin_amdgcn_permlane32_swap(__builtin_bit_cast(unsigned, v), __builtin_bit_cast(unsigned, v), false, false);
    const float a = __builtin_bit_cast(float, rr[0]), b = __builtin_bit_cast(float, rr[1]); return (a == v) ? b : a; }
__device__ __forceinline__ float wave_sum(float v, int lane) {
#pragma unroll
    for (int o = 1; o < 64; o <<= 1) v += shx(v, o, lane);
    return v;
}
#define LDS_WAIT() asm volatile("s_waitcnt lgkmcnt(0)" ::: "memory")

struct EpiUp {
    static constexpr bool PERM = true, AFTER_DRAIN = false;
    bf16_t* act;
    __device__ __forceinline__ void operator()(const f32x4 (&acc)[2][2][4][2], const Unit& u, int wr, int wc, int fr, int fq) const {
        const int row0 = u.pm * 256 + wr * 64 + fr, col0 = u.pn * 128 + wc * 32 + 8 * fq;
#pragma unroll
        for (int ai = 0; ai < 2; ++ai)
#pragma unroll
            for (int m = 0; m < 4; ++m) {
                const int row = row0 + ai * 128 + m * 16;
                const f32x4 a0 = acc[ai][0][m][0], a1 = acc[ai][0][m][1], b0 = acc[ai][1][m][0], b1 = acc[ai][1][m][1];
                u32x4 w;
                w.x = pk2(siluf(a0[0]) * b0[0], siluf(a0[1]) * b0[1]); w.y = pk2(siluf(a0[2]) * b0[2], siluf(a0[3]) * b0[3]);
                w.z = pk2(siluf(a1[0]) * b1[0], siluf(a1[1]) * b1[1]); w.w = pk2(siluf(a1[2]) * b1[2], siluf(a1[3]) * b1[3]);
                *(u32x4*)(act + (size_t)row * DFF + col0) = w;
            }
    }
};
struct EpiRes {
    static constexpr bool PERM = true, AFTER_DRAIN = false;
    const float* in_lat; const float* in_ctx; float* out_lat; float* out_ctx; const float* gate; float coef;
    __device__ __forceinline__ void operator()(const f32x4 (&acc)[2][2][4][2], const Unit& u, int wr, int wc, int fr, int fq) const {
        const int row0 = u.pm * 256 + wr * 64 + fr, col0 = u.pn * 256 + wc * 32 + 8 * fq;
        const int seg = (u.pm < 64) ? 0 : (u.pm < 128 ? 1 : 2);
        f32x4 gv[2][2];
#pragma unroll
        for (int bj = 0; bj < 2; ++bj)
#pragma unroll
            for (int n = 0; n < 2; ++n) gv[bj][n] = *(const f32x4*)(gate + seg * 9216 + col0 + bj * 128 + 4 * n) * coef;
#pragma unroll
        for (int ai = 0; ai < 2; ++ai)
#pragma unroll
            for (int m = 0; m < 4; ++m) {
                const int row = row0 + ai * 128 + m * 16;
                const float* ip; float* op;
                if (row < NLAT) { ip = in_lat + (size_t)row * DM; op = out_lat + (size_t)row * DM; }
                else { ip = in_ctx + (size_t)(row - NLAT) * DM; op = out_ctx + (size_t)(row - NLAT) * DM; }
#pragma unroll
                for (int bj = 0; bj < 2; ++bj)
#pragma unroll
                    for (int n = 0; n < 2; ++n) {
                        const int c = col0 + bj * 128 + 4 * n;
                        f32x4 v = *(const f32x4*)(ip + c);
                        v = v + gv[bj][n] * acc[ai][bj][m][n];
                        *(f32x4*)(op + c) = v;
                    }
            }
    }
};
struct SplitKOrder {
    int nunits, G, c, kc;
    __device__ void init(int nparts, int kc_, int G_, int c_) { nunits = nparts * 8; G = G_; c = c_; kc = kc_; }
    __device__ bool next(int i, Unit& u) const {
        const int L = i * G + c; if (L >= nunits) return false;
        const int part = L >> 3, r = L & 7; u.pm = r >> 2; u.pn = r & 3; u.koff = part * kc; return true;
    }
    __device__ __forceinline__ void a_ready(const Unit&) const {}
    __device__ __forceinline__ void done(const Unit&) const {}
};
struct EpiPart {
    static constexpr bool PERM = true, AFTER_DRAIN = false;
    float* P; const float* gate; float coef;
    __device__ __forceinline__ void operator()(const f32x4 (&acc)[2][2][4][2], const Unit& u, int wr, int wc, int fr, int fq) const {
        unsigned z_ = 0u; asm volatile("" : "+s"(z_));
        const int lane_ = (int)__builtin_amdgcn_mbcnt_hi(~0u, __builtin_amdgcn_mbcnt_lo(~0u, z_)), fr_ = lane_ & 15, fq_ = lane_ >> 4;
        const int row0 = u.pm * 256 + wr * 64 + fr_, col0 = u.pn * 256 + wc * 32 + 8 * fq_;
        float* Pp = P + (size_t)(u.koff >> 8) * NCTX * DM;
        f32x4 gv[2][2];
#pragma unroll
        for (int bj = 0; bj < 2; ++bj)
#pragma unroll
            for (int n = 0; n < 2; ++n) gv[bj][n] = *(const f32x4*)(gate + 2 * 9216 + col0 + bj * 128 + 4 * n) * coef;
#pragma unroll
        for (int ai = 0; ai < 2; ++ai)
#pragma unroll
            for (int m = 0; m < 4; ++m) {
                float* op = Pp + (size_t)(row0 + ai * 128 + m * 16) * DM;
#pragma unroll
                for (int bj = 0; bj < 2; ++bj)
#pragma unroll
                    for (int n = 0; n < 2; ++n) *(f32x4*)(op + col0 + bj * 128 + 4 * n) = gv[bj][n] * acc[ai][bj][m][n];
            }
    }
};
struct EpiWin {
    static constexpr bool PERM = true, AFTER_DRAIN = false;
    unsigned char* Z; const float* cs; const float* lb; int pn_off;
    __device__ __forceinline__ void operator()(const f32x4 (&acc)[2][2][4][2], const Unit& u, int wr, int wc, int fr, int fq) const {
        const int t = u.pn + pn_off;
        const int row0 = u.pm * 256 + wr * 64 + fr, cin = wc * 32 + 8 * fq;
        if (t < 4) {
            bf16_t* dst = (bf16_t*)(Z + ((t < 2) ? Z_Q : Z_K)); const float sc = (t < 2) ? C2 : 1.f; const int cb = (t & 1) * 256;
#pragma unroll
            for (int ai = 0; ai < 2; ++ai)
#pragma unroll
                for (int m = 0; m < 4; ++m) {
                    const int row = row0 + ai * 128 + m * 16;
                    f32x4 cv = {1.f, 1.f, 1.f, 1.f}, sv = {0.f, 0.f, 0.f, 0.f};
                    if (row < NLAT) { const int ts = row & (SEQ - 1); const int pos = (wc & 1) ? (ts & 63) : (ts >> 6);
                        cv = *(const f32x4*)(cs + pos * 32 + 4 * fq); sv = *(const f32x4*)(cs + pos * 32 + 16 + 4 * fq); }
#pragma unroll
                    for (int bj = 0; bj < 2; ++bj) {
                        const f32x4 x1 = acc[ai][bj][m][0], x2 = acc[ai][bj][m][1];
                        const f32x4 o1 = (x1 * cv - x2 * sv) * sc, o2 = (x1 * sv + x2 * cv) * sc;
                        u32x4 w; w.x = pk2(o1[0], o1[1]); w.y = pk2(o1[2], o1[3]); w.z = pk2(o2[0], o2[1]); w.w = pk2(o2[2], o2[3]);
                        *(u32x4*)(dst + (size_t)row * 512 + cb + bj * 128 + cin) = w;
                    }
                }
        } else if (t < 6) {
            bf16_t* vT = (bf16_t*)(Z + Z_VT);
#pragma unroll
            for (int ai = 0; ai < 2; ++ai)
#pragma unroll
                for (int m = 0; m < 4; ++m) {
                    const int row = row0 + ai * 128 + m * 16;
                    int b, key;
                    if (row < NLAT) { b = row >> 14; key = row & (SEQ - 1); } else { b = (row - NLAT) >> 8; key = SEQ + ((row - NLAT) & (CTXL - 1)); }
#pragma unroll
                    for (int bj = 0; bj < 2; ++bj) {
                        bf16_t* dp = vT + (size_t)(b * 512 + (t - 4) * 256 + bj * 128 + cin) * KEYS + key;
#pragma unroll
                        for (int n = 0; n < 2; ++n)
#pragma unroll
                            for (int i = 0; i < 4; i += 2) {
                                const unsigned w = pk2(acc[ai][bj][m][n][i], acc[ai][bj][m][n][i + 1]);
                                dp[(size_t)(4 * n + i) * KEYS] = (bf16_t)(w & 0xffffu); dp[(size_t)(4 * n + i + 1) * KEYS] = (bf16_t)(w >> 16);
                            }
                    }
                }
        } else if (t <= 8) {
            float* dst = (float*)(Z + ((t == 6) ? Z_HQ : (t == 7 ? Z_FF : Z_FB)));
            const float* lbp = lb + ((t == 8) ? 256 : 0);
#pragma unroll
            for (int bj = 0; bj < 2; ++bj)
#pragma unroll
                for (int n = 0; n < 2; ++n) {
                    f32x4 lbv = *(const f32x4*)(lbp + bj * 128 + cin + 4 * n);
                    f32x4 om = 1.f - lbv;
#pragma unroll
                    for (int ai = 0; ai < 2; ++ai)
#pragma unroll
                        for (int m = 0; m < 4; ++m) {
                            const int row = row0 + ai * 128 + m * 16;
                            const f32x4 z = acc[ai][bj][m][n];
                            f32x4 sg; sg[0] = sigm(z[0]); sg[1] = sigm(z[1]); sg[2] = sigm(z[2]); sg[3] = sigm(z[3]);
                            const f32x4 o = (t == 6) ? z * sg : lbv + om * sg;
                            *(f32x4*)(dst + (size_t)row * 256 + bj * 128 + cin + 4 * n) = o;
                        }
                }
        } else {
            bf16_t* dst = (bf16_t*)(Z + ((t == 9) ? Z_HI : (t == 10 ? Z_HG : Z_ZP)));
#pragma unroll
            for (int ai = 0; ai < 2; ++ai)
#pragma unroll
                for (int m = 0; m < 4; ++m) {
                    const int row = row0 + ai * 128 + m * 16;
#pragma unroll
                    for (int bj = 0; bj < 2; ++bj) {
                        f32x4 v0 = acc[ai][bj][m][0], v1 = acc[ai][bj][m][1];
                        if (t == 10) { v0[0] = siluf(v0[0]); v0[1] = siluf(v0[1]); v0[2] = siluf(v0[2]); v0[3] = siluf(v0[3]); v1[0] = siluf(v1[0]); v1[1] = siluf(v1[1]); v1[2] = siluf(v1[2]); v1[3] = siluf(v1[3]); }
                        u32x4 w; w.x = pk2(v0[0], v0[1]); w.y = pk2(v0[2], v0[3]); w.z = pk2(v1[0], v1[1]); w.w = pk2(v1[2], v1[3]);
                        *(u32x4*)(dst + (size_t)row * 256 + bj * 128 + cin) = w;
                    }
                }
        }
    }
};
struct EpiVT {
    static constexpr bool PERM = true, AFTER_DRAIN = false;
    bf16_t* vT;
    __device__ __forceinline__ void operator()(const f32x4 (&acc)[2][2][4][2], const Unit& u, int wr, int wc, int fr, int fq) const {
        const int e0 = u.pm * 256 + wr * 64 + fr;
        int b, key0;
        if (u.pn < 64) { b = 0; key0 = u.pn * 256; } else if (u.pn < 128) { b = 1; key0 = (u.pn - 64) * 256; } else { b = u.pn - 128; key0 = SEQ; }
        const int kc = key0 + wc * 32 + 8 * fq;
#pragma unroll
        for (int ai = 0; ai < 2; ++ai)
#pragma unroll
            for (int m = 0; m < 4; ++m) {
                const int e = e0 + ai * 128 + m * 16;
#pragma unroll
                for (int bj = 0; bj < 2; ++bj) {
                    const f32x4 v0 = acc[ai][bj][m][0], v1 = acc[ai][bj][m][1];
                    u32x4 w; w.x = pk2(v0[0], v0[1]); w.y = pk2(v0[2], v0[3]); w.z = pk2(v1[0], v1[1]); w.w = pk2(v1[2], v1[3]);
                    *(u32x4*)(vT + (size_t)(b * 512 + e) * KEYS + kc + bj * 128) = w;
                }
            }
    }
};
struct EpiG {
    static constexpr bool PERM = true, AFTER_DRAIN = false;
    bf16_t* G;
    __device__ __forceinline__ void operator()(const f32x4 (&acc)[2][2][4][2], const Unit& u, int wr, int wc, int fr, int fq) const {
        const int row0 = u.pm * 256 + wr * 64 + fr, col0 = u.pn * 256 + wc * 32 + 8 * fq;
#pragma unroll
        for (int ai = 0; ai < 2; ++ai)
#pragma unroll
            for (int m = 0; m < 4; ++m) {
                const int row = row0 + ai * 128 + m * 16;
#pragma unroll
                for (int bj = 0; bj < 2; ++bj) {
                    const f32x4 v0 = acc[ai][bj][m][0], v1 = acc[ai][bj][m][1];
                    u32x4 w; w.x = pk2(sigm(v0[0]), sigm(v0[1])); w.y = pk2(sigm(v0[2]), sigm(v0[3])); w.z = pk2(sigm(v1[0]), sigm(v1[1])); w.w = pk2(sigm(v1[2]), sigm(v1[3]));
                    *(u32x4*)(G + (size_t)row * 3072 + col0 + bj * 128) = w;
                }
            }
    }
};
struct EpiProj {
    static constexpr bool PERM = true, AFTER_DRAIN = false;
    bf16_t* y; const bf16_t* G; int gi; int first;
    __device__ __forceinline__ void operator()(const f32x4 (&acc)[2][2][4][2], const Unit& u, int wr, int wc, int fr, int fq) const {
        const int row0 = u.pm * 256 + wr * 64 + fr, col0 = u.pn * 256 + wc * 32 + 8 * fq;
#pragma unroll
        for (int ai = 0; ai < 2; ++ai)
#pragma unroll
            for (int m = 0; m < 4; ++m) {
                const int row = row0 + ai * 128 + m * 16;
#pragma unroll
                for (int bj = 0; bj < 2; ++bj) {
                    const int c = col0 + bj * 128;
                    const u32x4 g = *(const u32x4*)(G + (size_t)row * 3072 + gi * 1024 + c);
                    u32x4 yo = {0u, 0u, 0u, 0u};
                    if (!first) yo = *(const u32x4*)(y + (size_t)row * 1024 + c);
                    const f32x4 v0 = acc[ai][bj][m][0], v1 = acc[ai][bj][m][1];
                    u32x4 w;
                    w.x = pk2(bflo(yo.x) + bflo(g.x) * v0[0], bfhi(yo.x) + bfhi(g.x) * v0[1]);
                    w.y = pk2(bflo(yo.y) + bflo(g.y) * v0[2], bfhi(yo.y) + bfhi(g.y) * v0[3]);
                    w.z = pk2(bflo(yo.z) + bflo(g.z) * v1[0], bfhi(yo.z) + bfhi(g.z) * v1[1]);
                    w.w = pk2(bflo(yo.w) + bflo(g.w) * v1[2], bfhi(yo.w) + bfhi(g.w) * v1[3]);
                    *(u32x4*)(y + (size_t)row * 1024 + c) = w;
                }
            }
    }
};

__device__ __forceinline__ int map_row(int mode, int n) {
    if (mode == 1) return 256 * (n >> 7) + (n & 127);
    if (mode == 2) return 256 * (n >> 7) + 128 + (n & 127);
    if (mode == 3) return (n < 1024) ? ((n & ~31) + 8 * ((n & 15) >> 2) + 4 * ((n >> 4) & 1) + (n & 3)) : n;
    return n;
}
__device__ __forceinline__ void transpose_item(const float* W, int K, int N, bf16_t* WT, int mode, LAS float* scr, int item, int lane) {
    const int nblk = N / 32, kb = item / nblk, nb = item % nblk, k0 = 64 * kb, n0 = 32 * nb;
#pragma unroll 8
    for (int i = 0; i < 32; ++i) { const int kk = 2 * i + (lane >> 5); scr[kk * 33 + (lane & 31)] = W[(size_t)(k0 + kk) * N + n0 + (lane & 31)]; }
    LDS_WAIT(); asm volatile("" ::: "memory");
    const int c = lane & 7;
#pragma unroll
    for (int j = 0; j < 4; ++j) { const int n = (lane >> 3) + 8 * j; const LAS float* s = scr + (8 * c) * 33 + n;
        u32x4 o; o.x = pk2(s[0 * 33], s[1 * 33]); o.y = pk2(s[2 * 33], s[3 * 33]); o.z = pk2(s[4 * 33], s[5 * 33]); o.w = pk2(s[6 * 33], s[7 * 33]);
        *(u32x4*)(WT + (size_t)map_row(mode, n0 + n) * K + k0 + 8 * c) = o; }
    LDS_WAIT(); asm volatile("" ::: "memory");
}

__device__ __forceinline__ void norm_phase(const float* in_lat, const float* in_ctx, const float* gain, const float* modl, int shi, int sci, bf16_t* outp, int gw, int ngw, int lane,
                                           const float* part, int nparts, float* hc_out) {
    f32x4 gv[4];
#pragma unroll
    for (int j = 0; j < 4; ++j) gv[j] = *(const f32x4*)(gain + 4 * lane + 256 * j);
    for (int row = gw; row < R; row += ngw) {
        const float* ip = (row < NLAT) ? in_lat + (size_t)row * DM : in_ctx + (size_t)(row - NLAT) * DM;
        const int seg = (row < SEQ) ? 0 : (row < NLAT ? 1 : 2);
        const float* sh = modl + seg * 9216 + shi * 1024; const float* sc = modl + seg * 9216 + sci * 1024;
        f32x4 v[4]; float ss = 0.f;
#pragma unroll
        for (int j = 0; j < 4; ++j) v[j] = *(const f32x4*)(ip + 4 * lane + 256 * j);
        if (row >= NLAT && nparts > 0) {
            for (int p = 0; p < nparts; ++p) {
                const float* pp = part + ((size_t)p * NCTX + (row - NLAT)) * DM;
#pragma unroll
                for (int j = 0; j < 4; ++j) v[j] = v[j] + *(const f32x4*)(pp + 4 * lane + 256 * j);
            }
#pragma unroll
            for (int j = 0; j < 4; ++j) *(f32x4*)(hc_out + (size_t)(row - NLAT) * DM + 4 * lane + 256 * j) = v[j];
        }
#pragma unroll
        for (int j = 0; j < 4; ++j) ss += (v[j][0] * v[j][0] + v[j][1] * v[j][1]) + (v[j][2] * v[j][2] + v[j][3] * v[j][3]);
        ss = wave_sum(ss, lane);
        const float rstd = 1.0f / sqrtf(ss * (1.f / DM) + EPS);
#pragma unroll
        for (int j = 0; j < 4; ++j) {
            const f32x4 s4 = *(const f32x4*)(sc + 4 * lane + 256 * j), h4 = *(const f32x4*)(sh + 4 * lane + 256 * j);
            const f32x4 y = v[j] * rstd * gv[j] * (s4 + 1.f) + h4;
            u32x2 w; w.x = pk2(y[0], y[1]); w.y = pk2(y[2], y[3]);
            *(u32x2*)(outp + (size_t)row * DM + 4 * lane + 256 * j) = w;
        }
    }
}
__device__ __forceinline__ void final_norm_phase(float* out, const float* gain, int gw, int ngw, int lane) {
    f32x4 gv[4];
#pragma unroll
    for (int j = 0; j < 4; ++j) gv[j] = *(const f32x4*)(gain + 4 * lane + 256 * j);
    for (int row = gw; row < NLAT; row += ngw) {
        float* ip = out + (size_t)row * DM;
        f32x4 v[4]; float ss = 0.f;
#pragma unroll
        for (int j = 0; j < 4; ++j) { v[j] = *(const f32x4*)(ip + 4 * lane + 256 * j); ss += (v[j][0] * v[j][0] + v[j][1] * v[j][1]) + (v[j][2] * v[j][2] + v[j][3] * v[j][3]); }
        ss = wave_sum(ss, lane);
        const float rstd = 1.0f / sqrtf(ss * (1.f / DM) + EPS);
#pragma unroll
        for (int j = 0; j < 4; ++j) *(f32x4*)(ip + 4 * lane + 256 * j) = v[j] * rstd * gv[j];
    }
}
__device__ __forceinline__ void pool_phase(const bf16_t* zp, bf16_t* mx, int gtid, int ngt) {
    for (int it = gtid; it < R * 32; it += ngt) {
        const int row = it >> 5, ch = (it & 31) * 8, g = ch >> 6, hw = 1 << g;
        int base, n;
        if (row < NLAT) { base = row & ~(SEQ - 1); n = SEQ; } else { base = NLAT + ((row - NLAT) & ~(CTXL - 1)); n = CTXL; }
        const int t = row - base, lo = (t - hw > 0) ? t - hw : 0, hi = (t + hw < n) ? t + hw : n;
        float s[8];
#pragma unroll
        for (int i = 0; i < 8; ++i) s[i] = 0.f;
        for (int j = lo; j < hi; ++j) {
            const u32x4 v = *(const u32x4*)(zp + (size_t)(base + j) * 256 + ch);
            s[0] += bflo(v.x); s[1] += bfhi(v.x); s[2] += bflo(v.y); s[3] += bfhi(v.y); s[4] += bflo(v.z); s[5] += bfhi(v.z); s[6] += bflo(v.w); s[7] += bfhi(v.w);
        }
        const float inv = 1.f / (float)(hi - lo);
        const u32x4 c = *(const u32x4*)(zp + (size_t)row * 256 + ch);
        u32x4 w;
        w.x = pk2(s[0] * inv - bflo(c.x), s[1] * inv - bfhi(c.x)); w.y = pk2(s[2] * inv - bflo(c.y), s[3] * inv - bfhi(c.y));
        w.z = pk2(s[4] * inv - bflo(c.z), s[5] * inv - bfhi(c.z)); w.w = pk2(s[6] * inv - bflo(c.w), s[7] * inv - bfhi(c.w));
        *(u32x4*)(mx + (size_t)row * 256 + ch) = w;
    }
}

__device__ __forceinline__ int hg_row(int dir, int b, int step) {
    if (step < CTXL) { const int t = dir ? (CTXL - 1 - step) : step; return NLAT + b * CTXL + t; }
    int t = step - CTXL; if (dir) t = SEQ - 1 - t; return b * SEQ + t;
}
template <bool OUT>
__device__ __forceinline__ void hg_pass(const float* hq, const float* ff, const float* fb, const bf16_t* hi, float* carry, float* dk, bf16_t* odir, int wave, int lane, int G) {
    for (int item = blockIdx.x + G * wave; item < 16 * HG_SEG; item += G * 8) {
        const int s = item / HG_SEG, j = item % HG_SEG, dir = s >> 3, b = (s >> 2) & 1, h = s & 3;
        const float* fbase = dir ? fb : ff;
        f32x2v S[32];
#pragma unroll
        for (int k = 0; k < 32; ++k) { S[k][0] = OUT ? carry[((size_t)item * 64 + 2 * k) * 64 + lane] : 0.f; S[k][1] = OUT ? carry[((size_t)item * 64 + 2 * k + 1) * 64 + lane] : 0.f; }
        float dl = 1.f;
        const int st0 = j * HG_STEPS, st1 = st0 + HG_STEPS;
        constexpr int HG_PF = 8;
        float ivb[HG_PF], fvb[HG_PF], qvb[HG_PF];
#pragma unroll
        for (int u = 0; u < HG_PF; ++u) {
            const int stl = (st0 + u < st1) ? st0 + u : st1 - 1;
            const size_t off = (size_t)hg_row(dir, b, stl) * 256 + h * 64 + lane;
            ivb[u] = bf2f(hi[off]); fvb[u] = fbase[off]; qvb[u] = OUT ? hq[off] : 0.f;
        }
        for (int sb = st0; sb < st1; sb += HG_PF) {
#pragma unroll
            for (int u = 0; u < HG_PF; ++u) {
                const int st = sb + u;
                if (st < st1) {
                    const float iv = ivb[u], fv = fvb[u], qv = qvb[u];
                    const size_t offc = (size_t)hg_row(dir, b, st) * 256 + h * 64 + lane;
                    { const int stn = (st + HG_PF < st1) ? st + HG_PF : st1 - 1;
                      const size_t off = (size_t)hg_row(dir, b, stn) * 256 + h * 64 + lane;
                      ivb[u] = bf2f(hi[off]); fvb[u] = fbase[off]; if (OUT) qvb[u] = hq[off]; }
                    if (!OUT) dl *= fv;
                    f32x2v o2 = {0.f, 0.f};
                    const f32x2v iv2 = {iv, iv};
                    const int fvi = __builtin_bit_cast(int, fv), qvi = __builtin_bit_cast(int, qv);
#pragma unroll
                    for (int k = 0; k < 32; ++k) {
                        f32x2v f2; f2[0] = __builtin_bit_cast(float, __builtin_amdgcn_readlane(fvi, 2 * k)); f2[1] = __builtin_bit_cast(float, __builtin_amdgcn_readlane(fvi, 2 * k + 1));
                        const f32x2v d2 = S[k] - iv2;
                        S[k] = __builtin_elementwise_fma(f2, d2, iv2);
                        if (OUT) { f32x2v q2; q2[0] = __builtin_bit_cast(float, __builtin_amdgcn_readlane(qvi, 2 * k)); q2[1] = __builtin_bit_cast(float, __builtin_amdgcn_readlane(qvi, 2 * k + 1));
                            o2 = __builtin_elementwise_fma(q2, S[k], o2); }
                    }
                    if (OUT) odir[(size_t)dir * R * 256 + offc] = (bf16_t)(pk2(o2[0] + o2[1], 0.f) & 0xffffu);
                }
            }
        }
        if (!OUT) {
#pragma unroll
            for (int k = 0; k < 32; ++k) { carry[((size_t)item * 64 + 2 * k) * 64 + lane] = S[k][0]; carry[((size_t)item * 64 + 2 * k + 1) * 64 + lane] = S[k][1]; }
            dk[item * 64 + lane] = dl;
        }
    }
}
constexpr int HGA_T = 48, HGA_STR = 112, HGA_MAT = 64 * HGA_STR, HGA_WAVE = 2 * HGA_MAT;
static_assert(8 * HGA_WAVE <= LDS_BYTES - 64 && 3 * HGA_T >= HG_STEPS, "hg pass A LDS");
__device__ __forceinline__ void hg_passA_mfma(LAS unsigned char* lds, const float* ff, const float* fb, const bf16_t* hi, float* carry, float* dk, int wave, int lane, int G) {
    LAS unsigned char* KT = lds + wave * HGA_WAVE; LAS unsigned char* VT = KT + HGA_MAT;
    const int n = lane & 31, gq = lane >> 5;
    for (int item = blockIdx.x + G * wave; item < 16 * HG_SEG; item += G * 8) {
        const int s = item / HG_SEG, j = item % HG_SEG, dir = s >> 3, b = (s >> 2) & 1, h = s & 3;
        const float* fbase = dir ? fb : ff;
        const int st0 = j * HG_STEPS, st1 = st0 + HG_STEPS;
        f32x16 acc[2][2];
#pragma unroll
        for (int kb = 0; kb < 2; ++kb)
#pragma unroll
            for (int vb = 0; vb < 2; ++vb)
#pragma unroll
                for (int r = 0; r < 16; ++r) acc[kb][vb][r] = 0.f;
        float P = 1.f;
        for (int third = 2; third >= 0; --third) {
            const int sb = st0 + third * HGA_T;
            for (int s0 = HGA_T - 8; s0 >= 0; s0 -= 8) {
                float fv[8]; unsigned short iv[8];
#pragma unroll
                for (int u = 0; u < 8; ++u) {
                    const int st = sb + s0 + u;
                    const int stc = (st < st1) ? st : st1 - 1;
                    const size_t off = (size_t)hg_row(dir, b, stc) * 256 + h * 64 + lane;
                    fv[u] = fbase[off]; iv[u] = hi[off];
                }
#pragma unroll
                for (int u = 7; u >= 0; --u) {
                    const int st = sb + s0 + u;
                    const bool ok = (st < st1);
                    const float f = ok ? fv[u] : 1.f;
                    const float kh = ok ? (1.f - f) * P : 0.f;
                    P *= f;
                    *(LAS unsigned short*)(KT + lane * HGA_STR + (s0 + u) * 2) = (unsigned short)(pk2(kh, 0.f) & 0xffffu);
                    *(LAS unsigned short*)(VT + lane * HGA_STR + (s0 + u) * 2) = ok ? iv[u] : (unsigned short)0;
                }
            }
            LDS_WAIT(); asm volatile("" ::: "memory");
#pragma unroll
            for (int q = 0; q < HGA_T / 16; ++q) {
                bf16x8 af[2], bfr[2];
#pragma unroll
                for (int kb = 0; kb < 2; ++kb) af[kb] = *(LAS bf16x8*)(KT + (kb * 32 + n) * HGA_STR + (16 * q + 8 * gq) * 2);
#pragma unroll
                for (int vb = 0; vb < 2; ++vb) bfr[vb] = *(LAS bf16x8*)(VT + (vb * 32 + n) * HGA_STR + (16 * q + 8 * gq) * 2);
#pragma unroll
                for (int kb = 0; kb < 2; ++kb)
#pragma unroll
                    for (int vb = 0; vb < 2; ++vb) acc[kb][vb] = __builtin_amdgcn_mfma_f32_32x32x16_bf16(af[kb], bfr[vb], acc[kb][vb], 0, 0, 0);
            }
            LDS_WAIT(); asm volatile("" ::: "memory");
        }
#pragma unroll
        for (int kb = 0; kb < 2; ++kb)
#pragma unroll
            for (int vb = 0; vb < 2; ++vb)
#pragma unroll
                for (int r = 0; r < 16; ++r) {
                    const int k = kb * 32 + 8 * (r >> 2) + 4 * gq + (r & 3), v = vb * 32 + n;
                    carry[((size_t)item * 64 + k) * 64 + v] = acc[kb][vb][r];
                }
        dk[item * 64 + lane] = P;
    }
}
constexpr int HGB_QSTR = 144, HGB_TSTR = 48, HGB_Q = 0, HGB_K = HGB_Q + 16 * HGB_QSTR, HGB_KH = HGB_K + 16 * HGB_QSTR, HGB_IT = HGB_KH + 64 * HGB_TSTR, HGB_DC = HGB_IT + 64 * HGB_TSTR, HGB_WAVE = HGB_DC + 256;
static_assert(8 * HGB_WAVE <= LDS_BYTES - 64, "hg pass B LDS");
__device__ __forceinline__ bf16x8 hgb_pack8(const f32x16& t, int r0) {
    u32x4 w; w.x = pk2(t[r0 + 0], t[r0 + 1]); w.y = pk2(t[r0 + 2], t[r0 + 3]); w.z = pk2(t[r0 + 4], t[r0 + 5]); w.w = pk2(t[r0 + 6], t[r0 + 7]); return __builtin_bit_cast(bf16x8, w);
}
__device__ __forceinline__ void hg_passB_mfma(LAS unsigned char* lds, const float* hq, const float* ff, const float* fb, const bf16_t* hi, const float* carry, bf16_t* odir, int wave, int lane, int G) {
    LAS unsigned char* W = lds + wave * HGB_WAVE;
    const int n = lane & 31, gq = lane >> 5, n16 = n & 15;
    const int kpos = (lane & ~15) + (lane & 3) + ((lane >> 3) & 1) * 4 + ((lane >> 2) & 1) * 8;
    for (int item = blockIdx.x + G * wave; item < 16 * HG_SEG; item += G * 8) {
        const int s = item / HG_SEG, j = item % HG_SEG, dir = s >> 3, b = (s >> 2) & 1, h = s & 3;
        const float* fbase = dir ? fb : ff;
        const int st0 = j * HG_STEPS, st1 = st0 + HG_STEPS;
        f32x16 S[2][2];
#pragma unroll
        for (int kb = 0; kb < 2; ++kb)
#pragma unroll
            for (int vb = 0; vb < 2; ++vb)
#pragma unroll
                for (int r = 0; r < 16; ++r) S[kb][vb][r] = carry[((size_t)item * 64 + kb * 32 + 8 * (r >> 2) + 4 * gq + (r & 3)) * 64 + vb * 32 + n];
        for (int c0 = st0; c0 < st1; c0 += 16) {
            float fv[16], qv[16]; unsigned short iv[16];
#pragma unroll
            for (int t = 0; t < 16; ++t) {
                const int st = c0 + t; const int stc = (st < st1) ? st : st1 - 1;
                const size_t off = (size_t)hg_row(dir, b, stc) * 256 + h * 64 + lane;
                fv[t] = fbase[off]; qv[t] = hq[off]; iv[t] = hi[off];
            }
            float P = 1.f; float kt[16];
#pragma unroll
            for (int t = 0; t < 16; ++t) {
                const bool ok = (c0 + t < st1);
                const float f = ok ? fv[t] : 1.f, q = ok ? qv[t] : 0.f;
                P *= f;
                const float Pc = fmaxf(P, 1e-30f);
                kt[t] = ok ? (1.f - f) * rcpf_(Pc) : 0.f;
                *(LAS unsigned short*)(W + HGB_Q + t * HGB_QSTR + kpos * 2) = (unsigned short)(pk2(q * Pc, 0.f) & 0xffffu);
                *(LAS unsigned short*)(W + HGB_K + t * HGB_QSTR + kpos * 2) = (unsigned short)(pk2(kt[t], 0.f) & 0xffffu);
                *(LAS unsigned short*)(W + HGB_IT + lane * HGB_TSTR + t * 2) = ok ? iv[t] : (unsigned short)0;
            }
            const float P15 = fmaxf(P, 1e-30f);
#pragma unroll
            for (int t = 0; t < 16; ++t) *(LAS unsigned short*)(W + HGB_KH + lane * HGB_TSTR + t * 2) = (unsigned short)(pk2(kt[t] * P15, 0.f) & 0xffffu);
            *(LAS float*)(W + HGB_DC + lane * 4) = P;
            LDS_WAIT(); asm volatile("" ::: "memory");
            bf16x8 qb[4];
#pragma unroll
            for (int u = 0; u < 4; ++u) qb[u] = *(LAS bf16x8*)(W + HGB_Q + n16 * HGB_QSTR + (16 * u + 8 * gq) * 2);
            f32x16 OT[2], AT;
#pragma unroll
            for (int r = 0; r < 16; ++r) { OT[0][r] = 0.f; OT[1][r] = 0.f; AT[r] = 0.f; }
#pragma unroll
            for (int u = 0; u < 4; ++u) {
                const bf16x8 ka = *(LAS bf16x8*)(W + HGB_K + n16 * HGB_QSTR + (16 * u + 8 * gq) * 2);
                AT = __builtin_amdgcn_mfma_f32_32x32x16_bf16(ka, qb[u], AT, 0, 0, 0);
#pragma unroll
                for (int vb = 0; vb < 2; ++vb)
                    OT[vb] = __builtin_amdgcn_mfma_f32_32x32x16_bf16(hgb_pack8(S[u >> 1][vb], 8 * (u & 1)), qb[u], OT[vb], 0, 0, 0);
            }
#pragma unroll
            for (int r = 0; r < 8; ++r) { const int srow = 8 * (r >> 2) + 4 * gq + (r & 3); if (srow > n) AT[r] = 0.f; }
            const bf16x8 ab = hgb_pack8(AT, 0);
#pragma unroll
            for (int vb = 0; vb < 2; ++vb) {
                const u32x2 lo = *(LAS u32x2*)(W + HGB_IT + (vb * 32 + n) * HGB_TSTR + (4 * gq) * 2), hi2 = *(LAS u32x2*)(W + HGB_IT + (vb * 32 + n) * HGB_TSTR + (8 + 4 * gq) * 2);
                const bf16x8 ia = __builtin_bit_cast(bf16x8, ((u32x4){lo.x, lo.y, hi2.x, hi2.y}));
                OT[vb] = __builtin_amdgcn_mfma_f32_32x32x16_bf16(ia, ab, OT[vb], 0, 0, 0);
            }
            if (n < 16 && c0 + n < st1) {
                bf16_t* op = odir + (size_t)dir * R * 256 + (size_t)hg_row(dir, b, c0 + n) * 256 + h * 64;
#pragma unroll
                for (int vb = 0; vb < 2; ++vb)
#pragma unroll
                    for (int r4 = 0; r4 < 4; ++r4) {
                        u32x2 w; w.x = pk2(OT[vb][4 * r4 + 0], OT[vb][4 * r4 + 1]); w.y = pk2(OT[vb][4 * r4 + 2], OT[vb][4 * r4 + 3]);
                        *(u32x2*)(op + vb * 32 + 8 * r4 + 4 * gq) = w;
                    }
            }
#pragma unroll
            for (int kb = 0; kb < 2; ++kb) {
                f32x4 dc[4];
#pragma unroll
                for (int r4 = 0; r4 < 4; ++r4) dc[r4] = *(LAS f32x4*)(W + HGB_DC + (kb * 32 + 8 * r4 + 4 * gq) * 4);
                const bf16x8 kh = *(LAS bf16x8*)(W + HGB_KH + (kb * 32 + n) * HGB_TSTR + (8 * gq) * 2);
#pragma unroll
                for (int vb = 0; vb < 2; ++vb) {
#pragma unroll
                    for (int r = 0; r < 16; ++r) S[kb][vb][r] *= dc[r >> 2][r & 3];
                    const bf16x8 ib = *(LAS bf16x8*)(W + HGB_IT + (vb * 32 + n) * HGB_TSTR + (8 * gq) * 2);
                    S[kb][vb] = __builtin_amdgcn_mfma_f32_32x32x16_bf16(kh, ib, S[kb][vb], 0, 0, 0);
                }
            }
            LDS_WAIT(); asm volatile("" ::: "memory");
        }
    }
}
__device__ __forceinline__ void hg_carry(float* carry, const float* dk, int gtid, int ngt) {
    for (int e = gtid; e < 16 * 4096; e += ngt) {
        const int s = e >> 12, idx = e & 4095, k = idx >> 6;
        float run = 0.f;
        for (int j0 = 0; j0 < HG_SEG; j0 += 8) {
            float t[8], d[8];
#pragma unroll
            for (int u = 0; u < 8; ++u) { t[u] = carry[(size_t)(s * HG_SEG + j0 + u) * 4096 + idx]; d[u] = dk[(s * HG_SEG + j0 + u) * 64 + k]; }
#pragma unroll
            for (int u = 0; u < 8; ++u) { carry[(size_t)(s * HG_SEG + j0 + u) * 4096 + idx] = run; run = __builtin_fmaf(d[u], run, t[u]); }
        }
    }
}
__device__ __forceinline__ void hg_readout(const bf16_t* odir, const bf16_t* hgs, const float* gain, bf16_t* ohg, int gw, int ngw, int lane) {
    const f32x4 gv = *(const f32x4*)(gain + ((4 * lane) & 63));
    for (int row = gw; row < R; row += ngw) {
        const size_t off = (size_t)row * 256 + 4 * lane;
        const u32x2 a = *(const u32x2*)(odir + off), bq = *(const u32x2*)(odir + (size_t)R * 256 + off), hg = *(const u32x2*)(hgs + off);
        const float o0 = bflo(a.x) + bflo(bq.x), o1 = bfhi(a.x) + bfhi(bq.x), o2 = bflo(a.y) + bflo(bq.y), o3 = bfhi(a.y) + bfhi(bq.y);
        float ss = (o0 * o0 + o1 * o1) + (o2 * o2 + o3 * o3);
        ss += shx(ss, 1, lane); ss += shx(ss, 2, lane); ss += shx(ss, 4, lane); ss += shx(ss, 8, lane);
        const float rstd = 1.0f / sqrtf(ss * (1.f / 64.f) + EPS);
        u32x2 w;
        w.x = pk2(o0 * rstd * gv[0] * bflo(hg.x), o1 * rstd * gv[1] * bfhi(hg.x));
        w.y = pk2(o2 * rstd * gv[2] * bflo(hg.y), o3 * rstd * gv[3] * bfhi(hg.y));
        *(u32x2*)(ohg + off) = w;
    }
}

constexpr int AT_KSTR = 272, AT_VSTR = 144, AT_KBYTES = 64 * AT_KSTR, AT_VBYTES = 128 * AT_VSTR, AT_STAGE = AT_KBYTES + AT_VBYTES;
static_assert(2 * AT_STAGE <= LDS_BYTES && 65536 <= 2 * AT_STAGE, "attention LDS");
__device__ __forceinline__ void attn_unit(LAS unsigned char* lds, const bf16_t* qbuf, const bf16_t* kbuf, const bf16_t* vT, bf16_t* oda, const float* gain,
                                          int b, int h, int qrow0, int kt0, int kt1, float lam, float post, int tid, int wave, int lane) {
    const int c = wave & 1, g = wave >> 1, n = lane & 31, gq = lane >> 5;
    bf16x8 qf[4];
    { const bf16_t* qp = qbuf + (size_t)(qrow0 + 32 * g + n) * 512 + h * 128 + c * 64 + 8 * gq;
#pragma unroll
      for (int s = 0; s < 4; ++s) qf[s] = *(const bf16x8*)(qp + 16 * s); }
    f32x16 O[4];
#pragma unroll
    for (int e = 0; e < 4; ++e)
#pragma unroll
        for (int r = 0; r < 16; ++r) O[e][r] = 0.f;
    float l = 0.f;
    const int kkey0 = tid >> 4, kch = tid & 15, ve0 = tid >> 3, vc = tid & 7;
    const size_t kgoff = (size_t)kkey0 * 512 + h * 128 + kch * 8;
    const unsigned klds = kkey0 * AT_KSTR + kch * 16;
    const size_t vgoff = (size_t)(b * 512 + h * 128 + ve0) * KEYS + vc * 8;
    const unsigned vlds = ve0 * AT_VSTR + (vc >> 1) * 32 + (vc & 1) * 8;
    u32x4 kr0, kr1, vr0, vr1;
#define AT_KROW0(kt) (((kt) * 64 < SEQ) ? (size_t)b * SEQ + (kt) * 64 : (size_t)NLAT + b * CTXL + ((kt) * 64 - SEQ))
#define AT_LOADK(kt) do { const size_t krow0 = AT_KROW0(kt); kr0 = *(const u32x4*)(kbuf + krow0 * 512 + kgoff); kr1 = *(const u32x4*)(kbuf + (krow0 + 32) * 512 + kgoff); } while (0)
#define AT_LOADV(kt) do { vr0 = *(const u32x4*)(vT + vgoff + (kt) * 64); vr1 = *(const u32x4*)(vT + vgoff + (size_t)64 * KEYS + (kt) * 64); } while (0)
#define AT_STOREK(buf) do { LAS unsigned char* sb_ = lds + (buf) * AT_KBYTES; *(LAS u32x4*)(sb_ + klds) = kr0; *(LAS u32x4*)(sb_ + klds + 32 * AT_KSTR) = kr1; } while (0)
#define AT_STOREV(buf) do { LAS unsigned char* sb_ = lds + 2 * AT_KBYTES + (buf) * AT_VBYTES; \
        *(LAS u32x2*)(sb_ + vlds) = (u32x2){vr0.x, vr0.y}; *(LAS u32x2*)(sb_ + vlds + 16) = (u32x2){vr0.z, vr0.w}; \
        *(LAS u32x2*)(sb_ + vlds + 64 * AT_VSTR) = (u32x2){vr1.x, vr1.y}; *(LAS u32x2*)(sb_ + vlds + 64 * AT_VSTR + 16) = (u32x2){vr1.z, vr1.w}; } while (0)
#define AT_QK(Sa, Sb, buf) do { LAS unsigned char* kp = lds + (buf) * AT_KBYTES + n * AT_KSTR + (c * 8 + gq) * 16; \
        _Pragma("unroll") for (int s = 0; s < 4; ++s) { \
            const bf16x8 a0 = *(LAS bf16x8*)(kp + s * 32), a1 = *(LAS bf16x8*)(kp + 32 * AT_KSTR + s * 32); \
            Sa = __builtin_amdgcn_mfma_f32_32x32x16_bf16(a0, qf[s], Sa, 0, 0, 0); \
            Sb = __builtin_amdgcn_mfma_f32_32x32x16_bf16(a1, qf[s], Sb, 0, 0, 0); } } while (0)
#define AT_BAR() do { asm volatile("s_waitcnt lgkmcnt(0)" ::: "memory"); __builtin_amdgcn_s_barrier(); asm volatile("" ::: "memory"); } while (0)
    const int nt = kt1 - kt0;
    AT_LOADK(kt0); AT_LOADV(kt0); AT_STOREK(0); AT_STOREV(0);
    if (nt > 1) { AT_LOADK(kt0 + 1); AT_LOADV(kt0 + 1); }
    AT_BAR();
    f32x16 negm;
    {
        f32x16 S0, S1;
#pragma unroll
        for (int r = 0; r < 16; ++r) { S0[r] = 0.f; S1[r] = 0.f; }
        AT_QK(S0, S1, 0);
        float mx = fmaxf(S0[0], S1[0]);
#pragma unroll
        for (int r = 1; r < 16; ++r) mx = fmaxf(fmaxf(mx, S0[r]), S1[r]);
        { auto rr = __builtin_amdgcn_permlane32_swap(__builtin_bit_cast(unsigned, mx), __builtin_bit_cast(unsigned, mx), false, false);
          mx = fmaxf(__builtin_bit_cast(float, rr[0]), __builtin_bit_cast(float, rr[1])); }
#pragma unroll
        for (int r = 0; r < 16; ++r) negm[r] = -mx;
    }
    constexpr float THR = 8.f;
    for (int i = 0; i < nt; ++i) {
        const int cur = i & 1;
        bf16x8 kf[8];
        { LAS unsigned char* kp = lds + cur * AT_KBYTES + n * AT_KSTR + (c * 8 + gq) * 16;
#pragma unroll
          for (int s = 0; s < 4; ++s) { kf[2 * s] = *(LAS bf16x8*)(kp + s * 32); kf[2 * s + 1] = *(LAS bf16x8*)(kp + 32 * AT_KSTR + s * 32); } }
        LAS unsigned char* vp = lds + 2 * AT_KBYTES + cur * AT_VBYTES + n * AT_VSTR + gq * 16;
        bf16x8 va[8];
#pragma unroll
        for (int ks = 0; ks < 2; ++ks)
#pragma unroll
            for (int e = 0; e < 4; ++e) va[ks * 4 + e] = *(LAS bf16x8*)(vp + e * 32 * AT_VSTR + ks * 32);
        __builtin_amdgcn_sched_barrier(0);
        f32x16 S0 = negm, S1 = negm;
#pragma unroll
        for (int s = 0; s < 4; ++s) {
            S0 = __builtin_amdgcn_mfma_f32_32x32x16_bf16(kf[2 * s], qf[s], S0, 0, 0, 0);
            S1 = __builtin_amdgcn_mfma_f32_32x32x16_bf16(kf[2 * s + 1], qf[s], S1, 0, 0, 0);
        }
        __builtin_amdgcn_sched_barrier(0);
        bf16x8 vb[8];
#pragma unroll
        for (int ks = 0; ks < 2; ++ks)
#pragma unroll
            for (int e = 0; e < 4; ++e) vb[ks * 4 + e] = *(LAS bf16x8*)(vp + e * 32 * AT_VSTR + (ks + 2) * 32);
        if (i + 1 < nt) { AT_STOREK(cur ^ 1); AT_STOREV(cur ^ 1); }
        if (i + 2 < nt) { AT_LOADK(kt0 + i + 2); AT_LOADV(kt0 + i + 2); }
        __builtin_amdgcn_sched_barrier(0);
        float mx = fmaxf(S0[0], S1[0]);
#pragma unroll
        for (int r = 1; r < 16; ++r) mx = fmaxf(fmaxf(mx, S0[r]), S1[r]);
        { auto rr = __builtin_amdgcn_permlane32_swap(__builtin_bit_cast(unsigned, mx), __builtin_bit_cast(unsigned, mx), false, false);
          mx = fmaxf(__builtin_bit_cast(float, rr[0]), __builtin_bit_cast(float, rr[1])); }
        if (__builtin_amdgcn_ballot_w64(mx > THR) != 0ull) {
            const float delta = fmaxf(mx, 0.f), alpha = ex2(-delta);
            l *= alpha;
#pragma unroll
            for (int r = 0; r < 16; ++r) { S0[r] -= delta; S1[r] -= delta; negm[r] -= delta; }
#pragma unroll
            for (int e = 0; e < 4; ++e) O[e] = O[e] * alpha;
        }
        float ps = 0.f;
#pragma unroll
        for (int r = 0; r < 16; ++r) { S0[r] = ex2(S0[r]); S1[r] = ex2(S1[r]); ps += S0[r] + S1[r]; }
        l += ps;
        bf16x8 pb[4];
#pragma unroll
        for (int s = 0; s < 2; ++s) {
            u32x4 pw;
            pw.x = pk2(S0[8 * s + 0], S0[8 * s + 1]); pw.y = pk2(S0[8 * s + 2], S0[8 * s + 3]); pw.z = pk2(S0[8 * s + 4], S0[8 * s + 5]); pw.w = pk2(S0[8 * s + 6], S0[8 * s + 7]);
            pb[s] = __builtin_bit_cast(bf16x8, pw);
            pw.x = pk2(S1[8 * s + 0], S1[8 * s + 1]); pw.y = pk2(S1[8 * s + 2], S1[8 * s + 3]); pw.z = pk2(S1[8 * s + 4], S1[8 * s + 5]); pw.w = pk2(S1[8 * s + 6], S1[8 * s + 7]);
            pb[2 + s] = __builtin_bit_cast(bf16x8, pw);
        }
        __builtin_amdgcn_sched_barrier(0);
#pragma unroll
        for (int ks = 0; ks < 2; ++ks)
#pragma unroll
            for (int e = 0; e < 4; ++e) {
                O[e] = __builtin_amdgcn_mfma_f32_32x32x16_bf16(va[ks * 4 + e], pb[ks], O[e], 0, 0, 0);
            }
#pragma unroll
        for (int ks = 0; ks < 2; ++ks)
#pragma unroll
            for (int e = 0; e < 4; ++e) {
                O[e] = __builtin_amdgcn_mfma_f32_32x32x16_bf16(vb[ks * 4 + e], pb[2 + ks], O[e], 0, 0, 0);
            }
        AT_BAR();
    }
#undef AT_BAR
#undef AT_KROW0
#undef AT_LOADK
#undef AT_LOADV
#undef AT_STOREK
#undef AT_STOREV
#undef AT_QK
    l += shx(l, 32, lane);
    const float inv = 1.f / l;
    LAS float* xch = (LAS float*)lds;
    if (c == 1) {
#pragma unroll
        for (int e = 0; e < 4; ++e)
#pragma unroll
            for (int r = 0; r < 16; ++r) xch[(g * 64 + e * 16 + r) * 64 + lane] = O[e][r] * inv;
    }
    __syncthreads();
    if (c == 0) {
        float ss = 0.f;
#pragma unroll
        for (int e = 0; e < 4; ++e)
#pragma unroll
            for (int r = 0; r < 16; ++r) { const float o = O[e][r] * inv - lam * xch[(g * 64 + e * 16 + r) * 64 + lane]; O[e][r] = o; ss += o * o; }
        ss += shx(ss, 32, lane);
        const float rs = post / sqrtf(ss * (1.f / 128.f) + EPS);
        bf16_t* op = oda + (size_t)(qrow0 + 32 * g + n) * 512 + h * 128;
#pragma unroll
        for (int e = 0; e < 4; ++e)
#pragma unroll
            for (int r4 = 0; r4 < 4; ++r4) {
                const int e0 = e * 32 + 8 * r4 + 4 * gq;
                const f32x4 gv = *(const f32x4*)(gain + e0);
                u32x2 w; w.x = pk2(O[e][4 * r4 + 0] * rs * gv[0], O[e][4 * r4 + 1] * rs * gv[1]); w.y = pk2(O[e][4 * r4 + 2] * rs * gv[2], O[e][4 * r4 + 3] * rs * gv[3]);
                *(u32x2*)(op + e0) = w;
            }
    }
    __syncthreads();
}
#define XB_TMO      128
#define XB_XCNT(j)  (256  + 64 * (j))
#define XB_XSUB(j)  (1280 + 64 * (j))
#define XB_XGEN(j)  (2304 + 64 * (j))
#define XB_TOP      3328
#define XB_TOPGEN   3392
#define XCD_BAR_WORDS 3456
#define XB_SPIN_CAP (1u << 18)

__device__ __forceinline__ unsigned xb_ld(unsigned* p)              { return __hip_atomic_load(p, __ATOMIC_RELAXED, __HIP_MEMORY_SCOPE_AGENT); }
__device__ __forceinline__ unsigned xb_add(unsigned* p, unsigned v) { return __hip_atomic_fetch_add(p, v, __ATOMIC_RELAXED, __HIP_MEMORY_SCOPE_AGENT); }
__device__ __forceinline__ unsigned xb_xcc_id() { return (unsigned)__builtin_amdgcn_s_getreg((3 << 11) | 20) & 0xFu; }
#define XB_SPIN(cond, bar) do { unsigned _sp = 0; while (cond) { __builtin_amdgcn_s_sleep(1); \
    if ((++_sp & 255u) == 0u) { if (xb_ld(&(bar)[XB_TMO])) break; if (_sp > XB_SPIN_CAP) { atomicAdd(&(bar)[XB_TMO], 1u); break; } } } } while (0)

struct XcdBarrier {
    unsigned* bar; unsigned x;
    volatile LAS unsigned* st;
};

__device__ __forceinline__ XcdBarrier xcd_barrier_post(unsigned* bar, volatile LAS unsigned* st, int tid_in) {
    XcdBarrier b; b.bar = bar; b.x = xb_xcc_id(); b.st = st;
    if (tid_in == 0) (void)xb_add(&bar[XB_XCNT(b.x)], 1u);
    return b;
}
__device__ __forceinline__ void xcd_barrier_complete(unsigned* bar, unsigned x, unsigned& nloc, unsigned& nx) {
    const unsigned G = gridDim.x * gridDim.y * gridDim.z;
    unsigned sum, cnt, mine, sp = 0u;
    for (;;) {
        sum = 0u; cnt = 0u; mine = 0u;
#pragma unroll
        for (unsigned j = 0; j < 16; ++j) { const unsigned c = xb_ld(&bar[XB_XCNT(j)]); sum += c; cnt += (c > 0u) ? 1u : 0u; mine = (j == x) ? c : mine; }
        if (sum == G) break;
        __builtin_amdgcn_s_sleep(1);
        if ((++sp & 255u) == 0u) { if (xb_ld(&bar[XB_TMO])) break; if (sp > XB_SPIN_CAP) { atomicAdd(&bar[XB_TMO], 1u); break; } }
    }
    nloc = mine > 0u ? mine : 1u; nx = cnt > 0u ? cnt : 1u;
}

__device__ __forceinline__ void xcd_barrier(const XcdBarrier& b, int tid_in) {
    asm volatile("s_waitcnt vmcnt(0)" ::: "memory");
    __syncthreads();
    if (tid_in == 0) {
        unsigned* bar = b.bar;
        __builtin_amdgcn_s_waitcnt(0);
        unsigned nloc = b.st[0], nx = b.st[1];
        if (nloc == 0u) { xcd_barrier_complete(bar, b.x, nloc, nx); b.st[0] = nloc; b.st[1] = nx; }
        const unsigned old = xb_add(&bar[XB_XSUB(b.x)], 1u);
        const unsigned gen = old / nloc;
        if (old + 1u == (gen + 1u) * nloc) {
            __builtin_amdgcn_fence(__ATOMIC_RELEASE, "agent");
            asm volatile("s_waitcnt vmcnt(0)" ::: "memory");
            const unsigned og = xb_add(&bar[XB_TOP], 1u);
            const unsigned tg = og / nx;
            if (og + 1u == (tg + 1u) * nx) xb_add(&bar[XB_TOPGEN], 1u);
            else XB_SPIN(xb_ld(&bar[XB_TOPGEN]) == tg, bar);
            __builtin_amdgcn_fence(__ATOMIC_ACQUIRE, "agent");
            xb_add(&bar[XB_XGEN(b.x)], 1u);
            asm volatile("s_waitcnt vmcnt(0)" ::: "memory");
        } else {
            XB_SPIN(xb_ld(&bar[XB_XGEN(b.x)]) == gen, bar);
            __builtin_amdgcn_fence(__ATOMIC_ACQUIRE, "agent");
            asm volatile("s_waitcnt vmcnt(0)" ::: "memory");
        }
    }
    __syncthreads();
}


struct Args { const float* in[30]; float* out; unsigned char* ws; };
typedef const Args __attribute__((address_space(4))) Args_c;
__device__ __forceinline__ Args_c* kargs_ptr() { Args_c* p = (Args_c*)__builtin_amdgcn_kernarg_segment_ptr(); asm volatile("" : "+s"(p)); return p; }
#define GSYNC_CG() cg::this_grid().sync()
constexpr size_t WS_BAR = WS_END + 4096;
constexpr size_t WS_TOTAL = WS_BAR + (size_t)XCD_BAR_WORDS * 4;
static_assert(WS_TOTAL <= (size_t)512 * 1024 * 1024, "workspace");
constexpr int LDS_BARST = LDS_BYTES - 16;
#define GSYNC() do { XcdBarrier xb_; xb_.bar = (unsigned*)(kargs_ptr()->ws + WS_BAR); xb_.x = xb_xcc_id(); xb_.st = (volatile LAS unsigned*)(lds + LDS_BARST); xcd_barrier(xb_, TIDX()); } while (0)
#ifdef PROBE_A
#define TS(cat) do { if (blockIdx.x == 0 && TIDX() == 0) { unsigned long long* tsb = (unsigned long long*)(kargs_ptr()->ws + WS_END); const unsigned long long now = __builtin_amdgcn_s_memrealtime(); tsb[1 + (cat)] += now - tsb[0]; tsb[0] = now; } } while (0)
#else
#define TS(cat) do {} while (0)
#endif
__device__ __forceinline__ int tid_from(int wave_s) { int w_ = wave_s; unsigned z_ = 0u; asm volatile("" : "+s"(w_), "+s"(z_)); return w_ * 64 + (int)__builtin_amdgcn_mbcnt_hi(~0u, __builtin_amdgcn_mbcnt_lo(~0u, z_)); }
#define TIDX() tid_from(wave_s)
#define KA() int tid = TIDX(); asm volatile("" : "+v"(tid)); int G = gridDim.x, bid = blockIdx.x; asm volatile("" : "+s"(G), "+s"(bid)); \
    const int lane = tid & 63, wave = __builtin_amdgcn_readfirstlane(tid >> 6), gw = bid * 8 + wave, ngw = G * 8, gtid = bid * NTHR + tid, ngt = G * NTHR; \
    (void)lane; (void)wave; (void)gw; (void)ngw; (void)gtid; (void)ngt; \
    Args_c* ka = kargs_ptr(); unsigned char* ws = ka->ws; (void)ws

__global__ void __launch_bounds__(NTHR, 2) fwd_kernel(Args a_unused) {
    extern __shared__ __attribute__((aligned(16))) unsigned char lds_raw[];
    LAS unsigned char* lds = (LAS unsigned char*)lds_raw;
    const int wave_s = __builtin_amdgcn_readfirstlane((int)threadIdx.x >> 6);
    if (TIDX() < 4) ((volatile LAS unsigned*)(lds + LDS_BARST))[TIDX()] = 0u;
    __syncthreads();
    (void)xcd_barrier_post((unsigned*)(kargs_ptr()->ws + WS_BAR), (volatile LAS unsigned*)(lds + LDS_BARST), TIDX());
#ifdef PROBE_A
    if (blockIdx.x == 0 && TIDX() == 0) { unsigned long long* tsb = (unsigned long long*)(kargs_ptr()->ws + WS_END); for (int i = 1; i < 32; ++i) tsb[i] = 0; tsb[0] = __builtin_amdgcn_s_memrealtime(); }
#endif

#ifdef REP_INIT
#pragma unroll 1
    for (int rep_ = 0; rep_ < 2; ++rep_) {
#else
    {
#endif
    {
        KA();
        bf16_t* WB = (bf16_t*)(ws + WS_WB);
        LAS float* scr = (LAS float*)(lds + wave * 8448);
        constexpr int IT_L = 12416;
        for (int it = gw; it < 2 * IT_L; it += ngw) {
            const int l = it / IT_L; int r = it % IT_L;
            bf16_t* Wl = WB + (size_t)l * WL_TOTAL;
            if (r < 1408) { transpose_item(ka->in[9] + (size_t)l * 1024 * DFF, 1024, DFF, Wl + WL_UP1, 1, scr, r, lane); continue; } r -= 1408;
            if (r < 1408) { transpose_item(ka->in[10] + (size_t)l * 1024 * DFF, 1024, DFF, Wl + WL_UP1, 2, scr, r, lane); continue; } r -= 1408;
            if (r < 1408) { transpose_item(ka->in[11] + (size_t)l * DFF * 1024, DFF, 1024, Wl + WL_DN1, 0, scr, r, lane); continue; } r -= 1408;
            if (r < 1408) { transpose_item(ka->in[12] + (size_t)l * 1024 * DFF, 1024, DFF, Wl + WL_UP2, 1, scr, r, lane); continue; } r -= 1408;
            if (r < 1408) { transpose_item(ka->in[13] + (size_t)l * 1024 * DFF, 1024, DFF, Wl + WL_UP2, 2, scr, r, lane); continue; } r -= 1408;
            if (r < 1408) { transpose_item(ka->in[14] + (size_t)l * DFF * 1024, DFF, 1024, Wl + WL_DN2, 0, scr, r, lane); continue; } r -= 1408;
            if (r < 3072) { transpose_item(ka->in[15] + (size_t)l * 1024 * 6144, 1024, 6144, Wl + WL_IN, 3, scr, r, lane); continue; } r -= 3072;
            if (r < 256) { transpose_item(ka->in[25] + (size_t)l * 512 * 1024, 512, 1024, Wl + WL_PA, 0, scr, r, lane); continue; } r -= 256;
            if (r < 128) { transpose_item(ka->in[26] + (size_t)l * 256 * 1024, 256, 1024, Wl + WL_PH, 0, scr, r, lane); continue; } r -= 128;
            transpose_item(ka->in[28] + (size_t)l * 1024 * 1024, 1024, 1024, Wl + WL_O, 0, scr, r, lane);
        }
        __syncthreads();
    }
    {
        KA();
        float* MOD = (float*)(ws + WS_MOD);
        LAS float* sv = (LAS float*)lds;
        LAS float* part = (LAS float*)(lds + 12288);
        for (int i = tid; i < 3072; i += NTHR) { const int seg = i >> 10, k = i & 1023; const float x = (seg < 2) ? ka->in[1][seg * 1024 + k] : ka->in[3][k]; sv[i] = x / (1.f + __expf(-x)); }
        __syncthreads();
        for (int item = bid; item < 288; item += G) {
            const int l = item / 144, col = (item % 144) * 64 + lane;
            const float* W = ka->in[4] + (size_t)l * 1024 * 9216 + col;
            float a0 = 0.f, a1 = 0.f, a2 = 0.f;
            for (int k = wave * 128; k < wave * 128 + 128; ++k) { const float w = W[(size_t)k * 9216]; a0 = __builtin_fmaf(sv[k], w, a0); a1 = __builtin_fmaf(sv[1024 + k], w, a1); a2 = __builtin_fmaf(sv[2048 + k], w, a2); }
            part[(wave * 3 + 0) * 64 + lane] = a0; part[(wave * 3 + 1) * 64 + lane] = a1; part[(wave * 3 + 2) * 64 + lane] = a2;
            __syncthreads();
            if (tid < 192) { const int seg = tid >> 6, cl = tid & 63; float s = 0.f;
#pragma unroll
                for (int w = 0; w < 8; ++w) s += part[(w * 3 + seg) * 64 + cl];
                const int cc = (item % 144) * 64 + cl;
                MOD[(size_t)(l * 3 + seg) * 9216 + cc] = s + ka->in[5][l * 9216 + cc]; }
            __syncthreads();
        }
    }
    {
        KA();
        bf16_t* WB = (bf16_t*)(ws + WS_WB); float* CS = (float*)(ws + WS_CS); float* LBT = (float*)(ws + WS_LB); float* LAMV = (float*)(ws + WS_LAM);
        for (int idx = gtid; idx < 2 * 256 * 1024; idx += ngt) {
            const int n = idx & 1023, k = (idx >> 10) & 255, l = idx >> 18, g = k >> 6, c = k & 63;
            const float* pw = ka->in[23] + (size_t)l * 4 * 64 * 64 + (g * 64 + c) * 64;
            const float* psc = ka->in[24] + l * 256 + g * 64;
            const float* wp = ka->in[27] + (size_t)l * 256 * 1024 + (size_t)(g * 64) * 1024 + n;
            float s = 0.f;
            for (int d = 0; d < 64; ++d) s = __builtin_fmaf(pw[d] * psc[d], wp[(size_t)d * 1024], s);
            (WB + (size_t)l * WL_TOTAL + WL_PP)[(size_t)n * 256 + k] = (bf16_t)(pk2(s, 0.f) & 0xffffu);
        }
        for (int idx = gtid; idx < 4096; idx += ngt) {
            const int n = idx >> 4, j = idx & 15;
            const float invf = __builtin_exp2f(-(float)j * (13.287712379549449f / 16.f));
            const float ang = (float)n * invf;
            const double rev = (double)ang * 0.15915494309189535; const float fr = (float)(rev - __builtin_floor(rev));
            CS[n * 32 + j] = __builtin_amdgcn_cosf(fr); CS[n * 32 + 16 + j] = __builtin_amdgcn_sinf(fr);
        }
        for (int idx = gtid; idx < 1024; idx += ngt) {
            const int l = idx >> 9, dc = idx & 511;
            const float l0 = ka->in[21][dc], l1 = ka->in[21][512 + dc];
            LBT[idx] = (l == 0) ? 0.f : 1.f / (1.f + __expf(l0 - l1));
        }
        for (int idx = gtid; idx < NCTX * DM / 4; idx += ngt) ((f32x4*)(ws + WS_HC))[idx] = ((const f32x4*)ka->in[2])[idx];
        if (gtid < 2) {
            const int l = gtid; float s1 = 0.f, s2 = 0.f;
            for (int i = 0; i < 64; ++i) { s1 += ka->in[16][l * 64 + i] * ka->in[17][l * 64 + i]; s2 += ka->in[18][l * 64 + i] * ka->in[19][l * 64 + i]; }
            const float li = (l == 0) ? 0.2f : (0.8f - 0.6f * 0.7408182206817179f);
            LAMV[l * 2 + 0] = __expf(s1) - __expf(s2) + li; LAMV[l * 2 + 1] = 1.f - li;
        }
    }
    }
    GSYNC_CG();
    TS(0);

#pragma unroll 1
    for (int l = 0; l < 2; ++l) {
#ifdef REP_SYNC
#pragma unroll 1
        for (int rs_ = 0; rs_ < 10; ++rs_) { GSYNC(); }
#endif
#pragma unroll 1
        for (int f = 0; f < 2; ++f) {
            {   KA(); const bool first = (l == 0 && f == 0);
                const float* in_lat = first ? ka->in[0] : ka->out; const float* in_ctx = (const float*)(ws + WS_HC);
                norm_phase(in_lat, in_ctx, ka->in[f ? 8 : 6] + l * 1024, (const float*)(ws + WS_MOD) + (size_t)l * 3 * 9216, f ? 6 : 0, f ? 7 : 1, (bf16_t*)(ws + WS_XB), gw, ngw, lane,
                           (const float*)(ws + WS_O), first ? 0 : (f ? (l == 0 ? 4 : 0) : DFF / 256), (float*)(ws + WS_HC)); }
            GSYNC();
            TS(1);
            {   KA(); bf16_t* Wl = (bf16_t*)(ws + WS_WB) + (size_t)l * WL_TOTAL;
                const int Mr = (l == 1 && f == 1) ? NLAT : R;
                pg8::Gemm g{(bf16_t*)(ws + WS_XB), Wl + (f ? WL_UP2 : WL_UP1), Mr, 5632, 1024}; pg8::StaticOrder S; S.init(Mr, 5632, G, bid); EpiUp E{(bf16_t*)(ws + WS_Z)};
                pg8::gemm_phase<EpiUp, pg8::StaticOrder, true, true>(lds, g, S, E, tid); }
            GSYNC();
            TS(2);
            {   KA(); bf16_t* Wl = (bf16_t*)(ws + WS_WB) + (size_t)l * WL_TOTAL; const bool first = (l == 0 && f == 0);
                const float* in_lat = first ? ka->in[0] : ka->out;
                pg8::Gemm g{(bf16_t*)(ws + WS_Z), Wl + (f ? WL_DN2 : WL_DN1), NLAT, 1024, DFF}; pg8::StaticOrder S; S.init(NLAT, 1024, G, bid);
                EpiRes E{in_lat, (const float*)(ws + WS_HC), ka->out, (float*)(ws + WS_HC), (const float*)(ws + WS_MOD) + (size_t)l * 3 * 9216 + (f ? 8 : 2) * 1024, 0.5f};
                pg8::gemm_phase<EpiRes, pg8::StaticOrder, true, true>(lds, g, S, E, tid); }
            if (!(l == 1 && f == 1))
            {   KA(); bf16_t* Wl = (bf16_t*)(ws + WS_WB) + (size_t)l * WL_TOTAL;
                pg8::Gemm g{(bf16_t*)(ws + WS_Z) + (size_t)NLAT * DFF, Wl + (f ? WL_DN2 : WL_DN1), NCTX, 1024, 256, DFF}; SplitKOrder S; S.init(DFF / 256, 256, G, bid);
                EpiPart E{(float*)(ws + WS_O), (const float*)(ws + WS_MOD) + (size_t)l * 3 * 9216 + (f ? 8 : 2) * 1024, 0.5f};
                pg8::gemm_phase<EpiPart, SplitKOrder, true, true>(lds, g, S, E, tid); }
            GSYNC();
            TS(3);
            if (f == 1) break;
            {   KA();
                norm_phase(ka->out, (const float*)(ws + WS_HC), ka->in[7] + l * 1024, (const float*)(ws + WS_MOD) + (size_t)l * 3 * 9216, 3, 4, (bf16_t*)(ws + WS_XB), gw, ngw, lane,
                           (const float*)(ws + WS_O), DFF / 256, (float*)(ws + WS_HC)); }
            GSYNC();
            TS(1);
            {   KA(); bf16_t* Wl = (bf16_t*)(ws + WS_WB) + (size_t)l * WL_TOTAL;
                pg8::Gemm g{(bf16_t*)(ws + WS_XB), Wl + WL_IN, R, 3072, 1024}; pg8::StaticOrder S; S.init(R, 3072, G, bid);
                EpiWin E{ws + WS_Z, (const float*)(ws + WS_CS), (const float*)(ws + WS_LB) + l * 512, 0};
                pg8::gemm_phase<EpiWin, pg8::StaticOrder, true, true>(lds, g, S, E, tid); }
            GSYNC();
            TS(4);
            {   KA(); pool_phase((const bf16_t*)(ws + WS_Z + Z_ZP), (bf16_t*)(ws + WS_O + O_MX), gtid, ngt); }
#ifdef REP_ATTN
            for (int rep_ = 0; rep_ < 2; ++rep_)
#endif
            {   KA();
                const float* LAMV = (const float*)(ws + WS_LAM);
                const int nunits = 1024 + (l == 0 ? 16 : 0);
                for (int u = bid; u < nunits; u += G) {
                    int bh, qrow0, kt0, kt1;
                    if (u < 1024) { bh = u >> 7; qrow0 = (bh >> 2) * SEQ + (u & 127) * 128; kt0 = 0; kt1 = KEYS / 64; }
                    else { const int v = u - 1024; bh = v >> 1; qrow0 = NLAT + (bh >> 2) * CTXL + (v & 1) * 128; kt0 = SEQ / 64; kt1 = KEYS / 64; }
                    attn_unit(lds, (const bf16_t*)(ws + WS_Z + Z_Q), (const bf16_t*)(ws + WS_Z + Z_K), (const bf16_t*)(ws + WS_Z + Z_VT), (bf16_t*)(ws + WS_O + O_DA), ka->in[20] + l * 128,
                              bh >> 2, bh & 3, qrow0, kt0, kt1, LAMV[l * 2], LAMV[l * 2 + 1], tid, wave, lane);
                }
            }
            GSYNC();
            TS(5);
#ifdef REP_HG
#pragma unroll 1
            for (int rep_ = 0; rep_ < 2; ++rep_) {
#else
            {
#endif
            {   KA(); hg_passA_mfma(lds, (const float*)(ws + WS_Z + Z_FF), (const float*)(ws + WS_Z + Z_FB), (const bf16_t*)(ws + WS_Z + Z_HI),
                                      (float*)(ws + WS_CAR), (float*)(ws + WS_DK), wave, lane, G); }
            GSYNC();
            TS(6);
            {   KA(); hg_carry((float*)(ws + WS_CAR), (const float*)(ws + WS_DK), gtid, ngt); }
            GSYNC();
            TS(7);
            {   KA(); hg_passB_mfma(lds, (const float*)(ws + WS_Z + Z_HQ), (const float*)(ws + WS_Z + Z_FF), (const float*)(ws + WS_Z + Z_FB), (const bf16_t*)(ws + WS_Z + Z_HI),
                                      (const float*)(ws + WS_CAR), (bf16_t*)(ws + WS_Z + Z_K), wave, lane, G); }
            GSYNC();
            TS(8);
            {   KA(); hg_readout((const bf16_t*)(ws + WS_Z + Z_K), (const bf16_t*)(ws + WS_Z + Z_HG), ka->in[22] + l * 64, (bf16_t*)(ws + WS_O + O_HG), gw, ngw, lane); }
            GSYNC();
            TS(9);
            }
            {   KA(); bf16_t* Wl = (bf16_t*)(ws + WS_WB) + (size_t)l * WL_TOTAL;
                const int Mr = (l == 1) ? NLAT : R;
                pg8::Gemm g{(bf16_t*)(ws + WS_XB), Wl + WL_IN + (size_t)3072 * 1024, Mr, 3072, 1024}; pg8::StaticOrder S; S.init(Mr, 3072, G, bid); EpiG E{(bf16_t*)(ws + WS_Z)};
                pg8::gemm_phase<EpiG, pg8::StaticOrder, true, true>(lds, g, S, E, tid); }
            GSYNC();
            TS(10);
#pragma unroll 1
            for (int gi = 0; gi < 3; ++gi) {
                KA(); bf16_t* Wl = (bf16_t*)(ws + WS_WB) + (size_t)l * WL_TOTAL;
                const bf16_t* A = (const bf16_t*)(ws + WS_O + ((gi == 0) ? O_DA : (gi == 1 ? O_HG : O_MX))); const int K = (gi == 0) ? 512 : 256;
                const bf16_t* Bt = Wl + ((gi == 0) ? WL_PA : (gi == 1 ? WL_PH : WL_PP));
                const int Mr = (l == 1) ? NLAT : R;
                pg8::Gemm g{A, Bt, Mr, 1024, K}; pg8::StaticOrder S; S.init(Mr, 1024, G, bid); EpiProj E{(bf16_t*)(ws + WS_XB), (const bf16_t*)(ws + WS_Z), gi, gi == 0};
                pg8::gemm_phase<EpiProj, pg8::StaticOrder, true, true>(lds, g, S, E, tid);
            }
            GSYNC();
            TS(11);
            {   KA(); bf16_t* Wl = (bf16_t*)(ws + WS_WB) + (size_t)l * WL_TOTAL;
                pg8::Gemm g{(bf16_t*)(ws + WS_XB), Wl + WL_O, NLAT, 1024, 1024}; pg8::StaticOrder S; S.init(NLAT, 1024, G, bid);
                EpiRes E{ka->out, (const float*)(ws + WS_HC), ka->out, (float*)(ws + WS_HC), (const float*)(ws + WS_MOD) + (size_t)l * 3 * 9216 + 5 * 1024, 1.0f};
                pg8::gemm_phase<EpiRes, pg8::StaticOrder, true, true>(lds, g, S, E, tid); }
            if (l == 0)
            {   KA(); bf16_t* Wl = (bf16_t*)(ws + WS_WB) + (size_t)l * WL_TOTAL;
                pg8::Gemm g{(bf16_t*)(ws + WS_XB) + (size_t)NLAT * 1024, Wl + WL_O, NCTX, 1024, 256, 1024}; SplitKOrder S; S.init(4, 256, G, bid);
                EpiPart E{(float*)(ws + WS_O), (const float*)(ws + WS_MOD) + (size_t)l * 3 * 9216 + 5 * 1024, 1.0f};
                pg8::gemm_phase<EpiPart, SplitKOrder, true, true>(lds, g, S, E, tid); }
            GSYNC();
            TS(12);
        }
    }
    {   KA(); final_norm_phase(ka->out, ka->in[29], gw, ngw, lane); }
#ifdef PROBE_A
    GSYNC(); TS(1);
    if (blockIdx.x == 0) { KA(); const unsigned long long* tsb = (const unsigned long long*)(ws + WS_END);
        __syncthreads();
        const float va = (float)tsb[1 + PROBE_A] * 0.01f, vb = (float)tsb[1 + PROBE_B] * 0.01f;
        __syncthreads();
        if (tid == 0) ka->out[0] += va;
        for (int i = tid; i < 65536; i += NTHR) ka->out[(size_t)(i / 1024 + 8) * 1024 + (i & 1023)] += vb; }
#endif
}

extern "C" void kernel_launch(void* const* d_in, const int* in_sizes, int n_in, void* d_out, int out_size, void* d_ws, size_t ws_size, hipStream_t stream) {
    static int grid = 0;
    if (grid == 0) {
        if (n_in != 30 || out_size != NLAT * DM || ws_size < WS_TOTAL) { fprintf(stderr, "kernel_launch: unexpected shapes (n_in %d out %d ws %zu need %zu)\n", n_in, out_size, ws_size, (size_t)WS_TOTAL); grid = -1; return; }
        int dev = 0, cus = 0, per_cu = 0;
        (void)hipGetDevice(&dev);
        (void)hipDeviceGetAttribute(&cus, hipDeviceAttributeMultiprocessorCount, dev);
        if (hipFuncSetAttribute((const void*)fwd_kernel, hipFuncAttributeMaxDynamicSharedMemorySize, LDS_BYTES) != hipSuccess) { fprintf(stderr, "kernel_launch: hipFuncSetAttribute failed\n"); grid = -1; return; }
        if (hipOccupancyMaxActiveBlocksPerMultiprocessor(&per_cu, (const void*)fwd_kernel, NTHR, LDS_BYTES) != hipSuccess || per_cu < 1) { fprintf(stderr, "kernel_launch: occupancy query failed (%d)\n", per_cu); (void)hipGetLastError(); per_cu = 1; }
        if (per_cu > 1) per_cu = 1;
        grid = cus * per_cu;
    }
    if (grid < 0) return;
    if (hipMemsetAsync((unsigned char*)d_ws + WS_BAR, 0, (size_t)XCD_BAR_WORDS * 4, stream) != hipSuccess) { fprintf(stderr, "kernel_launch: memset failed\n"); return; }
    Args a{};
    for (int i = 0; i < 30; ++i) a.in[i] = (const float*)d_in[i];
    a.out = (float*)d_out; a.ws = (unsigned char*)d_ws;
    void* args[] = {&a};
    hipError_t e = hipLaunchCooperativeKernel((const void*)fwd_kernel, dim3(grid), dim3(NTHR), args, LDS_BYTES, stream);
    if (e != hipSuccess) fprintf(stderr, "cooperative launch failed: %s (grid %d)\n", hipGetErrorString(e), grid);
}
```

```cpp
#include <hip/hip_runtime.h>
#include <hip/hip_cooperative_groups.h>
#include <cstdio>
#include <cstdint>
namespace cg = cooperative_groups;
namespace pg8 {
#define PG8_LAS __attribute__((address_space(3)))
typedef unsigned short bf16_t;
typedef short bf16x8 __attribute__((ext_vector_type(8)));
typedef float f32x4 __attribute__((ext_vector_type(4)));
typedef unsigned u32x4 __attribute__((ext_vector_type(4)));
constexpr int BM = 256, BK = 64, HALF = 128, HTB = HALF * BK * 2  , STAGE_BYTES = 8 * HTB, NXCD = 8, WGM = 8;

__host__ __device__ __forceinline__ int lds_byte(int r, int c) { const int st = (r >> 4) * 2 + (c >> 5), rr = r & 15, cc = c & 31, ob = rr * 64 + cc * 2; return st * 1024 + (ob ^ (((ob >> 9) & 1) << 5)); }
__host__ __device__ __forceinline__ void stage_rc(int b, int& R, int& C) { const int st = b / 1024, sb = b % 1024, swz = sb ^ (((sb >> 9) & 1) << 5); R = (st >> 1) * 16 + swz / 64; C = (st & 1) * 32 + (swz % 64) / 2; }
__host__ __device__ __forceinline__ int perm32(int rho) { const int n = rho >> 4, i = rho & 15; return 8 * (i >> 2) + 4 * n + (i & 3); }

struct Unit { int pm, pn; int koff = 0; };
struct Gemm { const bf16_t* A; const bf16_t* Bt; int M, N, K; int ld = 0; };

struct StaticOrder {
    int nM, nN, nwg, G, c;
    __host__ __device__ void init(int M, int N, int G_, int c_) { nM = M / BM; nN = N / BM; nwg = nM * nN; G = G_; c = c_; }
    __host__ __device__ bool next(int i, Unit& u) const {
        const long L = (long)i * G + c; if (L >= nwg) return false;
        int wgid = (int)L; { const int q = nwg / NXCD, r = nwg % NXCD, xcd = wgid % NXCD, off = wgid / NXCD; wgid = (xcd < r ? xcd * (q + 1) : r * (q + 1) + (xcd - r) * q) + off; }
        const int nig = WGM * nN, gid = wgid / nig, fm = gid * WGM, gsz = (nM - fm) < WGM ? (nM - fm) : WGM;
        u.pm = fm + ((wgid % nig) % gsz); u.pn = (wgid % nig) / gsz; u.koff = 0; return true;
    }
    __device__ __forceinline__ void a_ready(const Unit&) const {}
    __device__ __forceinline__ void done(const Unit&) const {}
};

}
namespace pg8 {
template <class Epi, class Sched, bool ALIGN_EPI = false, bool SP2 = false>
__device__ __forceinline__ void gemm_phase(PG8_LAS unsigned char* lds, const Gemm g, const Sched& S, const Epi& E, int tid_in) {
    int tid_ = tid_in; asm volatile("" : "+v"(tid_)); const int tid = tid_, wid = __builtin_amdgcn_readfirstlane(tid >> 6), lane = tid & 63, wr = wid >> 2, wc = wid & 3, fr = lane & 15, fq = lane >> 4;
    const int K = g.ld ? g.ld : g.K, nt = g.K / BK;
    unsigned voffA[2], voffB[2];
#pragma unroll
    for (int i = 0; i < 2; ++i) { int R, C; stage_rc(tid * 16 + i * 8192, R, C); const int Rb = Epi::PERM ? ((R & ~31) + perm32(R & 31)) : R;
        voffA[i] = (unsigned)(R * K + C) * 2u; voffB[i] = (unsigned)(Rb * K + C) * 2u; }
    const size_t kstep = (size_t)(BK * 2);
    const size_t hstep = (size_t)HALF * K * 2;
    const size_t tstep = 2 * hstep;
    const unsigned ldsw = (unsigned)wid * 1024u;
    const int aoff = lds_byte(wr * 64 + fr, fq * 8), boff = lds_byte(wc * 32 + fr, fq * 8);
#define PG8_SA(b, h) (((b) * 2 + (h)) * HTB)
#define PG8_SB(b, h) ((4 + (b) * 2 + (h)) * HTB)
#define PG8_STAGE(bufoff, gbase, voff) do { _Pragma("unroll") for (int _i = 0; _i < 2; ++_i) \
        __builtin_amdgcn_global_load_lds((const unsigned*)((const char*)(gbase) + (voff)[_i]), (PG8_LAS unsigned*)(lds + (bufoff) + ldsw + _i * 8192), 16, 0, 0); } while (0)
#define PG8_LDA(dst, b, h) do { _Pragma("unroll") for (int m = 0; m < 4; ++m) _Pragma("unroll") for (int k = 0; k < 2; ++k) dst[m][k] = *(const PG8_LAS bf16x8*)(lds + PG8_SA(b, h) + aoff + m * 2048 + k * 1024); } while (0)
#define PG8_LDB(dst, b, h) do { _Pragma("unroll") for (int n = 0; n < 2; ++n) _Pragma("unroll") for (int k = 0; k < 2; ++k) dst[n][k] = *(const PG8_LAS bf16x8*)(lds + PG8_SB(b, h) + boff + n * 2048 + k * 1024); } while (0)
#define PG8_MMA(ai, bj, At, Bt) do { __builtin_amdgcn_s_setprio(1); _Pragma("unroll") for (int m = 0; m < 4; ++m) _Pragma("unroll") for (int n = 0; n < 2; ++n) _Pragma("unroll") for (int k = 0; k < 2; ++k) \
        acc[ai][bj][m][n] = __builtin_amdgcn_mfma_f32_16x16x32_bf16(Bt[n][k], At[m][k], acc[ai][bj][m][n], 0, 0, 0); __builtin_amdgcn_s_setprio(0); } while (0)
#define PG8_WAIT_V(n) asm volatile("s_waitcnt vmcnt(" #n ")" ::: "memory")
#define PG8_WAIT_L(n) asm volatile("s_waitcnt lgkmcnt(" #n ")" ::: "memory")
#define PG8_BAR __builtin_amdgcn_s_barrier()
#define PG8_SCHED __builtin_amdgcn_sched_barrier(0)
    Unit cur, nxt; int ui = 0;
    if (!S.next(0, cur)) return;
    f32x4 acc[2][2][4][2];
#pragma unroll
    for (int a = 0; a < 2; ++a)
#pragma unroll
        for (int b = 0; b < 2; ++b)
#pragma unroll
            for (int m = 0; m < 4; ++m)
#pragma unroll
                for (int n = 0; n < 2; ++n) acc[a][b][m][n] = (f32x4){0.f, 0.f, 0.f, 0.f};
    bf16x8 At[4][2], B0[2][2], B1[2][2];
    const char* cA = (const char*)g.A + (size_t)cur.pm * tstep + (size_t)cur.koff * 2; const char* cB = (const char*)g.Bt + (size_t)cur.pn * tstep + (size_t)cur.koff * 2;
    S.a_ready(cur);
    if constexpr (SP2) {
        PG8_STAGE(PG8_SB(0, 0), cB, voffB); PG8_STAGE(PG8_SB(0, 1), cB + hstep, voffB); PG8_STAGE(PG8_SA(0, 0), cA, voffA); PG8_STAGE(PG8_SA(0, 1), cA + hstep, voffA);
        if (wr == 1) PG8_BAR;
        PG8_WAIT_V(2); PG8_BAR;
        PG8_STAGE(PG8_SB(1, 0), cB + kstep, voffB); PG8_STAGE(PG8_SA(1, 0), cA + kstep, voffA); PG8_STAGE(PG8_SB(1, 1), cB + hstep + kstep, voffB);
        PG8_WAIT_V(6); PG8_BAR;
    } else {
        PG8_STAGE(PG8_SB(0, 0), cB, voffB); PG8_STAGE(PG8_SA(0, 0), cA, voffA); PG8_STAGE(PG8_SB(0, 1), cB + hstep, voffB); PG8_STAGE(PG8_SA(0, 1), cA + hstep, voffA);
        if (wr == 1) PG8_BAR;
        PG8_WAIT_V(4); PG8_BAR;
        PG8_STAGE(PG8_SB(1, 0), cB + kstep, voffB); PG8_STAGE(PG8_SA(1, 0), cA + kstep, voffA); PG8_STAGE(PG8_SB(1, 1), cB + hstep + kstep, voffB);
        PG8_WAIT_V(6); PG8_BAR;
    }
    for (;;) {
        const bool has_next = S.next(ui + 1, nxt);
        const char* nA = has_next ? (const char*)g.A + (size_t)nxt.pm * tstep + (size_t)nxt.koff * 2 : cA; const char* nB = has_next ? (const char*)g.Bt + (size_t)nxt.pn * tstep + (size_t)nxt.koff * 2 : cB;
        for (int t = 0; t < nt; t += 2) {
            const bool last = (t == nt - 2);
            const char* a1 = cA + (size_t)(t + 1) * kstep;
            const char* a2 = last ? nA : cA + (size_t)(t + 2) * kstep; const char* b2 = last ? nB : cB + (size_t)(t + 2) * kstep;
            const char* a3 = a2 + kstep; const char* b3 = b2 + kstep;
            if (last && has_next) S.a_ready(nxt);
            if constexpr (SP2) {
            PG8_LDB(B0, 0, 0); PG8_LDB(B1, 0, 1); PG8_SCHED; PG8_LDA(At, 0, 0); PG8_STAGE(PG8_SA(1, 1), a1 + hstep, voffA);
            PG8_WAIT_V(8); PG8_WAIT_L(0); PG8_BAR; PG8_MMA(0, 0, At, B0); PG8_MMA(0, 1, At, B1); PG8_BAR; PG8_SCHED;
            PG8_LDA(At, 0, 1); PG8_STAGE(PG8_SB(0, 0), b2, voffB); PG8_STAGE(PG8_SB(0, 1), b2 + hstep, voffB); PG8_STAGE(PG8_SA(0, 0), a2, voffA);
            PG8_WAIT_V(8); PG8_WAIT_L(0); PG8_BAR; PG8_MMA(1, 0, At, B0); PG8_MMA(1, 1, At, B1); PG8_BAR; PG8_SCHED;
            PG8_LDB(B0, 1, 0); PG8_LDB(B1, 1, 1); PG8_SCHED; PG8_LDA(At, 1, 0); PG8_STAGE(PG8_SA(0, 1), a2 + hstep, voffA);
            PG8_WAIT_V(8); PG8_WAIT_L(0); PG8_BAR; PG8_MMA(0, 0, At, B0); PG8_MMA(0, 1, At, B1); PG8_BAR; PG8_SCHED;
            PG8_LDA(At, 1, 1); PG8_STAGE(PG8_SB(1, 0), b3, voffB); PG8_STAGE(PG8_SB(1, 1), b3 + hstep, voffB); PG8_STAGE(PG8_SA(1, 0), a3, voffA);
            PG8_WAIT_V(8); PG8_WAIT_L(0); PG8_BAR; PG8_MMA(1, 0, At, B0); PG8_MMA(1, 1, At, B1); PG8_BAR; PG8_SCHED;
            } else {
            PG8_LDB(B0, 0, 0); PG8_SCHED; PG8_LDA(At, 0, 0); PG8_STAGE(PG8_SA(1, 1), a1 + hstep, voffA);
            PG8_WAIT_L(8); PG8_BAR; PG8_WAIT_L(0); PG8_MMA(0, 0, At, B0); PG8_BAR; PG8_SCHED;
            PG8_LDB(B1, 0, 1); PG8_STAGE(PG8_SB(0, 0), b2, voffB);
            PG8_BAR; PG8_WAIT_L(0); PG8_MMA(0, 1, At, B1); PG8_BAR;
            PG8_LDA(At, 0, 1); PG8_STAGE(PG8_SA(0, 0), a2, voffA);
            PG8_BAR; PG8_WAIT_L(0); PG8_MMA(1, 0, At, B0); PG8_BAR; PG8_SCHED;
            PG8_STAGE(PG8_SB(0, 1), b2 + hstep, voffB);
            PG8_WAIT_V(6); PG8_BAR; PG8_MMA(1, 1, At, B1); PG8_BAR;
            PG8_LDB(B0, 1, 0); PG8_SCHED; PG8_LDA(At, 1, 0); PG8_STAGE(PG8_SA(0, 1), a2 + hstep, voffA);
            PG8_WAIT_L(8); PG8_BAR; PG8_WAIT_L(0); PG8_MMA(0, 0, At, B0); PG8_BAR; PG8_SCHED;
            PG8_LDB(B1, 1, 1); PG8_STAGE(PG8_SB(1, 0), b3, voffB);
            PG8_BAR; PG8_WAIT_L(0); PG8_MMA(0, 1, At, B1); PG8_BAR;
            PG8_LDA(At, 1, 1); PG8_STAGE(PG8_SA(1, 0), a3, voffA);
            PG8_BAR; PG8_WAIT_L(0); PG8_MMA(1, 0, At, B0); PG8_BAR; PG8_SCHED;
            PG8_STAGE(PG8_SB(1, 1), b3 + hstep, voffB);
            PG8_WAIT_V(6); PG8_BAR; PG8_MMA(1, 1, At, B1); PG8_BAR;
            }
        }
        if constexpr (ALIGN_EPI) { if (wr == 0) PG8_BAR; }
        if constexpr (!Epi::AFTER_DRAIN) { E(acc, cur, wr, wc, fr, fq); S.done(cur); }
        if (!has_next) break;
#pragma unroll
        for (int a = 0; a < 2; ++a)
#pragma unroll
            for (int b = 0; b < 2; ++b)
#pragma unroll
                for (int m = 0; m < 4; ++m)
#pragma unroll
                    for (int n = 0; n < 2; ++n) acc[a][b][m][n] = (f32x4){0.f, 0.f, 0.f, 0.f};
        cur = nxt; cA = nA; cB = nB; ++ui;
        if constexpr (ALIGN_EPI) { if (wr == 1) PG8_BAR; }
    }
    PG8_WAIT_V(0);
    if constexpr (!ALIGN_EPI) { if (wr == 0) PG8_BAR; }
    PG8_BAR;
    if constexpr (Epi::AFTER_DRAIN) { E.fused(acc, cur, wr, wc, fr, fq, lds, wid, lane); S.done(cur); }
#undef PG8_SA
#undef PG8_SB
#undef PG8_STAGE
#undef PG8_LDA
#undef PG8_LDB
#undef PG8_MMA
#undef PG8_WAIT_V
#undef PG8_WAIT_L
#undef PG8_BAR
#undef PG8_SCHED
}
}

using pg8::bf16_t; using pg8::bf16x8; using pg8::f32x4; using pg8::u32x4; using pg8::Unit;
typedef float f32x16 __attribute__((ext_vector_type(16)));
typedef float f32x2v __attribute__((ext_vector_type(2)));
typedef __bf16 bf16x2v __attribute__((ext_vector_type(2)));
typedef unsigned u32x2 __attribute__((ext_vector_type(2)));
#define LAS __attribute__((address_space(3)))

constexpr int DM = 1024, NBATCH = 2, SEQ = 16384, CTXL = 256;
constexpr int NLAT = NBATCH * SEQ, NCTX = NBATCH * CTXL, R = NLAT + NCTX;
constexpr int DFF = 2816, KEYS = SEQ + CTXL;
constexpr float EPS = 1e-6f;
constexpr float C2 = 0.125f * 1.4426950408889634f;
constexpr int NTHR = 512;
constexpr int LDS_BYTES = 135168;
constexpr int HG_SEG = 128, HG_STEPS = KEYS / HG_SEG;

constexpr size_t WL_UP1 = 0, WL_DN1 = WL_UP1 + (size_t)5632 * 1024, WL_UP2 = WL_DN1 + (size_t)1024 * 2816, WL_DN2 = WL_UP2 + (size_t)5632 * 1024,
                 WL_IN = WL_DN2 + (size_t)1024 * 2816, WL_PA = WL_IN + (size_t)6144 * 1024, WL_PH = WL_PA + (size_t)1024 * 512, WL_PP = WL_PH + (size_t)1024 * 256,
                 WL_O = WL_PP + (size_t)1024 * 256, WL_TOTAL = WL_O + (size_t)1024 * 1024;
constexpr size_t WS_WB = 0;
constexpr size_t WS_XB = WS_WB + 2 * WL_TOTAL * 2;
constexpr size_t WS_Z = WS_XB + (size_t)R * 1024 * 2;
constexpr size_t Z_VT = 0, Z_HQ = Z_VT + (size_t)R * 512 * 2, Z_FF = Z_HQ + (size_t)R * 256 * 4, Z_FB = Z_FF + (size_t)R * 256 * 4, Z_HI = Z_FB + (size_t)R * 256 * 4,
                 Z_ZP = Z_HI + (size_t)R * 256 * 2, Z_Q = Z_ZP + (size_t)R * 256 * 2, Z_K = Z_Q + (size_t)R * 512 * 2, Z_HG = Z_K + (size_t)R * 512 * 2, Z_END = Z_HG + (size_t)R * 256 * 2;
static_assert((size_t)R * 3072 * 2 <= Z_K, "gate buffer must not reach k / odir / hgate");
static_assert((size_t)R * DFF * 2 <= Z_END, "act fits Z");
constexpr size_t WS_O = WS_Z + Z_END;
constexpr size_t O_DA = 0, O_HG = O_DA + (size_t)R * 512 * 2, O_MX = O_HG + (size_t)R * 256 * 2, O_END = O_MX + (size_t)R * 256 * 2;
constexpr size_t WS_CAR = WS_O + O_END;
constexpr size_t WS_DK = WS_CAR + (size_t)16 * HG_SEG * 4096 * 4;
constexpr size_t WS_HC = WS_DK + (size_t)16 * HG_SEG * 64 * 4;
constexpr size_t WS_MOD = WS_HC + (size_t)NCTX * 1024 * 4;
constexpr size_t WS_CS = WS_MOD + (size_t)2 * 3 * 9216 * 4;
constexpr size_t WS_LB = WS_CS + (size_t)256 * 32 * 4;
constexpr size_t WS_LAM = WS_LB + (size_t)2 * 2 * 256 * 4;
constexpr size_t WS_END = WS_LAM + 256;
static_assert(WS_END <= (size_t)512 * 1024 * 1024, "workspace");

__device__ __forceinline__ unsigned pk2(float lo, float hi) { f32x2v v = {lo, hi}; bf16x2v b = __builtin_convertvector(v, bf16x2v); return __builtin_bit_cast(unsigned, b); }
__device__ __forceinline__ float bf2f(unsigned short u) { return __builtin_bit_cast(float, (unsigned)u << 16); }
__device__ __forceinline__ float bflo(unsigned u) { return __builtin_bit_cast(float, u << 16); }
__device__ __forceinline__ float bfhi(unsigned u) { return __builtin_bit_cast(float, u & 0xffff0000u); }
__device__ __forceinline__ float ex2(float x) { return __builtin_amdgcn_exp2f(x); }
__device__ __forceinline__ float rcpf_(float x) { return __builtin_amdgcn_rcpf(x); }
__device__ __forceinline__ float sigm(float x) { return rcpf_(1.f + ex2(-1.4426950408889634f * x)); }
__device__ __forceinline__ float siluf(float x) { return x * sigm(x); }
__device__ __forceinline__ float shx(float v, int o, int lane) { return __builtin_bit_cast(float, __builtin_amdgcn_ds_bpermute((lane ^ o) << 2, __builtin_bit_cast(int, v))); }
__device__ __forceinline__ float swap32(float v) { auto rr = __builtin_amdgcn_permlane32_swap(__builtin_bit_cast(unsigned, v), __builtin_bit_cast(unsigned, v), false, false);
    const float a = __builtin_bit_cast(float, rr[0]), b = __builtin_bit_cast(float, rr[1]); return (a == v) ? b : a; }
__device__ __forceinline__ float wave_sum(float v, int lane) {
#pragma unroll
    for (int o = 1; o < 64; o <<= 1) v += shx(v, o, lane);
    return v;
}
#define LDS_WAIT() asm volatile("s_waitcnt lgkmcnt(0)" ::: "memory")

struct EpiUp {
    static constexpr bool PERM = true, AFTER_DRAIN = false;
    bf16_t* act;
    __device__ __forceinline__ void operator()(const f32x4 (&acc)[2][2][4][2], const Unit& u, int wr, int wc, int fr, int fq) const {
        const int row0 = u.pm * 256 + wr * 64 + fr, col0 = u.pn * 128 + wc * 32 + 8 * fq;
#pragma unroll
        for (int ai = 0; ai < 2; ++ai)
#pragma unroll
            for (int m = 0; m < 4; ++m) {
                const int row = row0 + ai * 128 + m * 16;
                const f32x4 a0 = acc[ai][0][m][0], a1 = acc[ai][0][m][1], b0 = acc[ai][1][m][0], b1 = acc[ai][1][m][1];
                u32x4 w;
                w.x = pk2(siluf(a0[0]) * b0[0], siluf(a0[1]) * b0[1]); w.y = pk2(siluf(a0[2]) * b0[2], siluf(a0[3]) * b0[3]);
                w.z = pk2(siluf(a1[0]) * b1[0], siluf(a1[1]) * b1[1]); w.w = pk2(siluf(a1[2]) * b1[2], siluf(a1[3]) * b1[3]);
                *(u32x4*)(act + (size_t)row * DFF + col0) = w;
            }
    }
};
struct EpiRes {
    static constexpr bool PERM = true, AFTER_DRAIN = false;
    const float* in_lat; const float* in_ctx; float* out_lat; float* out_ctx; const float* gate; float coef;
    __device__ __forceinline__ void operator()(const f32x4 (&acc)[2][2][4][2], const Unit& u, int wr, int wc, int fr, int fq) const {
        const int row0 = u.pm * 256 + wr * 64 + fr, col0 = u.pn * 256 + wc * 32 + 8 * fq;
        const int seg = (u.pm < 64) ? 0 : (u.pm < 128 ? 1 : 2);
        f32x4 gv[2][2];
#pragma unroll
        for (int bj = 0; bj < 2; ++bj)
#pragma unroll
            for (int n = 0; n < 2; ++n) gv[bj][n] = *(const f32x4*)(gate + seg * 9216 + col0 + bj * 128 + 4 * n) * coef;
#pragma unroll
        for (int ai = 0; ai < 2; ++ai)
#pragma unroll
            for (int m = 0; m < 4; ++m) {
                const int row = row0 + ai * 128 + m * 16;
                const float* ip; float* op;
                if (row < NLAT) { ip = in_lat + (size_t)row * DM; op = out_lat + (size_t)row * DM; }
                else { ip = in_ctx + (size_t)(row - NLAT) * DM; op = out_ctx + (size_t)(row - NLAT) * DM; }
#pragma unroll
                for (int bj = 0; bj < 2; ++bj)
#pragma unroll
                    for (int n = 0; n < 2; ++n) {
                        const int c = col0 + bj * 128 + 4 * n;
                        f32x4 v = *(const f32x4*)(ip + c);
                        v = v + gv[bj][n] * acc[ai][bj][m][n];
                        *(f32x4*)(op + c) = v;
                    }
            }
    }
};
struct SplitKOrder {
    int nunits, G, c, kc;
    __device__ void init(int nparts, int kc_, int G_, int c_) { nunits = nparts * 8; G = G_; c = c_; kc = kc_; }
    __device__ bool next(int i, Unit& u) const {
        const int L = i * G + c; if (L >= nunits) return false;
        const int part = L >> 3, r = L & 7; u.pm = r >> 2; u.pn = r & 3; u.koff = part * kc; return true;
    }
    __device__ __forceinline__ void a_ready(const Unit&) const {}
    __device__ __forceinline__ void done(const Unit&) const {}
};
struct EpiPart {
    static constexpr bool PERM = true, AFTER_DRAIN = false;
    float* P; const float* gate; float coef;
    __device__ __forceinline__ void operator()(const f32x4 (&acc)[2][2][4][2], const Unit& u, int wr, int wc, int fr, int fq) const {
        unsigned z_ = 0u; asm volatile("" : "+s"(z_));
        const int lane_ = (int)__builtin_amdgcn_mbcnt_hi(~0u, __builtin_amdgcn_mbcnt_lo(~0u, z_)), fr_ = lane_ & 15, fq_ = lane_ >> 4;
        const int row0 = u.pm * 256 + wr * 64 + fr_, col0 = u.pn * 256 + wc * 32 + 8 * fq_;
        float* Pp = P + (size_t)(u.koff >> 8) * NCTX * DM;
        f32x4 gv[2][2];
#pragma unroll
        for (int bj = 0; bj < 2; ++bj)
#pragma unroll
            for (int n = 0; n < 2; ++n) gv[bj][n] = *(const f32x4*)(gate + 2 * 9216 + col0 + bj * 128 + 4 * n) * coef;
#pragma unroll
        for (int ai = 0; ai < 2; ++ai)
#pragma unroll
            for (int m = 0; m < 4; ++m) {
                float* op = Pp + (size_t)(row0 + ai * 128 + m * 16) * DM;
#pragma unroll
                for (int bj = 0; bj < 2; ++bj)
#pragma unroll
                    for (int n = 0; n < 2; ++n) *(f32x4*)(op + col0 + bj * 128 + 4 * n) = gv[bj][n] * acc[ai][bj][m][n];
            }
    }
};
struct EpiWin {
    static constexpr bool PERM = true, AFTER_DRAIN = false;
    unsigned char* Z; const float* cs; const float* lb; int pn_off;
    __device__ __forceinline__ void operator()(const f32x4 (&acc)[2][2][4][2], const Unit& u, int wr, int wc, int fr, int fq) const {
        const int t = u.pn + pn_off;
        const int row0 = u.pm * 256 + wr * 64 + fr, cin = wc * 32 + 8 * fq;
        if (t < 4) {
            bf16_t* dst = (bf16_t*)(Z + ((t < 2) ? Z_Q : Z_K)); const float sc = (t < 2) ? C2 : 1.f; const int cb = (t & 1) * 256;
#pragma unroll
            for (int ai = 0; ai < 2; ++ai)
#pragma unroll
                for (int m = 0; m < 4; ++m) {
                    const int row = row0 + ai * 128 + m * 16;
                    f32x4 cv = {1.f, 1.f, 1.f, 1.f}, sv = {0.f, 0.f, 0.f, 0.f};
                    if (row < NLAT) { const int ts = row & (SEQ - 1); const int pos = (wc & 1) ? (ts & 63) : (ts >> 6);
                        cv = *(const f32x4*)(cs + pos * 32 + 4 * fq); sv = *(const f32x4*)(cs + pos * 32 + 16 + 4 * fq); }
#pragma unroll
                    for (int bj = 0; bj < 2; ++bj) {
                        const f32x4 x1 = acc[ai][bj][m][0], x2 = acc[ai][bj][m][1];
                        const f32x4 o1 = (x1 * cv - x2 * sv) * sc, o2 = (x1 * sv + x2 * cv) * sc;
                        u32x4 w; w.x = pk2(o1[0], o1[1]); w.y = pk2(o1[2], o1[3]); w.z = pk2(o2[0], o2[1]); w.w = pk2(o2[2], o2[3]);
                        *(u32x4*)(dst + (size_t)row * 512 + cb + bj * 128 + cin) = w;
                    }
                }
        } else if (t < 6) {
            bf16_t* vT = (bf16_t*)(Z + Z_VT);
#pragma unroll
            for (int ai = 0; ai < 2; ++ai)
#pragma unroll
                for (int m = 0; m < 4; ++m) {
                    const int row = row0 + ai * 128 + m * 16;
                    int b, key;
                    if (row < NLAT) { b = row >> 14; key = row & (SEQ - 1); } else { b = (row - NLAT) >> 8; key = SEQ + ((row - NLAT) & (CTXL - 1)); }
                    key = (key & ~15) + (key & 3) + ((key >> 3) & 1) * 4 + ((key >> 2) & 1) * 8;
#pragma unroll
                    for (int bj = 0; bj < 2; ++bj) {
                        bf16_t* dp = vT + (size_t)(b * 512 + (t - 4) * 256 + bj * 128 + cin) * KEYS + key;
#pragma unroll
                        for (int n = 0; n < 2; ++n)
#pragma unroll
                            for (int i = 0; i < 4; i += 2) {
                                const unsigned w = pk2(acc[ai][bj][m][n][i], acc[ai][bj][m][n][i + 1]);
                                dp[(size_t)(4 * n + i) * KEYS] = (bf16_t)(w & 0xffffu); dp[(size_t)(4 * n + i + 1) * KEYS] = (bf16_t)(w >> 16);
                            }
                    }
                }
        } else if (t <= 8) {
            float* dst = (float*)(Z + ((t == 6) ? Z_HQ : (t == 7 ? Z_FF : Z_FB)));
            const float* lbp = lb + ((t == 8) ? 256 : 0);
#pragma unroll
            for (int bj = 0; bj < 2; ++bj)
#pragma unroll
                for (int n = 0; n < 2; ++n) {
                    f32x4 lbv = *(const f32x4*)(lbp + bj * 128 + cin + 4 * n);
                    f32x4 om = 1.f - lbv;
#pragma unroll
                    for (int ai = 0; ai < 2; ++ai)
#pragma unroll
                        for (int m = 0; m < 4; ++m) {
                            const int row = row0 + ai * 128 + m * 16;
                            const f32x4 z = acc[ai][bj][m][n];
                            f32x4 sg; sg[0] = sigm(z[0]); sg[1] = sigm(z[1]); sg[2] = sigm(z[2]); sg[3] = sigm(z[3]);
                            const f32x4 o = (t == 6) ? z * sg : lbv + om * sg;
                            *(f32x4*)(dst + (size_t)row * 256 + bj * 128 + cin + 4 * n) = o;
                        }
                }
        } else {
            bf16_t* dst = (bf16_t*)(Z + ((t == 9) ? Z_HI : (t == 10 ? Z_HG : Z_ZP)));
#pragma unroll
            for (int ai = 0; ai < 2; ++ai)
#pragma unroll
                for (int m = 0; m < 4; ++m) {
                    const int row = row0 + ai * 128 + m * 16;
#pragma unroll
                    for (int bj = 0; bj < 2; ++bj) {
                        f32x4 v0 = acc[ai][bj][m][0], v1 = acc[ai][bj][m][1];
                        if (t == 10) { v0[0] = siluf(v0[0]); v0[1] = siluf(v0[1]); v0[2] = siluf(v0[2]); v0[3] = siluf(v0[3]); v1[0] = siluf(v1[0]); v1[1] = siluf(v1[1]); v1[2] = siluf(v1[2]); v1[3] = siluf(v1[3]); }
                        u32x4 w; w.x = pk2(v0[0], v0[1]); w.y = pk2(v0[2], v0[3]); w.z = pk2(v1[0], v1[1]); w.w = pk2(v1[2], v1[3]);
                        *(u32x4*)(dst + (size_t)row * 256 + bj * 128 + cin) = w;
                    }
                }
        }
    }
};
struct EpiVT {
    static constexpr bool PERM = true, AFTER_DRAIN = false;
    bf16_t* vT;
    __device__ __forceinline__ void operator()(const f32x4 (&acc)[2][2][4][2], const Unit& u, int wr, int wc, int fr, int fq) const {
        const int e0 = u.pm * 256 + wr * 64 + fr;
        int b, key0;
        if (u.pn < 64) { b = 0; key0 = u.pn * 256; } else if (u.pn < 128) { b = 1; key0 = (u.pn - 64) * 256; } else { b = u.pn - 128; key0 = SEQ; }
        const int kc = key0 + wc * 32 + 8 * fq;
#pragma unroll
        for (int ai = 0; ai < 2; ++ai)
#pragma unroll
            for (int m = 0; m < 4; ++m) {
                const int e = e0 + ai * 128 + m * 16;
#pragma unroll
                for (int bj = 0; bj < 2; ++bj) {
                    const f32x4 v0 = acc[ai][bj][m][0], v1 = acc[ai][bj][m][1];
                    u32x4 w; w.x = pk2(v0[0], v0[1]); w.y = pk2(v0[2], v0[3]); w.z = pk2(v1[0], v1[1]); w.w = pk2(v1[2], v1[3]);
                    *(u32x4*)(vT + (size_t)(b * 512 + e) * KEYS + kc + bj * 128) = w;
                }
            }
    }
};
struct EpiG {
    static constexpr bool PERM = true, AFTER_DRAIN = false;
    bf16_t* G;
    __device__ __forceinline__ void operator()(const f32x4 (&acc)[2][2][4][2], const Unit& u, int wr, int wc, int fr, int fq) const {
        const int row0 = u.pm * 256 + wr * 64 + fr, col0 = u.pn * 256 + wc * 32 + 8 * fq;
#pragma unroll
        for (int ai = 0; ai < 2; ++ai)
#pragma unroll
            for (int m = 0; m < 4; ++m) {
                const int row = row0 + ai * 128 + m * 16;
#pragma unroll
                for (int bj = 0; bj < 2; ++bj) {
                    const f32x4 v0 = acc[ai][bj][m][0], v1 = acc[ai][bj][m][1];
                    u32x4 w; w.x = pk2(sigm(v0[0]), sigm(v0[1])); w.y = pk2(sigm(v0[2]), sigm(v0[3])); w.z = pk2(sigm(v1[0]), sigm(v1[1])); w.w = pk2(sigm(v1[2]), sigm(v1[3]));
                    *(u32x4*)(G + (size_t)row * 3072 + col0 + bj * 128) = w;
                }
            }
    }
};
struct EpiProj {
    static constexpr bool PERM = true, AFTER_DRAIN = false;
    bf16_t* y; const bf16_t* G; int gi; int first;
    __device__ __forceinline__ void operator()(const f32x4 (&acc)[2][2][4][2], const Unit& u, int wr, int wc, int fr, int fq) const {
        const int row0 = u.pm * 256 + wr * 64 + fr, col0 = u.pn * 256 + wc * 32 + 8 * fq;
#pragma unroll
        for (int ai = 0; ai < 2; ++ai)
#pragma unroll
            for (int m = 0; m < 4; ++m) {
                const int row = row0 + ai * 128 + m * 16;
#pragma unroll
                for (int bj = 0; bj < 2; ++bj) {
                    const int c = col0 + bj * 128;
                    const u32x4 g = *(const u32x4*)(G + (size_t)row * 3072 + gi * 1024 + c);
                    u32x4 yo = {0u, 0u, 0u, 0u};
                    if (!first) yo = *(const u32x4*)(y + (size_t)row * 1024 + c);
                    const f32x4 v0 = acc[ai][bj][m][0], v1 = acc[ai][bj][m][1];
                    u32x4 w;
                    w.x = pk2(bflo(yo.x) + bflo(g.x) * v0[0], bfhi(yo.x) + bfhi(g.x) * v0[1]);
                    w.y = pk2(bflo(yo.y) + bflo(g.y) * v0[2], bfhi(yo.y) + bfhi(g.y) * v0[3]);
                    w.z = pk2(bflo(yo.z) + bflo(g.z) * v1[0], bfhi(yo.z) + bfhi(g.z) * v1[1]);
                    w.w = pk2(bflo(yo.w) + bflo(g.w) * v1[2], bfhi(yo.w) + bfhi(g.w) * v1[3]);
                    *(u32x4*)(y + (size_t)row * 1024 + c) = w;
                }
            }
    }
};

__device__ __forceinline__ int map_row(int mode, int n) {
    if (mode == 1) return 256 * (n >> 7) + (n & 127);
    if (mode == 2) return 256 * (n >> 7) + 128 + (n & 127);
    if (mode == 3) return (n < 1024) ? ((n & ~31) + 8 * ((n & 15) >> 2) + 4 * ((n >> 4) & 1) + (n & 3)) : n;
    return n;
}
__device__ __forceinline__ void transpose_item(const float* W, int K, int N, bf16_t* WT, int mode, LAS float* scr, int item, int lane) {
    const int nblk = N / 32, kb = item / nblk, nb = item % nblk, k0 = 64 * kb, n0 = 32 * nb;
#pragma unroll 8
    for (int i = 0; i < 32; ++i) { const int kk = 2 * i + (lane >> 5); scr[kk * 33 + (lane & 31)] = W[(size_t)(k0 + kk) * N + n0 + (lane & 31)]; }
    LDS_WAIT(); asm volatile("" ::: "memory");
    const int c = lane & 7;
#pragma unroll
    for (int j = 0; j < 4; ++j) { const int n = (lane >> 3) + 8 * j; const LAS float* s = scr + (8 * c) * 33 + n;
        u32x4 o; o.x = pk2(s[0 * 33], s[1 * 33]); o.y = pk2(s[2 * 33], s[3 * 33]); o.z = pk2(s[4 * 33], s[5 * 33]); o.w = pk2(s[6 * 33], s[7 * 33]);
        *(u32x4*)(WT + (size_t)map_row(mode, n0 + n) * K + k0 + 8 * c) = o; }
    LDS_WAIT(); asm volatile("" ::: "memory");
}

__device__ __forceinline__ void norm_phase(const float* in_lat, const float* in_ctx, const float* gain, const float* modl, int shi, int sci, bf16_t* outp, int gw, int ngw, int lane,
                                           const float* part, int nparts, float* hc_out) {
    f32x4 gv[4];
#pragma unroll
    for (int j = 0; j < 4; ++j) gv[j] = *(const f32x4*)(gain + 4 * lane + 256 * j);
    for (int row = gw; row < R; row += ngw) {
        const float* ip = (row < NLAT) ? in_lat + (size_t)row * DM : in_ctx + (size_t)(row - NLAT) * DM;
        const int seg = (row < SEQ) ? 0 : (row < NLAT ? 1 : 2);
        const float* sh = modl + seg * 9216 + shi * 1024; const float* sc = modl + seg * 9216 + sci * 1024;
        f32x4 v[4]; float ss = 0.f;
#pragma unroll
        for (int j = 0; j < 4; ++j) v[j] = *(const f32x4*)(ip + 4 * lane + 256 * j);
        if (row >= NLAT && nparts > 0) {
            for (int p = 0; p < nparts; ++p) {
                const float* pp = part + ((size_t)p * NCTX + (row - NLAT)) * DM;
#pragma unroll
                for (int j = 0; j < 4; ++j) v[j] = v[j] + *(const f32x4*)(pp + 4 * lane + 256 * j);
            }
#pragma unroll
            for (int j = 0; j < 4; ++j) *(f32x4*)(hc_out + (size_t)(row - NLAT) * DM + 4 * lane + 256 * j) = v[j];
        }
#pragma unroll
        for (int j = 0; j < 4; ++j) ss += (v[j][0] * v[j][0] + v[j][1] * v[j][1]) + (v[j][2] * v[j][2] + v[j][3] * v[j][3]);
        ss = wave_sum(ss, lane);
        const float rstd = 1.0f / sqrtf(ss * (1.f / DM) + EPS);
#pragma unroll
        for (int j = 0; j < 4; ++j) {
            const f32x4 s4 = *(const f32x4*)(sc + 4 * lane + 256 * j), h4 = *(const f32x4*)(sh + 4 * lane + 256 * j);
            const f32x4 y = v[j] * rstd * gv[j] * (s4 + 1.f) + h4;
            u32x2 w; w.x = pk2(y[0], y[1]); w.y = pk2(y[2], y[3]);
            *(u32x2*)(outp + (size_t)row * DM + 4 * lane + 256 * j) = w;
        }
    }
}
__device__ __forceinline__ void final_norm_phase(float* out, const float* gain, int gw, int ngw, int lane) {
    f32x4 gv[4];
#pragma unroll
    for (int j = 0; j < 4; ++j) gv[j] = *(const f32x4*)(gain + 4 * lane + 256 * j);
    for (int row = gw; row < NLAT; row += ngw) {
        float* ip = out + (size_t)row * DM;
        f32x4 v[4]; float ss = 0.f;
#pragma unroll
        for (int j = 0; j < 4; ++j) { v[j] = *(const f32x4*)(ip + 4 * lane + 256 * j); ss += (v[j][0] * v[j][0] + v[j][1] * v[j][1]) + (v[j][2] * v[j][2] + v[j][3] * v[j][3]); }
        ss = wave_sum(ss, lane);
        const float rstd = 1.0f / sqrtf(ss * (1.f / DM) + EPS);
#pragma unroll
        for (int j = 0; j < 4; ++j) *(f32x4*)(ip + 4 * lane + 256 * j) = v[j] * rstd * gv[j];
    }
}
__device__ __forceinline__ void pool_phase(const bf16_t* zp, bf16_t* mx, int gtid, int ngt) {
    for (int it = gtid; it < R * 32; it += ngt) {
        const int row = it >> 5, ch = (it & 31) * 8, g = ch >> 6, hw = 1 << g;
        int base, n;
        if (row < NLAT) { base = row & ~(SEQ - 1); n = SEQ; } else { base = NLAT + ((row - NLAT) & ~(CTXL - 1)); n = CTXL; }
        const int t = row - base, lo = (t - hw > 0) ? t - hw : 0, hi = (t + hw < n) ? t + hw : n;
        float s[8];
#pragma unroll
        for (int i = 0; i < 8; ++i) s[i] = 0.f;
        for (int j = lo; j < hi; ++j) {
            const u32x4 v = *(const u32x4*)(zp + (size_t)(base + j) * 256 + ch);
            s[0] += bflo(v.x); s[1] += bfhi(v.x); s[2] += bflo(v.y); s[3] += bfhi(v.y); s[4] += bflo(v.z); s[5] += bfhi(v.z); s[6] += bflo(v.w); s[7] += bfhi(v.w);
        }
        const float inv = 1.f / (float)(hi - lo);
        const u32x4 c = *(const u32x4*)(zp + (size_t)row * 256 + ch);
        u32x4 w;
        w.x = pk2(s[0] * inv - bflo(c.x), s[1] * inv - bfhi(c.x)); w.y = pk2(s[2] * inv - bflo(c.y), s[3] * inv - bfhi(c.y));
        w.z = pk2(s[4] * inv - bflo(c.z), s[5] * inv - bfhi(c.z)); w.w = pk2(s[6] * inv - bflo(c.w), s[7] * inv - bfhi(c.w));
        *(u32x4*)(mx + (size_t)row * 256 + ch) = w;
    }
}

__device__ __forceinline__ int hg_row(int dir, int b, int step) {
    if (step < CTXL) { const int t = dir ? (CTXL - 1 - step) : step; return NLAT + b * CTXL + t; }
    int t = step - CTXL; if (dir) t = SEQ - 1 - t; return b * SEQ + t;
}
template <bool OUT>
__device__ __forceinline__ void hg_pass(const float* hq, const float* ff, const float* fb, const bf16_t* hi, float* carry, float* dk, bf16_t* odir, int wave, int lane, int G) {
    for (int item = blockIdx.x + G * wave; item < 16 * HG_SEG; item += G * 8) {
        const int s = item / HG_SEG, j = item % HG_SEG, dir = s >> 3, b = (s >> 2) & 1, h = s & 3;
        const float* fbase = dir ? fb : ff;
        f32x2v S[32];
#pragma unroll
        for (int k = 0; k < 32; ++k) { S[k][0] = OUT ? carry[((size_t)item * 64 + 2 * k) * 64 + lane] : 0.f; S[k][1] = OUT ? carry[((size_t)item * 64 + 2 * k + 1) * 64 + lane] : 0.f; }
        float dl = 1.f;
        const int st0 = j * HG_STEPS, st1 = st0 + HG_STEPS;
        constexpr int HG_PF = 8;
        float ivb[HG_PF], fvb[HG_PF], qvb[HG_PF];
#pragma unroll
        for (int u = 0; u < HG_PF; ++u) {
            const int stl = (st0 + u < st1) ? st0 + u : st1 - 1;
            const size_t off = (size_t)hg_row(dir, b, stl) * 256 + h * 64 + lane;
            ivb[u] = bf2f(hi[off]); fvb[u] = fbase[off]; qvb[u] = OUT ? hq[off] : 0.f;
        }
        for (int sb = st0; sb < st1; sb += HG_PF) {
#pragma unroll
            for (int u = 0; u < HG_PF; ++u) {
                const int st = sb + u;
                if (st < st1) {
                    const float iv = ivb[u], fv = fvb[u], qv = qvb[u];
                    const size_t offc = (size_t)hg_row(dir, b, st) * 256 + h * 64 + lane;
                    { const int stn = (st + HG_PF < st1) ? st + HG_PF : st1 - 1;
                      const size_t off = (size_t)hg_row(dir, b, stn) * 256 + h * 64 + lane;
                      ivb[u] = bf2f(hi[off]); fvb[u] = fbase[off]; if (OUT) qvb[u] = hq[off]; }
                    if (!OUT) dl *= fv;
                    f32x2v o2 = {0.f, 0.f};
                    const f32x2v iv2 = {iv, iv};
                    const int fvi = __builtin_bit_cast(int, fv), qvi = __builtin_bit_cast(int, qv);
#pragma unroll
                    for (int k = 0; k < 32; ++k) {
                        f32x2v f2; f2[0] = __builtin_bit_cast(float, __builtin_amdgcn_readlane(fvi, 2 * k)); f2[1] = __builtin_bit_cast(float, __builtin_amdgcn_readlane(fvi, 2 * k + 1));
                        const f32x2v d2 = S[k] - iv2;
                        S[k] = __builtin_elementwise_fma(f2, d2, iv2);
                        if (OUT) { f32x2v q2; q2[0] = __builtin_bit_cast(float, __builtin_amdgcn_readlane(qvi, 2 * k)); q2[1] = __builtin_bit_cast(float, __builtin_amdgcn_readlane(qvi, 2 * k + 1));
                            o2 = __builtin_elementwise_fma(q2, S[k], o2); }
                    }
                    if (OUT) odir[(size_t)dir * R * 256 + offc] = (bf16_t)(pk2(o2[0] + o2[1], 0.f) & 0xffffu);
                }
            }
        }
        if (!OUT) {
#pragma unroll
            for (int k = 0; k < 32; ++k) { carry[((size_t)item * 64 + 2 * k) * 64 + lane] = S[k][0]; carry[((size_t)item * 64 + 2 * k + 1) * 64 + lane] = S[k][1]; }
            dk[item * 64 + lane] = dl;
        }
    }
}
constexpr int HGA_T = 48, HGA_STR = 112, HGA_MAT = 64 * HGA_STR, HGA_WAVE = 2 * HGA_MAT;
static_assert(8 * HGA_WAVE <= LDS_BYTES - 64 && 3 * HGA_T >= HG_STEPS, "hg pass A LDS");
__device__ __forceinline__ void hg_passA_mfma(LAS unsigned char* lds, const float* ff, const float* fb, const bf16_t* hi, float* carry, float* dk, int wave, int lane, int G) {
    LAS unsigned char* KT = lds + wave * HGA_WAVE; LAS unsigned char* VT = KT + HGA_MAT;
    const int n = lane & 31, gq = lane >> 5;
    for (int item = blockIdx.x + G * wave; item < 16 * HG_SEG; item += G * 8) {
        const int s = item / HG_SEG, j = item % HG_SEG, dir = s >> 3, b = (s >> 2) & 1, h = s & 3;
        const float* fbase = dir ? fb : ff;
        const int st0 = j * HG_STEPS, st1 = st0 + HG_STEPS;
        f32x16 acc[2][2];
#pragma unroll
        for (int kb = 0; kb < 2; ++kb)
#pragma unroll
            for (int vb = 0; vb < 2; ++vb)
#pragma unroll
                for (int r = 0; r < 16; ++r) acc[kb][vb][r] = 0.f;
        float P = 1.f;
        for (int third = 2; third >= 0; --third) {
            const int sb = st0 + third * HGA_T;
            for (int s0 = HGA_T - 8; s0 >= 0; s0 -= 8) {
                float fv[8]; unsigned short iv[8];
#pragma unroll
                for (int u = 0; u < 8; ++u) {
                    const int st = sb + s0 + u;
                    const int stc = (st < st1) ? st : st1 - 1;
                    const size_t off = (size_t)hg_row(dir, b, stc) * 256 + h * 64 + lane;
                    fv[u] = fbase[off]; iv[u] = hi[off];
                }
#pragma unroll
                for (int u = 7; u >= 0; --u) {
                    const int st = sb + s0 + u;
                    const bool ok = (st < st1);
                    const float f = ok ? fv[u] : 1.f;
                    const float kh = ok ? (1.f - f) * P : 0.f;
                    P *= f;
                    *(LAS unsigned short*)(KT + lane * HGA_STR + (s0 + u) * 2) = (unsigned short)(pk2(kh, 0.f) & 0xffffu);
                    *(LAS unsigned short*)(VT + lane * HGA_STR + (s0 + u) * 2) = ok ? iv[u] : (unsigned short)0;
                }
            }
            LDS_WAIT(); asm volatile("" ::: "memory");
#pragma unroll
            for (int q = 0; q < HGA_T / 16; ++q) {
                bf16x8 af[2], bfr[2];
#pragma unroll
                for (int kb = 0; kb < 2; ++kb) af[kb] = *(LAS bf16x8*)(KT + (kb * 32 + n) * HGA_STR + (16 * q + 8 * gq) * 2);
#pragma unroll
                for (int vb = 0; vb < 2; ++vb) bfr[vb] = *(LAS bf16x8*)(VT + (vb * 32 + n) * HGA_STR + (16 * q + 8 * gq) * 2);
#pragma unroll
                for (int kb = 0; kb < 2; ++kb)
#pragma unroll
                    for (int vb = 0; vb < 2; ++vb) acc[kb][vb] = __builtin_amdgcn_mfma_f32_32x32x16_bf16(af[kb], bfr[vb], acc[kb][vb], 0, 0, 0);
            }
            LDS_WAIT(); asm volatile("" ::: "memory");
        }
#pragma unroll
        for (int kb = 0; kb < 2; ++kb)
#pragma unroll
            for (int vb = 0; vb < 2; ++vb)
#pragma unroll
                for (int r = 0; r < 16; ++r) {
                    const int k = kb * 32 + 8 * (r >> 2) + 4 * gq + (r & 3), v = vb * 32 + n;
                    carry[((size_t)item * 64 + k) * 64 + v] = acc[kb][vb][r];
                }
        dk[item * 64 + lane] = P;
    }
}
constexpr int HGB_QSTR = 144, HGB_TSTR = 48, HGB_Q = 0, HGB_K = HGB_Q + 16 * HGB_QSTR, HGB_KH = HGB_K + 16 * HGB_QSTR, HGB_IT = HGB_KH + 64 * HGB_TSTR, HGB_DC = HGB_IT + 64 * HGB_TSTR, HGB_WAVE = HGB_DC + 256;
static_assert(8 * HGB_WAVE <= LDS_BYTES - 64, "hg pass B LDS");
__device__ __forceinline__ bf16x8 hgb_pack8(const f32x16& t, int r0) {
    u32x4 w; w.x = pk2(t[r0 + 0], t[r0 + 1]); w.y = pk2(t[r0 + 2], t[r0 + 3]); w.z = pk2(t[r0 + 4], t[r0 + 5]); w.w = pk2(t[r0 + 6], t[r0 + 7]); return __builtin_bit_cast(bf16x8, w);
}
__device__ __forceinline__ void hg_passB_mfma(LAS unsigned char* lds, const float* hq, const float* ff, const float* fb, const bf16_t* hi, const float* carry, bf16_t* odir, int wave, int lane, int G) {
    LAS unsigned char* W = lds + wave * HGB_WAVE;
    const int n = lane & 31, gq = lane >> 5, n16 = n & 15;
    const int kpos = (lane & ~15) + (lane & 3) + ((lane >> 3) & 1) * 4 + ((lane >> 2) & 1) * 8;
    for (int item = blockIdx.x + G * wave; item < 16 * HG_SEG; item += G * 8) {
        const int s = item / HG_SEG, j = item % HG_SEG, dir = s >> 3, b = (s >> 2) & 1, h = s & 3;
        const float* fbase = dir ? fb : ff;
        const int st0 = j * HG_STEPS, st1 = st0 + HG_STEPS;
        f32x16 S[2][2];
#pragma unroll
        for (int kb = 0; kb < 2; ++kb)
#pragma unroll
            for (int vb = 0; vb < 2; ++vb)
#pragma unroll
                for (int r = 0; r < 16; ++r) S[kb][vb][r] = carry[((size_t)item * 64 + kb * 32 + 8 * (r >> 2) + 4 * gq + (r & 3)) * 64 + vb * 32 + n];
        for (int c0 = st0; c0 < st1; c0 += 16) {
            float fv[16], qv[16]; unsigned short iv[16];
#pragma unroll
            for (int t = 0; t < 16; ++t) {
                const int st = c0 + t; const int stc = (st < st1) ? st : st1 - 1;
                const size_t off = (size_t)hg_row(dir, b, stc) * 256 + h * 64 + lane;
                fv[t] = fbase[off]; qv[t] = hq[off]; iv[t] = hi[off];
            }
            float P = 1.f; float kt[16];
#pragma unroll
            for (int t = 0; t < 16; ++t) {
                const bool ok = (c0 + t < st1);
                const float f = ok ? fv[t] : 1.f, q = ok ? qv[t] : 0.f;
                P *= f;
                const float Pc = fmaxf(P, 1e-30f);
                kt[t] = ok ? (1.f - f) * rcpf_(Pc) : 0.f;
                *(LAS unsigned short*)(W + HGB_Q + t * HGB_QSTR + kpos * 2) = (unsigned short)(pk2(q * Pc, 0.f) & 0xffffu);
                *(LAS unsigned short*)(W + HGB_K + t * HGB_QSTR + kpos * 2) = (unsigned short)(pk2(kt[t], 0.f) & 0xffffu);
                *(LAS unsigned short*)(W + HGB_IT + lane * HGB_TSTR + t * 2) = ok ? iv[t] : (unsigned short)0;
            }
            const float P15 = fmaxf(P, 1e-30f);
#pragma unroll
            for (int t = 0; t < 16; ++t) *(LAS unsigned short*)(W + HGB_KH + lane * HGB_TSTR + t * 2) = (unsigned short)(pk2(kt[t] * P15, 0.f) & 0xffffu);
            *(LAS float*)(W + HGB_DC + lane * 4) = P;
            LDS_WAIT(); asm volatile("" ::: "memory");
            bf16x8 qb[4];
#pragma unroll
            for (int u = 0; u < 4; ++u) qb[u] = *(LAS bf16x8*)(W + HGB_Q + n16 * HGB_QSTR + (16 * u + 8 * gq) * 2);
            f32x16 OT[2], AT;
#pragma unroll
            for (int r = 0; r < 16; ++r) { OT[0][r] = 0.f; OT[1][r] = 0.f; AT[r] = 0.f; }
#pragma unroll
            for (int u = 0; u < 4; ++u) {
                const bf16x8 ka = *(LAS bf16x8*)(W + HGB_K + n16 * HGB_QSTR + (16 * u + 8 * gq) * 2);
                AT = __builtin_amdgcn_mfma_f32_32x32x16_bf16(ka, qb[u], AT, 0, 0, 0);
#pragma unroll
                for (int vb = 0; vb < 2; ++vb)
                    OT[vb] = __builtin_amdgcn_mfma_f32_32x32x16_bf16(hgb_pack8(S[u >> 1][vb], 8 * (u & 1)), qb[u], OT[vb], 0, 0, 0);
            }
#pragma unroll
            for (int r = 0; r < 8; ++r) { const int srow = 8 * (r >> 2) + 4 * gq + (r & 3); if (srow > n) AT[r] = 0.f; }
            const bf16x8 ab = hgb_pack8(AT, 0);
#pragma unroll
            for (int vb = 0; vb < 2; ++vb) {
                const u32x2 lo = *(LAS u32x2*)(W + HGB_IT + (vb * 32 + n) * HGB_TSTR + (4 * gq) * 2), hi2 = *(LAS u32x2*)(W + HGB_IT + (vb * 32 + n) * HGB_TSTR + (8 + 4 * gq) * 2);
                const bf16x8 ia = __builtin_bit_cast(bf16x8, ((u32x4){lo.x, lo.y, hi2.x, hi2.y}));
                OT[vb] = __builtin_amdgcn_mfma_f32_32x32x16_bf16(ia, ab, OT[vb], 0, 0, 0);
            }
            if (n < 16 && c0 + n < st1) {
                bf16_t* op = odir + (size_t)dir * R * 256 + (size_t)hg_row(dir, b, c0 + n) * 256 + h * 64;
#pragma unroll
                for (int vb = 0; vb < 2; ++vb)
#pragma unroll
                    for (int r4 = 0; r4 < 4; ++r4) {
                        u32x2 w; w.x = pk2(OT[vb][4 * r4 + 0], OT[vb][4 * r4 + 1]); w.y = pk2(OT[vb][4 * r4 + 2], OT[vb][4 * r4 + 3]);
                        *(u32x2*)(op + vb * 32 + 8 * r4 + 4 * gq) = w;
                    }
            }
#pragma unroll
            for (int kb = 0; kb < 2; ++kb) {
                f32x4 dc[4];
#pragma unroll
                for (int r4 = 0; r4 < 4; ++r4) dc[r4] = *(LAS f32x4*)(W + HGB_DC + (kb * 32 + 8 * r4 + 4 * gq) * 4);
                const bf16x8 kh = *(LAS bf16x8*)(W + HGB_KH + (kb * 32 + n) * HGB_TSTR + (8 * gq) * 2);
#pragma unroll
                for (int vb = 0; vb < 2; ++vb) {
#pragma unroll
                    for (int r = 0; r < 16; ++r) S[kb][vb][r] *= dc[r >> 2][r & 3];
                    const bf16x8 ib = *(LAS bf16x8*)(W + HGB_IT + (vb * 32 + n) * HGB_TSTR + (8 * gq) * 2);
                    S[kb][vb] = __builtin_amdgcn_mfma_f32_32x32x16_bf16(kh, ib, S[kb][vb], 0, 0, 0);
                }
            }
            LDS_WAIT(); asm volatile("" ::: "memory");
        }
    }
}
__device__ __forceinline__ void hg_carry(float* carry, const float* dk, int gtid, int ngt) {
    for (int e = gtid; e < 16 * 4096; e += ngt) {
        const int s = e >> 12, idx = e & 4095, k = idx >> 6;
        float run = 0.f;
        for (int j0 = 0; j0 < HG_SEG; j0 += 8) {
            float t[8], d[8];
#pragma unroll
            for (int u = 0; u < 8; ++u) { t[u] = carry[(size_t)(s * HG_SEG + j0 + u) * 4096 + idx]; d[u] = dk[(s * HG_SEG + j0 + u) * 64 + k]; }
#pragma unroll
            for (int u = 0; u < 8; ++u) { carry[(size_t)(s * HG_SEG + j0 + u) * 4096 + idx] = run; run = __builtin_fmaf(d[u], run, t[u]); }
        }
    }
}
__device__ __forceinline__ void hg_readout(const bf16_t* odir, const bf16_t* hgs, const float* gain, bf16_t* ohg, int gw, int ngw, int lane) {
    const f32x4 gv = *(const f32x4*)(gain + ((4 * lane) & 63));
    for (int row = gw; row < R; row += ngw) {
        const size_t off = (size_t)row * 256 + 4 * lane;
        const u32x2 a = *(const u32x2*)(odir + off), bq = *(const u32x2*)(odir + (size_t)R * 256 + off), hg = *(const u32x2*)(hgs + off);
        const float o0 = bflo(a.x) + bflo(bq.x), o1 = bfhi(a.x) + bfhi(bq.x), o2 = bflo(a.y) + bflo(bq.y), o3 = bfhi(a.y) + bfhi(bq.y);
        float ss = (o0 * o0 + o1 * o1) + (o2 * o2 + o3 * o3);
        ss += shx(ss, 1, lane); ss += shx(ss, 2, lane); ss += shx(ss, 4, lane); ss += shx(ss, 8, lane);
        const float rstd = 1.0f / sqrtf(ss * (1.f / 64.f) + EPS);
        u32x2 w;
        w.x = pk2(o0 * rstd * gv[0] * bflo(hg.x), o1 * rstd * gv[1] * bfhi(hg.x));
        w.y = pk2(o2 * rstd * gv[2] * bflo(hg.y), o3 * rstd * gv[3] * bfhi(hg.y));
        *(u32x2*)(ohg + off) = w;
    }
}

constexpr int AT_KSTR = 256, AT_VSTR = 128, AT_KBYTES = 64 * AT_KSTR, AT_VBYTES = 128 * AT_VSTR, AT_STAGE = AT_KBYTES + AT_VBYTES;
static_assert(2 * AT_STAGE <= LDS_BYTES && 65536 <= 2 * AT_STAGE, "attention LDS");
__device__ __forceinline__ void attn_unit(LAS unsigned char* lds, const bf16_t* qbuf, const bf16_t* kbuf, const bf16_t* vT, bf16_t* oda, const float* gain,
                                          int b, int h, int qrow0, int kt0, int kt1, float lam, float post, int tid, int wave, int lane) {
    const int c = wave & 1, g = wave >> 1, n = lane & 31, gq = lane >> 5;
    bf16x8 qf[4];
    { const bf16_t* qp = qbuf + (size_t)(qrow0 + 32 * g + n) * 512 + h * 128 + c * 64 + 8 * gq;
#pragma unroll
      for (int s = 0; s < 4; ++s) qf[s] = *(const bf16x8*)(qp + 16 * s); }
    f32x16 O[4];
#pragma unroll
    for (int e = 0; e < 4; ++e)
#pragma unroll
        for (int r = 0; r < 16; ++r) O[e][r] = 0.f;
    float l = 0.f;
    const int kr_ = lane >> 4, kpos_ = lane & 15;
    const int vr_ = lane >> 3, vpos_ = lane & 7;
    const unsigned char* kbase = (const unsigned char*)(kbuf + h * 128);
    const unsigned char* vbase = (const unsigned char*)(vT + (size_t)(b * 512 + h * 128) * KEYS);
#define AT_KROW0(kt) (((kt) * 64 < SEQ) ? (size_t)b * SEQ + (kt) * 64 : (size_t)NLAT + b * CTXL + ((kt) * 64 - SEQ))
#define AT_DMA(kt, buf) do { const unsigned char* kb_ = kbase + AT_KROW0(kt) * 1024; const unsigned char* vb_ = vbase + (size_t)(kt) * 128; \
        _Pragma("unroll") for (int pp = 0; pp < 2; ++pp) { const int p_ = wave + 8 * pp; \
            { const int r_ = 4 * p_ + kr_; \
              __builtin_amdgcn_global_load_lds((const unsigned*)(kb_ + (size_t)r_ * 1024 + ((kpos_ ^ (r_ & 15)) * 16)), (LAS unsigned*)(lds + (buf) * AT_KBYTES + p_ * 1024), 16, 0, 0); } \
            { const int e_ = 8 * p_ + vr_; \
              __builtin_amdgcn_global_load_lds((const unsigned*)(vb_ + (size_t)e_ * (KEYS * 2) + ((vpos_ ^ ((e_ >> 1) & 7)) * 16)), (LAS unsigned*)(lds + 2 * AT_KBYTES + (buf) * AT_VBYTES + p_ * 1024), 16, 0, 0); } } } while (0)
#define AT_QK(Sa, Sb, buf) do { LAS unsigned char* kp = lds + (buf) * AT_KBYTES + n * AT_KSTR; \
        _Pragma("unroll") for (int s = 0; s < 4; ++s) { \
            const bf16x8 a0 = *(LAS bf16x8*)(kp + (((c * 8 + 2 * s + gq) ^ (n & 15)) * 16)), a1 = *(LAS bf16x8*)(kp + 32 * AT_KSTR + (((c * 8 + 2 * s + gq) ^ (n & 15)) * 16)); \
            Sa = __builtin_amdgcn_mfma_f32_32x32x16_bf16(a0, qf[s], Sa, 0, 0, 0); \
            Sb = __builtin_amdgcn_mfma_f32_32x32x16_bf16(a1, qf[s], Sb, 0, 0, 0); } } while (0)
#define AT_BAR() do { asm volatile("s_waitcnt vmcnt(0) lgkmcnt(0)" ::: "memory"); __builtin_amdgcn_s_barrier(); asm volatile("" ::: "memory"); } while (0)
    const int nt = kt1 - kt0;
    AT_DMA(kt0, 0);
    AT_BAR();
    f32x16 negm;
    {
        f32x16 S0, S1;
#pragma unroll
        for (int r = 0; r < 16; ++r) { S0[r] = 0.f; S1[r] = 0.f; }
        AT_QK(S0, S1, 0);
        float mx = fmaxf(S0[0], S1[0]);
#pragma unroll
        for (int r = 1; r < 16; ++r) mx = fmaxf(fmaxf(mx, S0[r]), S1[r]);
        { auto rr = __builtin_amdgcn_permlane32_swap(__builtin_bit_cast(unsigned, mx), __builtin_bit_cast(unsigned, mx), false, false);
          mx = fmaxf(__builtin_bit_cast(float, rr[0]), __builtin_bit_cast(float, rr[1])); }
#pragma unroll
        for (int r = 0; r < 16; ++r) negm[r] = -mx;
    }
    constexpr float THR = 8.f;
    for (int i = 0; i < nt; ++i) {
        const int cur = i & 1;
        bf16x8 kf[8];
        if (i + 1 < nt) AT_DMA(kt0 + i + 1, cur ^ 1);
        { LAS unsigned char* kp = lds + cur * AT_KBYTES + n * AT_KSTR;
#pragma unroll
          for (int s = 0; s < 4; ++s) { const int po = ((c * 8 + 2 * s + gq) ^ (n & 15)) * 16; kf[2 * s] = *(LAS bf16x8*)(kp + po); kf[2 * s + 1] = *(LAS bf16x8*)(kp + 32 * AT_KSTR + po); } }
        LAS unsigned char* vp = lds + 2 * AT_KBYTES + cur * AT_VBYTES + n * AT_VSTR;
        const int vsw = (n >> 1) & 7;
        bf16x8 va[8];
#pragma unroll
        for (int ks = 0; ks < 2; ++ks)
#pragma unroll
            for (int e = 0; e < 4; ++e) va[ks * 4 + e] = *(LAS bf16x8*)(vp + e * 32 * AT_VSTR + (((2 * ks + gq) ^ vsw) * 16));
        __builtin_amdgcn_sched_barrier(0);
        f32x16 S0 = negm, S1 = negm;
#pragma unroll
        for (int s = 0; s < 4; ++s) {
            S0 = __builtin_amdgcn_mfma_f32_32x32x16_bf16(kf[2 * s], qf[s], S0, 0, 0, 0);
            S1 = __builtin_amdgcn_mfma_f32_32x32x16_bf16(kf[2 * s + 1], qf[s], S1, 0, 0, 0);
        }
        __builtin_amdgcn_sched_barrier(0);
        bf16x8 vb[8];
#pragma unroll
        for (int ks = 0; ks < 2; ++ks)
#pragma unroll
            for (int e = 0; e < 4; ++e) vb[ks * 4 + e] = *(LAS bf16x8*)(vp + e * 32 * AT_VSTR + (((2 * (ks + 2) + gq) ^ vsw) * 16));
        __builtin_amdgcn_sched_barrier(0);
        float mx = fmaxf(S0[0], S1[0]);
#pragma unroll
        for (int r = 1; r < 16; ++r) mx = fmaxf(fmaxf(mx, S0[r]), S1[r]);
        { auto rr = __builtin_amdgcn_permlane32_swap(__builtin_bit_cast(unsigned, mx), __builtin_bit_cast(unsigned, mx), false, false);
          mx = fmaxf(__builtin_bit_cast(float, rr[0]), __builtin_bit_cast(float, rr[1])); }
        if (__builtin_amdgcn_ballot_w64(mx > THR) != 0ull) {
            const float delta = fmaxf(mx, 0.f), alpha = ex2(-delta);
            l *= alpha;
#pragma unroll
            for (int r = 0; r < 16; ++r) { S0[r] -= delta; S1[r] -= delta; negm[r] -= delta; }
#pragma unroll
            for (int e = 0; e < 4; ++e) O[e] = O[e] * alpha;
        }
        float ps = 0.f;
#pragma unroll
        for (int r = 0; r < 16; ++r) { S0[r] = ex2(S0[r]); S1[r] = ex2(S1[r]); ps += S0[r] + S1[r]; }
        l += ps;
        bf16x8 pb[4];
#pragma unroll
        for (int s = 0; s < 2; ++s) {
            u32x4 pw;
            pw.x = pk2(S0[8 * s + 0], S0[8 * s + 1]); pw.y = pk2(S0[8 * s + 2], S0[8 * s + 3]); pw.z = pk2(S0[8 * s + 4], S0[8 * s + 5]); pw.w = pk2(S0[8 * s + 6], S0[8 * s + 7]);
            pb[s] = __builtin_bit_cast(bf16x8, pw);
            pw.x = pk2(S1[8 * s + 0], S1[8 * s + 1]); pw.y = pk2(S1[8 * s + 2], S1[8 * s + 3]); pw.z = pk2(S1[8 * s + 4], S1[8 * s + 5]); pw.w = pk2(S1[8 * s + 6], S1[8 * s + 7]);
            pb[2 + s] = __builtin_bit_cast(bf16x8, pw);
        }
        __builtin_amdgcn_sched_barrier(0);
#pragma unroll
        for (int ks = 0; ks < 2; ++ks)
#pragma unroll
            for (int e = 0; e < 4; ++e) {
                O[e] = __builtin_amdgcn_mfma_f32_32x32x16_bf16(va[ks * 4 + e], pb[ks], O[e], 0, 0, 0);
            }
#pragma unroll
        for (int ks = 0; ks < 2; ++ks)
#pragma unroll
            for (int e = 0; e < 4; ++e) {
                O[e] = __builtin_amdgcn_mfma_f32_32x32x16_bf16(vb[ks * 4 + e], pb[2 + ks], O[e], 0, 0, 0);
            }
        AT_BAR();
    }
#undef AT_BAR
#undef AT_KROW0
#undef AT_DMA
#undef AT_QK
    l += shx(l, 32, lane);
    const float inv = 1.f / l;
    LAS float* xch = (LAS float*)lds;
    if (c == 1) {
#pragma unroll
        for (int e = 0; e < 4; ++e)
#pragma unroll
            for (int r = 0; r < 16; ++r) xch[(g * 64 + e * 16 + r) * 64 + lane] = O[e][r] * inv;
    }
    __syncthreads();
    if (c == 0) {
        float ss = 0.f;
#pragma unroll
        for (int e = 0; e < 4; ++e)
#pragma unroll
            for (int r = 0; r < 16; ++r) { const float o = O[e][r] * inv - lam * xch[(g * 64 + e * 16 + r) * 64 + lane]; O[e][r] = o; ss += o * o; }
        ss += shx(ss, 32, lane);
        const float rs = post / sqrtf(ss * (1.f / 128.f) + EPS);
        bf16_t* op = oda + (size_t)(qrow0 + 32 * g + n) * 512 + h * 128;
#pragma unroll
        for (int e = 0; e < 4; ++e)
#pragma unroll
            for (int r4 = 0; r4 < 4; ++r4) {
                const int e0 = e * 32 + 8 * r4 + 4 * gq;
                const f32x4 gv = *(const f32x4*)(gain + e0);
                u32x2 w; w.x = pk2(O[e][4 * r4 + 0] * rs * gv[0], O[e][4 * r4 + 1] * rs * gv[1]); w.y = pk2(O[e][4 * r4 + 2] * rs * gv[2], O[e][4 * r4 + 3] * rs * gv[3]);
                *(u32x2*)(op + e0) = w;
            }
    }
    __syncthreads();
}
#define XB_TMO      128
#define XB_XCNT(j)  (256  + 64 * (j))
#define XB_XSUB(j)  (1280 + 64 * (j))
#define XB_XGEN(j)  (2304 + 64 * (j))
#define XB_TOP      3328
#define XB_TOPGEN   3392
#define XCD_BAR_WORDS 3456
#define XB_SPIN_CAP (1u << 18)

__device__ __forceinline__ unsigned xb_ld(unsigned* p)              { return __hip_atomic_load(p, __ATOMIC_RELAXED, __HIP_MEMORY_SCOPE_AGENT); }
__device__ __forceinline__ unsigned xb_add(unsigned* p, unsigned v) { return __hip_atomic_fetch_add(p, v, __ATOMIC_RELAXED, __HIP_MEMORY_SCOPE_AGENT); }
__device__ __forceinline__ unsigned xb_xcc_id() { return (unsigned)__builtin_amdgcn_s_getreg((3 << 11) | 20) & 0xFu; }
#define XB_SPIN(cond, bar) do { unsigned _sp = 0; while (cond) { __builtin_amdgcn_s_sleep(1); \
    if ((++_sp & 255u) == 0u) { if (xb_ld(&(bar)[XB_TMO])) break; if (_sp > XB_SPIN_CAP) { atomicAdd(&(bar)[XB_TMO], 1u); break; } } } } while (0)

struct XcdBarrier {
    unsigned* bar; unsigned x;
    volatile LAS unsigned* st;
};

__device__ __forceinline__ XcdBarrier xcd_barrier_post(unsigned* bar, volatile LAS unsigned* st, int tid_in) {
    XcdBarrier b; b.bar = bar; b.x = xb_xcc_id(); b.st = st;
    if (tid_in == 0) (void)xb_add(&bar[XB_XCNT(b.x)], 1u);
    return b;
}
__device__ __forceinline__ void xcd_barrier_complete(unsigned* bar, unsigned x, unsigned& nloc, unsigned& nx) {
    const unsigned G = gridDim.x * gridDim.y * gridDim.z;
    unsigned sum, cnt, mine, sp = 0u;
    for (;;) {
        sum = 0u; cnt = 0u; mine = 0u;
#pragma unroll
        for (unsigned j = 0; j < 16; ++j) { const unsigned c = xb_ld(&bar[XB_XCNT(j)]); sum += c; cnt += (c > 0u) ? 1u : 0u; mine = (j == x) ? c : mine; }
        if (sum == G) break;
        __builtin_amdgcn_s_sleep(1);
        if ((++sp & 255u) == 0u) { if (xb_ld(&bar[XB_TMO])) break; if (sp > XB_SPIN_CAP) { atomicAdd(&bar[XB_TMO], 1u); break; } }
    }
    nloc = mine > 0u ? mine : 1u; nx = cnt > 0u ? cnt : 1u;
}

__device__ __forceinline__ void xcd_barrier(const XcdBarrier& b, int tid_in) {
    asm volatile("s_waitcnt vmcnt(0)" ::: "memory");
    __syncthreads();
    if (tid_in == 0) {
        unsigned* bar = b.bar;
        __builtin_amdgcn_s_waitcnt(0);
        unsigned nloc = b.st[0], nx = b.st[1];
        if (nloc == 0u) { xcd_barrier_complete(bar, b.x, nloc, nx); b.st[0] = nloc; b.st[1] = nx; }
        const unsigned old = xb_add(&bar[XB_XSUB(b.x)], 1u);
        const unsigned gen = old / nloc;
        if (old + 1u == (gen + 1u) * nloc) {
            __builtin_amdgcn_fence(__ATOMIC_RELEASE, "agent");
            asm volatile("s_waitcnt vmcnt(0)" ::: "memory");
            const unsigned og = xb_add(&bar[XB_TOP], 1u);
            const unsigned tg = og / nx;
            if (og + 1u == (tg + 1u) * nx) xb_add(&bar[XB_TOPGEN], 1u);
            else XB_SPIN(xb_ld(&bar[XB_TOPGEN]) == tg, bar);
            __builtin_amdgcn_fence(__ATOMIC_ACQUIRE, "agent");
            xb_add(&bar[XB_XGEN(b.x)], 1u);
            asm volatile("s_waitcnt vmcnt(0)" ::: "memory");
        } else {
            XB_SPIN(xb_ld(&bar[XB_XGEN(b.x)]) == gen, bar);
            __builtin_amdgcn_fence(__ATOMIC_ACQUIRE, "agent");
            asm volatile("s_waitcnt vmcnt(0)" ::: "memory");
        }
    }
    __syncthreads();
}


struct Args { const float* in[30]; float* out; unsigned char* ws; };
typedef const Args __attribute__((address_space(4))) Args_c;
__device__ __forceinline__ Args_c* kargs_ptr() { Args_c* p = (Args_c*)__builtin_amdgcn_kernarg_segment_ptr(); asm volatile("" : "+s"(p)); return p; }
#define GSYNC_CG() cg::this_grid().sync()
constexpr size_t WS_BAR = WS_END + 4096;
constexpr size_t WS_TOTAL = WS_BAR + (size_t)XCD_BAR_WORDS * 4;
static_assert(WS_TOTAL <= (size_t)512 * 1024 * 1024, "workspace");
constexpr int LDS_BARST = LDS_BYTES - 16;
#define GSYNC() do { XcdBarrier xb_; xb_.bar = (unsigned*)(kargs_ptr()->ws + WS_BAR); xb_.x = xb_xcc_id(); xb_.st = (volatile LAS unsigned*)(lds + LDS_BARST); xcd_barrier(xb_, TIDX()); } while (0)
#ifdef PROBE_A
#define TS(cat) do { if (blockIdx.x == 0 && TIDX() == 0) { unsigned long long* tsb = (unsigned long long*)(kargs_ptr()->ws + WS_END); const unsigned long long now = __builtin_amdgcn_s_memrealtime(); tsb[1 + (cat)] += now - tsb[0]; tsb[0] = now; } } while (0)
#else
#define TS(cat) do {} while (0)
#endif
__device__ __forceinline__ int tid_from(int wave_s) { int w_ = wave_s; unsigned z_ = 0u; asm volatile("" : "+s"(w_), "+s"(z_)); return w_ * 64 + (int)__builtin_amdgcn_mbcnt_hi(~0u, __builtin_amdgcn_mbcnt_lo(~0u, z_)); }
#define TIDX() tid_from(wave_s)
#define KA() int tid = TIDX(); asm volatile("" : "+v"(tid)); int G = gridDim.x, bid = blockIdx.x; asm volatile("" : "+s"(G), "+s"(bid)); \
    const int lane = tid & 63, wave = __builtin_amdgcn_readfirstlane(tid >> 6), gw = bid * 8 + wave, ngw = G * 8, gtid = bid * NTHR + tid, ngt = G * NTHR; \
    (void)lane; (void)wave; (void)gw; (void)ngw; (void)gtid; (void)ngt; \
    Args_c* ka = kargs_ptr(); unsigned char* ws = ka->ws; (void)ws

__global__ void __launch_bounds__(NTHR, 2) fwd_kernel(Args a_unused) {
    extern __shared__ __attribute__((aligned(16))) unsigned char lds_raw[];
    LAS unsigned char* lds = (LAS unsigned char*)lds_raw;
    const int wave_s = __builtin_amdgcn_readfirstlane((int)threadIdx.x >> 6);
    if (TIDX() < 4) ((volatile LAS unsigned*)(lds + LDS_BARST))[TIDX()] = 0u;
    __syncthreads();
    (void)xcd_barrier_post((unsigned*)(kargs_ptr()->ws + WS_BAR), (volatile LAS unsigned*)(lds + LDS_BARST), TIDX());
#ifdef PROBE_A
    if (blockIdx.x == 0 && TIDX() == 0) { unsigned long long* tsb = (unsigned long long*)(kargs_ptr()->ws + WS_END); for (int i = 1; i < 32; ++i) tsb[i] = 0; tsb[0] = __builtin_amdgcn_s_memrealtime(); }
#endif

#ifdef REP_INIT
#pragma unroll 1
    for (int rep_ = 0; rep_ < 2; ++rep_) {
#else
    {
#endif
    {
        KA();
        bf16_t* WB = (bf16_t*)(ws + WS_WB);
        LAS float* scr = (LAS float*)(lds + wave * 8448);
        constexpr int IT_L = 12416;
        for (int it = gw; it < 2 * IT_L; it += ngw) {
            const int l = it / IT_L; int r = it % IT_L;
            bf16_t* Wl = WB + (size_t)l * WL_TOTAL;
            if (r < 1408) { transpose_item(ka->in[9] + (size_t)l * 1024 * DFF, 1024, DFF, Wl + WL_UP1, 1, scr, r, lane); continue; } r -= 1408;
            if (r < 1408) { transpose_item(ka->in[10] + (size_t)l * 1024 * DFF, 1024, DFF, Wl + WL_UP1, 2, scr, r, lane); continue; } r -= 1408;
            if (r < 1408) { transpose_item(ka->in[11] + (size_t)l * DFF * 1024, DFF, 1024, Wl + WL_DN1, 0, scr, r, lane); continue; } r -= 1408;
            if (r < 1408) { transpose_item(ka->in[12] + (size_t)l * 1024 * DFF, 1024, DFF, Wl + WL_UP2, 1, scr, r, lane); continue; } r -= 1408;
            if (r < 1408) { transpose_item(ka->in[13] + (size_t)l * 1024 * DFF, 1024, DFF, Wl + WL_UP2, 2, scr, r, lane); continue; } r -= 1408;
            if (r < 1408) { transpose_item(ka->in[14] + (size_t)l * DFF * 1024, DFF, 1024, Wl + WL_DN2, 0, scr, r, lane); continue; } r -= 1408;
            if (r < 3072) { transpose_item(ka->in[15] + (size_t)l * 1024 * 6144, 1024, 6144, Wl + WL_IN, 3, scr, r, lane); continue; } r -= 3072;
            if (r < 256) { transpose_item(ka->in[25] + (size_t)l * 512 * 1024, 512, 1024, Wl + WL_PA, 0, scr, r, lane); continue; } r -= 256;
            if (r < 128) { transpose_item(ka->in[26] + (size_t)l * 256 * 1024, 256, 1024, Wl + WL_PH, 0, scr, r, lane); continue; } r -= 128;
            transpose_item(ka->in[28] + (size_t)l * 1024 * 1024, 1024, 1024, Wl + WL_O, 0, scr, r, lane);
        }
        __syncthreads();
    }
    {
        KA();
        float* MOD = (float*)(ws + WS_MOD);
        LAS float* sv = (LAS float*)lds;
        LAS float* part = (LAS float*)(lds + 12288);
        for (int i = tid; i < 3072; i += NTHR) { const int seg = i >> 10, k = i & 1023; const float x = (seg < 2) ? ka->in[1][seg * 1024 + k] : ka->in[3][k]; sv[i] = x / (1.f + __expf(-x)); }
        __syncthreads();
        for (int item = bid; item < 288; item += G) {
            const int l = item / 144, col = (item % 144) * 64 + lane;
            const float* W = ka->in[4] + (size_t)l * 1024 * 9216 + col;
            float a0 = 0.f, a1 = 0.f, a2 = 0.f;
            for (int k = wave * 128; k < wave * 128 + 128; ++k) { const float w = W[(size_t)k * 9216]; a0 = __builtin_fmaf(sv[k], w, a0); a1 = __builtin_fmaf(sv[1024 + k], w, a1); a2 = __builtin_fmaf(sv[2048 + k], w, a2); }
            part[(wave * 3 + 0) * 64 + lane] = a0; part[(wave * 3 + 1) * 64 + lane] = a1; part[(wave * 3 + 2) * 64 + lane] = a2;
            __syncthreads();
            if (tid < 192) { const int seg = tid >> 6, cl = tid & 63; float s = 0.f;
#pragma unroll
                for (int w = 0; w < 8; ++w) s += part[(w * 3 + seg) * 64 + cl];
                const int cc = (item % 144) * 64 + cl;
                MOD[(size_t)(l * 3 + seg) * 9216 + cc] = s + ka->in[5][l * 9216 + cc]; }
            __syncthreads();
        }
    }
    {
        KA();
        bf16_t* WB = (bf16_t*)(ws + WS_WB); float* CS = (float*)(ws + WS_CS); float* LBT = (float*)(ws + WS_LB); float* LAMV = (float*)(ws + WS_LAM);
        for (int idx = gtid; idx < 2 * 256 * 1024; idx += ngt) {
            const int n = idx & 1023, k = (idx >> 10) & 255, l = idx >> 18, g = k >> 6, c = k & 63;
            const float* pw = ka->in[23] + (size_t)l * 4 * 64 * 64 + (g * 64 + c) * 64;
            const float* psc = ka->in[24] + l * 256 + g * 64;
            const float* wp = ka->in[27] + (size_t)l * 256 * 1024 + (size_t)(g * 64) * 1024 + n;
            float s = 0.f;
            for (int d = 0; d < 64; ++d) s = __builtin_fmaf(pw[d] * psc[d], wp[(size_t)d * 1024], s);
            (WB + (size_t)l * WL_TOTAL + WL_PP)[(size_t)n * 256 + k] = (bf16_t)(pk2(s, 0.f) & 0xffffu);
        }
        for (int idx = gtid; idx < 4096; idx += ngt) {
            const int n = idx >> 4, j = idx & 15;
            const float invf = __builtin_exp2f(-(float)j * (13.287712379549449f / 16.f));
            const float ang = (float)n * invf;
            const double rev = (double)ang * 0.15915494309189535; const float fr = (float)(rev - __builtin_floor(rev));
            CS[n * 32 + j] = __builtin_amdgcn_cosf(fr); CS[n * 32 + 16 + j] = __builtin_amdgcn_sinf(fr);
        }
        for (int idx = gtid; idx < 1024; idx += ngt) {
            const int l = idx >> 9, dc = idx & 511;
            const float l0 = ka->in[21][dc], l1 = ka->in[21][512 + dc];
            LBT[idx] = (l == 0) ? 0.f : 1.f / (1.f + __expf(l0 - l1));
        }
        for (int idx = gtid; idx < NCTX * DM / 4; idx += ngt) ((f32x4*)(ws + WS_HC))[idx] = ((const f32x4*)ka->in[2])[idx];
        if (gtid < 2) {
            const int l = gtid; float s1 = 0.f, s2 = 0.f;
            for (int i = 0; i < 64; ++i) { s1 += ka->in[16][l * 64 + i] * ka->in[17][l * 64 + i]; s2 += ka->in[18][l * 64 + i] * ka->in[19][l * 64 + i]; }
            const float li = (l == 0) ? 0.2f : (0.8f - 0.6f * 0.7408182206817179f);
            LAMV[l * 2 + 0] = __expf(s1) - __expf(s2) + li; LAMV[l * 2 + 1] = 1.f - li;
        }
    }
    }
    GSYNC_CG();
    TS(0);

#pragma unroll 1
    for (int l = 0; l < 2; ++l) {
#ifdef REP_SYNC
#pragma unroll 1
        for (int rs_ = 0; rs_ < 10; ++rs_) { GSYNC(); }
#endif
#pragma unroll 1
        for (int f = 0; f < 2; ++f) {
            {   KA(); const bool first = (l == 0 && f == 0);
                const float* in_lat = first ? ka->in[0] : ka->out; const float* in_ctx = (const float*)(ws + WS_HC);
                norm_phase(in_lat, in_ctx, ka->in[f ? 8 : 6] + l * 1024, (const float*)(ws + WS_MOD) + (size_t)l * 3 * 9216, f ? 6 : 0, f ? 7 : 1, (bf16_t*)(ws + WS_XB), gw, ngw, lane,
                           (const float*)(ws + WS_O), first ? 0 : (f ? (l == 0 ? 4 : 0) : DFF / 256), (float*)(ws + WS_HC)); }
            GSYNC();
            TS(1);
            {   KA(); bf16_t* Wl = (bf16_t*)(ws + WS_WB) + (size_t)l * WL_TOTAL;
                const int Mr = (l == 1 && f == 1) ? NLAT : R;
                pg8::Gemm g{(bf16_t*)(ws + WS_XB), Wl + (f ? WL_UP2 : WL_UP1), Mr, 5632, 1024}; pg8::StaticOrder S; S.init(Mr, 5632, G, bid); EpiUp E{(bf16_t*)(ws + WS_Z)};
                pg8::gemm_phase<EpiUp, pg8::StaticOrder, true, true>(lds, g, S, E, tid); }
            GSYNC();
            TS(2);
            {   KA(); bf16_t* Wl = (bf16_t*)(ws + WS_WB) + (size_t)l * WL_TOTAL; const bool first = (l == 0 && f == 0);
                const float* in_lat = first ? ka->in[0] : ka->out;
                pg8::Gemm g{(bf16_t*)(ws + WS_Z), Wl + (f ? WL_DN2 : WL_DN1), NLAT, 1024, DFF}; pg8::StaticOrder S; S.init(NLAT, 1024, G, bid);
                EpiRes E{in_lat, (const float*)(ws + WS_HC), ka->out, (float*)(ws + WS_HC), (const float*)(ws + WS_MOD) + (size_t)l * 3 * 9216 + (f ? 8 : 2) * 1024, 0.5f};
                pg8::gemm_phase<EpiRes, pg8::StaticOrder, true, true>(lds, g, S, E, tid); }
            if (!(l == 1 && f == 1))
            {   KA(); bf16_t* Wl = (bf16_t*)(ws + WS_WB) + (size_t)l * WL_TOTAL;
                pg8::Gemm g{(bf16_t*)(ws + WS_Z) + (size_t)NLAT * DFF, Wl + (f ? WL_DN2 : WL_DN1), NCTX, 1024, 256, DFF}; SplitKOrder S; S.init(DFF / 256, 256, G, bid);
                EpiPart E{(float*)(ws + WS_O), (const float*)(ws + WS_MOD) + (size_t)l * 3 * 9216 + (f ? 8 : 2) * 1024, 0.5f};
                pg8::gemm_phase<EpiPart, SplitKOrder, true, true>(lds, g, S, E, tid); }
            GSYNC();
            TS(3);
            if (f == 1) break;
            {   KA();
                norm_phase(ka->out, (const float*)(ws + WS_HC), ka->in[7] + l * 1024, (const float*)(ws + WS_MOD) + (size_t)l * 3 * 9216, 3, 4, (bf16_t*)(ws + WS_XB), gw, ngw, lane,
                           (const float*)(ws + WS_O), DFF / 256, (float*)(ws + WS_HC)); }
            GSYNC();
            TS(1);
            {   KA(); bf16_t* Wl = (bf16_t*)(ws + WS_WB) + (size_t)l * WL_TOTAL;
                pg8::Gemm g{(bf16_t*)(ws + WS_XB), Wl + WL_IN, R, 3072, 1024}; pg8::StaticOrder S; S.init(R, 3072, G, bid);
                EpiWin E{ws + WS_Z, (const float*)(ws + WS_CS), (const float*)(ws + WS_LB) + l * 512, 0};
                pg8::gemm_phase<EpiWin, pg8::StaticOrder, true, true>(lds, g, S, E, tid); }
            GSYNC();
            TS(4);
            {   KA(); pool_phase((const bf16_t*)(ws + WS_Z + Z_ZP), (bf16_t*)(ws + WS_O + O_MX), gtid, ngt); }
#ifdef REP_ATTN
            for (int rep_ = 0; rep_ < 2; ++rep_)
#endif
            {   KA();
                const float* LAMV = (const float*)(ws + WS_LAM);
                const int nunits = 1024 + (l == 0 ? 16 : 0);
                for (int u = bid; u < nunits; u += G) {
                    int bh, qrow0, kt0, kt1;
                    if (u < 1024) { bh = u >> 7; qrow0 = (bh >> 2) * SEQ + (u & 127) * 128; kt0 = 0; kt1 = KEYS / 64; }
                    else { const int v = u - 1024; bh = v >> 1; qrow0 = NLAT + (bh >> 2) * CTXL + (v & 1) * 128; kt0 = SEQ / 64; kt1 = KEYS / 64; }
                    attn_unit(lds, (const bf16_t*)(ws + WS_Z + Z_Q), (const bf16_t*)(ws + WS_Z + Z_K), (const bf16_t*)(ws + WS_Z + Z_VT), (bf16_t*)(ws + WS_O + O_DA), ka->in[20] + l * 128,
                              bh >> 2, bh & 3, qrow0, kt0, kt1, LAMV[l * 2], LAMV[l * 2 + 1], tid, wave, lane);
                }
            }
            GSYNC();
            TS(5);
#ifdef REP_HG
#pragma unroll 1
            for (int rep_ = 0; rep_ < 2; ++rep_) {
#else
            {
#endif
            {   KA(); hg_passA_mfma(lds, (const float*)(ws + WS_Z + Z_FF), (const float*)(ws + WS_Z + Z_FB), (const bf16_t*)(ws + WS_Z + Z_HI),
                                      (float*)(ws + WS_CAR), (float*)(ws + WS_DK), wave, lane, G); }
            GSYNC();
            TS(6);
            {   KA(); hg_carry((float*)(ws + WS_CAR), (const float*)(ws + WS_DK), gtid, ngt); }
            GSYNC();
            TS(7);
            {   KA(); hg_passB_mfma(lds, (const float*)(ws + WS_Z + Z_HQ), (const float*)(ws + WS_Z + Z_FF), (const float*)(ws + WS_Z + Z_FB), (const bf16_t*)(ws + WS_Z + Z_HI),
                                      (const float*)(ws + WS_CAR), (bf16_t*)(ws + WS_Z + Z_K), wave, lane, G); }
            GSYNC();
            TS(8);
            {   KA(); hg_readout((const bf16_t*)(ws + WS_Z + Z_K), (const bf16_t*)(ws + WS_Z + Z_HG), ka->in[22] + l * 64, (bf16_t*)(ws + WS_O + O_HG), gw, ngw, lane); }
            GSYNC();
            TS(9);
            }
            {   KA(); bf16_t* Wl = (bf16_t*)(ws + WS_WB) + (size_t)l * WL_TOTAL;
                const int Mr = (l == 1) ? NLAT : R;
                pg8::Gemm g{(bf16_t*)(ws + WS_XB), Wl + WL_IN + (size_t)3072 * 1024, Mr, 3072, 1024}; pg8::StaticOrder S; S.init(Mr, 3072, G, bid); EpiG E{(bf16_t*)(ws + WS_Z)};
                pg8::gemm_phase<EpiG, pg8::StaticOrder, true, true>(lds, g, S, E, tid); }
            GSYNC();
            TS(10);
#pragma unroll 1
            for (int gi = 0; gi < 3; ++gi) {
                KA(); bf16_t* Wl = (bf16_t*)(ws + WS_WB) + (size_t)l * WL_TOTAL;
                const bf16_t* A = (const bf16_t*)(ws + WS_O + ((gi == 0) ? O_DA : (gi == 1 ? O_HG : O_MX))); const int K = (gi == 0) ? 512 : 256;
                const bf16_t* Bt = Wl + ((gi == 0) ? WL_PA : (gi == 1 ? WL_PH : WL_PP));
                const int Mr = (l == 1) ? NLAT : R;
                pg8::Gemm g{A, Bt, Mr, 1024, K}; pg8::StaticOrder S; S.init(Mr, 1024, G, bid); EpiProj E{(bf16_t*)(ws + WS_XB), (const bf16_t*)(ws + WS_Z), gi, gi == 0};
                pg8::gemm_phase<EpiProj, pg8::StaticOrder, true, true>(lds, g, S, E, tid);
            }
            GSYNC();
            TS(11);
            {   KA(); bf16_t* Wl = (bf16_t*)(ws + WS_WB) + (size_t)l * WL_TOTAL;
                pg8::Gemm g{(bf16_t*)(ws + WS_XB), Wl + WL_O, NLAT, 1024, 1024}; pg8::StaticOrder S; S.init(NLAT, 1024, G, bid);
                EpiRes E{ka->out, (const float*)(ws + WS_HC), ka->out, (float*)(ws + WS_HC), (const float*)(ws + WS_MOD) + (size_t)l * 3 * 9216 + 5 * 1024, 1.0f};
                pg8::gemm_phase<EpiRes, pg8::StaticOrder, true, true>(lds, g, S, E, tid); }
            if (l == 0)
            {   KA(); bf16_t* Wl = (bf16_t*)(ws + WS_WB) + (size_t)l * WL_TOTAL;
                pg8::Gemm g{(bf16_t*)(ws + WS_XB) + (size_t)NLAT * 1024, Wl + WL_O, NCTX, 1024, 256, 1024}; SplitKOrder S; S.init(4, 256, G, bid);
                EpiPart E{(float*)(ws + WS_O), (const float*)(ws + WS_MOD) + (size_t)l * 3 * 9216 + 5 * 1024, 1.0f};
                pg8::gemm_phase<EpiPart, SplitKOrder, true, true>(lds, g, S, E, tid); }
            GSYNC();
            TS(12);
        }
    }
    {   KA(); final_norm_phase(ka->out, ka->in[29], gw, ngw, lane); }
#ifdef PROBE_A
    GSYNC(); TS(1);
    if (blockIdx.x == 0) { KA(); const unsigned long long* tsb = (const unsigned long long*)(ws + WS_END);
        __syncthreads();
        const float va = (float)tsb[1 + PROBE_A] * 0.01f, vb = (float)tsb[1 + PROBE_B] * 0.01f;
        __syncthreads();
        if (tid == 0) ka->out[0] += va;
        for (int i = tid; i < 65536; i += NTHR) ka->out[(size_t)(i / 1024 + 8) * 1024 + (i & 1023)] += vb; }
#endif
}

extern "C" void kernel_launch(void* const* d_in, const int* in_sizes, int n_in, void* d_out, int out_size, void* d_ws, size_t ws_size, hipStream_t stream) {
    static int grid = 0;
    if (grid == 0) {
        if (n_in != 30 || out_size != NLAT * DM || ws_size < WS_TOTAL) { fprintf(stderr, "kernel_launch: unexpected shapes (n_in %d out %d ws %zu need %zu)\n", n_in, out_size, ws_size, (size_t)WS_TOTAL); grid = -1; return; }
        int dev = 0, cus = 0, per_cu = 0;
        (void)hipGetDevice(&dev);
        (void)hipDeviceGetAttribute(&cus, hipDeviceAttributeMultiprocessorCount, dev);
        if (hipFuncSetAttribute((const void*)fwd_kernel, hipFuncAttributeMaxDynamicSharedMemorySize, LDS_BYTES) != hipSuccess) { fprintf(stderr, "kernel_launch: hipFuncSetAttribute failed\n"); grid = -1; return; }
        if (hipOccupancyMaxActiveBlocksPerMultiprocessor(&per_cu, (const void*)fwd_kernel, NTHR, LDS_BYTES) != hipSuccess || per_cu < 1) { fprintf(stderr, "kernel_launch: occupancy query failed (%d)\n", per_cu); (void)hipGetLastError(); per_cu = 1; }
        if (per_cu > 1) per_cu = 1;
        grid = cus * per_cu;
    }
    if (grid < 0) return;
    if (hipMemsetAsync((unsigned char*)d_ws + WS_BAR, 0, (size_t)XCD_BAR_WORDS * 4, stream) != hipSuccess) { fprintf(stderr, "kernel_launch: memset failed\n"); return; }
    Args a{};
    for (int i = 0; i < 30; ++i) a.in[i] = (const float*)d_in[i];
    a.out = (float*)d_out; a.ws = (unsigned char*)d_ws;
    void* args[] = {&a};
    hipError_t e = hipLaunchCooperativeKernel((const void*)fwd_kernel, dim3(grid), dim3(NTHR), args, LDS_BYTES, stream);
    if (e != hipSuccess) fprintf(stderr, "cooperative launch failed: %s (grid %d)\n", hipGetErrorString(e), grid);
}
```

```cpp
#include <hip/hip_runtime.h>
#include <hip/hip_cooperative_groups.h>
#include <cstdio>
#include <cstdint>
namespace cg = cooperative_groups;
namespace pg8 {
#define PG8_LAS __attribute__((address_space(3)))
typedef unsigned short bf16_t;
typedef short bf16x8 __attribute__((ext_vector_type(8)));
typedef float f32x4 __attribute__((ext_vector_type(4)));
typedef unsigned u32x4 __attribute__((ext_vector_type(4)));
constexpr int BM = 256, BK = 64, HALF = 128, HTB = HALF * BK * 2  , STAGE_BYTES = 8 * HTB, NXCD = 8, WGM = 8;

__host__ __device__ __forceinline__ int lds_byte(int r, int c) { const int st = (r >> 4) * 2 + (c >> 5), rr = r & 15, cc = c & 31, ob = rr * 64 + cc * 2; return st * 1024 + (ob ^ (((ob >> 9) & 1) << 5)); }
__host__ __device__ __forceinline__ void stage_rc(int b, int& R, int& C) { const int st = b / 1024, sb = b % 1024, swz = sb ^ (((sb >> 9) & 1) << 5); R = (st >> 1) * 16 + swz / 64; C = (st & 1) * 32 + (swz % 64) / 2; }
__host__ __device__ __forceinline__ int perm32(int rho) { const int n = rho >> 4, i = rho & 15; return 8 * (i >> 2) + 4 * n + (i & 3); }

struct Unit { int pm, pn; int koff = 0; };
struct Gemm { const bf16_t* A; const bf16_t* Bt; int M, N, K; int ld = 0; };

struct StaticOrder {
    int nM, nN, nwg, G, c;
    __host__ __device__ void init(int M, int N, int G_, int c_) { nM = M / BM; nN = N / BM; nwg = nM * nN; G = G_; c = c_; }
    __host__ __device__ bool next(int i, Unit& u) const {
        const long L = (long)i * G + c; if (L >= nwg) return false;
        int wgid = (int)L; { const int q = nwg / NXCD, r = nwg % NXCD, xcd = wgid % NXCD, off = wgid / NXCD; wgid = (xcd < r ? xcd * (q + 1) : r * (q + 1) + (xcd - r) * q) + off; }
        const int nig = WGM * nN, gid = wgid / nig, fm = gid * WGM, gsz = (nM - fm) < WGM ? (nM - fm) : WGM;
        u.pm = fm + ((wgid % nig) % gsz); u.pn = (wgid % nig) / gsz; u.koff = 0; return true;
    }
    __device__ __forceinline__ void a_ready(const Unit&) const {}
    __device__ __forceinline__ void done(const Unit&) const {}
};

}
namespace pg8 {
template <class Epi, class Sched, bool ALIGN_EPI = false, bool SP2 = false>
__device__ __forceinline__ void gemm_phase(PG8_LAS unsigned char* lds, const Gemm g, const Sched& S, const Epi& E, int tid_in) {
    int tid_ = tid_in; asm volatile("" : "+v"(tid_)); const int tid = tid_, wid = __builtin_amdgcn_readfirstlane(tid >> 6), lane = tid & 63, wr = wid >> 2, wc = wid & 3, fr = lane & 15, fq = lane >> 4;
    const int K = g.ld ? g.ld : g.K, nt = g.K / BK;
    unsigned voffA[2], voffB[2];
#pragma unroll
    for (int i = 0; i < 2; ++i) { int R, C; stage_rc(tid * 16 + i * 8192, R, C); const int Rb = Epi::PERM ? ((R & ~31) + perm32(R & 31)) : R;
        voffA[i] = (unsigned)(R * K + C) * 2u; voffB[i] = (unsigned)(Rb * K + C) * 2u; }
    const size_t kstep = (size_t)(BK * 2);
    const size_t hstep = (size_t)HALF * K * 2;
    const size_t tstep = 2 * hstep;
    const unsigned ldsw = (unsigned)wid * 1024u;
    const int aoff = lds_byte(wr * 64 + fr, fq * 8), boff = lds_byte(wc * 32 + fr, fq * 8);
#define PG8_SA(b, h) (((b) * 2 + (h)) * HTB)
#define PG8_SB(b, h) ((4 + (b) * 2 + (h)) * HTB)
#define PG8_STAGE(bufoff, gbase, voff) do { _Pragma("unroll") for (int _i = 0; _i < 2; ++_i) \
        __builtin_amdgcn_global_load_lds((const unsigned*)((const char*)(gbase) + (voff)[_i]), (PG8_LAS unsigned*)(lds + (bufoff) + ldsw + _i * 8192), 16, 0, 0); } while (0)
#define PG8_LDA(dst, b, h) do { _Pragma("unroll") for (int m = 0; m < 4; ++m) _Pragma("unroll") for (int k = 0; k < 2; ++k) dst[m][k] = *(const PG8_LAS bf16x8*)(lds + PG8_SA(b, h) + aoff + m * 2048 + k * 1024); } while (0)
#define PG8_LDB(dst, b, h) do { _Pragma("unroll") for (int n = 0; n < 2; ++n) _Pragma("unroll") for (int k = 0; k < 2; ++k) dst[n][k] = *(const PG8_LAS bf16x8*)(lds + PG8_SB(b, h) + boff + n * 2048 + k * 1024); } while (0)
#define PG8_MMA(ai, bj, At, Bt) do { __builtin_amdgcn_s_setprio(1); _Pragma("unroll") for (int m = 0; m < 4; ++m) _Pragma("unroll") for (int n = 0; n < 2; ++n) _Pragma("unroll") for (int k = 0; k < 2; ++k) \
        acc[ai][bj][m][n] = __builtin_amdgcn_mfma_f32_16x16x32_bf16(Bt[n][k], At[m][k], acc[ai][bj][m][n], 0, 0, 0); __builtin_amdgcn_s_setprio(0); } while (0)
#define PG8_WAIT_V(n) asm volatile("s_waitcnt vmcnt(" #n ")" ::: "memory")
#define PG8_WAIT_L(n) asm volatile("s_waitcnt lgkmcnt(" #n ")" ::: "memory")
#define PG8_BAR __builtin_amdgcn_s_barrier()
#define PG8_SCHED __builtin_amdgcn_sched_barrier(0)
    Unit cur, nxt; int ui = 0;
    if (!S.next(0, cur)) return;
    f32x4 acc[2][2][4][2];
#pragma unroll
    for (int a = 0; a < 2; ++a)
#pragma unroll
        for (int b = 0; b < 2; ++b)
#pragma unroll
            for (int m = 0; m < 4; ++m)
#pragma unroll
                for (int n = 0; n < 2; ++n) acc[a][b][m][n] = (f32x4){0.f, 0.f, 0.f, 0.f};
    bf16x8 At[4][2], B0[2][2], B1[2][2];
    const char* cA = (const char*)g.A + (size_t)cur.pm * tstep + (size_t)cur.koff * 2; const char* cB = (const char*)g.Bt + (size_t)cur.pn * tstep + (size_t)cur.koff * 2;
    S.a_ready(cur);
    if constexpr (SP2) {
        PG8_STAGE(PG8_SB(0, 0), cB, voffB); PG8_STAGE(PG8_SB(0, 1), cB + hstep, voffB); PG8_STAGE(PG8_SA(0, 0), cA, voffA); PG8_STAGE(PG8_SA(0, 1), cA + hstep, voffA);
        if (wr == 1) PG8_BAR;
        PG8_WAIT_V(2); PG8_BAR;
        PG8_STAGE(PG8_SB(1, 0), cB + kstep, voffB); PG8_STAGE(PG8_SA(1, 0), cA + kstep, voffA); PG8_STAGE(PG8_SB(1, 1), cB + hstep + kstep, voffB);
        PG8_WAIT_V(6); PG8_BAR;
    } else {
        PG8_STAGE(PG8_SB(0, 0), cB, voffB); PG8_STAGE(PG8_SA(0, 0), cA, voffA); PG8_STAGE(PG8_SB(0, 1), cB + hstep, voffB); PG8_STAGE(PG8_SA(0, 1), cA + hstep, voffA);
        if (wr == 1) PG8_BAR;
        PG8_WAIT_V(4); PG8_BAR;
        PG8_STAGE(PG8_SB(1, 0), cB + kstep, voffB); PG8_STAGE(PG8_SA(1, 0), cA + kstep, voffA); PG8_STAGE(PG8_SB(1, 1), cB + hstep + kstep, voffB);
        PG8_WAIT_V(6); PG8_BAR;
    }
    for (;;) {
        const bool has_next = S.next(ui + 1, nxt);
        const char* nA = has_next ? (const char*)g.A + (size_t)nxt.pm * tstep + (size_t)nxt.koff * 2 : cA; const char* nB = has_next ? (const char*)g.Bt + (size_t)nxt.pn * tstep + (size_t)nxt.koff * 2 : cB;
        for (int t = 0; t < nt; t += 2) {
            const bool last = (t == nt - 2);
            const char* a1 = cA + (size_t)(t + 1) * kstep;
            const char* a2 = last ? nA : cA + (size_t)(t + 2) * kstep; const char* b2 = last ? nB : cB + (size_t)(t + 2) * kstep;
            const char* a3 = a2 + kstep; const char* b3 = b2 + kstep;
            if (last && has_next) S.a_ready(nxt);
            if constexpr (SP2) {
            PG8_LDB(B0, 0, 0); PG8_LDB(B1, 0, 1); PG8_SCHED; PG8_LDA(At, 0, 0); PG8_STAGE(PG8_SA(1, 1), a1 + hstep, voffA);
            PG8_WAIT_V(8); PG8_WAIT_L(0); PG8_BAR; PG8_MMA(0, 0, At, B0); PG8_MMA(0, 1, At, B1); PG8_BAR; PG8_SCHED;
            PG8_LDA(At, 0, 1); PG8_STAGE(PG8_SB(0, 0), b2, voffB); PG8_STAGE(PG8_SB(0, 1), b2 + hstep, voffB); PG8_STAGE(PG8_SA(0, 0), a2, voffA);
            PG8_WAIT_V(8); PG8_WAIT_L(0); PG8_BAR; PG8_MMA(1, 0, At, B0); PG8_MMA(1, 1, At, B1); PG8_BAR; PG8_SCHED;
            PG8_LDB(B0, 1, 0); PG8_LDB(B1, 1, 1); PG8_SCHED; PG8_LDA(At, 1, 0); PG8_STAGE(PG8_SA(0, 1), a2 + hstep, voffA);
            PG8_WAIT_V(8); PG8_WAIT_L(0); PG8_BAR; PG8_MMA(0, 0, At, B0); PG8_MMA(0, 1, At, B1); PG8_BAR; PG8_SCHED;
            PG8_LDA(At, 1, 1); PG8_STAGE(PG8_SB(1, 0), b3, voffB); PG8_STAGE(PG8_SB(1, 1), b3 + hstep, voffB); PG8_STAGE(PG8_SA(1, 0), a3, voffA);
            PG8_WAIT_V(8); PG8_WAIT_L(0); PG8_BAR; PG8_MMA(1, 0, At, B0); PG8_MMA(1, 1, At, B1); PG8_BAR; PG8_SCHED;
            } else {
            PG8_LDB(B0, 0, 0); PG8_SCHED; PG8_LDA(At, 0, 0); PG8_STAGE(PG8_SA(1, 1), a1 + hstep, voffA);
            PG8_WAIT_L(8); PG8_BAR; PG8_WAIT_L(0); PG8_MMA(0, 0, At, B0); PG8_BAR; PG8_SCHED;
            PG8_LDB(B1, 0, 1); PG8_STAGE(PG8_SB(0, 0), b2, voffB);
            PG8_BAR; PG8_WAIT_L(0); PG8_MMA(0, 1, At, B1); PG8_BAR;
            PG8_LDA(At, 0, 1); PG8_STAGE(PG8_SA(0, 0), a2, voffA);
            PG8_BAR; PG8_WAIT_L(0); PG8_MMA(1, 0, At, B0); PG8_BAR; PG8_SCHED;
            PG8_STAGE(PG8_SB(0, 1), b2 + hstep, voffB);
            PG8_WAIT_V(6); PG8_BAR; PG8_MMA(1, 1, At, B1); PG8_BAR;
            PG8_LDB(B0, 1, 0); PG8_SCHED; PG8_LDA(At, 1, 0); PG8_STAGE(PG8_SA(0, 1), a2 + hstep, voffA);
            PG8_WAIT_L(8); PG8_BAR; PG8_WAIT_L(0); PG8_MMA(0, 0, At, B0); PG8_BAR; PG8_SCHED;
            PG8_LDB(B1, 1, 1); PG8_STAGE(PG8_SB(1, 0), b3, voffB);
            PG8_BAR; PG8_WAIT_L(0); PG8_MMA(0, 1, At, B1); PG8_BAR;
            PG8_LDA(At, 1, 1); PG8_STAGE(PG8_SA(1, 0), a3, voffA);
            PG8_BAR; PG8_WAIT_L(0); PG8_MMA(1, 0, At, B0); PG8_BAR; PG8_SCHED;
            PG8_STAGE(PG8_SB(1, 1), b3 + hstep, voffB);
            PG8_WAIT_V(6); PG8_BAR; PG8_MMA(1, 1, At, B1); PG8_BAR;
            }
        }
        if constexpr (ALIGN_EPI) { if (wr == 0) PG8_BAR; }
        if constexpr (!Epi::AFTER_DRAIN) { E(acc, cur, wr, wc, fr, fq); S.done(cur); }
        if (!has_next) break;
#pragma unroll
        for (int a = 0; a < 2; ++a)
#pragma unroll
            for (int b = 0; b < 2; ++b)
#pragma unroll
                for (int m = 0; m < 4; ++m)
#pragma unroll
                    for (int n = 0; n < 2; ++n) acc[a][b][m][n] = (f32x4){0.f, 0.f, 0.f, 0.f};
        cur = nxt; cA = nA; cB = nB; ++ui;
        if constexpr (ALIGN_EPI) { if (wr == 1) PG8_BAR; }
    }
    PG8_WAIT_V(0);
    if constexpr (!ALIGN_EPI) { if (wr == 0) PG8_BAR; }
    PG8_BAR;
    if constexpr (Epi::AFTER_DRAIN) { E.fused(acc, cur, wr, wc, fr, fq, lds, wid, lane); S.done(cur); }
#undef PG8_SA
#undef PG8_SB
#undef PG8_STAGE
#undef PG8_LDA
#undef PG8_LDB
#undef PG8_MMA
#undef PG8_WAIT_V
#undef PG8_WAIT_L
#undef PG8_BAR
#undef PG8_SCHED
}
}

using pg8::bf16_t; using pg8::bf16x8; using pg8::f32x4; using pg8::u32x4; using pg8::Unit;
typedef float f32x16 __attribute__((ext_vector_type(16)));
typedef float f32x2v __attribute__((ext_vector_type(2)));
typedef __bf16 bf16x2v __attribute__((ext_vector_type(2)));
typedef unsigned u32x2 __attribute__((ext_vector_type(2)));
#define LAS __attribute__((address_space(3)))

constexpr int DM = 1024, NBATCH = 2, SEQ = 16384, CTXL = 256;
constexpr int NLAT = NBATCH * SEQ, NCTX = NBATCH * CTXL, R = NLAT + NCTX;
constexpr int DFF = 2816, KEYS = SEQ + CTXL;
constexpr float EPS = 1e-6f;
constexpr float C2 = 0.125f * 1.4426950408889634f;
constexpr int NTHR = 512;
constexpr int LDS_BYTES = 135168;
constexpr int HG_SEG = 128, HG_STEPS = KEYS / HG_SEG;

constexpr size_t WL_UP1 = 0, WL_DN1 = WL_UP1 + (size_t)5632 * 1024, WL_UP2 = WL_DN1 + (size_t)1024 * 2816, WL_DN2 = WL_UP2 + (size_t)5632 * 1024,
                 WL_IN = WL_DN2 + (size_t)1024 * 2816, WL_PA = WL_IN + (size_t)6144 * 1024, WL_PH = WL_PA + (size_t)1024 * 512, WL_PP = WL_PH + (size_t)1024 * 256,
                 WL_O = WL_PP + (size_t)1024 * 256, WL_TOTAL = WL_O + (size_t)1024 * 1024;
constexpr size_t WS_WB = 0;
constexpr size_t WS_XB = WS_WB + 2 * WL_TOTAL * 2;
constexpr size_t WS_Z = WS_XB + (size_t)R * 1024 * 2;
constexpr size_t Z_VT = 0, Z_HQ = Z_VT + (size_t)R * 512 * 2, Z_FF = Z_HQ + (size_t)R * 256 * 4, Z_FB = Z_FF + (size_t)R * 256 * 4, Z_HI = Z_FB + (size_t)R * 256 * 4,
                 Z_ZP = Z_HI + (size_t)R * 256 * 2, Z_Q = Z_ZP + (size_t)R * 256 * 2, Z_K = Z_Q + (size_t)R * 512 * 2, Z_HG = Z_K + (size_t)R * 512 * 2, Z_END = Z_HG + (size_t)R * 256 * 2;
static_assert((size_t)R * 3072 * 2 <= Z_K, "gate buffer must not reach k / odir / hgate");
static_assert((size_t)R * DFF * 2 <= Z_END, "act fits Z");
constexpr size_t WS_O = WS_Z + Z_END;
constexpr size_t O_DA = 0, O_HG = O_DA + (size_t)R * 512 * 2, O_MX = O_HG + (size_t)R * 256 * 2, O_END = O_MX + (size_t)R * 256 * 2;
constexpr size_t WS_CAR = WS_O + O_END;
constexpr size_t WS_DK = WS_CAR + (size_t)16 * HG_SEG * 4096 * 4;
constexpr size_t WS_HC = WS_DK + (size_t)16 * HG_SEG * 64 * 4;
constexpr size_t WS_MOD = WS_HC + (size_t)NCTX * 1024 * 4;
constexpr size_t WS_CS = WS_MOD + (size_t)2 * 3 * 9216 * 4;
constexpr size_t WS_LB = WS_CS + (size_t)256 * 32 * 4;
constexpr size_t WS_LAM = WS_LB + (size_t)2 * 2 * 256 * 4;
constexpr size_t WS_END = WS_LAM + 256;
static_assert(WS_END <= (size_t)512 * 1024 * 1024, "workspace");

__device__ __forceinline__ unsigned pk2(float lo, float hi) { f32x2v v = {lo, hi}; bf16x2v b = __builtin_convertvector(v, bf16x2v); return __builtin_bit_cast(unsigned, b); }
__device__ __forceinline__ float bf2f(unsigned short u) { return __builtin_bit_cast(float, (unsigned)u << 16); }
__device__ __forceinline__ float bflo(unsigned u) { return __builtin_bit_cast(float, u << 16); }
__device__ __forceinline__ float bfhi(unsigned u) { return __builtin_bit_cast(float, u & 0xffff0000u); }
__device__ __forceinline__ float ex2(float x) { return __builtin_amdgcn_exp2f(x); }
__device__ __forceinline__ float rcpf_(float x) { return __builtin_amdgcn_rcpf(x); }
__device__ __forceinline__ float sigm(float x) { return rcpf_(1.f + ex2(-1.4426950408889634f * x)); }
__device__ __forceinline__ float siluf(float x) { return x * sigm(x); }
__device__ __forceinline__ float shx(float v, int o, int lane) { return __builtin_bit_cast(float, __builtin_amdgcn_ds_bpermute((lane ^ o) << 2, __builtin_bit_cast(int, v))); }
__device__ __forceinline__ float swap32(float v) { auto rr = __builtin_amdgcn_permlane32_swap(__builtin_bit_cast(unsigned, v), __builtin_bit_cast(unsigned, v), false, false);
    const float a = __builtin_bit_cast(float, rr[0]), b = __builtin_bit_cast(float, rr[1]); return (a == v) ? b : a; }
__device__ __forceinline__ float wave_sum(float v, int lane) {
#pragma unroll
    for (int o = 1; o < 64; o <<= 1) v += shx(v, o, lane);
    return v;
}
#define LDS_WAIT() asm volatile("s_waitcnt lgkmcnt(0)" ::: "memory")

struct EpiUp {
    static constexpr bool PERM = true, AFTER_DRAIN = false;
    bf16_t* act;
    __device__ __forceinline__ void operator()(const f32x4 (&acc)[2][2][4][2], const Unit& u, int wr, int wc, int fr, int fq) const {
        const int row0 = u.pm * 256 + wr * 64 + fr, col0 = u.pn * 128 + wc * 32 + 8 * fq;
#pragma unroll
        for (int ai = 0; ai < 2; ++ai)
#pragma unroll
            for (int m = 0; m < 4; ++m) {
                const int row = row0 + ai * 128 + m * 16;
                const f32x4 a0 = acc[ai][0][m][0], a1 = acc[ai][0][m][1], b0 = acc[ai][1][m][0], b1 = acc[ai][1][m][1];
                u32x4 w;
                w.x = pk2(siluf(a0[0]) * b0[0], siluf(a0[1]) * b0[1]); w.y = pk2(siluf(a0[2]) * b0[2], siluf(a0[3]) * b0[3]);
                w.z = pk2(siluf(a1[0]) * b1[0], siluf(a1[1]) * b1[1]); w.w = pk2(siluf(a1[2]) * b1[2], siluf(a1[3]) * b1[3]);
                *(u32x4*)(act + (size_t)row * DFF + col0) = w;
            }
    }
};
struct EpiRes {
    static constexpr bool PERM = true, AFTER_DRAIN = false;
    const float* in_lat; const float* in_ctx; float* out_lat; float* out_ctx; const float* gate; float coef;
    __device__ __forceinline__ void operator()(const f32x4 (&acc)[2][2][4][2], const Unit& u, int wr, int wc, int fr, int fq) const {
        const int row0 = u.pm * 256 + wr * 64 + fr, col0 = u.pn * 256 + wc * 32 + 8 * fq;
        const int seg = (u.pm < 64) ? 0 : (u.pm < 128 ? 1 : 2);
        f32x4 gv[2][2];
#pragma unroll
        for (int bj = 0; bj < 2; ++bj)
#pragma unroll
            for (int n = 0; n < 2; ++n) gv[bj][n] = *(const f32x4*)(gate + seg * 9216 + col0 + bj * 128 + 4 * n) * coef;
#pragma unroll
        for (int ai = 0; ai < 2; ++ai)
#pragma unroll
            for (int m = 0; m < 4; ++m) {
                const int row = row0 + ai * 128 + m * 16;
                const float* ip; float* op;
                if (row < NLAT) { ip = in_lat + (size_t)row * DM; op = out_lat + (size_t)row * DM; }
                else { ip = in_ctx + (size_t)(row - NLAT) * DM; op = out_ctx + (size_t)(row - NLAT) * DM; }
#pragma unroll
                for (int bj = 0; bj < 2; ++bj)
#pragma unroll
                    for (int n = 0; n < 2; ++n) {
                        const int c = col0 + bj * 128 + 4 * n;
                        f32x4 v = *(const f32x4*)(ip + c);
                        v = v + gv[bj][n] * acc[ai][bj][m][n];
                        *(f32x4*)(op + c) = v;
                    }
            }
    }
};
struct SplitKOrder {
    int nunits, G, c, kc;
    __device__ void init(int nparts, int kc_, int G_, int c_) { nunits = nparts * 8; G = G_; c = c_; kc = kc_; }
    __device__ bool next(int i, Unit& u) const {
        const int L = i * G + c; if (L >= nunits) return false;
        const int part = L >> 3, r = L & 7; u.pm = r >> 2; u.pn = r & 3; u.koff = part * kc; return true;
    }
    __device__ __forceinline__ void a_ready(const Unit&) const {}
    __device__ __forceinline__ void done(const Unit&) const {}
};
struct EpiPart {
    static constexpr bool PERM = true, AFTER_DRAIN = false;
    float* P; const float* gate; float coef;
    __device__ __forceinline__ void operator()(const f32x4 (&acc)[2][2][4][2], const Unit& u, int wr, int wc, int fr, int fq) const {
        unsigned z_ = 0u; asm volatile("" : "+s"(z_));
        const int lane_ = (int)__builtin_amdgcn_mbcnt_hi(~0u, __builtin_amdgcn_mbcnt_lo(~0u, z_)), fr_ = lane_ & 15, fq_ = lane_ >> 4;
        const int row0 = u.pm * 256 + wr * 64 + fr_, col0 = u.pn * 256 + wc * 32 + 8 * fq_;
        float* Pp = P + (size_t)(u.koff >> 8) * NCTX * DM;
        f32x4 gv[2][2];
#pragma unroll
        for (int bj = 0; bj < 2; ++bj)
#pragma unroll
            for (int n = 0; n < 2; ++n) gv[bj][n] = *(const f32x4*)(gate + 2 * 9216 + col0 + bj * 128 + 4 * n) * coef;
#pragma unroll
        for (int ai = 0; ai < 2; ++ai)
#pragma unroll
            for (int m = 0; m < 4; ++m) {
                float* op = Pp + (size_t)(row0 + ai * 128 + m * 16) * DM;
#pragma unroll
                for (int bj = 0; bj < 2; ++bj)
#pragma unroll
                    for (int n = 0; n < 2; ++n) *(f32x4*)(op + col0 + bj * 128 + 4 * n) = gv[bj][n] * acc[ai][bj][m][n];
            }
    }
};
struct EpiWin {
    static constexpr bool PERM = true, AFTER_DRAIN = false;
    unsigned char* Z; const float* cs; const float* lb; int pn_off;
    __device__ __forceinline__ void operator()(const f32x4 (&acc)[2][2][4][2], const Unit& u, int wr, int wc, int fr, int fq) const {
        const int t = u.pn + pn_off;
        const int row0 = u.pm * 256 + wr * 64 + fr, cin = wc * 32 + 8 * fq;
        if (t < 4) {
            bf16_t* dst = (bf16_t*)(Z + ((t < 2) ? Z_Q : Z_K)); const float sc = (t < 2) ? C2 : 1.f; const int cb = (t & 1) * 256;
#pragma unroll
            for (int ai = 0; ai < 2; ++ai)
#pragma unroll
                for (int m = 0; m < 4; ++m) {
                    const int row = row0 + ai * 128 + m * 16;
                    f32x4 cv = {1.f, 1.f, 1.f, 1.f}, sv = {0.f, 0.f, 0.f, 0.f};
                    if (row < NLAT) { const int ts = row & (SEQ - 1); const int pos = (wc & 1) ? (ts & 63) : (ts >> 6);
                        cv = *(const f32x4*)(cs + pos * 32 + 4 * fq); sv = *(const f32x4*)(cs + pos * 32 + 16 + 4 * fq); }
#pragma unroll
                    for (int bj = 0; bj < 2; ++bj) {
                        const f32x4 x1 = acc[ai][bj][m][0], x2 = acc[ai][bj][m][1];
                        const f32x4 o1 = (x1 * cv - x2 * sv) * sc, o2 = (x1 * sv + x2 * cv) * sc;
                        u32x4 w; w.x = pk2(o1[0], o1[1]); w.y = pk2(o1[2], o1[3]); w.z = pk2(o2[0], o2[1]); w.w = pk2(o2[2], o2[3]);
                        *(u32x4*)(dst + (size_t)row * 512 + cb + bj * 128 + cin) = w;
                    }
                }
        } else if (t < 6) {
            bf16_t* vT = (bf16_t*)(Z + Z_VT);
#pragma unroll
            for (int ai = 0; ai < 2; ++ai)
#pragma unroll
                for (int m = 0; m < 4; ++m) {
                    const int row = row0 + ai * 128 + m * 16;
                    int b, key;
                    if (row < NLAT) { b = row >> 14; key = row & (SEQ - 1); } else { b = (row - NLAT) >> 8; key = SEQ + ((row - NLAT) & (CTXL - 1)); }
                    key = (key & ~15) + (key & 3) + ((key >> 3) & 1) * 4 + ((key >> 2) & 1) * 8;
#pragma unroll
                    for (int bj = 0; bj < 2; ++bj) {
                        bf16_t* dp = vT + (size_t)(b * 512 + (t - 4) * 256 + bj * 128 + cin) * KEYS + key;
#pragma unroll
                        for (int n = 0; n < 2; ++n)
#pragma unroll
                            for (int i = 0; i < 4; i += 2) {
                                const unsigned w = pk2(acc[ai][bj][m][n][i], acc[ai][bj][m][n][i + 1]);
                                dp[(size_t)(4 * n + i) * KEYS] = (bf16_t)(w & 0xffffu); dp[(size_t)(4 * n + i + 1) * KEYS] = (bf16_t)(w >> 16);
                            }
                    }
                }
        } else if (t <= 8) {
            float* dst = (float*)(Z + ((t == 6) ? Z_HQ : (t == 7 ? Z_FF : Z_FB)));
            const float* lbp = lb + ((t == 8) ? 256 : 0);
#pragma unroll
            for (int bj = 0; bj < 2; ++bj)
#pragma unroll
                for (int n = 0; n < 2; ++n) {
                    f32x4 lbv = *(const f32x4*)(lbp + bj * 128 + cin + 4 * n);
                    f32x4 om = 1.f - lbv;
#pragma unroll
                    for (int ai = 0; ai < 2; ++ai)
#pragma unroll
                        for (int m = 0; m < 4; ++m) {
                            const int row = row0 + ai * 128 + m * 16;
                            const f32x4 z = acc[ai][bj][m][n];
                            f32x4 sg; sg[0] = sigm(z[0]); sg[1] = sigm(z[1]); sg[2] = sigm(z[2]); sg[3] = sigm(z[3]);
                            const f32x4 o = (t == 6) ? z * sg : lbv + om * sg;
                            *(f32x4*)(dst + (size_t)row * 256 + bj * 128 + cin + 4 * n) = o;
                        }
                }
        } else {
            bf16_t* dst = (bf16_t*)(Z + ((t == 9) ? Z_HI : (t == 10 ? Z_HG : Z_ZP)));
#pragma unroll
            for (int ai = 0; ai < 2; ++ai)
#pragma unroll
                for (int m = 0; m < 4; ++m) {
                    const int row = row0 + ai * 128 + m * 16;
#pragma unroll
                    for (int bj = 0; bj < 2; ++bj) {
                        f32x4 v0 = acc[ai][bj][m][0], v1 = acc[ai][bj][m][1];
                        if (t == 10) { v0[0] = siluf(v0[0]); v0[1] = siluf(v0[1]); v0[2] = siluf(v0[2]); v0[3] = siluf(v0[3]); v1[0] = siluf(v1[0]); v1[1] = siluf(v1[1]); v1[2] = siluf(v1[2]); v1[3] = siluf(v1[3]); }
                        u32x4 w; w.x = pk2(v0[0], v0[1]); w.y = pk2(v0[2], v0[3]); w.z = pk2(v1[0], v1[1]); w.w = pk2(v1[2], v1[3]);
                        *(u32x4*)(dst + (size_t)row * 256 + bj * 128 + cin) = w;
                    }
                }
        }
    }
};
struct EpiVT {
    static constexpr bool PERM = true, AFTER_DRAIN = false;
    bf16_t* vT;
    __device__ __forceinline__ void operator()(const f32x4 (&acc)[2][2][4][2], const Unit& u, int wr, int wc, int fr, int fq) const {
        const int e0 = u.pm * 256 + wr * 64 + fr;
        int b, key0;
        if (u.pn < 64) { b = 0; key0 = u.pn * 256; } else if (u.pn < 128) { b = 1; key0 = (u.pn - 64) * 256; } else { b = u.pn - 128; key0 = SEQ; }
        const int kc = key0 + wc * 32 + 8 * fq;
#pragma unroll
        for (int ai = 0; ai < 2; ++ai)
#pragma unroll
            for (int m = 0; m < 4; ++m) {
                const int e = e0 + ai * 128 + m * 16;
#pragma unroll
                for (int bj = 0; bj < 2; ++bj) {
                    const f32x4 v0 = acc[ai][bj][m][0], v1 = acc[ai][bj][m][1];
                    u32x4 w; w.x = pk2(v0[0], v0[1]); w.y = pk2(v0[2], v0[3]); w.z = pk2(v1[0], v1[1]); w.w = pk2(v1[2], v1[3]);
                    *(u32x4*)(vT + (size_t)(b * 512 + e) * KEYS + kc + bj * 128) = w;
                }
            }
    }
};
struct EpiG {
    static constexpr bool PERM = true, AFTER_DRAIN = false;
    bf16_t* G;
    __device__ __forceinline__ void operator()(const f32x4 (&acc)[2][2][4][2], const Unit& u, int wr, int wc, int fr, int fq) const {
        const int row0 = u.pm * 256 + wr * 64 + fr, col0 = u.pn * 256 + wc * 32 + 8 * fq;
#pragma unroll
        for (int ai = 0; ai < 2; ++ai)
#pragma unroll
            for (int m = 0; m < 4; ++m) {
                const int row = row0 + ai * 128 + m * 16;
#pragma unroll
                for (int bj = 0; bj < 2; ++bj) {
                    const f32x4 v0 = acc[ai][bj][m][0], v1 = acc[ai][bj][m][1];
                    u32x4 w; w.x = pk2(sigm(v0[0]), sigm(v0[1])); w.y = pk2(sigm(v0[2]), sigm(v0[3])); w.z = pk2(sigm(v1[0]), sigm(v1[1])); w.w = pk2(sigm(v1[2]), sigm(v1[3]));
                    *(u32x4*)(G + (size_t)row * 3072 + col0 + bj * 128) = w;
                }
            }
    }
};
struct EpiProj {
    static constexpr bool PERM = true, AFTER_DRAIN = false;
    bf16_t* y; const bf16_t* G; int gi; int first;
    __device__ __forceinline__ void operator()(const f32x4 (&acc)[2][2][4][2], const Unit& u, int wr, int wc, int fr, int fq) const {
        const int row0 = u.pm * 256 + wr * 64 + fr, col0 = u.pn * 256 + wc * 32 + 8 * fq;
#pragma unroll
        for (int ai = 0; ai < 2; ++ai)
#pragma unroll
            for (int m = 0; m < 4; ++m) {
                const int row = row0 + ai * 128 + m * 16;
#pragma unroll
                for (int bj = 0; bj < 2; ++bj) {
                    const int c = col0 + bj * 128;
                    const u32x4 g = *(const u32x4*)(G + (size_t)row * 3072 + gi * 1024 + c);
                    u32x4 yo = {0u, 0u, 0u, 0u};
                    if (!first) yo = *(const u32x4*)(y + (size_t)row * 1024 + c);
                    const f32x4 v0 = acc[ai][bj][m][0], v1 = acc[ai][bj][m][1];
                    u32x4 w;
                    w.x = pk2(bflo(yo.x) + bflo(g.x) * v0[0], bfhi(yo.x) + bfhi(g.x) * v0[1]);
                    w.y = pk2(bflo(yo.y) + bflo(g.y) * v0[2], bfhi(yo.y) + bfhi(g.y) * v0[3]);
                    w.z = pk2(bflo(yo.z) + bflo(g.z) * v1[0], bfhi(yo.z) + bfhi(g.z) * v1[1]);
                    w.w = pk2(bflo(yo.w) + bflo(g.w) * v1[2], bfhi(yo.w) + bfhi(g.w) * v1[3]);
                    *(u32x4*)(y + (size_t)row * 1024 + c) = w;
                }
            }
    }
};

__device__ __forceinline__ int map_row(int mode, int n) {
    if (mode == 1) return 256 * (n >> 7) + (n & 127);
    if (mode == 2) return 256 * (n >> 7) + 128 + (n & 127);
    if (mode == 3) return (n < 1024) ? ((n & ~31) + 8 * ((n & 15) >> 2) + 4 * ((n >> 4) & 1) + (n & 3)) : n;
    return n;
}
__device__ __forceinline__ void transpose_item(const float* W, int K, int N, bf16_t* WT, int mode, LAS float* scr, int item, int lane) {
    const int nblk = N / 32, kb = item / nblk, nb = item % nblk, k0 = 64 * kb, n0 = 32 * nb;
#pragma unroll 8
    for (int i = 0; i < 32; ++i) { const int kk = 2 * i + (lane >> 5); scr[kk * 33 + (lane & 31)] = W[(size_t)(k0 + kk) * N + n0 + (lane & 31)]; }
    LDS_WAIT(); asm volatile("" ::: "memory");
    const int c = lane & 7;
#pragma unroll
    for (int j = 0; j < 4; ++j) { const int n = (lane >> 3) + 8 * j; const LAS float* s = scr + (8 * c) * 33 + n;
        u32x4 o; o.x = pk2(s[0 * 33], s[1 * 33]); o.y = pk2(s[2 * 33], s[3 * 33]); o.z = pk2(s[4 * 33], s[5 * 33]); o.w = pk2(s[6 * 33], s[7 * 33]);
        *(u32x4*)(WT + (size_t)map_row(mode, n0 + n) * K + k0 + 8 * c) = o; }
    LDS_WAIT(); asm volatile("" ::: "memory");
}

__device__ __forceinline__ void norm_phase(const float* in_lat, const float* in_ctx, const float* gain, const float* modl, int shi, int sci, bf16_t* outp, int gw, int ngw, int lane,
                                           const float* part, int nparts, float* hc_out) {
    f32x4 gv[4];
#pragma unroll
    for (int j = 0; j < 4; ++j) gv[j] = *(const f32x4*)(gain + 4 * lane + 256 * j);
    for (int row = gw; row < R; row += ngw) {
        const float* ip = (row < NLAT) ? in_lat + (size_t)row * DM : in_ctx + (size_t)(row - NLAT) * DM;
        const int seg = (row < SEQ) ? 0 : (row < NLAT ? 1 : 2);
        const float* sh = modl + seg * 9216 + shi * 1024; const float* sc = modl + seg * 9216 + sci * 1024;
        f32x4 v[4]; float ss = 0.f;
#pragma unroll
        for (int j = 0; j < 4; ++j) v[j] = *(const f32x4*)(ip + 4 * lane + 256 * j);
        if (row >= NLAT && nparts > 0) {
            for (int p = 0; p < nparts; ++p) {
                const float* pp = part + ((size_t)p * NCTX + (row - NLAT)) * DM;
#pragma unroll
                for (int j = 0; j < 4; ++j) v[j] = v[j] + *(const f32x4*)(pp + 4 * lane + 256 * j);
            }
#pragma unroll
            for (int j = 0; j < 4; ++j) *(f32x4*)(hc_out + (size_t)(row - NLAT) * DM + 4 * lane + 256 * j) = v[j];
        }
#pragma unroll
        for (int j = 0; j < 4; ++j) ss += (v[j][0] * v[j][0] + v[j][1] * v[j][1]) + (v[j][2] * v[j][2] + v[j][3] * v[j][3]);
        ss = wave_sum(ss, lane);
        const float rstd = 1.0f / sqrtf(ss * (1.f / DM) + EPS);
#pragma unroll
        for (int j = 0; j < 4; ++j) {
            const f32x4 s4 = *(const f32x4*)(sc + 4 * lane + 256 * j), h4 = *(const f32x4*)(sh + 4 * lane + 256 * j);
            const f32x4 y = v[j] * rstd * gv[j] * (s4 + 1.f) + h4;
            u32x2 w; w.x = pk2(y[0], y[1]); w.y = pk2(y[2], y[3]);
            *(u32x2*)(outp + (size_t)row * DM + 4 * lane + 256 * j) = w;
        }
    }
}
__device__ __forceinline__ void final_norm_phase(float* out, const float* gain, int gw, int ngw, int lane) {
    f32x4 gv[4];
#pragma unroll
    for (int j = 0; j < 4; ++j) gv[j] = *(const f32x4*)(gain + 4 * lane + 256 * j);
    for (int row = gw; row < NLAT; row += ngw) {
        float* ip = out + (size_t)row * DM;
        f32x4 v[4]; float ss = 0.f;
#pragma unroll
        for (int j = 0; j < 4; ++j) { v[j] = *(const f32x4*)(ip + 4 * lane + 256 * j); ss += (v[j][0] * v[j][0] + v[j][1] * v[j][1]) + (v[j][2] * v[j][2] + v[j][3] * v[j][3]); }
        ss = wave_sum(ss, lane);
        const float rstd = 1.0f / sqrtf(ss * (1.f / DM) + EPS);
#pragma unroll
        for (int j = 0; j < 4; ++j) *(f32x4*)(ip + 4 * lane + 256 * j) = v[j] * rstd * gv[j];
    }
}
__device__ __forceinline__ void pool_phase(const bf16_t* zp, bf16_t* mx, int gtid, int ngt) {
    for (int it = gtid; it < R * 32; it += ngt) {
        const int row = it >> 5, ch = (it & 31) * 8, g = ch >> 6, hw = 1 << g;
        int base, n;
        if (row < NLAT) { base = row & ~(SEQ - 1); n = SEQ; } else { base = NLAT + ((row - NLAT) & ~(CTXL - 1)); n = CTXL; }
        const int t = row - base, lo = (t - hw > 0) ? t - hw : 0, hi = (t + hw < n) ? t + hw : n;
        float s[8];
#pragma unroll
        for (int i = 0; i < 8; ++i) s[i] = 0.f;
        for (int j = lo; j < hi; ++j) {
            const u32x4 v = *(const u32x4*)(zp + (size_t)(base + j) * 256 + ch);
            s[0] += bflo(v.x); s[1] += bfhi(v.x); s[2] += bflo(v.y); s[3] += bfhi(v.y); s[4] += bflo(v.z); s[5] += bfhi(v.z); s[6] += bflo(v.w); s[7] += bfhi(v.w);
        }
        const float inv = 1.f / (float)(hi - lo);
        const u32x4 c = *(const u32x4*)(zp + (size_t)row * 256 + ch);
        u32x4 w;
        w.x = pk2(s[0] * inv - bflo(c.x), s[1] * inv - bfhi(c.x)); w.y = pk2(s[2] * inv - bflo(c.y), s[3] * inv - bfhi(c.y));
        w.z = pk2(s[4] * inv - bflo(c.z), s[5] * inv - bfhi(c.z)); w.w = pk2(s[6] * inv - bflo(c.w), s[7] * inv - bfhi(c.w));
        *(u32x4*)(mx + (size_t)row * 256 + ch) = w;
    }
}

__device__ __forceinline__ int hg_row(int dir, int b, int step) {
    if (step < CTXL) { const int t = dir ? (CTXL - 1 - step) : step; return NLAT + b * CTXL + t; }
    int t = step - CTXL; if (dir) t = SEQ - 1 - t; return b * SEQ + t;
}
template <bool OUT>
__device__ __forceinline__ void hg_pass(const float* hq, const float* ff, const float* fb, const bf16_t* hi, float* carry, float* dk, bf16_t* odir, int wave, int lane, int G) {
    for (int item = blockIdx.x + G * wave; item < 16 * HG_SEG; item += G * 8) {
        const int s = item / HG_SEG, j = item % HG_SEG, dir = s >> 3, b = (s >> 2) & 1, h = s & 3;
        const float* fbase = dir ? fb : ff;
        f32x2v S[32];
#pragma unroll
        for (int k = 0; k < 32; ++k) { S[k][0] = OUT ? carry[((size_t)item * 64 + 2 * k) * 64 + lane] : 0.f; S[k][1] = OUT ? carry[((size_t)item * 64 + 2 * k + 1) * 64 + lane] : 0.f; }
        float dl = 1.f;
        const int st0 = j * HG_STEPS, st1 = st0 + HG_STEPS;
        constexpr int HG_PF = 8;
        float ivb[HG_PF], fvb[HG_PF], qvb[HG_PF];
#pragma unroll
        for (int u = 0; u < HG_PF; ++u) {
            const int stl = (st0 + u < st1) ? st0 + u : st1 - 1;
            const size_t off = (size_t)hg_row(dir, b, stl) * 256 + h * 64 + lane;
            ivb[u] = bf2f(hi[off]); fvb[u] = fbase[off]; qvb[u] = OUT ? hq[off] : 0.f;
        }
        for (int sb = st0; sb < st1; sb += HG_PF) {
#pragma unroll
            for (int u = 0; u < HG_PF; ++u) {
                const int st = sb + u;
                if (st < st1) {
                    const float iv = ivb[u], fv = fvb[u], qv = qvb[u];
                    const size_t offc = (size_t)hg_row(dir, b, st) * 256 + h * 64 + lane;
                    { const int stn = (st + HG_PF < st1) ? st + HG_PF : st1 - 1;
                      const size_t off = (size_t)hg_row(dir, b, stn) * 256 + h * 64 + lane;
                      ivb[u] = bf2f(hi[off]); fvb[u] = fbase[off]; if (OUT) qvb[u] = hq[off]; }
                    if (!OUT) dl *= fv;
                    f32x2v o2 = {0.f, 0.f};
                    const f32x2v iv2 = {iv, iv};
                    const int fvi = __builtin_bit_cast(int, fv), qvi = __builtin_bit_cast(int, qv);
#pragma unroll
                    for (int k = 0; k < 32; ++k) {
                        f32x2v f2; f2[0] = __builtin_bit_cast(float, __builtin_amdgcn_readlane(fvi, 2 * k)); f2[1] = __builtin_bit_cast(float, __builtin_amdgcn_readlane(fvi, 2 * k + 1));
                        const f32x2v d2 = S[k] - iv2;
                        S[k] = __builtin_elementwise_fma(f2, d2, iv2);
                        if (OUT) { f32x2v q2; q2[0] = __builtin_bit_cast(float, __builtin_amdgcn_readlane(qvi, 2 * k)); q2[1] = __builtin_bit_cast(float, __builtin_amdgcn_readlane(qvi, 2 * k + 1));
                            o2 = __builtin_elementwise_fma(q2, S[k], o2); }
                    }
                    if (OUT) odir[(size_t)dir * R * 256 + offc] = (bf16_t)(pk2(o2[0] + o2[1], 0.f) & 0xffffu);
                }
            }
        }
        if (!OUT) {
#pragma unroll
            for (int k = 0; k < 32; ++k) { carry[((size_t)item * 64 + 2 * k) * 64 + lane] = S[k][0]; carry[((size_t)item * 64 + 2 * k + 1) * 64 + lane] = S[k][1]; }
            dk[item * 64 + lane] = dl;
        }
    }
}
constexpr int HGA_T = 48, HGA_STR = 112, HGA_MAT = 64 * HGA_STR, HGA_WAVE = 2 * HGA_MAT;
static_assert(8 * HGA_WAVE <= LDS_BYTES - 64 && 3 * HGA_T >= HG_STEPS, "hg pass A LDS");
__device__ __forceinline__ void hg_passA_mfma(LAS unsigned char* lds, const float* ff, const float* fb, const bf16_t* hi, float* carry, float* dk, int wave, int lane, int G) {
    LAS unsigned char* KT = lds + wave * HGA_WAVE; LAS unsigned char* VT = KT + HGA_MAT;
    const int n = lane & 31, gq = lane >> 5;
    for (int item = blockIdx.x + G * wave; item < 16 * HG_SEG; item += G * 8) {
        const int s = item / HG_SEG, j = item % HG_SEG, dir = s >> 3, b = (s >> 2) & 1, h = s & 3;
        const float* fbase = dir ? fb : ff;
        const int st0 = j * HG_STEPS, st1 = st0 + HG_STEPS;
        f32x16 acc[2][2];
#pragma unroll
        for (int kb = 0; kb < 2; ++kb)
#pragma unroll
            for (int vb = 0; vb < 2; ++vb)
#pragma unroll
                for (int r = 0; r < 16; ++r) acc[kb][vb][r] = 0.f;
        float P = 1.f;
        for (int third = 2; third >= 0; --third) {
            const int sb = st0 + third * HGA_T;
            for (int s0 = HGA_T - 8; s0 >= 0; s0 -= 8) {
                float fv[8]; unsigned short iv[8];
#pragma unroll
                for (int u = 0; u < 8; ++u) {
                    const int st = sb + s0 + u;
                    const int stc = (st < st1) ? st : st1 - 1;
                    const size_t off = (size_t)hg_row(dir, b, stc) * 256 + h * 64 + lane;
                    fv[u] = fbase[off]; iv[u] = hi[off];
                }
#pragma unroll
                for (int u = 7; u >= 0; --u) {
                    const int st = sb + s0 + u;
                    const bool ok = (st < st1);
                    const float f = ok ? fv[u] : 1.f;
                    const float kh = ok ? (1.f - f) * P : 0.f;
                    P *= f;
                    *(LAS unsigned short*)(KT + lane * HGA_STR + (s0 + u) * 2) = (unsigned short)(pk2(kh, 0.f) & 0xffffu);
                    *(LAS unsigned short*)(VT + lane * HGA_STR + (s0 + u) * 2) = ok ? iv[u] : (unsigned short)0;
                }
            }
            LDS_WAIT(); asm volatile("" ::: "memory");
#pragma unroll
            for (int q = 0; q < HGA_T / 16; ++q) {
                bf16x8 af[2], bfr[2];
#pragma unroll
                for (int kb = 0; kb < 2; ++kb) af[kb] = *(LAS bf16x8*)(KT + (kb * 32 + n) * HGA_STR + (16 * q + 8 * gq) * 2);
#pragma unroll
                for (int vb = 0; vb < 2; ++vb) bfr[vb] = *(LAS bf16x8*)(VT + (vb * 32 + n) * HGA_STR + (16 * q + 8 * gq) * 2);
#pragma unroll
                for (int kb = 0; kb < 2; ++kb)
#pragma unroll
                    for (int vb = 0; vb < 2; ++vb) acc[kb][vb] = __builtin_amdgcn_mfma_f32_32x32x16_bf16(af[kb], bfr[vb], acc[kb][vb], 0, 0, 0);
            }
            LDS_WAIT(); asm volatile("" ::: "memory");
        }
#pragma unroll
        for (int kb = 0; kb < 2; ++kb)
#pragma unroll
            for (int vb = 0; vb < 2; ++vb)
#pragma unroll
                for (int r = 0; r < 16; ++r) {
                    const int k = kb * 32 + 8 * (r >> 2) + 4 * gq + (r & 3), v = vb * 32 + n;
                    carry[((size_t)item * 64 + k) * 64 + v] = acc[kb][vb][r];
                }
        dk[item * 64 + lane] = P;
    }
}
constexpr int HGB_QSTR = 144, HGB_TSTR = 48, HGB_Q = 0, HGB_K = HGB_Q + 16 * HGB_QSTR, HGB_KH = HGB_K + 16 * HGB_QSTR, HGB_IT = HGB_KH + 64 * HGB_TSTR, HGB_DC = HGB_IT + 64 * HGB_TSTR, HGB_WAVE = HGB_DC + 256;
static_assert(8 * HGB_WAVE <= LDS_BYTES - 64, "hg pass B LDS");
__device__ __forceinline__ bf16x8 hgb_pack8(const f32x16& t, int r0) {
    u32x4 w; w.x = pk2(t[r0 + 0], t[r0 + 1]); w.y = pk2(t[r0 + 2], t[r0 + 3]); w.z = pk2(t[r0 + 4], t[r0 + 5]); w.w = pk2(t[r0 + 6], t[r0 + 7]); return __builtin_bit_cast(bf16x8, w);
}
__device__ __forceinline__ void hg_passB_mfma(LAS unsigned char* lds, const float* hq, const float* ff, const float* fb, const bf16_t* hi, const float* carry, bf16_t* odir, int wave, int lane, int G) {
    LAS unsigned char* W = lds + wave * HGB_WAVE;
    const int n = lane & 31, gq = lane >> 5, n16 = n & 15;
    const int kpos = (lane & ~15) + (lane & 3) + ((lane >> 3) & 1) * 4 + ((lane >> 2) & 1) * 8;
    for (int item = blockIdx.x + G * wave; item < 16 * HG_SEG; item += G * 8) {
        const int s = item / HG_SEG, j = item % HG_SEG, dir = s >> 3, b = (s >> 2) & 1, h = s & 3;
        const float* fbase = dir ? fb : ff;
        const int st0 = j * HG_STEPS, st1 = st0 + HG_STEPS;
        f32x16 S[2][2];
#pragma unroll
        for (int kb = 0; kb < 2; ++kb)
#pragma unroll
            for (int vb = 0; vb < 2; ++vb)
#pragma unroll
                for (int r = 0; r < 16; ++r) S[kb][vb][r] = carry[((size_t)item * 64 + kb * 32 + 8 * (r >> 2) + 4 * gq + (r & 3)) * 64 + vb * 32 + n];
        for (int c0 = st0; c0 < st1; c0 += 16) {
            float fv[16], qv[16]; unsigned short iv[16];
#pragma unroll
            for (int t = 0; t < 16; ++t) {
                const int st = c0 + t; const int stc = (st < st1) ? st : st1 - 1;
                const size_t off = (size_t)hg_row(dir, b, stc) * 256 + h * 64 + lane;
                fv[t] = fbase[off]; qv[t] = hq[off]; iv[t] = hi[off];
            }
            float P = 1.f; float kt[16];
#pragma unroll
            for (int t = 0; t < 16; ++t) {
                const bool ok = (c0 + t < st1);
                const float f = ok ? fv[t] : 1.f, q = ok ? qv[t] : 0.f;
                P *= f;
                const float Pc = fmaxf(P, 1e-30f);
                kt[t] = ok ? (1.f - f) * rcpf_(Pc) : 0.f;
                *(LAS unsigned short*)(W + HGB_Q + t * HGB_QSTR + kpos * 2) = (unsigned short)(pk2(q * Pc, 0.f) & 0xffffu);
                *(LAS unsigned short*)(W + HGB_K + t * HGB_QSTR + kpos * 2) = (unsigned short)(pk2(kt[t], 0.f) & 0xffffu);
                *(LAS unsigned short*)(W + HGB_IT + lane * HGB_TSTR + t * 2) = ok ? iv[t] : (unsigned short)0;
            }
            const float P15 = fmaxf(P, 1e-30f);
#pragma unroll
            for (int t = 0; t < 16; ++t) *(LAS unsigned short*)(W + HGB_KH + lane * HGB_TSTR + t * 2) = (unsigned short)(pk2(kt[t] * P15, 0.f) & 0xffffu);
            *(LAS float*)(W + HGB_DC + lane * 4) = P;
            LDS_WAIT(); asm volatile("" ::: "memory");
            bf16x8 qb[4];
#pragma unroll
            for (int u = 0; u < 4; ++u) qb[u] = *(LAS bf16x8*)(W + HGB_Q + n16 * HGB_QSTR + (16 * u + 8 * gq) * 2);
            f32x16 OT[2], AT;
#pragma unroll
            for (int r = 0; r < 16; ++r) { OT[0][r] = 0.f; OT[1][r] = 0.f; AT[r] = 0.f; }
#pragma unroll
            for (int u = 0; u < 4; ++u) {
                const bf16x8 ka = *(LAS bf16x8*)(W + HGB_K + n16 * HGB_QSTR + (16 * u + 8 * gq) * 2);
                AT = __builtin_amdgcn_mfma_f32_32x32x16_bf16(ka, qb[u], AT, 0, 0, 0);
#pragma unroll
                for (int vb = 0; vb < 2; ++vb)
                    OT[vb] = __builtin_amdgcn_mfma_f32_32x32x16_bf16(hgb_pack8(S[u >> 1][vb], 8 * (u & 1)), qb[u], OT[vb], 0, 0, 0);
            }
#pragma unroll
            for (int r = 0; r < 8; ++r) { const int srow = 8 * (r >> 2) + 4 * gq + (r & 3); if (srow > n) AT[r] = 0.f; }
            const bf16x8 ab = hgb_pack8(AT, 0);
#pragma unroll
            for (int vb = 0; vb < 2; ++vb) {
                const u32x2 lo = *(LAS u32x2*)(W + HGB_IT + (vb * 32 + n) * HGB_TSTR + (4 * gq) * 2), hi2 = *(LAS u32x2*)(W + HGB_IT + (vb * 32 + n) * HGB_TSTR + (8 + 4 * gq) * 2);
                const bf16x8 ia = __builtin_bit_cast(bf16x8, ((u32x4){lo.x, lo.y, hi2.x, hi2.y}));
                OT[vb] = __builtin_amdgcn_mfma_f32_32x32x16_bf16(ia, ab, OT[vb], 0, 0, 0);
            }
            if (n < 16 && c0 + n < st1) {
                bf16_t* op = odir + (size_t)dir * R * 256 + (size_t)hg_row(dir, b, c0 + n) * 256 + h * 64;
#pragma unroll
                for (int vb = 0; vb < 2; ++vb)
#pragma unroll
                    for (int r4 = 0; r4 < 4; ++r4) {
                        u32x2 w; w.x = pk2(OT[vb][4 * r4 + 0], OT[vb][4 * r4 + 1]); w.y = pk2(OT[vb][4 * r4 + 2], OT[vb][4 * r4 + 3]);
                        *(u32x2*)(op + vb * 32 + 8 * r4 + 4 * gq) = w;
                    }
            }
#pragma unroll
            for (int kb = 0; kb < 2; ++kb) {
                f32x4 dc[4];
#pragma unroll
                for (int r4 = 0; r4 < 4; ++r4) dc[r4] = *(LAS f32x4*)(W + HGB_DC + (kb * 32 + 8 * r4 + 4 * gq) * 4);
                const bf16x8 kh = *(LAS bf16x8*)(W + HGB_KH + (kb * 32 + n) * HGB_TSTR + (8 * gq) * 2);
#pragma unroll
                for (int vb = 0; vb < 2; ++vb) {
#pragma unroll
                    for (int r = 0; r < 16; ++r) S[kb][vb][r] *= dc[r >> 2][r & 3];
                    const bf16x8 ib = *(LAS bf16x8*)(W + HGB_IT + (vb * 32 + n) * HGB_TSTR + (8 * gq) * 2);
                    S[kb][vb] = __builtin_amdgcn_mfma_f32_32x32x16_bf16(kh, ib, S[kb][vb], 0, 0, 0);
                }
            }
            LDS_WAIT(); asm volatile("" ::: "memory");
        }
    }
}
__device__ __forceinline__ void hg_carry(float* carry, const float* dk, int gtid, int ngt) {
    for (int e = gtid; e < 16 * 4096; e += ngt) {
        const int s = e >> 12, idx = e & 4095, k = idx >> 6;
        float run = 0.f;
        for (int j0 = 0; j0 < HG_SEG; j0 += 8) {
            float t[8], d[8];
#pragma unroll
            for (int u = 0; u < 8; ++u) { t[u] = carry[(size_t)(s * HG_SEG + j0 + u) * 4096 + idx]; d[u] = dk[(s * HG_SEG + j0 + u) * 64 + k]; }
#pragma unroll
            for (int u = 0; u < 8; ++u) { carry[(size_t)(s * HG_SEG + j0 + u) * 4096 + idx] = run; run = __builtin_fmaf(d[u], run, t[u]); }
        }
    }
}
__device__ __forceinline__ void hg_readout(const bf16_t* odir, const bf16_t* hgs, const float* gain, bf16_t* ohg, int gw, int ngw, int lane) {
    const f32x4 gv = *(const f32x4*)(gain + ((4 * lane) & 63));
    for (int row = gw; row < R; row += ngw) {
        const size_t off = (size_t)row * 256 + 4 * lane;
        const u32x2 a = *(const u32x2*)(odir + off), bq = *(const u32x2*)(odir + (size_t)R * 256 + off), hg = *(const u32x2*)(hgs + off);
        const float o0 = bflo(a.x) + bflo(bq.x), o1 = bfhi(a.x) + bfhi(bq.x), o2 = bflo(a.y) + bflo(bq.y), o3 = bfhi(a.y) + bfhi(bq.y);
        float ss = (o0 * o0 + o1 * o1) + (o2 * o2 + o3 * o3);
        ss += shx(ss, 1, lane); ss += shx(ss, 2, lane); ss += shx(ss, 4, lane); ss += shx(ss, 8, lane);
        const float rstd = 1.0f / sqrtf(ss * (1.f / 64.f) + EPS);
        u32x2 w;
        w.x = pk2(o0 * rstd * gv[0] * bflo(hg.x), o1 * rstd * gv[1] * bfhi(hg.x));
        w.y = pk2(o2 * rstd * gv[2] * bflo(hg.y), o3 * rstd * gv[3] * bfhi(hg.y));
        *(u32x2*)(ohg + off) = w;
    }
}

constexpr int AT_KSTR = 256, AT_VSTR = 128, AT_KBYTES = 64 * AT_KSTR, AT_VBYTES = 128 * AT_VSTR, AT_STAGE = AT_KBYTES + AT_VBYTES;
static_assert(2 * AT_STAGE <= LDS_BYTES && 65536 <= 2 * AT_STAGE, "attention LDS");
__device__ __forceinline__ void attn_unit(LAS unsigned char* lds, const bf16_t* qbuf, const bf16_t* kbuf, const bf16_t* vT, bf16_t* oda, const float* gain,
                                          int b, int h, int qrow0, int kt0, int kt1, float lam, float post, int tid, int wave, int lane) {
    const int c = wave & 1, g = wave >> 1, n = lane & 31, gq = lane >> 5;
    bf16x8 qf[4];
    { const bf16_t* qp = qbuf + (size_t)(qrow0 + 32 * g + n) * 512 + h * 128 + c * 64 + 8 * gq;
#pragma unroll
      for (int s = 0; s < 4; ++s) qf[s] = *(const bf16x8*)(qp + 16 * s); }
    f32x16 O[4];
#pragma unroll
    for (int e = 0; e < 4; ++e)
#pragma unroll
        for (int r = 0; r < 16; ++r) O[e][r] = 0.f;
    float l = 0.f;
    const int kr_ = lane >> 4, kpos_ = lane & 15;
    const int vr_ = lane >> 3, vpos_ = lane & 7;
    const unsigned char* kbase = (const unsigned char*)(kbuf + h * 128);
    const unsigned char* vbase = (const unsigned char*)(vT + (size_t)(b * 512 + h * 128) * KEYS);
#define AT_KROW0(kt) (((kt) * 64 < SEQ) ? (size_t)b * SEQ + (kt) * 64 : (size_t)NLAT + b * CTXL + ((kt) * 64 - SEQ))
#define AT_DMA(kt, buf) do { const unsigned char* kb_ = kbase + AT_KROW0(kt) * 1024; const unsigned char* vb_ = vbase + (size_t)(kt) * 128; \
        _Pragma("unroll") for (int pp = 0; pp < 2; ++pp) { const int p_ = wave + 8 * pp; \
            { const int r_ = 4 * p_ + kr_; \
              __builtin_amdgcn_global_load_lds((const unsigned*)(kb_ + (size_t)r_ * 1024 + ((kpos_ ^ (r_ & 15)) * 16)), (LAS unsigned*)(lds + (buf) * AT_KBYTES + p_ * 1024), 16, 0, 0); } \
            { const int e_ = 8 * p_ + vr_; \
              __builtin_amdgcn_global_load_lds((const unsigned*)(vb_ + (size_t)e_ * (KEYS * 2) + ((vpos_ ^ ((e_ >> 1) & 7)) * 16)), (LAS unsigned*)(lds + 2 * AT_KBYTES + (buf) * AT_VBYTES + p_ * 1024), 16, 0, 0); } } } while (0)
#define AT_QK(Sa, Sb, buf) do { LAS unsigned char* kp = lds + (buf) * AT_KBYTES + n * AT_KSTR; \
        _Pragma("unroll") for (int s = 0; s < 4; ++s) { \
            const bf16x8 a0 = *(LAS bf16x8*)(kp + (((c * 8 + 2 * s + gq) ^ (n & 15)) * 16)), a1 = *(LAS bf16x8*)(kp + 32 * AT_KSTR + (((c * 8 + 2 * s + gq) ^ (n & 15)) * 16)); \
            Sa = __builtin_amdgcn_mfma_f32_32x32x16_bf16(a0, qf[s], Sa, 0, 0, 0); \
            Sb = __builtin_amdgcn_mfma_f32_32x32x16_bf16(a1, qf[s], Sb, 0, 0, 0); } } while (0)
#define AT_BAR() do { asm volatile("s_waitcnt vmcnt(0) lgkmcnt(0)" ::: "memory"); __builtin_amdgcn_s_barrier(); asm volatile("" ::: "memory"); } while (0)
    const int nt = kt1 - kt0;
    AT_DMA(kt0, 0);
    AT_BAR();
    f32x16 negm;
    {
        f32x16 S0, S1;
#pragma unroll
        for (int r = 0; r < 16; ++r) { S0[r] = 0.f; S1[r] = 0.f; }
        AT_QK(S0, S1, 0);
        float mx = fmaxf(S0[0], S1[0]);
#pragma unroll
        for (int r = 1; r < 16; ++r) mx = fmaxf(fmaxf(mx, S0[r]), S1[r]);
        { auto rr = __builtin_amdgcn_permlane32_swap(__builtin_bit_cast(unsigned, mx), __builtin_bit_cast(unsigned, mx), false, false);
          mx = fmaxf(__builtin_bit_cast(float, rr[0]), __builtin_bit_cast(float, rr[1])); }
#pragma unroll
        for (int r = 0; r < 16; ++r) negm[r] = -mx;
    }
    constexpr float THR = 8.f;
    for (int i = 0; i < nt; ++i) {
        const int cur = i & 1;
        bf16x8 kf[8];
        if (i + 1 < nt) AT_DMA(kt0 + i + 1, cur ^ 1);
        { LAS unsigned char* kp = lds + cur * AT_KBYTES + n * AT_KSTR;
#pragma unroll
          for (int s = 0; s < 4; ++s) { const int po = ((c * 8 + 2 * s + gq) ^ (n & 15)) * 16; kf[2 * s] = *(LAS bf16x8*)(kp + po); kf[2 * s + 1] = *(LAS bf16x8*)(kp + 32 * AT_KSTR + po); } }
        LAS unsigned char* vp = lds + 2 * AT_KBYTES + cur * AT_VBYTES + n * AT_VSTR;
        const int vsw = (n >> 1) & 7;
        bf16x8 va[8];
#pragma unroll
        for (int ks = 0; ks < 2; ++ks)
#pragma unroll
            for (int e = 0; e < 4; ++e) va[ks * 4 + e] = *(LAS bf16x8*)(vp + e * 32 * AT_VSTR + (((2 * ks + gq) ^ vsw) * 16));
        __builtin_amdgcn_sched_barrier(0);
        f32x16 S0 = negm, S1 = negm;
#pragma unroll
        for (int s = 0; s < 4; ++s) {
            S0 = __builtin_amdgcn_mfma_f32_32x32x16_bf16(kf[2 * s], qf[s], S0, 0, 0, 0);
            S1 = __builtin_amdgcn_mfma_f32_32x32x16_bf16(kf[2 * s + 1], qf[s], S1, 0, 0, 0);
        }
        __builtin_amdgcn_sched_barrier(0);
        bf16x8 vb[8];
#pragma unroll
        for (int ks = 0; ks < 2; ++ks)
#pragma unroll
            for (int e = 0; e < 4; ++e) vb[ks * 4 + e] = *(LAS bf16x8*)(vp + e * 32 * AT_VSTR + (((2 * (ks + 2) + gq) ^ vsw) * 16));
        __builtin_amdgcn_sched_barrier(0);
        float mx = fmaxf(S0[0], S1[0]);
#pragma unroll
        for (int r = 1; r < 16; ++r) mx = fmaxf(fmaxf(mx, S0[r]), S1[r]);
        { auto rr = __builtin_amdgcn_permlane32_swap(__builtin_bit_cast(unsigned, mx), __builtin_bit_cast(unsigned, mx), false, false);
          mx = fmaxf(__builtin_bit_cast(float, rr[0]), __builtin_bit_cast(float, rr[1])); }
        if (__builtin_amdgcn_ballot_w64(mx > THR) != 0ull) {
            const float delta = fmaxf(mx, 0.f), alpha = ex2(-delta);
            l *= alpha;
#pragma unroll
            for (int r = 0; r < 16; ++r) { S0[r] -= delta; S1[r] -= delta; negm[r] -= delta; }
#pragma unroll
            for (int e = 0; e < 4; ++e) O[e] = O[e] * alpha;
        }
        float ps = 0.f;
        bf16x8 pb[4];
#pragma unroll
        for (int r = 0; r < 16; ++r) { S0[r] = ex2(S0[r]); ps += S0[r]; }
#pragma unroll
        for (int s = 0; s < 2; ++s) { u32x4 pw;
            pw.x = pk2(S0[8 * s + 0], S0[8 * s + 1]); pw.y = pk2(S0[8 * s + 2], S0[8 * s + 3]); pw.z = pk2(S0[8 * s + 4], S0[8 * s + 5]); pw.w = pk2(S0[8 * s + 6], S0[8 * s + 7]);
            pb[s] = __builtin_bit_cast(bf16x8, pw); }
        __builtin_amdgcn_sched_barrier(0);
#pragma unroll
        for (int ks = 0; ks < 2; ++ks)
#pragma unroll
            for (int e = 0; e < 4; ++e) O[e] = __builtin_amdgcn_mfma_f32_32x32x16_bf16(va[ks * 4 + e], pb[ks], O[e], 0, 0, 0);
#pragma unroll
        for (int r = 0; r < 16; ++r) { S1[r] = ex2(S1[r]); ps += S1[r]; }
        l += ps;
#pragma unroll
        for (int s = 0; s < 2; ++s) { u32x4 pw;
            pw.x = pk2(S1[8 * s + 0], S1[8 * s + 1]); pw.y = pk2(S1[8 * s + 2], S1[8 * s + 3]); pw.z = pk2(S1[8 * s + 4], S1[8 * s + 5]); pw.w = pk2(S1[8 * s + 6], S1[8 * s + 7]);
            pb[2 + s] = __builtin_bit_cast(bf16x8, pw); }
        __builtin_amdgcn_sched_barrier(0);
#pragma unroll
        for (int ks = 0; ks < 2; ++ks)
#pragma unroll
            for (int e = 0; e < 4; ++e) O[e] = __builtin_amdgcn_mfma_f32_32x32x16_bf16(vb[ks * 4 + e], pb[2 + ks], O[e], 0, 0, 0);
        AT_BAR();
    }
#undef AT_BAR
#undef AT_KROW0
#undef AT_DMA
#undef AT_QK
    l += shx(l, 32, lane);
    const float inv = 1.f / l;
    LAS float* xch = (LAS float*)lds;
    if (c == 1) {
#pragma unroll
        for (int e = 0; e < 4; ++e)
#pragma unroll
            for (int r = 0; r < 16; ++r) xch[(g * 64 + e * 16 + r) * 64 + lane] = O[e][r] * inv;
    }
    __syncthreads();
    if (c == 0) {
        float ss = 0.f;
#pragma unroll
        for (int e = 0; e < 4; ++e)
#pragma unroll
            for (int r = 0; r < 16; ++r) { const float o = O[e][r] * inv - lam * xch[(g * 64 + e * 16 + r) * 64 + lane]; O[e][r] = o; ss += o * o; }
        ss += shx(ss, 32, lane);
        const float rs = post / sqrtf(ss * (1.f / 128.f) + EPS);
        bf16_t* op = oda + (size_t)(qrow0 + 32 * g + n) * 512 + h * 128;
#pragma unroll
        for (int e = 0; e < 4; ++e)
#pragma unroll
            for (int r4 = 0; r4 < 4; ++r4) {
                const int e0 = e * 32 + 8 * r4 + 4 * gq;
                const f32x4 gv = *(const f32x4*)(gain + e0);
                u32x2 w; w.x = pk2(O[e][4 * r4 + 0] * rs * gv[0], O[e][4 * r4 + 1] * rs * gv[1]); w.y = pk2(O[e][4 * r4 + 2] * rs * gv[2], O[e][4 * r4 + 3] * rs * gv[3]);
                *(u32x2*)(op + e0) = w;
            }
    }
    __syncthreads();
}
#define XB_TMO      128
#define XB_XCNT(j)  (256  + 64 * (j))
#define XB_XSUB(j)  (1280 + 64 * (j))
#define XB_XGEN(j)  (2304 + 64 * (j))
#define XB_TOP      3328
#define XB_TOPGEN   3392
#define XCD_BAR_WORDS 3456
#define XB_SPIN_CAP (1u << 18)

__device__ __forceinline__ unsigned xb_ld(unsigned* p)              { return __hip_atomic_load(p, __ATOMIC_RELAXED, __HIP_MEMORY_SCOPE_AGENT); }
__device__ __forceinline__ unsigned xb_add(unsigned* p, unsigned v) { return __hip_atomic_fetch_add(p, v, __ATOMIC_RELAXED, __HIP_MEMORY_SCOPE_AGENT); }
__device__ __forceinline__ unsigned xb_xcc_id() { return (unsigned)__builtin_amdgcn_s_getreg((3 << 11) | 20) & 0xFu; }
#define XB_SPIN(cond, bar) do { unsigned _sp = 0; while (cond) { __builtin_amdgcn_s_sleep(1); \
    if ((++_sp & 255u) == 0u) { if (xb_ld(&(bar)[XB_TMO])) break; if (_sp > XB_SPIN_CAP) { atomicAdd(&(bar)[XB_TMO], 1u); break; } } } } while (0)

struct XcdBarrier {
    unsigned* bar; unsigned x;
    volatile LAS unsigned* st;
};

__device__ __forceinline__ XcdBarrier xcd_barrier_post(unsigned* bar, volatile LAS unsigned* st, int tid_in) {
    XcdBarrier b; b.bar = bar; b.x = xb_xcc_id(); b.st = st;
    if (tid_in == 0) (void)xb_add(&bar[XB_XCNT(b.x)], 1u);
    return b;
}
__device__ __forceinline__ void xcd_barrier_complete(unsigned* bar, unsigned x, unsigned& nloc, unsigned& nx) {
    const unsigned G = gridDim.x * gridDim.y * gridDim.z;
    unsigned sum, cnt, mine, sp = 0u;
    for (;;) {
        sum = 0u; cnt = 0u; mine = 0u;
#pragma unroll
        for (unsigned j = 0; j < 16; ++j) { const unsigned c = xb_ld(&bar[XB_XCNT(j)]); sum += c; cnt += (c > 0u) ? 1u : 0u; mine = (j == x) ? c : mine; }
        if (sum == G) break;
        __builtin_amdgcn_s_sleep(1);
        if ((++sp & 255u) == 0u) { if (xb_ld(&bar[XB_TMO])) break; if (sp > XB_SPIN_CAP) { atomicAdd(&bar[XB_TMO], 1u); break; } }
    }
    nloc = mine > 0u ? mine : 1u; nx = cnt > 0u ? cnt : 1u;
}

__device__ __forceinline__ void xcd_barrier(const XcdBarrier& b, int tid_in) {
    asm volatile("s_waitcnt vmcnt(0)" ::: "memory");
    __syncthreads();
    if (tid_in == 0) {
        unsigned* bar = b.bar;
        __builtin_amdgcn_s_waitcnt(0);
        unsigned nloc = b.st[0], nx = b.st[1];
        if (nloc == 0u) { xcd_barrier_complete(bar, b.x, nloc, nx); b.st[0] = nloc; b.st[1] = nx; }
        const unsigned old = xb_add(&bar[XB_XSUB(b.x)], 1u);
        const unsigned gen = old / nloc;
        if (old + 1u == (gen + 1u) * nloc) {
            __builtin_amdgcn_fence(__ATOMIC_RELEASE, "agent");
            asm volatile("s_waitcnt vmcnt(0)" ::: "memory");
            const unsigned og = xb_add(&bar[XB_TOP], 1u);
            const unsigned tg = og / nx;
            if (og + 1u == (tg + 1u) * nx) xb_add(&bar[XB_TOPGEN], 1u);
            else XB_SPIN(xb_ld(&bar[XB_TOPGEN]) == tg, bar);
            __builtin_amdgcn_fence(__ATOMIC_ACQUIRE, "agent");
            xb_add(&bar[XB_XGEN(b.x)], 1u);
            asm volatile("s_waitcnt vmcnt(0)" ::: "memory");
        } else {
            XB_SPIN(xb_ld(&bar[XB_XGEN(b.x)]) == gen, bar);
            __builtin_amdgcn_fence(__ATOMIC_ACQUIRE, "agent");
            asm volatile("s_waitcnt vmcnt(0)" ::: "memory");
        }
    }
    __syncthreads();
}


struct Args { const float* in[30]; float* out; unsigned char* ws; };
typedef const Args __attribute__((address_space(4))) Args_c;
__device__ __forceinline__ Args_c* kargs_ptr() { Args_c* p = (Args_c*)__builtin_amdgcn_kernarg_segment_ptr(); asm volatile("" : "+s"(p)); return p; }
#define GSYNC_CG() cg::this_grid().sync()
constexpr size_t WS_BAR = WS_END + 4096;
constexpr size_t WS_TOTAL = WS_BAR + (size_t)XCD_BAR_WORDS * 4;
static_assert(WS_TOTAL <= (size_t)512 * 1024 * 1024, "workspace");
constexpr int LDS_BARST = LDS_BYTES - 16;
#define GSYNC() do { XcdBarrier xb_; xb_.bar = (unsigned*)(kargs_ptr()->ws + WS_BAR); xb_.x = xb_xcc_id(); xb_.st = (volatile LAS unsigned*)(lds + LDS_BARST); xcd_barrier(xb_, TIDX()); } while (0)
#ifdef PROBE_A
#define TS(cat) do { if (blockIdx.x == 0 && TIDX() == 0) { unsigned long long* tsb = (unsigned long long*)(kargs_ptr()->ws + WS_END); const unsigned long long now = __builtin_amdgcn_s_memrealtime(); tsb[1 + (cat)] += now - tsb[0]; tsb[0] = now; } } while (0)
#else
#define TS(cat) do {} while (0)
#endif
__device__ __forceinline__ int tid_from(int wave_s) { int w_ = wave_s; unsigned z_ = 0u; asm volatile("" : "+s"(w_), "+s"(z_)); return w_ * 64 + (int)__builtin_amdgcn_mbcnt_hi(~0u, __builtin_amdgcn_mbcnt_lo(~0u, z_)); }
#define TIDX() tid_from(wave_s)
#define KA() int tid = TIDX(); asm volatile("" : "+v"(tid)); int G = gridDim.x, bid = blockIdx.x; asm volatile("" : "+s"(G), "+s"(bid)); \
    const int lane = tid & 63, wave = __builtin_amdgcn_readfirstlane(tid >> 6), gw = bid * 8 + wave, ngw = G * 8, gtid = bid * NTHR + tid, ngt = G * NTHR; \
    (void)lane; (void)wave; (void)gw; (void)ngw; (void)gtid; (void)ngt; \
    Args_c* ka = kargs_ptr(); unsigned char* ws = ka->ws; (void)ws

__global__ void __launch_bounds__(NTHR, 2) fwd_kernel(Args a_unused) {
    extern __shared__ __attribute__((aligned(16))) unsigned char lds_raw[];
    LAS unsigned char* lds = (LAS unsigned char*)lds_raw;
    const int wave_s = __builtin_amdgcn_readfirstlane((int)threadIdx.x >> 6);
    if (TIDX() < 4) ((volatile LAS unsigned*)(lds + LDS_BARST))[TIDX()] = 0u;
    __syncthreads();
    (void)xcd_barrier_post((unsigned*)(kargs_ptr()->ws + WS_BAR), (volatile LAS unsigned*)(lds + LDS_BARST), TIDX());
#ifdef PROBE_A
    if (blockIdx.x == 0 && TIDX() == 0) { unsigned long long* tsb = (unsigned long long*)(kargs_ptr()->ws + WS_END); for (int i = 1; i < 32; ++i) tsb[i] = 0; tsb[0] = __builtin_amdgcn_s_memrealtime(); }
#endif

#ifdef REP_INIT
#pragma unroll 1
    for (int rep_ = 0; rep_ < 2; ++rep_) {
#else
    {
#endif
    {
        KA();
        bf16_t* WB = (bf16_t*)(ws + WS_WB);
        LAS float* scr = (LAS float*)(lds + wave * 8448);
        constexpr int IT_L = 12416;
        for (int it = gw; it < 2 * IT_L; it += ngw) {
            const int l = it / IT_L; int r = it % IT_L;
            bf16_t* Wl = WB + (size_t)l * WL_TOTAL;
            if (r < 1408) { transpose_item(ka->in[9] + (size_t)l * 1024 * DFF, 1024, DFF, Wl + WL_UP1, 1, scr, r, lane); continue; } r -= 1408;
            if (r < 1408) { transpose_item(ka->in[10] + (size_t)l * 1024 * DFF, 1024, DFF, Wl + WL_UP1, 2, scr, r, lane); continue; } r -= 1408;
            if (r < 1408) { transpose_item(ka->in[11] + (size_t)l * DFF * 1024, DFF, 1024, Wl + WL_DN1, 0, scr, r, lane); continue; } r -= 1408;
            if (r < 1408) { transpose_item(ka->in[12] + (size_t)l * 1024 * DFF, 1024, DFF, Wl + WL_UP2, 1, scr, r, lane); continue; } r -= 1408;
            if (r < 1408) { transpose_item(ka->in[13] + (size_t)l * 1024 * DFF, 1024, DFF, Wl + WL_UP2, 2, scr, r, lane); continue; } r -= 1408;
            if (r < 1408) { transpose_item(ka->in[14] + (size_t)l * DFF * 1024, DFF, 1024, Wl + WL_DN2, 0, scr, r, lane); continue; } r -= 1408;
            if (r < 3072) { transpose_item(ka->in[15] + (size_t)l * 1024 * 6144, 1024, 6144, Wl + WL_IN, 3, scr, r, lane); continue; } r -= 3072;
            if (r < 256) { transpose_item(ka->in[25] + (size_t)l * 512 * 1024, 512, 1024, Wl + WL_PA, 0, scr, r, lane); continue; } r -= 256;
            if (r < 128) { transpose_item(ka->in[26] + (size_t)l * 256 * 1024, 256, 1024, Wl + WL_PH, 0, scr, r, lane); continue; } r -= 128;
            transpose_item(ka->in[28] + (size_t)l * 1024 * 1024, 1024, 1024, Wl + WL_O, 0, scr, r, lane);
        }
        __syncthreads();
    }
    {
        KA();
        float* MOD = (float*)(ws + WS_MOD);
        LAS float* sv = (LAS float*)lds;
        LAS float* part = (LAS float*)(lds + 12288);
        for (int i = tid; i < 3072; i += NTHR) { const int seg = i >> 10, k = i & 1023; const float x = (seg < 2) ? ka->in[1][seg * 1024 + k] : ka->in[3][k]; sv[i] = x / (1.f + __expf(-x)); }
        __syncthreads();
        for (int item = bid; item < 288; item += G) {
            const int l = item / 144, col = (item % 144) * 64 + lane;
            const float* W = ka->in[4] + (size_t)l * 1024 * 9216 + col;
            float a0 = 0.f, a1 = 0.f, a2 = 0.f;
            for (int k = wave * 128; k < wave * 128 + 128; ++k) { const float w = W[(size_t)k * 9216]; a0 = __builtin_fmaf(sv[k], w, a0); a1 = __builtin_fmaf(sv[1024 + k], w, a1); a2 = __builtin_fmaf(sv[2048 + k], w, a2); }
            part[(wave * 3 + 0) * 64 + lane] = a0; part[(wave * 3 + 1) * 64 + lane] = a1; part[(wave * 3 + 2) * 64 + lane] = a2;
            __syncthreads();
            if (tid < 192) { const int seg = tid >> 6, cl = tid & 63; float s = 0.f;
#pragma unroll
                for (int w = 0; w < 8; ++w) s += part[(w * 3 + seg) * 64 + cl];
                const int cc = (item % 144) * 64 + cl;
                MOD[(size_t)(l * 3 + seg) * 9216 + cc] = s + ka->in[5][l * 9216 + cc]; }
            __syncthreads();
        }
    }
    {
        KA();
        bf16_t* WB = (bf16_t*)(ws + WS_WB); float* CS = (float*)(ws + WS_CS); float* LBT = (float*)(ws + WS_LB); float* LAMV = (float*)(ws + WS_LAM);
        for (int idx = gtid; idx < 2 * 256 * 1024; idx += ngt) {
            const int n = idx & 1023, k = (idx >> 10) & 255, l = idx >> 18, g = k >> 6, c = k & 63;
            const float* pw = ka->in[23] + (size_t)l * 4 * 64 * 64 + (g * 64 + c) * 64;
            const float* psc = ka->in[24] + l * 256 + g * 64;
            const float* wp = ka->in[27] + (size_t)l * 256 * 1024 + (size_t)(g * 64) * 1024 + n;
            float s = 0.f;
            for (int d = 0; d < 64; ++d) s = __builtin_fmaf(pw[d] * psc[d], wp[(size_t)d * 1024], s);
            (WB + (size_t)l * WL_TOTAL + WL_PP)[(size_t)n * 256 + k] = (bf16_t)(pk2(s, 0.f) & 0xffffu);
        }
        for (int idx = gtid; idx < 4096; idx += ngt) {
            const int n = idx >> 4, j = idx & 15;
            const float invf = __builtin_exp2f(-(float)j * (13.287712379549449f / 16.f));
            const float ang = (float)n * invf;
            const double rev = (double)ang * 0.15915494309189535; const float fr = (float)(rev - __builtin_floor(rev));
            CS[n * 32 + j] = __builtin_amdgcn_cosf(fr); CS[n * 32 + 16 + j] = __builtin_amdgcn_sinf(fr);
        }
        for (int idx = gtid; idx < 1024; idx += ngt) {
            const int l = idx >> 9, dc = idx & 511;
            const float l0 = ka->in[21][dc], l1 = ka->in[21][512 + dc];
            LBT[idx] = (l == 0) ? 0.f : 1.f / (1.f + __expf(l0 - l1));
        }
        for (int idx = gtid; idx < NCTX * DM / 4; idx += ngt) ((f32x4*)(ws + WS_HC))[idx] = ((const f32x4*)ka->in[2])[idx];
        if (gtid < 2) {
            const int l = gtid; float s1 = 0.f, s2 = 0.f;
            for (int i = 0; i < 64; ++i) { s1 += ka->in[16][l * 64 + i] * ka->in[17][l * 64 + i]; s2 += ka->in[18][l * 64 + i] * ka->in[19][l * 64 + i]; }
            const float li = (l == 0) ? 0.2f : (0.8f - 0.6f * 0.7408182206817179f);
            LAMV[l * 2 + 0] = __expf(s1) - __expf(s2) + li; LAMV[l * 2 + 1] = 1.f - li;
        }
    }
    }
    GSYNC_CG();
    TS(0);

#pragma unroll 1
    for (int l = 0; l < 2; ++l) {
#ifdef REP_SYNC
#pragma unroll 1
        for (int rs_ = 0; rs_ < 10; ++rs_) { GSYNC(); }
#endif
#pragma unroll 1
        for (int f = 0; f < 2; ++f) {
            {   KA(); const bool first = (l == 0 && f == 0);
                const float* in_lat = first ? ka->in[0] : ka->out; const float* in_ctx = (const float*)(ws + WS_HC);
                norm_phase(in_lat, in_ctx, ka->in[f ? 8 : 6] + l * 1024, (const float*)(ws + WS_MOD) + (size_t)l * 3 * 9216, f ? 6 : 0, f ? 7 : 1, (bf16_t*)(ws + WS_XB), gw, ngw, lane,
                           (const float*)(ws + WS_O), first ? 0 : (f ? (l == 0 ? 4 : 0) : DFF / 256), (float*)(ws + WS_HC)); }
            GSYNC();
            TS(1);
            {   KA(); bf16_t* Wl = (bf16_t*)(ws + WS_WB) + (size_t)l * WL_TOTAL;
                const int Mr = (l == 1 && f == 1) ? NLAT : R;
                pg8::Gemm g{(bf16_t*)(ws + WS_XB), Wl + (f ? WL_UP2 : WL_UP1), Mr, 5632, 1024}; pg8::StaticOrder S; S.init(Mr, 5632, G, bid); EpiUp E{(bf16_t*)(ws + WS_Z)};
                pg8::gemm_phase<EpiUp, pg8::StaticOrder, true, true>(lds, g, S, E, tid); }
            GSYNC();
            TS(2);
            {   KA(); bf16_t* Wl = (bf16_t*)(ws + WS_WB) + (size_t)l * WL_TOTAL; const bool first = (l == 0 && f == 0);
                const float* in_lat = first ? ka->in[0] : ka->out;
                pg8::Gemm g{(bf16_t*)(ws + WS_Z), Wl + (f ? WL_DN2 : WL_DN1), NLAT, 1024, DFF}; pg8::StaticOrder S; S.init(NLAT, 1024, G, bid);
                EpiRes E{in_lat, (const float*)(ws + WS_HC), ka->out, (float*)(ws + WS_HC), (const float*)(ws + WS_MOD) + (size_t)l * 3 * 9216 + (f ? 8 : 2) * 1024, 0.5f};
                pg8::gemm_phase<EpiRes, pg8::StaticOrder, true, true>(lds, g, S, E, tid); }
            if (!(l == 1 && f == 1))
            {   KA(); bf16_t* Wl = (bf16_t*)(ws + WS_WB) + (size_t)l * WL_TOTAL;
                pg8::Gemm g{(bf16_t*)(ws + WS_Z) + (size_t)NLAT * DFF, Wl + (f ? WL_DN2 : WL_DN1), NCTX, 1024, 256, DFF}; SplitKOrder S; S.init(DFF / 256, 256, G, bid);
                EpiPart E{(float*)(ws + WS_O), (const float*)(ws + WS_MOD) + (size_t)l * 3 * 9216 + (f ? 8 : 2) * 1024, 0.5f};
                pg8::gemm_phase<EpiPart, SplitKOrder, true, true>(lds, g, S, E, tid); }
            GSYNC();
            TS(3);
            if (f == 1) break;
            {   KA();
                norm_phase(ka->out, (const float*)(ws + WS_HC), ka->in[7] + l * 1024, (const float*)(ws + WS_MOD) + (size_t)l * 3 * 9216, 3, 4, (bf16_t*)(ws + WS_XB), gw, ngw, lane,
                           (const float*)(ws + WS_O), DFF / 256, (float*)(ws + WS_HC)); }
            GSYNC();
            TS(1);
            {   KA(); bf16_t* Wl = (bf16_t*)(ws + WS_WB) + (size_t)l * WL_TOTAL;
                pg8::Gemm g{(bf16_t*)(ws + WS_XB), Wl + WL_IN, R, 3072, 1024}; pg8::StaticOrder S; S.init(R, 3072, G, bid);
                EpiWin E{ws + WS_Z, (const float*)(ws + WS_CS), (const float*)(ws + WS_LB) + l * 512, 0};
                pg8::gemm_phase<EpiWin, pg8::StaticOrder, true, true>(lds, g, S, E, tid); }
            GSYNC();
            TS(4);
            {   KA(); pool_phase((const bf16_t*)(ws + WS_Z + Z_ZP), (bf16_t*)(ws + WS_O + O_MX), gtid, ngt); }
#ifdef REP_ATTN
            for (int rep_ = 0; rep_ < 2; ++rep_)
#endif
            {   KA();
                const float* LAMV = (const float*)(ws + WS_LAM);
                const int nunits = 1024 + (l == 0 ? 16 : 0);
                for (int u = bid; u < nunits; u += G) {
                    int bh, qrow0, kt0, kt1;
                    if (u < 1024) { bh = u >> 7; qrow0 = (bh >> 2) * SEQ + (u & 127) * 128; kt0 = 0; kt1 = KEYS / 64; }
                    else { const int v = u - 1024; bh = v >> 1; qrow0 = NLAT + (bh >> 2) * CTXL + (v & 1) * 128; kt0 = SEQ / 64; kt1 = KEYS / 64; }
                    attn_unit(lds, (const bf16_t*)(ws + WS_Z + Z_Q), (const bf16_t*)(ws + WS_Z + Z_K), (const bf16_t*)(ws + WS_Z + Z_VT), (bf16_t*)(ws + WS_O + O_DA), ka->in[20] + l * 128,
                              bh >> 2, bh & 3, qrow0, kt0, kt1, LAMV[l * 2], LAMV[l * 2 + 1], tid, wave, lane);
                }
            }
            GSYNC();
            TS(5);
#ifdef REP_HG
#pragma unroll 1
            for (int rep_ = 0; rep_ < 2; ++rep_) {
#else
            {
#endif
            {   KA(); hg_passA_mfma(lds, (const float*)(ws + WS_Z + Z_FF), (const float*)(ws + WS_Z + Z_FB), (const bf16_t*)(ws + WS_Z + Z_HI),
                                      (float*)(ws + WS_CAR), (float*)(ws + WS_DK), wave, lane, G); }
            GSYNC();
            TS(6);
            {   KA(); hg_carry((float*)(ws + WS_CAR), (const float*)(ws + WS_DK), gtid, ngt); }
            GSYNC();
            TS(7);
            {   KA(); hg_passB_mfma(lds, (const float*)(ws + WS_Z + Z_HQ), (const float*)(ws + WS_Z + Z_FF), (const float*)(ws + WS_Z + Z_FB), (const bf16_t*)(ws + WS_Z + Z_HI),
                                      (const float*)(ws + WS_CAR), (bf16_t*)(ws + WS_Z + Z_K), wave, lane, G); }
            GSYNC();
            TS(8);
            {   KA(); hg_readout((const bf16_t*)(ws + WS_Z + Z_K), (const bf16_t*)(ws + WS_Z + Z_HG), ka->in[22] + l * 64, (bf16_t*)(ws + WS_O + O_HG), gw, ngw, lane); }
            GSYNC();
            TS(9);
            }
            {   KA(); bf16_t* Wl = (bf16_t*)(ws + WS_WB) + (size_t)l * WL_TOTAL;
                const int Mr = (l == 1) ? NLAT : R;
                pg8::Gemm g{(bf16_t*)(ws + WS_XB), Wl + WL_IN + (size_t)3072 * 1024, Mr, 3072, 1024}; pg8::StaticOrder S; S.init(Mr, 3072, G, bid); EpiG E{(bf16_t*)(ws + WS_Z)};
                pg8::gemm_phase<EpiG, pg8::StaticOrder, true, true>(lds, g, S, E, tid); }
            GSYNC();
            TS(10);
#pragma unroll 1
            for (int gi = 0; gi < 3; ++gi) {
                KA(); bf16_t* Wl = (bf16_t*)(ws + WS_WB) + (size_t)l * WL_TOTAL;
                const bf16_t* A = (const bf16_t*)(ws + WS_O + ((gi == 0) ? O_DA : (gi == 1 ? O_HG : O_MX))); const int K = (gi == 0) ? 512 : 256;
                const bf16_t* Bt = Wl + ((gi == 0) ? WL_PA : (gi == 1 ? WL_PH : WL_PP));
                const int Mr = (l == 1) ? NLAT : R;
                pg8::Gemm g{A, Bt, Mr, 1024, K}; pg8::StaticOrder S; S.init(Mr, 1024, G, bid); EpiProj E{(bf16_t*)(ws + WS_XB), (const bf16_t*)(ws + WS_Z), gi, gi == 0};
                pg8::gemm_phase<EpiProj, pg8::StaticOrder, true, true>(lds, g, S, E, tid);
            }
            GSYNC();
            TS(11);
            {   KA(); bf16_t* Wl = (bf16_t*)(ws + WS_WB) + (size_t)l * WL_TOTAL;
                pg8::Gemm g{(bf16_t*)(ws + WS_XB), Wl + WL_O, NLAT, 1024, 1024}; pg8::StaticOrder S; S.init(NLAT, 1024, G, bid);
                EpiRes E{ka->out, (const float*)(ws + WS_HC), ka->out, (float*)(ws + WS_HC), (const float*)(ws + WS_MOD) + (size_t)l * 3 * 9216 + 5 * 1024, 1.0f};
                pg8::gemm_phase<EpiRes, pg8::StaticOrder, true, true>(lds, g, S, E, tid); }
            if (l == 0)
            {   KA(); bf16_t* Wl = (bf16_t*)(ws + WS_WB) + (size_t)l * WL_TOTAL;
                pg8::Gemm g{(bf16_t*)(ws + WS_XB) + (size_t)NLAT * 1024, Wl + WL_O, NCTX, 1024, 256, 1024}; SplitKOrder S; S.init(4, 256, G, bid);
                EpiPart E{(float*)(ws + WS_O), (const float*)(ws + WS_MOD) + (size_t)l * 3 * 9216 + 5 * 1024, 1.0f};
                pg8::gemm_phase<EpiPart, SplitKOrder, true, true>(lds, g, S, E, tid); }
            GSYNC();
            TS(12);
        }
    }
    {   KA(); final_norm_phase(ka->out, ka->in[29], gw, ngw, lane); }
#ifdef PROBE_A
    GSYNC(); TS(1);
    if (blockIdx.x == 0) { KA(); const unsigned long long* tsb = (const unsigned long long*)(ws + WS_END);
        __syncthreads();
        const float va = (float)tsb[1 + PROBE_A] * 0.01f, vb = (float)tsb[1 + PROBE_B] * 0.01f;
        __syncthreads();
        if (tid == 0) ka->out[0] += va;
        for (int i = tid; i < 65536; i += NTHR) ka->out[(size_t)(i / 1024 + 8) * 1024 + (i & 1023)] += vb; }
#endif
}

extern "C" void kernel_launch(void* const* d_in, const int* in_sizes, int n_in, void* d_out, int out_size, void* d_ws, size_t ws_size, hipStream_t stream) {
    static int grid = 0;
    if (grid == 0) {
        if (n_in != 30 || out_size != NLAT * DM || ws_size < WS_TOTAL) { fprintf(stderr, "kernel_launch: unexpected shapes (n_in %d out %d ws %zu need %zu)\n", n_in, out_size, ws_size, (size_t)WS_TOTAL); grid = -1; return; }
        int dev = 0, cus = 0, per_cu = 0;
        (void)hipGetDevice(&dev);
        (void)hipDeviceGetAttribute(&cus, hipDeviceAttributeMultiprocessorCount, dev);
        if (hipFuncSetAttribute((const void*)fwd_kernel, hipFuncAttributeMaxDynamicSharedMemorySize, LDS_BYTES) != hipSuccess) { fprintf(stderr, "kernel_launch: hipFuncSetAttribute failed\n"); grid = -1; return; }
        if (hipOccupancyMaxActiveBlocksPerMultiprocessor(&per_cu, (const void*)fwd_kernel, NTHR, LDS_BYTES) != hipSuccess || per_cu < 1) { fprintf(stderr, "kernel_launch: occupancy query failed (%d)\n", per_cu); (void)hipGetLastError(); per_cu = 1; }
        if (per_cu > 1) per_cu = 1;
        grid = cus * per_cu;
    }
    if (grid < 0) return;
    if (hipMemsetAsync((unsigned char*)d_ws + WS_BAR, 0, (size_t)XCD_BAR_WORDS * 4, stream) != hipSuccess) { fprintf(stderr, "kernel_launch: memset failed\n"); return; }
    Args a{};
    for (int i = 0; i < 30; ++i) a.in[i] = (const float*)d_in[i];
    a.out = (float*)d_out; a.ws = (unsigned char*)d_ws;
    void* args[] = {&a};
    hipError_t e = hipLaunchCooperativeKernel((const void*)fwd_kernel, dim3(grid), dim3(NTHR), args, LDS_BYTES, stream);
    if (e != hipSuccess) fprintf(stderr, "cooperative launch failed: %s (grid %d)\n", hipGetErrorString(e), grid);
}
```

```cpp
#include <hip/hip_runtime.h>
#include <hip/hip_cooperative_groups.h>
#include <cstdio>
#include <cstdint>
namespace cg = cooperative_groups;
namespace pg8 {
#define PG8_LAS __attribute__((address_space(3)))
typedef unsigned short bf16_t;
typedef short bf16x8 __attribute__((ext_vector_type(8)));
typedef float f32x4 __attribute__((ext_vector_type(4)));
typedef unsigned u32x4 __attribute__((ext_vector_type(4)));
constexpr int BM = 256, BK = 64, HALF = 128, HTB = HALF * BK * 2  , STAGE_BYTES = 8 * HTB, NXCD = 8, WGM = 8;

__host__ __device__ __forceinline__ int lds_byte(int r, int c) { const int st = (r >> 4) * 2 + (c >> 5), rr = r & 15, cc = c & 31, ob = rr * 64 + cc * 2; return st * 1024 + (ob ^ (((ob >> 9) & 1) << 5)); }
__host__ __device__ __forceinline__ void stage_rc(int b, int& R, int& C) { const int st = b / 1024, sb = b % 1024, swz = sb ^ (((sb >> 9) & 1) << 5); R = (st >> 1) * 16 + swz / 64; C = (st & 1) * 32 + (swz % 64) / 2; }
__host__ __device__ __forceinline__ int perm32(int rho) { const int n = rho >> 4, i = rho & 15; return 8 * (i >> 2) + 4 * n + (i & 3); }

struct Unit { int pm, pn; int koff = 0; };
struct Gemm { const bf16_t* A; const bf16_t* Bt; int M, N, K; int ld = 0; };

struct StaticOrder {
    int nM, nN, nwg, G, c;
    __host__ __device__ void init(int M, int N, int G_, int c_) { nM = M / BM; nN = N / BM; nwg = nM * nN; G = G_; c = c_; }
    __host__ __device__ bool next(int i, Unit& u) const {
        const long L = (long)i * G + c; if (L >= nwg) return false;
        int wgid = (int)L; { const int q = nwg / NXCD, r = nwg % NXCD, xcd = wgid % NXCD, off = wgid / NXCD; wgid = (xcd < r ? xcd * (q + 1) : r * (q + 1) + (xcd - r) * q) + off; }
        const int nig = WGM * nN, gid = wgid / nig, fm = gid * WGM, gsz = (nM - fm) < WGM ? (nM - fm) : WGM;
        u.pm = fm + ((wgid % nig) % gsz); u.pn = (wgid % nig) / gsz; u.koff = 0; return true;
    }
    __device__ __forceinline__ void a_ready(const Unit&) const {}
    __device__ __forceinline__ void done(const Unit&) const {}
};

}
namespace pg8 {
template <class Epi, class Sched, bool ALIGN_EPI = false, bool SP2 = false>
__device__ __forceinline__ void gemm_phase(PG8_LAS unsigned char* lds, const Gemm g, const Sched& S, const Epi& E, int tid_in) {
    int tid_ = tid_in; asm volatile("" : "+v"(tid_)); const int tid = tid_, wid = __builtin_amdgcn_readfirstlane(tid >> 6), lane = tid & 63, wr = wid >> 2, wc = wid & 3, fr = lane & 15, fq = lane >> 4;
    const int K = g.ld ? g.ld : g.K, nt = g.K / BK;
    unsigned voffA[2], voffB[2];
#pragma unroll
    for (int i = 0; i < 2; ++i) { int R, C; stage_rc(tid * 16 + i * 8192, R, C); const int Rb = Epi::PERM ? ((R & ~31) + perm32(R & 31)) : R;
        voffA[i] = (unsigned)(R * K + C) * 2u; voffB[i] = (unsigned)(Rb * K + C) * 2u; }
    const size_t kstep = (size_t)(BK * 2);
    const size_t hstep = (size_t)HALF * K * 2;
    const size_t tstep = 2 * hstep;
    const unsigned ldsw = (unsigned)wid * 1024u;
    const int aoff = lds_byte(wr * 64 + fr, fq * 8), boff = lds_byte(wc * 32 + fr, fq * 8);
#define PG8_SA(b, h) (((b) * 2 + (h)) * HTB)
#define PG8_SB(b, h) ((4 + (b) * 2 + (h)) * HTB)
#define PG8_STAGE(bufoff, gbase, voff) do { _Pragma("unroll") for (int _i = 0; _i < 2; ++_i) \
        __builtin_amdgcn_global_load_lds((const unsigned*)((const char*)(gbase) + (voff)[_i]), (PG8_LAS unsigned*)(lds + (bufoff) + ldsw + _i * 8192), 16, 0, 0); } while (0)
#define PG8_LDA(dst, b, h) do { _Pragma("unroll") for (int m = 0; m < 4; ++m) _Pragma("unroll") for (int k = 0; k < 2; ++k) dst[m][k] = *(const PG8_LAS bf16x8*)(lds + PG8_SA(b, h) + aoff + m * 2048 + k * 1024); } while (0)
#define PG8_LDB(dst, b, h) do { _Pragma("unroll") for (int n = 0; n < 2; ++n) _Pragma("unroll") for (int k = 0; k < 2; ++k) dst[n][k] = *(const PG8_LAS bf16x8*)(lds + PG8_SB(b, h) + boff + n * 2048 + k * 1024); } while (0)
#define PG8_MMA(ai, bj, At, Bt) do { __builtin_amdgcn_s_setprio(1); _Pragma("unroll") for (int m = 0; m < 4; ++m) _Pragma("unroll") for (int n = 0; n < 2; ++n) _Pragma("unroll") for (int k = 0; k < 2; ++k) \
        acc[ai][bj][m][n] = __builtin_amdgcn_mfma_f32_16x16x32_bf16(Bt[n][k], At[m][k], acc[ai][bj][m][n], 0, 0, 0); __builtin_amdgcn_s_setprio(0); } while (0)
#define PG8_WAIT_V(n) asm volatile("s_waitcnt vmcnt(" #n ")" ::: "memory")
#define PG8_WAIT_L(n) asm volatile("s_waitcnt lgkmcnt(" #n ")" ::: "memory")
#define PG8_BAR __builtin_amdgcn_s_barrier()
#define PG8_SCHED __builtin_amdgcn_sched_barrier(0)
    Unit cur, nxt; int ui = 0;
    if (!S.next(0, cur)) return;
    f32x4 acc[2][2][4][2];
#pragma unroll
    for (int a = 0; a < 2; ++a)
#pragma unroll
        for (int b = 0; b < 2; ++b)
#pragma unroll
            for (int m = 0; m < 4; ++m)
#pragma unroll
                for (int n = 0; n < 2; ++n) acc[a][b][m][n] = (f32x4){0.f, 0.f, 0.f, 0.f};
    bf16x8 At[4][2], B0[2][2], B1[2][2];
    const char* cA = (const char*)g.A + (size_t)cur.pm * tstep + (size_t)cur.koff * 2; const char* cB = (const char*)g.Bt + (size_t)cur.pn * tstep + (size_t)cur.koff * 2;
    S.a_ready(cur);
    if constexpr (SP2) {
        PG8_STAGE(PG8_SB(0, 0), cB, voffB); PG8_STAGE(PG8_SB(0, 1), cB + hstep, voffB); PG8_STAGE(PG8_SA(0, 0), cA, voffA); PG8_STAGE(PG8_SA(0, 1), cA + hstep, voffA);
        if (wr == 1) PG8_BAR;
        PG8_WAIT_V(2); PG8_BAR;
        PG8_STAGE(PG8_SB(1, 0), cB + kstep, voffB); PG8_STAGE(PG8_SA(1, 0), cA + kstep, voffA); PG8_STAGE(PG8_SB(1, 1), cB + hstep + kstep, voffB);
        PG8_WAIT_V(6); PG8_BAR;
    } else {
        PG8_STAGE(PG8_SB(0, 0), cB, voffB); PG8_STAGE(PG8_SA(0, 0), cA, voffA); PG8_STAGE(PG8_SB(0, 1), cB + hstep, voffB); PG8_STAGE(PG8_SA(0, 1), cA + hstep, voffA);
        if (wr == 1) PG8_BAR;
        PG8_WAIT_V(4); PG8_BAR;
        PG8_STAGE(PG8_SB(1, 0), cB + kstep, voffB); PG8_STAGE(PG8_SA(1, 0), cA + kstep, voffA); PG8_STAGE(PG8_SB(1, 1), cB + hstep + kstep, voffB);
        PG8_WAIT_V(6); PG8_BAR;
    }
    for (;;) {
        const bool has_next = S.next(ui + 1, nxt);
        const char* nA = has_next ? (const char*)g.A + (size_t)nxt.pm * tstep + (size_t)nxt.koff * 2 : cA; const char* nB = has_next ? (const char*)g.Bt + (size_t)nxt.pn * tstep + (size_t)nxt.koff * 2 : cB;
        for (int t = 0; t < nt; t += 2) {
            const bool last = (t == nt - 2);
            const char* a1 = cA + (size_t)(t + 1) * kstep;
            const char* a2 = last ? nA : cA + (size_t)(t + 2) * kstep; const char* b2 = last ? nB : cB + (size_t)(t + 2) * kstep;
            const char* a3 = a2 + kstep; const char* b3 = b2 + kstep;
            if (last && has_next) S.a_ready(nxt);
            if constexpr (SP2) {
            PG8_LDB(B0, 0, 0); PG8_LDB(B1, 0, 1); PG8_SCHED; PG8_LDA(At, 0, 0); PG8_STAGE(PG8_SA(1, 1), a1 + hstep, voffA);
            PG8_WAIT_V(8); PG8_WAIT_L(0); PG8_BAR; PG8_MMA(0, 0, At, B0); PG8_MMA(0, 1, At, B1); PG8_BAR; PG8_SCHED;
            PG8_LDA(At, 0, 1); PG8_STAGE(PG8_SB(0, 0), b2, voffB); PG8_STAGE(PG8_SB(0, 1), b2 + hstep, voffB); PG8_STAGE(PG8_SA(0, 0), a2, voffA);
            PG8_WAIT_V(8); PG8_WAIT_L(0); PG8_BAR; PG8_MMA(1, 0, At, B0); PG8_MMA(1, 1, At, B1); PG8_BAR; PG8_SCHED;
            PG8_LDB(B0, 1, 0); PG8_LDB(B1, 1, 1); PG8_SCHED; PG8_LDA(At, 1, 0); PG8_STAGE(PG8_SA(0, 1), a2 + hstep, voffA);
            PG8_WAIT_V(8); PG8_WAIT_L(0); PG8_BAR; PG8_MMA(0, 0, At, B0); PG8_MMA(0, 1, At, B1); PG8_BAR; PG8_SCHED;
            PG8_LDA(At, 1, 1); PG8_STAGE(PG8_SB(1, 0), b3, voffB); PG8_STAGE(PG8_SB(1, 1), b3 + hstep, voffB); PG8_STAGE(PG8_SA(1, 0), a3, voffA);
            PG8_WAIT_V(8); PG8_WAIT_L(0); PG8_BAR; PG8_MMA(1, 0, At, B0); PG8_MMA(1, 1, At, B1); PG8_BAR; PG8_SCHED;
            } else {
            PG8_LDB(B0, 0, 0); PG8_SCHED; PG8_LDA(At, 0, 0); PG8_STAGE(PG8_SA(1, 1), a1 + hstep, voffA);
            PG8_WAIT_L(8); PG8_BAR; PG8_WAIT_L(0); PG8_MMA(0, 0, At, B0); PG8_BAR; PG8_SCHED;
            PG8_LDB(B1, 0, 1); PG8_STAGE(PG8_SB(0, 0), b2, voffB);
            PG8_BAR; PG8_WAIT_L(0); PG8_MMA(0, 1, At, B1); PG8_BAR;
            PG8_LDA(At, 0, 1); PG8_STAGE(PG8_SA(0, 0), a2, voffA);
            PG8_BAR; PG8_WAIT_L(0); PG8_MMA(1, 0, At, B0); PG8_BAR; PG8_SCHED;
            PG8_STAGE(PG8_SB(0, 1), b2 + hstep, voffB);
            PG8_WAIT_V(6); PG8_BAR; PG8_MMA(1, 1, At, B1); PG8_BAR;
            PG8_LDB(B0, 1, 0); PG8_SCHED; PG8_LDA(At, 1, 0); PG8_STAGE(PG8_SA(0, 1), a2 + hstep, voffA);
            PG8_WAIT_L(8); PG8_BAR; PG8_WAIT_L(0); PG8_MMA(0, 0, At, B0); PG8_BAR; PG8_SCHED;
            PG8_LDB(B1, 1, 1); PG8_STAGE(PG8_SB(1, 0), b3, voffB);
            PG8_BAR; PG8_WAIT_L(0); PG8_MMA(0, 1, At, B1); PG8_BAR;
            PG8_LDA(At, 1, 1); PG8_STAGE(PG8_SA(1, 0), a3, voffA);
            PG8_BAR; PG8_WAIT_L(0); PG8_MMA(1, 0, At, B0); PG8_BAR; PG8_SCHED;
            PG8_STAGE(PG8_SB(1, 1), b3 + hstep, voffB);
            PG8_WAIT_V(6); PG8_BAR; PG8_MMA(1, 1, At, B1); PG8_BAR;
            }
        }
        if constexpr (ALIGN_EPI) { if (wr == 0) PG8_BAR; }
        if constexpr (!Epi::AFTER_DRAIN) { E(acc, cur, wr, wc, fr, fq); S.done(cur); }
        if (!has_next) break;
#pragma unroll
        for (int a = 0; a < 2; ++a)
#pragma unroll
            for (int b = 0; b < 2; ++b)
#pragma unroll
                for (int m = 0; m < 4; ++m)
#pragma unroll
                    for (int n = 0; n < 2; ++n) acc[a][b][m][n] = (f32x4){0.f, 0.f, 0.f, 0.f};
        cur = nxt; cA = nA; cB = nB; ++ui;
        if constexpr (ALIGN_EPI) { if (wr == 1) PG8_BAR; }
    }
    PG8_WAIT_V(0);
    if constexpr (!ALIGN_EPI) { if (wr == 0) PG8_BAR; }
    PG8_BAR;
    if constexpr (Epi::AFTER_DRAIN) { E.fused(acc, cur, wr, wc, fr, fq, lds, wid, lane); S.done(cur); }
#undef PG8_SA
#undef PG8_SB
#undef PG8_STAGE
#undef PG8_LDA
#undef PG8_LDB
#undef PG8_MMA
#undef PG8_WAIT_V
#undef PG8_WAIT_L
#undef PG8_BAR
#undef PG8_SCHED
}
}

using pg8::bf16_t; using pg8::bf16x8; using pg8::f32x4; using pg8::u32x4; using pg8::Unit;
typedef float f32x16 __attribute__((ext_vector_type(16)));
typedef float f32x2v __attribute__((ext_vector_type(2)));
typedef __bf16 bf16x2v __attribute__((ext_vector_type(2)));
typedef unsigned u32x2 __attribute__((ext_vector_type(2)));
#define LAS __attribute__((address_space(3)))

constexpr int DM = 1024, NBATCH = 2, SEQ = 16384, CTXL = 256;
constexpr int NLAT = NBATCH * SEQ, NCTX = NBATCH * CTXL, R = NLAT + NCTX;
constexpr int DFF = 2816, KEYS = SEQ + CTXL;
constexpr float EPS = 1e-6f;
constexpr float C2 = 0.125f * 1.4426950408889634f;
constexpr int NTHR = 512;
constexpr int LDS_BYTES = 135168;
constexpr int HG_SEG = 128, HG_STEPS = KEYS / HG_SEG;

constexpr size_t WL_UP1 = 0, WL_DN1 = WL_UP1 + (size_t)5632 * 1024, WL_UP2 = WL_DN1 + (size_t)1024 * 2816, WL_DN2 = WL_UP2 + (size_t)5632 * 1024,
                 WL_IN = WL_DN2 + (size_t)1024 * 2816, WL_PA = WL_IN + (size_t)6144 * 1024, WL_PH = WL_PA + (size_t)1024 * 512, WL_PP = WL_PH + (size_t)1024 * 256,
                 WL_O = WL_PP + (size_t)1024 * 256, WL_TOTAL = WL_O + (size_t)1024 * 1024;
constexpr size_t WS_WB = 0;
constexpr size_t WS_XB = WS_WB + 2 * WL_TOTAL * 2;
constexpr size_t WS_Z = WS_XB + (size_t)R * 1024 * 2;
constexpr size_t Z_VT = 0, Z_HQ = Z_VT + (size_t)R * 512 * 2, Z_FF = Z_HQ + (size_t)R * 256 * 4, Z_FB = Z_FF + (size_t)R * 256 * 4, Z_HI = Z_FB + (size_t)R * 256 * 4,
                 Z_ZP = Z_HI + (size_t)R * 256 * 2, Z_Q = Z_ZP + (size_t)R * 256 * 2, Z_K = Z_Q + (size_t)R * 512 * 2, Z_HG = Z_K + (size_t)R * 512 * 2, Z_END = Z_HG + (size_t)R * 256 * 2;
static_assert((size_t)R * 3072 * 2 <= Z_K, "gate buffer must not reach k / odir / hgate");
static_assert((size_t)R * DFF * 2 <= Z_END, "act fits Z");
constexpr size_t WS_O = WS_Z + Z_END;
constexpr size_t O_DA = 0, O_HG = O_DA + (size_t)R * 512 * 2, O_MX = O_HG + (size_t)R * 256 * 2, O_END = O_MX + (size_t)R * 256 * 2;
constexpr size_t WS_CAR = WS_O + O_END;
constexpr size_t WS_DK = WS_CAR + (size_t)16 * HG_SEG * 4096 * 4;
constexpr size_t WS_HC = WS_DK + (size_t)16 * HG_SEG * 64 * 4;
constexpr size_t WS_MOD = WS_HC + (size_t)NCTX * 1024 * 4;
constexpr size_t WS_CS = WS_MOD + (size_t)2 * 3 * 9216 * 4;
constexpr size_t WS_LB = WS_CS + (size_t)256 * 32 * 4;
constexpr size_t WS_LAM = WS_LB + (size_t)2 * 2 * 256 * 4;
constexpr size_t WS_END = WS_LAM + 256;
static_assert(WS_END <= (size_t)512 * 1024 * 1024, "workspace");

__device__ __forceinline__ unsigned pk2(float lo, float hi) { f32x2v v = {lo, hi}; bf16x2v b = __builtin_convertvector(v, bf16x2v); return __builtin_bit_cast(unsigned, b); }
__device__ __forceinline__ float bf2f(unsigned short u) { return __builtin_bit_cast(float, (unsigned)u << 16); }
__device__ __forceinline__ float bflo(unsigned u) { return __builtin_bit_cast(float, u << 16); }
__device__ __forceinline__ float bfhi(unsigned u) { return __builtin_bit_cast(float, u & 0xffff0000u); }
__device__ __forceinline__ float ex2(float x) { return __builtin_amdgcn_exp2f(x); }
__device__ __forceinline__ float rcpf_(float x) { return __builtin_amdgcn_rcpf(x); }
__device__ __forceinline__ float sigm(float x) { return rcpf_(1.f + ex2(-1.4426950408889634f * x)); }
__device__ __forceinline__ float siluf(float x) { return x * sigm(x); }
__device__ __forceinline__ float shx(float v, int o, int lane) { return __builtin_bit_cast(float, __builtin_amdgcn_ds_bpermute((lane ^ o) << 2, __builtin_bit_cast(int, v))); }
__device__ __forceinline__ float swap32(float v) { auto rr = __builtin_amdgcn_permlane32_swap(__builtin_bit_cast(unsigned, v), __builtin_bit_cast(unsigned, v), false, false);
    const float a = __builtin_bit_cast(float, rr[0]), b = __builtin_bit_cast(float, rr[1]); return (a == v) ? b : a; }
__device__ __forceinline__ float wave_sum(float v, int lane) {
#pragma unroll
    for (int o = 1; o < 64; o <<= 1) v += shx(v, o, lane);
    return v;
}
#define LDS_WAIT() asm volatile("s_waitcnt lgkmcnt(0)" ::: "memory")

struct EpiUp {
    static constexpr bool PERM = true, AFTER_DRAIN = false;
    bf16_t* act;
    __device__ __forceinline__ void operator()(const f32x4 (&acc)[2][2][4][2], const Unit& u, int wr, int wc, int fr, int fq) const {
        const int row0 = u.pm * 256 + wr * 64 + fr, col0 = u.pn * 128 + wc * 32 + 8 * fq;
#pragma unroll
        for (int ai = 0; ai < 2; ++ai)
#pragma unroll
            for (int m = 0; m < 4; ++m) {
                const int row = row0 + ai * 128 + m * 16;
                const f32x4 a0 = acc[ai][0][m][0], a1 = acc[ai][0][m][1], b0 = acc[ai][1][m][0], b1 = acc[ai][1][m][1];
                u32x4 w;
                w.x = pk2(siluf(a0[0]) * b0[0], siluf(a0[1]) * b0[1]); w.y = pk2(siluf(a0[2]) * b0[2], siluf(a0[3]) * b0[3]);
                w.z = pk2(siluf(a1[0]) * b1[0], siluf(a1[1]) * b1[1]); w.w = pk2(siluf(a1[2]) * b1[2], siluf(a1[3]) * b1[3]);
                *(u32x4*)(act + (size_t)row * DFF + col0) = w;
            }
    }
};
struct EpiRes {
    static constexpr bool PERM = true, AFTER_DRAIN = false;
    const float* in_lat; const float* in_ctx; float* out_lat; float* out_ctx; const float* gate; float coef;
    __device__ __forceinline__ void operator()(const f32x4 (&acc)[2][2][4][2], const Unit& u, int wr, int wc, int fr, int fq) const {
        const int row0 = u.pm * 256 + wr * 64 + fr, col0 = u.pn * 256 + wc * 32 + 8 * fq;
        const int seg = (u.pm < 64) ? 0 : (u.pm < 128 ? 1 : 2);
        f32x4 gv[2][2];
#pragma unroll
        for (int bj = 0; bj < 2; ++bj)
#pragma unroll
            for (int n = 0; n < 2; ++n) gv[bj][n] = *(const f32x4*)(gate + seg * 9216 + col0 + bj * 128 + 4 * n) * coef;
#pragma unroll
        for (int ai = 0; ai < 2; ++ai)
#pragma unroll
            for (int m = 0; m < 4; ++m) {
                const int row = row0 + ai * 128 + m * 16;
                const float* ip; float* op;
                if (row < NLAT) { ip = in_lat + (size_t)row * DM; op = out_lat + (size_t)row * DM; }
                else { ip = in_ctx + (size_t)(row - NLAT) * DM; op = out_ctx + (size_t)(row - NLAT) * DM; }
#pragma unroll
                for (int bj = 0; bj < 2; ++bj)
#pragma unroll
                    for (int n = 0; n < 2; ++n) {
                        const int c = col0 + bj * 128 + 4 * n;
                        f32x4 v = *(const f32x4*)(ip + c);
                        v = v + gv[bj][n] * acc[ai][bj][m][n];
                        *(f32x4*)(op + c) = v;
                    }
            }
    }
};
struct SplitKOrder {
    int nunits, G, c, kc;
    __device__ void init(int nparts, int kc_, int G_, int c_) { nunits = nparts * 8; G = G_; c = c_; kc = kc_; }
    __device__ bool next(int i, Unit& u) const {
        const int L = i * G + c; if (L >= nunits) return false;
        const int part = L >> 3, r = L & 7; u.pm = r >> 2; u.pn = r & 3; u.koff = part * kc; return true;
    }
    __device__ __forceinline__ void a_ready(const Unit&) const {}
    __device__ __forceinline__ void done(const Unit&) const {}
};
struct EpiPart {
    static constexpr bool PERM = true, AFTER_DRAIN = false;
    float* P; const float* gate; float coef;
    __device__ __forceinline__ void operator()(const f32x4 (&acc)[2][2][4][2], const Unit& u, int wr, int wc, int fr, int fq) const {
        unsigned z_ = 0u; asm volatile("" : "+s"(z_));
        const int lane_ = (int)__builtin_amdgcn_mbcnt_hi(~0u, __builtin_amdgcn_mbcnt_lo(~0u, z_)), fr_ = lane_ & 15, fq_ = lane_ >> 4;
        const int row0 = u.pm * 256 + wr * 64 + fr_, col0 = u.pn * 256 + wc * 32 + 8 * fq_;
        float* Pp = P + (size_t)(u.koff >> 8) * NCTX * DM;
        f32x4 gv[2][2];
#pragma unroll
        for (int bj = 0; bj < 2; ++bj)
#pragma unroll
            for (int n = 0; n < 2; ++n) gv[bj][n] = *(const f32x4*)(gate + 2 * 9216 + col0 + bj * 128 + 4 * n) * coef;
#pragma unroll
        for (int ai = 0; ai < 2; ++ai)
#pragma unroll
            for (int m = 0; m < 4; ++m) {
                float* op = Pp + (size_t)(row0 + ai * 128 + m * 16) * DM;
#pragma unroll
                for (int bj = 0; bj < 2; ++bj)
#pragma unroll
                    for (int n = 0; n < 2; ++n) *(f32x4*)(op + col0 + bj * 128 + 4 * n) = gv[bj][n] * acc[ai][bj][m][n];
            }
    }
};
struct EpiWin {
    static constexpr bool PERM = true, AFTER_DRAIN = false;
    unsigned char* Z; const float* cs; const float* lb; int pn_off;
    __device__ __forceinline__ void operator()(const f32x4 (&acc)[2][2][4][2], const Unit& u, int wr, int wc, int fr, int fq) const {
        const int t = u.pn + pn_off;
        const int row0 = u.pm * 256 + wr * 64 + fr, cin = wc * 32 + 8 * fq;
        if (t < 4) {
            bf16_t* dst = (bf16_t*)(Z + ((t < 2) ? Z_Q : Z_K)); const float sc = (t < 2) ? C2 : 1.f; const int cb = (t & 1) * 256;
#pragma unroll
            for (int ai = 0; ai < 2; ++ai)
#pragma unroll
                for (int m = 0; m < 4; ++m) {
                    const int row = row0 + ai * 128 + m * 16;
                    f32x4 cv = {1.f, 1.f, 1.f, 1.f}, sv = {0.f, 0.f, 0.f, 0.f};
                    if (row < NLAT) { const int ts = row & (SEQ - 1); const int pos = (wc & 1) ? (ts & 63) : (ts >> 6);
                        cv = *(const f32x4*)(cs + pos * 32 + 4 * fq); sv = *(const f32x4*)(cs + pos * 32 + 16 + 4 * fq); }
#pragma unroll
                    for (int bj = 0; bj < 2; ++bj) {
                        const f32x4 x1 = acc[ai][bj][m][0], x2 = acc[ai][bj][m][1];
                        const f32x4 o1 = (x1 * cv - x2 * sv) * sc, o2 = (x1 * sv + x2 * cv) * sc;
                        u32x4 w; w.x = pk2(o1[0], o1[1]); w.y = pk2(o1[2], o1[3]); w.z = pk2(o2[0], o2[1]); w.w = pk2(o2[2], o2[3]);
                        *(u32x4*)(dst + (size_t)row * 512 + cb + bj * 128 + cin) = w;
                    }
                }
        } else if (t < 6) {
            bf16_t* vT = (bf16_t*)(Z + Z_VT);
#pragma unroll
            for (int ai = 0; ai < 2; ++ai)
#pragma unroll
                for (int m = 0; m < 4; ++m) {
                    const int row = row0 + ai * 128 + m * 16;
                    int b, key;
                    if (row < NLAT) { b = row >> 14; key = row & (SEQ - 1); } else { b = (row - NLAT) >> 8; key = SEQ + ((row - NLAT) & (CTXL - 1)); }
                    key = (key & ~15) + (key & 3) + ((key >> 3) & 1) * 4 + ((key >> 2) & 1) * 8;
#pragma unroll
                    for (int bj = 0; bj < 2; ++bj) {
                        bf16_t* dp = vT + (size_t)(b * 512 + (t - 4) * 256 + bj * 128 + cin) * KEYS + key;
#pragma unroll
                        for (int n = 0; n < 2; ++n)
#pragma unroll
                            for (int i = 0; i < 4; i += 2) {
                                const unsigned w = pk2(acc[ai][bj][m][n][i], acc[ai][bj][m][n][i + 1]);
                                dp[(size_t)(4 * n + i) * KEYS] = (bf16_t)(w & 0xffffu); dp[(size_t)(4 * n + i + 1) * KEYS] = (bf16_t)(w >> 16);
                            }
                    }
                }
        } else if (t <= 8) {
            float* dst = (float*)(Z + ((t == 6) ? Z_HQ : (t == 7 ? Z_FF : Z_FB)));
            const float* lbp = lb + ((t == 8) ? 256 : 0);
#pragma unroll
            for (int bj = 0; bj < 2; ++bj)
#pragma unroll
                for (int n = 0; n < 2; ++n) {
                    f32x4 lbv = *(const f32x4*)(lbp + bj * 128 + cin + 4 * n);
                    f32x4 om = 1.f - lbv;
#pragma unroll
                    for (int ai = 0; ai < 2; ++ai)
#pragma unroll
                        for (int m = 0; m < 4; ++m) {
                            const int row = row0 + ai * 128 + m * 16;
                            const f32x4 z = acc[ai][bj][m][n];
                            f32x4 sg; sg[0] = sigm(z[0]); sg[1] = sigm(z[1]); sg[2] = sigm(z[2]); sg[3] = sigm(z[3]);
                            const f32x4 o = (t == 6) ? z * sg : lbv + om * sg;
                            *(f32x4*)(dst + (size_t)row * 256 + bj * 128 + cin + 4 * n) = o;
                        }
                }
        } else {
            bf16_t* dst = (bf16_t*)(Z + ((t == 9) ? Z_HI : (t == 10 ? Z_HG : Z_ZP)));
#pragma unroll
            for (int ai = 0; ai < 2; ++ai)
#pragma unroll
                for (int m = 0; m < 4; ++m) {
                    const int row = row0 + ai * 128 + m * 16;
#pragma unroll
                    for (int bj = 0; bj < 2; ++bj) {
                        f32x4 v0 = acc[ai][bj][m][0], v1 = acc[ai][bj][m][1];
                        if (t == 10) { v0[0] = siluf(v0[0]); v0[1] = siluf(v0[1]); v0[2] = siluf(v0[2]); v0[3] = siluf(v0[3]); v1[0] = siluf(v1[0]); v1[1] = siluf(v1[1]); v1[2] = siluf(v1[2]); v1[3] = siluf(v1[3]); }
                        u32x4 w; w.x = pk2(v0[0], v0[1]); w.y = pk2(v0[2], v0[3]); w.z = pk2(v1[0], v1[1]); w.w = pk2(v1[2], v1[3]);
                        *(u32x4*)(dst + (size_t)row * 256 + bj * 128 + cin) = w;
                    }
                }
        }
    }
};
struct EpiVT {
    static constexpr bool PERM = true, AFTER_DRAIN = false;
    bf16_t* vT;
    __device__ __forceinline__ void operator()(const f32x4 (&acc)[2][2][4][2], const Unit& u, int wr, int wc, int fr, int fq) const {
        const int e0 = u.pm * 256 + wr * 64 + fr;
        int b, key0;
        if (u.pn < 64) { b = 0; key0 = u.pn * 256; } else if (u.pn < 128) { b = 1; key0 = (u.pn - 64) * 256; } else { b = u.pn - 128; key0 = SEQ; }
        const int kc = key0 + wc * 32 + 8 * fq;
#pragma unroll
        for (int ai = 0; ai < 2; ++ai)
#pragma unroll
            for (int m = 0; m < 4; ++m) {
                const int e = e0 + ai * 128 + m * 16;
#pragma unroll
                for (int bj = 0; bj < 2; ++bj) {
                    const f32x4 v0 = acc[ai][bj][m][0], v1 = acc[ai][bj][m][1];
                    u32x4 w; w.x = pk2(v0[0], v0[1]); w.y = pk2(v0[2], v0[3]); w.z = pk2(v1[0], v1[1]); w.w = pk2(v1[2], v1[3]);
                    *(u32x4*)(vT + (size_t)(b * 512 + e) * KEYS + kc + bj * 128) = w;
                }
            }
    }
};
struct EpiG {
    static constexpr bool PERM = true, AFTER_DRAIN = false;
    bf16_t* G;
    __device__ __forceinline__ void operator()(const f32x4 (&acc)[2][2][4][2], const Unit& u, int wr, int wc, int fr, int fq) const {
        const int row0 = u.pm * 256 + wr * 64 + fr, col0 = u.pn * 256 + wc * 32 + 8 * fq;
#pragma unroll
        for (int ai = 0; ai < 2; ++ai)
#pragma unroll
            for (int m = 0; m < 4; ++m) {
                const int row = row0 + ai * 128 + m * 16;
#pragma unroll
                for (int bj = 0; bj < 2; ++bj) {
                    const f32x4 v0 = acc[ai][bj][m][0], v1 = acc[ai][bj][m][1];
                    u32x4 w; w.x = pk2(sigm(v0[0]), sigm(v0[1])); w.y = pk2(sigm(v0[2]), sigm(v0[3])); w.z = pk2(sigm(v1[0]), sigm(v1[1])); w.w = pk2(sigm(v1[2]), sigm(v1[3]));
                    *(u32x4*)(G + (size_t)row * 3072 + col0 + bj * 128) = w;
                }
            }
    }
};
struct EpiProj {
    static constexpr bool PERM = true, AFTER_DRAIN = false;
    bf16_t* y; const bf16_t* G; int gi; int first;
    __device__ __forceinline__ void operator()(const f32x4 (&acc)[2][2][4][2], const Unit& u, int wr, int wc, int fr, int fq) const {
        const int row0 = u.pm * 256 + wr * 64 + fr, col0 = u.pn * 256 + wc * 32 + 8 * fq;
#pragma unroll
        for (int ai = 0; ai < 2; ++ai)
#pragma unroll
            for (int m = 0; m < 4; ++m) {
                const int row = row0 + ai * 128 + m * 16;
#pragma unroll
                for (int bj = 0; bj < 2; ++bj) {
                    const int c = col0 + bj * 128;
                    const u32x4 g = *(const u32x4*)(G + (size_t)row * 3072 + gi * 1024 + c);
                    u32x4 yo = {0u, 0u, 0u, 0u};
                    if (!first) yo = *(const u32x4*)(y + (size_t)row * 1024 + c);
                    const f32x4 v0 = acc[ai][bj][m][0], v1 = acc[ai][bj][m][1];
                    u32x4 w;
                    w.x = pk2(bflo(yo.x) + bflo(g.x) * v0[0], bfhi(yo.x) + bfhi(g.x) * v0[1]);
                    w.y = pk2(bflo(yo.y) + bflo(g.y) * v0[2], bfhi(yo.y) + bfhi(g.y) * v0[3]);
                    w.z = pk2(bflo(yo.z) + bflo(g.z) * v1[0], bfhi(yo.z) + bfhi(g.z) * v1[1]);
                    w.w = pk2(bflo(yo.w) + bflo(g.w) * v1[2], bfhi(yo.w) + bfhi(g.w) * v1[3]);
                    *(u32x4*)(y + (size_t)row * 1024 + c) = w;
                }
            }
    }
};

__device__ __forceinline__ int map_row(int mode, int n) {
    if (mode == 1) return 256 * (n >> 7) + (n & 127);
    if (mode == 2) return 256 * (n >> 7) + 128 + (n & 127);
    if (mode == 3) return (n < 1024) ? ((n & ~31) + 8 * ((n & 15) >> 2) + 4 * ((n >> 4) & 1) + (n & 3)) : n;
    return n;
}
__device__ __forceinline__ void transpose_item(const float* W, int K, int N, bf16_t* WT, int mode, LAS float* scr, int item, int lane) {
    const int nblk = N / 32, kb = item / nblk, nb = item % nblk, k0 = 64 * kb, n0 = 32 * nb;
#pragma unroll 8
    for (int i = 0; i < 32; ++i) { const int kk = 2 * i + (lane >> 5); scr[kk * 33 + (lane & 31)] = W[(size_t)(k0 + kk) * N + n0 + (lane & 31)]; }
    LDS_WAIT(); asm volatile("" ::: "memory");
    const int c = lane & 7;
#pragma unroll
    for (int j = 0; j < 4; ++j) { const int n = (lane >> 3) + 8 * j; const LAS float* s = scr + (8 * c) * 33 + n;
        u32x4 o; o.x = pk2(s[0 * 33], s[1 * 33]); o.y = pk2(s[2 * 33], s[3 * 33]); o.z = pk2(s[4 * 33], s[5 * 33]); o.w = pk2(s[6 * 33], s[7 * 33]);
        *(u32x4*)(WT + (size_t)map_row(mode, n0 + n) * K + k0 + 8 * c) = o; }
    LDS_WAIT(); asm volatile("" ::: "memory");
}

__device__ __forceinline__ void norm_phase(const float* in_lat, const float* in_ctx, const float* gain, const float* modl, int shi, int sci, bf16_t* outp, int gw, int ngw, int lane,
                                           const float* part, int nparts, float* hc_out) {
    f32x4 gv[4];
#pragma unroll
    for (int j = 0; j < 4; ++j) gv[j] = *(const f32x4*)(gain + 4 * lane + 256 * j);
    for (int row = gw; row < R; row += ngw) {
        const float* ip = (row < NLAT) ? in_lat + (size_t)row * DM : in_ctx + (size_t)(row - NLAT) * DM;
        const int seg = (row < SEQ) ? 0 : (row < NLAT ? 1 : 2);
        const float* sh = modl + seg * 9216 + shi * 1024; const float* sc = modl + seg * 9216 + sci * 1024;
        f32x4 v[4]; float ss = 0.f;
#pragma unroll
        for (int j = 0; j < 4; ++j) v[j] = *(const f32x4*)(ip + 4 * lane + 256 * j);
        if (row >= NLAT && nparts > 0) {
            for (int p = 0; p < nparts; ++p) {
                const float* pp = part + ((size_t)p * NCTX + (row - NLAT)) * DM;
#pragma unroll
                for (int j = 0; j < 4; ++j) v[j] = v[j] + *(const f32x4*)(pp + 4 * lane + 256 * j);
            }
#pragma unroll
            for (int j = 0; j < 4; ++j) *(f32x4*)(hc_out + (size_t)(row - NLAT) * DM + 4 * lane + 256 * j) = v[j];
        }
#pragma unroll
        for (int j = 0; j < 4; ++j) ss += (v[j][0] * v[j][0] + v[j][1] * v[j][1]) + (v[j][2] * v[j][2] + v[j][3] * v[j][3]);
        ss = wave_sum(ss, lane);
        const float rstd = 1.0f / sqrtf(ss * (1.f / DM) + EPS);
#pragma unroll
        for (int j = 0; j < 4; ++j) {
            const f32x4 s4 = *(const f32x4*)(sc + 4 * lane + 256 * j), h4 = *(const f32x4*)(sh + 4 * lane + 256 * j);
            const f32x4 y = v[j] * rstd * gv[j] * (s4 + 1.f) + h4;
            u32x2 w; w.x = pk2(y[0], y[1]); w.y = pk2(y[2], y[3]);
            *(u32x2*)(outp + (size_t)row * DM + 4 * lane + 256 * j) = w;
        }
    }
}
__device__ __forceinline__ void final_norm_phase(float* out, const float* gain, int gw, int ngw, int lane) {
    f32x4 gv[4];
#pragma unroll
    for (int j = 0; j < 4; ++j) gv[j] = *(const f32x4*)(gain + 4 * lane + 256 * j);
    for (int row = gw; row < NLAT; row += ngw) {
        float* ip = out + (size_t)row * DM;
        f32x4 v[4]; float ss = 0.f;
#pragma unroll
        for (int j = 0; j < 4; ++j) { v[j] = *(const f32x4*)(ip + 4 * lane + 256 * j); ss += (v[j][0] * v[j][0] + v[j][1] * v[j][1]) + (v[j][2] * v[j][2] + v[j][3] * v[j][3]); }
        ss = wave_sum(ss, lane);
        const float rstd = 1.0f / sqrtf(ss * (1.f / DM) + EPS);
#pragma unroll
        for (int j = 0; j < 4; ++j) *(f32x4*)(ip + 4 * lane + 256 * j) = v[j] * rstd * gv[j];
    }
}
__device__ __forceinline__ void pool_phase(const bf16_t* zp, bf16_t* mx, int gtid, int ngt) {
    for (int it = gtid; it < R * 32; it += ngt) {
        const int row = it >> 5, ch = (it & 31) * 8, g = ch >> 6, hw = 1 << g;
        int base, n;
        if (row < NLAT) { base = row & ~(SEQ - 1); n = SEQ; } else { base = NLAT + ((row - NLAT) & ~(CTXL - 1)); n = CTXL; }
        const int t = row - base, lo = (t - hw > 0) ? t - hw : 0, hi = (t + hw < n) ? t + hw : n;
        float s[8];
#pragma unroll
        for (int i = 0; i < 8; ++i) s[i] = 0.f;
        for (int j = lo; j < hi; ++j) {
            const u32x4 v = *(const u32x4*)(zp + (size_t)(base + j) * 256 + ch);
            s[0] += bflo(v.x); s[1] += bfhi(v.x); s[2] += bflo(v.y); s[3] += bfhi(v.y); s[4] += bflo(v.z); s[5] += bfhi(v.z); s[6] += bflo(v.w); s[7] += bfhi(v.w);
        }
        const float inv = 1.f / (float)(hi - lo);
        const u32x4 c = *(const u32x4*)(zp + (size_t)row * 256 + ch);
        u32x4 w;
        w.x = pk2(s[0] * inv - bflo(c.x), s[1] * inv - bfhi(c.x)); w.y = pk2(s[2] * inv - bflo(c.y), s[3] * inv - bfhi(c.y));
        w.z = pk2(s[4] * inv - bflo(c.z), s[5] * inv - bfhi(c.z)); w.w = pk2(s[6] * inv - bflo(c.w), s[7] * inv - bfhi(c.w));
        *(u32x4*)(mx + (size_t)row * 256 + ch) = w;
    }
}

__device__ __forceinline__ int hg_row(int dir, int b, int step) {
    if (step < CTXL) { const int t = dir ? (CTXL - 1 - step) : step; return NLAT + b * CTXL + t; }
    int t = step - CTXL; if (dir) t = SEQ - 1 - t; return b * SEQ + t;
}
template <bool OUT>
__device__ __forceinline__ void hg_pass(const float* hq, const float* ff, const float* fb, const bf16_t* hi, float* carry, float* dk, bf16_t* odir, int wave, int lane, int G) {
    for (int item = blockIdx.x + G * wave; item < 16 * HG_SEG; item += G * 8) {
        const int s = item / HG_SEG, j = item % HG_SEG, dir = s >> 3, b = (s >> 2) & 1, h = s & 3;
        const float* fbase = dir ? fb : ff;
        f32x2v S[32];
#pragma unroll
        for (int k = 0; k < 32; ++k) { S[k][0] = OUT ? carry[((size_t)item * 64 + 2 * k) * 64 + lane] : 0.f; S[k][1] = OUT ? carry[((size_t)item * 64 + 2 * k + 1) * 64 + lane] : 0.f; }
        float dl = 1.f;
        const int st0 = j * HG_STEPS, st1 = st0 + HG_STEPS;
        constexpr int HG_PF = 8;
        float ivb[HG_PF], fvb[HG_PF], qvb[HG_PF];
#pragma unroll
        for (int u = 0; u < HG_PF; ++u) {
            const int stl = (st0 + u < st1) ? st0 + u : st1 - 1;
            const size_t off = (size_t)hg_row(dir, b, stl) * 256 + h * 64 + lane;
            ivb[u] = bf2f(hi[off]); fvb[u] = fbase[off]; qvb[u] = OUT ? hq[off] : 0.f;
        }
        for (int sb = st0; sb < st1; sb += HG_PF) {
#pragma unroll
            for (int u = 0; u < HG_PF; ++u) {
                const int st = sb + u;
                if (st < st1) {
                    const float iv = ivb[u], fv = fvb[u], qv = qvb[u];
                    const size_t offc = (size_t)hg_row(dir, b, st) * 256 + h * 64 + lane;
                    { const int stn = (st + HG_PF < st1) ? st + HG_PF : st1 - 1;
                      const size_t off = (size_t)hg_row(dir, b, stn) * 256 + h * 64 + lane;
                      ivb[u] = bf2f(hi[off]); fvb[u] = fbase[off]; if (OUT) qvb[u] = hq[off]; }
                    if (!OUT) dl *= fv;
                    f32x2v o2 = {0.f, 0.f};
                    const f32x2v iv2 = {iv, iv};
                    const int fvi = __builtin_bit_cast(int, fv), qvi = __builtin_bit_cast(int, qv);
#pragma unroll
                    for (int k = 0; k < 32; ++k) {
                        f32x2v f2; f2[0] = __builtin_bit_cast(float, __builtin_amdgcn_readlane(fvi, 2 * k)); f2[1] = __builtin_bit_cast(float, __builtin_amdgcn_readlane(fvi, 2 * k + 1));
                        const f32x2v d2 = S[k] - iv2;
                        S[k] = __builtin_elementwise_fma(f2, d2, iv2);
                        if (OUT) { f32x2v q2; q2[0] = __builtin_bit_cast(float, __builtin_amdgcn_readlane(qvi, 2 * k)); q2[1] = __builtin_bit_cast(float, __builtin_amdgcn_readlane(qvi, 2 * k + 1));
                            o2 = __builtin_elementwise_fma(q2, S[k], o2); }
                    }
                    if (OUT) odir[(size_t)dir * R * 256 + offc] = (bf16_t)(pk2(o2[0] + o2[1], 0.f) & 0xffffu);
                }
            }
        }
        if (!OUT) {
#pragma unroll
            for (int k = 0; k < 32; ++k) { carry[((size_t)item * 64 + 2 * k) * 64 + lane] = S[k][0]; carry[((size_t)item * 64 + 2 * k + 1) * 64 + lane] = S[k][1]; }
            dk[item * 64 + lane] = dl;
        }
    }
}
constexpr int HGA_T = 48, HGA_STR = 112, HGA_MAT = 64 * HGA_STR, HGA_WAVE = 2 * HGA_MAT;
static_assert(8 * HGA_WAVE <= LDS_BYTES - 64 && 3 * HGA_T >= HG_STEPS, "hg pass A LDS");
__device__ __forceinline__ void hg_passA_mfma(LAS unsigned char* lds, const float* ff, const float* fb, const bf16_t* hi, float* carry, float* dk, int wave, int lane, int G) {
    LAS unsigned char* KT = lds + wave * HGA_WAVE; LAS unsigned char* VT = KT + HGA_MAT;
    const int n = lane & 31, gq = lane >> 5;
    for (int item = blockIdx.x + G * wave; item < 16 * HG_SEG; item += G * 8) {
        const int s = item / HG_SEG, j = item % HG_SEG, dir = s >> 3, b = (s >> 2) & 1, h = s & 3;
        const float* fbase = dir ? fb : ff;
        const int st0 = j * HG_STEPS, st1 = st0 + HG_STEPS;
        f32x16 acc[2][2];
#pragma unroll
        for (int kb = 0; kb < 2; ++kb)
#pragma unroll
            for (int vb = 0; vb < 2; ++vb)
#pragma unroll
                for (int r = 0; r < 16; ++r) acc[kb][vb][r] = 0.f;
        float P = 1.f;
        for (int third = 2; third >= 0; --third) {
            const int sb = st0 + third * HGA_T;
            for (int s0 = HGA_T - 8; s0 >= 0; s0 -= 8) {
                float fv[8]; unsigned short iv[8];
#pragma unroll
                for (int u = 0; u < 8; ++u) {
                    const int st = sb + s0 + u;
                    const int stc = (st < st1) ? st : st1 - 1;
                    const size_t off = (size_t)hg_row(dir, b, stc) * 256 + h * 64 + lane;
                    fv[u] = fbase[off]; iv[u] = hi[off];
                }
#pragma unroll
                for (int u = 7; u >= 0; --u) {
                    const int st = sb + s0 + u;
                    const bool ok = (st < st1);
                    const float f = ok ? fv[u] : 1.f;
                    const float kh = ok ? (1.f - f) * P : 0.f;
                    P *= f;
                    *(LAS unsigned short*)(KT + lane * HGA_STR + (s0 + u) * 2) = (unsigned short)(pk2(kh, 0.f) & 0xffffu);
                    *(LAS unsigned short*)(VT + lane * HGA_STR + (s0 + u) * 2) = ok ? iv[u] : (unsigned short)0;
                }
            }
            LDS_WAIT(); asm volatile("" ::: "memory");
#pragma unroll
            for (int q = 0; q < HGA_T / 16; ++q) {
                bf16x8 af[2], bfr[2];
#pragma unroll
                for (int kb = 0; kb < 2; ++kb) af[kb] = *(LAS bf16x8*)(KT + (kb * 32 + n) * HGA_STR + (16 * q + 8 * gq) * 2);
#pragma unroll
                for (int vb = 0; vb < 2; ++vb) bfr[vb] = *(LAS bf16x8*)(VT + (vb * 32 + n) * HGA_STR + (16 * q + 8 * gq) * 2);
#pragma unroll
                for (int kb = 0; kb < 2; ++kb)
#pragma unroll
                    for (int vb = 0; vb < 2; ++vb) acc[kb][vb] = __builtin_amdgcn_mfma_f32_32x32x16_bf16(af[kb], bfr[vb], acc[kb][vb], 0, 0, 0);
            }
            LDS_WAIT(); asm volatile("" ::: "memory");
        }
#pragma unroll
        for (int kb = 0; kb < 2; ++kb)
#pragma unroll
            for (int vb = 0; vb < 2; ++vb)
#pragma unroll
                for (int r = 0; r < 16; ++r) {
                    const int k = kb * 32 + 8 * (r >> 2) + 4 * gq + (r & 3), v = vb * 32 + n;
                    carry[((size_t)item * 64 + k) * 64 + v] = acc[kb][vb][r];
                }
        dk[item * 64 + lane] = P;
    }
}
constexpr int HGB_QSTR = 144, HGB_TSTR = 48, HGB_Q = 0, HGB_K = HGB_Q + 16 * HGB_QSTR, HGB_KH = HGB_K + 16 * HGB_QSTR, HGB_IT = HGB_KH + 64 * HGB_TSTR, HGB_DC = HGB_IT + 64 * HGB_TSTR, HGB_WAVE = HGB_DC + 256;
static_assert(8 * HGB_WAVE <= LDS_BYTES - 64, "hg pass B LDS");
__device__ __forceinline__ bf16x8 hgb_pack8(const f32x16& t, int r0) {
    u32x4 w; w.x = pk2(t[r0 + 0], t[r0 + 1]); w.y = pk2(t[r0 + 2], t[r0 + 3]); w.z = pk2(t[r0 + 4], t[r0 + 5]); w.w = pk2(t[r0 + 6], t[r0 + 7]); return __builtin_bit_cast(bf16x8, w);
}
__device__ __forceinline__ void hg_passB_mfma(LAS unsigned char* lds, const float* hq, const float* ff, const float* fb, const bf16_t* hi, const float* carry, bf16_t* odir, int wave, int lane, int G) {
    LAS unsigned char* W = lds + wave * HGB_WAVE;
    const int n = lane & 31, gq = lane >> 5, n16 = n & 15;
    const int kpos = (lane & ~15) + (lane & 3) + ((lane >> 3) & 1) * 4 + ((lane >> 2) & 1) * 8;
    for (int item = blockIdx.x + G * wave; item < 16 * HG_SEG; item += G * 8) {
        const int s = item / HG_SEG, j = item % HG_SEG, dir = s >> 3, b = (s >> 2) & 1, h = s & 3;
        const float* fbase = dir ? fb : ff;
        const int st0 = j * HG_STEPS, st1 = st0 + HG_STEPS;
        f32x16 S[2][2];
#pragma unroll
        for (int kb = 0; kb < 2; ++kb)
#pragma unroll
            for (int vb = 0; vb < 2; ++vb)
#pragma unroll
                for (int r = 0; r < 16; ++r) S[kb][vb][r] = carry[((size_t)item * 64 + kb * 32 + 8 * (r >> 2) + 4 * gq + (r & 3)) * 64 + vb * 32 + n];
        for (int c0 = st0; c0 < st1; c0 += 16) {
            float fv[16], qv[16]; unsigned short iv[16];
#pragma unroll
            for (int t = 0; t < 16; ++t) {
                const int st = c0 + t; const int stc = (st < st1) ? st : st1 - 1;
                const size_t off = (size_t)hg_row(dir, b, stc) * 256 + h * 64 + lane;
                fv[t] = fbase[off]; qv[t] = hq[off]; iv[t] = hi[off];
            }
            float P = 1.f; float kt[16];
#pragma unroll
            for (int t = 0; t < 16; ++t) {
                const bool ok = (c0 + t < st1);
                const float f = ok ? fv[t] : 1.f, q = ok ? qv[t] : 0.f;
                P *= f;
                const float Pc = fmaxf(P, 1e-30f);
                kt[t] = ok ? (1.f - f) * rcpf_(Pc) : 0.f;
                *(LAS unsigned short*)(W + HGB_Q + t * HGB_QSTR + kpos * 2) = (unsigned short)(pk2(q * Pc, 0.f) & 0xffffu);
                *(LAS unsigned short*)(W + HGB_K + t * HGB_QSTR + kpos * 2) = (unsigned short)(pk2(kt[t], 0.f) & 0xffffu);
                *(LAS unsigned short*)(W + HGB_IT + lane * HGB_TSTR + t * 2) = ok ? iv[t] : (unsigned short)0;
            }
            const float P15 = fmaxf(P, 1e-30f);
#pragma unroll
            for (int t = 0; t < 16; ++t) *(LAS unsigned short*)(W + HGB_KH + lane * HGB_TSTR + t * 2) = (unsigned short)(pk2(kt[t] * P15, 0.f) & 0xffffu);
            *(LAS float*)(W + HGB_DC + lane * 4) = P;
            LDS_WAIT(); asm volatile("" ::: "memory");
            bf16x8 qb[4];
#pragma unroll
            for (int u = 0; u < 4; ++u) qb[u] = *(LAS bf16x8*)(W + HGB_Q + n16 * HGB_QSTR + (16 * u + 8 * gq) * 2);
            f32x16 OT[2], AT;
#pragma unroll
            for (int r = 0; r < 16; ++r) { OT[0][r] = 0.f; OT[1][r] = 0.f; AT[r] = 0.f; }
#pragma unroll
            for (int u = 0; u < 4; ++u) {
                const bf16x8 ka = *(LAS bf16x8*)(W + HGB_K + n16 * HGB_QSTR + (16 * u + 8 * gq) * 2);
                AT = __builtin_amdgcn_mfma_f32_32x32x16_bf16(ka, qb[u], AT, 0, 0, 0);
#pragma unroll
                for (int vb = 0; vb < 2; ++vb)
                    OT[vb] = __builtin_amdgcn_mfma_f32_32x32x16_bf16(hgb_pack8(S[u >> 1][vb], 8 * (u & 1)), qb[u], OT[vb], 0, 0, 0);
            }
#pragma unroll
            for (int r = 0; r < 8; ++r) { const int srow = 8 * (r >> 2) + 4 * gq + (r & 3); if (srow > n) AT[r] = 0.f; }
            const bf16x8 ab = hgb_pack8(AT, 0);
#pragma unroll
            for (int vb = 0; vb < 2; ++vb) {
                const u32x2 lo = *(LAS u32x2*)(W + HGB_IT + (vb * 32 + n) * HGB_TSTR + (4 * gq) * 2), hi2 = *(LAS u32x2*)(W + HGB_IT + (vb * 32 + n) * HGB_TSTR + (8 + 4 * gq) * 2);
                const bf16x8 ia = __builtin_bit_cast(bf16x8, ((u32x4){lo.x, lo.y, hi2.x, hi2.y}));
                OT[vb] = __builtin_amdgcn_mfma_f32_32x32x16_bf16(ia, ab, OT[vb], 0, 0, 0);
            }
            if (n < 16 && c0 + n < st1) {
                bf16_t* op = odir + (size_t)dir * R * 256 + (size_t)hg_row(dir, b, c0 + n) * 256 + h * 64;
#pragma unroll
                for (int vb = 0; vb < 2; ++vb)
#pragma unroll
                    for (int r4 = 0; r4 < 4; ++r4) {
                        u32x2 w; w.x = pk2(OT[vb][4 * r4 + 0], OT[vb][4 * r4 + 1]); w.y = pk2(OT[vb][4 * r4 + 2], OT[vb][4 * r4 + 3]);
                        *(u32x2*)(op + vb * 32 + 8 * r4 + 4 * gq) = w;
                    }
            }
#pragma unroll
            for (int kb = 0; kb < 2; ++kb) {
                f32x4 dc[4];
#pragma unroll
                for (int r4 = 0; r4 < 4; ++r4) dc[r4] = *(LAS f32x4*)(W + HGB_DC + (kb * 32 + 8 * r4 + 4 * gq) * 4);
                const bf16x8 kh = *(LAS bf16x8*)(W + HGB_KH + (kb * 32 + n) * HGB_TSTR + (8 * gq) * 2);
#pragma unroll
                for (int vb = 0; vb < 2; ++vb) {
#pragma unroll
                    for (int r = 0; r < 16; ++r) S[kb][vb][r] *= dc[r >> 2][r & 3];
                    const bf16x8 ib = *(LAS bf16x8*)(W + HGB_IT + (vb * 32 + n) * HGB_TSTR + (8 * gq) * 2);
                    S[kb][vb] = __builtin_amdgcn_mfma_f32_32x32x16_bf16(kh, ib, S[kb][vb], 0, 0, 0);
                }
            }
            LDS_WAIT(); asm volatile("" ::: "memory");
        }
    }
}
__device__ __forceinline__ void hg_carry(float* carry, const float* dk, int gtid, int ngt) {
    for (int e = gtid; e < 16 * 4096; e += ngt) {
        const int s = e >> 12, idx = e & 4095, k = idx >> 6;
        float run = 0.f;
        for (int j0 = 0; j0 < HG_SEG; j0 += 8) {
            float t[8], d[8];
#pragma unroll
            for (int u = 0; u < 8; ++u) { t[u] = carry[(size_t)(s * HG_SEG + j0 + u) * 4096 + idx]; d[u] = dk[(s * HG_SEG + j0 + u) * 64 + k]; }
#pragma unroll
            for (int u = 0; u < 8; ++u) { carry[(size_t)(s * HG_SEG + j0 + u) * 4096 + idx] = run; run = __builtin_fmaf(d[u], run, t[u]); }
        }
    }
}
__device__ __forceinline__ void hg_readout(const bf16_t* odir, const bf16_t* hgs, const float* gain, bf16_t* ohg, int gw, int ngw, int lane) {
    const f32x4 gv = *(const f32x4*)(gain + ((4 * lane) & 63));
    for (int row = gw; row < R; row += ngw) {
        const size_t off = (size_t)row * 256 + 4 * lane;
        const u32x2 a = *(const u32x2*)(odir + off), bq = *(const u32x2*)(odir + (size_t)R * 256 + off), hg = *(const u32x2*)(hgs + off);
        const float o0 = bflo(a.x) + bflo(bq.x), o1 = bfhi(a.x) + bfhi(bq.x), o2 = bflo(a.y) + bflo(bq.y), o3 = bfhi(a.y) + bfhi(bq.y);
        float ss = (o0 * o0 + o1 * o1) + (o2 * o2 + o3 * o3);
        ss += shx(ss, 1, lane); ss += shx(ss, 2, lane); ss += shx(ss, 4, lane); ss += shx(ss, 8, lane);
        const float rstd = 1.0f / sqrtf(ss * (1.f / 64.f) + EPS);
        u32x2 w;
        w.x = pk2(o0 * rstd * gv[0] * bflo(hg.x), o1 * rstd * gv[1] * bfhi(hg.x));
        w.y = pk2(o2 * rstd * gv[2] * bflo(hg.y), o3 * rstd * gv[3] * bfhi(hg.y));
        *(u32x2*)(ohg + off) = w;
    }
}

constexpr int AT_KSTR = 256, AT_VSTR = 128, AT_KBYTES = 64 * AT_KSTR, AT_VBYTES = 128 * AT_VSTR, AT_STAGE = AT_KBYTES + AT_VBYTES;
static_assert(2 * AT_STAGE <= LDS_BYTES && 65536 <= 2 * AT_STAGE, "attention LDS");
__device__ __forceinline__ void attn_unit(LAS unsigned char* lds, const bf16_t* qbuf, const bf16_t* kbuf, const bf16_t* vT, bf16_t* oda, const float* gain,
                                          int b, int h, int qrow0, int kt0, int kt1, float lam, float post, int tid, int wave, int lane) {
    const int c = wave & 1, g = wave >> 1, n = lane & 31, gq = lane >> 5;
    bf16x8 qf[4];
    { const bf16_t* qp = qbuf + (size_t)(qrow0 + 32 * g + n) * 512 + h * 128 + c * 64 + 8 * gq;
#pragma unroll
      for (int s = 0; s < 4; ++s) qf[s] = *(const bf16x8*)(qp + 16 * s); }
    f32x16 O[4];
#pragma unroll
    for (int e = 0; e < 4; ++e)
#pragma unroll
        for (int r = 0; r < 16; ++r) O[e][r] = 0.f;
    float l = 0.f;
    const int kr_ = lane >> 4, kpos_ = lane & 15;
    const int vr_ = lane >> 3, vpos_ = lane & 7;
    const unsigned char* kbase = (const unsigned char*)(kbuf + h * 128);
    const unsigned char* vbase = (const unsigned char*)(vT + (size_t)(b * 512 + h * 128) * KEYS);
#define AT_KROW0(kt) (((kt) * 64 < SEQ) ? (size_t)b * SEQ + (kt) * 64 : (size_t)NLAT + b * CTXL + ((kt) * 64 - SEQ))
#define AT_DMA(kt, buf) do { const unsigned char* kb_ = kbase + AT_KROW0(kt) * 1024; const unsigned char* vb_ = vbase + (size_t)(kt) * 128; \
        _Pragma("unroll") for (int pp = 0; pp < 2; ++pp) { const int p_ = wave + 8 * pp; \
            { const int r_ = 4 * p_ + kr_; \
              __builtin_amdgcn_global_load_lds((const unsigned*)(kb_ + (size_t)r_ * 1024 + ((kpos_ ^ (r_ & 15)) * 16)), (LAS unsigned*)(lds + (buf) * AT_KBYTES + p_ * 1024), 16, 0, 0); } \
            { const int e_ = 8 * p_ + vr_; \
              __builtin_amdgcn_global_load_lds((const unsigned*)(vb_ + (size_t)e_ * (KEYS * 2) + ((vpos_ ^ ((e_ >> 1) & 7)) * 16)), (LAS unsigned*)(lds + 2 * AT_KBYTES + (buf) * AT_VBYTES + p_ * 1024), 16, 0, 0); } } } while (0)
#define AT_QK(Sa, Sb, buf) do { LAS unsigned char* kp = lds + (buf) * AT_KBYTES + n * AT_KSTR; \
        _Pragma("unroll") for (int s = 0; s < 4; ++s) { \
            const bf16x8 a0 = *(LAS bf16x8*)(kp + (((c * 8 + 2 * s + gq) ^ (n & 15)) * 16)), a1 = *(LAS bf16x8*)(kp + 32 * AT_KSTR + (((c * 8 + 2 * s + gq) ^ (n & 15)) * 16)); \
            Sa = __builtin_amdgcn_mfma_f32_32x32x16_bf16(a0, qf[s], Sa, 0, 0, 0); \
            Sb = __builtin_amdgcn_mfma_f32_32x32x16_bf16(a1, qf[s], Sb, 0, 0, 0); } } while (0)
#define AT_BAR() do { asm volatile("s_waitcnt vmcnt(0) lgkmcnt(0)" ::: "memory"); __builtin_amdgcn_s_barrier(); asm volatile("" ::: "memory"); } while (0)
    const int nt = kt1 - kt0;
    AT_DMA(kt0, 0);
    AT_BAR();
    f32x16 negm;
    {
        f32x16 S0, S1;
#pragma unroll
        for (int r = 0; r < 16; ++r) { S0[r] = 0.f; S1[r] = 0.f; }
        AT_QK(S0, S1, 0);
        float mx = fmaxf(S0[0], S1[0]);
#pragma unroll
        for (int r = 1; r < 16; ++r) mx = fmaxf(fmaxf(mx, S0[r]), S1[r]);
        { auto rr = __builtin_amdgcn_permlane32_swap(__builtin_bit_cast(unsigned, mx), __builtin_bit_cast(unsigned, mx), false, false);
          mx = fmaxf(__builtin_bit_cast(float, rr[0]), __builtin_bit_cast(float, rr[1])); }
#pragma unroll
        for (int r = 0; r < 16; ++r) negm[r] = -mx;
    }
    constexpr float THR = 8.f;
    for (int i = 0; i < nt; ++i) {
        const int cur = i & 1;
        bf16x8 kf[8];
        if (i + 1 < nt) AT_DMA(kt0 + i + 1, cur ^ 1);
        { LAS unsigned char* kp = lds + cur * AT_KBYTES + n * AT_KSTR;
#pragma unroll
          for (int s = 0; s < 4; ++s) { const int po = ((c * 8 + 2 * s + gq) ^ (n & 15)) * 16; kf[2 * s] = *(LAS bf16x8*)(kp + po); kf[2 * s + 1] = *(LAS bf16x8*)(kp + 32 * AT_KSTR + po); } }
        LAS unsigned char* vp = lds + 2 * AT_KBYTES + cur * AT_VBYTES + n * AT_VSTR;
        const int vsw = (n >> 1) & 7;
        bf16x8 va[8];
#pragma unroll
        for (int ks = 0; ks < 2; ++ks)
#pragma unroll
            for (int e = 0; e < 4; ++e) va[ks * 4 + e] = *(LAS bf16x8*)(vp + e * 32 * AT_VSTR + (((2 * ks + gq) ^ vsw) * 16));
        __builtin_amdgcn_sched_barrier(0);
        f32x16 S0 = negm, S1 = negm;
#pragma unroll
        for (int s = 0; s < 4; ++s) {
            S0 = __builtin_amdgcn_mfma_f32_32x32x16_bf16(kf[2 * s], qf[s], S0, 0, 0, 0);
            S1 = __builtin_amdgcn_mfma_f32_32x32x16_bf16(kf[2 * s + 1], qf[s], S1, 0, 0, 0);
        }
        __builtin_amdgcn_sched_barrier(0);
        bf16x8 vb[8];
#pragma unroll
        for (int ks = 0; ks < 2; ++ks)
#pragma unroll
            for (int e = 0; e < 4; ++e) vb[ks * 4 + e] = *(LAS bf16x8*)(vp + e * 32 * AT_VSTR + (((2 * (ks + 2) + gq) ^ vsw) * 16));
        __builtin_amdgcn_sched_barrier(0);
        float mx = fmaxf(S0[0], S1[0]);
#pragma unroll
        for (int r = 1; r < 16; ++r) mx = fmaxf(fmaxf(mx, S0[r]), S1[r]);
        { auto rr = __builtin_amdgcn_permlane32_swap(__builtin_bit_cast(unsigned, mx), __builtin_bit_cast(unsigned, mx), false, false);
          mx = fmaxf(__builtin_bit_cast(float, rr[0]), __builtin_bit_cast(float, rr[1])); }
        if (__builtin_amdgcn_ballot_w64(mx > THR) != 0ull) {
            const float delta = fmaxf(mx, 0.f), alpha = ex2(-delta);
            l *= alpha;
#pragma unroll
            for (int r = 0; r < 16; ++r) { S0[r] -= delta; S1[r] -= delta; negm[r] -= delta; }
#pragma unroll
            for (int e = 0; e < 4; ++e) O[e] = O[e] * alpha;
        }
        float ps = 0.f;
#define AT_QTR(Sx, r0, va_, ksl) do { \
        _Pragma("unroll") for (int r = 0; r < 8; ++r) { Sx[(r0) + r] = ex2(Sx[(r0) + r]); ps += Sx[(r0) + r]; } \
        u32x4 pw; pw.x = pk2(Sx[(r0) + 0], Sx[(r0) + 1]); pw.y = pk2(Sx[(r0) + 2], Sx[(r0) + 3]); pw.z = pk2(Sx[(r0) + 4], Sx[(r0) + 5]); pw.w = pk2(Sx[(r0) + 6], Sx[(r0) + 7]); \
        const bf16x8 pq = __builtin_bit_cast(bf16x8, pw); \
        __builtin_amdgcn_sched_barrier(0); \
        _Pragma("unroll") for (int e = 0; e < 4; ++e) O[e] = __builtin_amdgcn_mfma_f32_32x32x16_bf16(va_[(ksl) * 4 + e], pq, O[e], 0, 0, 0); } while (0)
        AT_QTR(S0, 0, va, 0);
        AT_QTR(S0, 8, va, 1);
        AT_QTR(S1, 0, vb, 0);
        AT_QTR(S1, 8, vb, 1);
#undef AT_QTR
        l += ps;
        AT_BAR();
    }
#undef AT_BAR
#undef AT_KROW0
#undef AT_DMA
#undef AT_QK
    l += shx(l, 32, lane);
    const float inv = 1.f / l;
    LAS float* xch = (LAS float*)lds;
    if (c == 1) {
#pragma unroll
        for (int e = 0; e < 4; ++e)
#pragma unroll
            for (int r = 0; r < 16; ++r) xch[(g * 64 + e * 16 + r) * 64 + lane] = O[e][r] * inv;
    }
    __syncthreads();
    if (c == 0) {
        float ss = 0.f;
#pragma unroll
        for (int e = 0; e < 4; ++e)
#pragma unroll
            for (int r = 0; r < 16; ++r) { const float o = O[e][r] * inv - lam * xch[(g * 64 + e * 16 + r) * 64 + lane]; O[e][r] = o; ss += o * o; }
        ss += shx(ss, 32, lane);
        const float rs = post / sqrtf(ss * (1.f / 128.f) + EPS);
        bf16_t* op = oda + (size_t)(qrow0 + 32 * g + n) * 512 + h * 128;
#pragma unroll
        for (int e = 0; e < 4; ++e)
#pragma unroll
            for (int r4 = 0; r4 < 4; ++r4) {
                const int e0 = e * 32 + 8 * r4 + 4 * gq;
                const f32x4 gv = *(const f32x4*)(gain + e0);
                u32x2 w; w.x = pk2(O[e][4 * r4 + 0] * rs * gv[0], O[e][4 * r4 + 1] * rs * gv[1]); w.y = pk2(O[e][4 * r4 + 2] * rs * gv[2], O[e][4 * r4 + 3] * rs * gv[3]);
                *(u32x2*)(op + e0) = w;
            }
    }
    __syncthreads();
}
#define XB_TMO      128
#define XB_XCNT(j)  (256  + 64 * (j))
#define XB_XSUB(j)  (1280 + 64 * (j))
#define XB_XGEN(j)  (2304 + 64 * (j))
#define XB_TOP      3328
#define XB_TOPGEN   3392
#define XCD_BAR_WORDS 3456
#define XB_SPIN_CAP (1u << 18)

__device__ __forceinline__ unsigned xb_ld(unsigned* p)              { return __hip_atomic_load(p, __ATOMIC_RELAXED, __HIP_MEMORY_SCOPE_AGENT); }
__device__ __forceinline__ unsigned xb_add(unsigned* p, unsigned v) { return __hip_atomic_fetch_add(p, v, __ATOMIC_RELAXED, __HIP_MEMORY_SCOPE_AGENT); }
__device__ __forceinline__ unsigned xb_xcc_id() { return (unsigned)__builtin_amdgcn_s_getreg((3 << 11) | 20) & 0xFu; }
#define XB_SPIN(cond, bar) do { unsigned _sp = 0; while (cond) { __builtin_amdgcn_s_sleep(1); \
    if ((++_sp & 255u) == 0u) { if (xb_ld(&(bar)[XB_TMO])) break; if (_sp > XB_SPIN_CAP) { atomicAdd(&(bar)[XB_TMO], 1u); break; } } } } while (0)

struct XcdBarrier {
    unsigned* bar; unsigned x;
    volatile LAS unsigned* st;
};

__device__ __forceinline__ XcdBarrier xcd_barrier_post(unsigned* bar, volatile LAS unsigned* st, int tid_in) {
    XcdBarrier b; b.bar = bar; b.x = xb_xcc_id(); b.st = st;
    if (tid_in == 0) (void)xb_add(&bar[XB_XCNT(b.x)], 1u);
    return b;
}
__device__ __forceinline__ void xcd_barrier_complete(unsigned* bar, unsigned x, unsigned& nloc, unsigned& nx) {
    const unsigned G = gridDim.x * gridDim.y * gridDim.z;
    unsigned sum, cnt, mine, sp = 0u;
    for (;;) {
        sum = 0u; cnt = 0u; mine = 0u;
#pragma unroll
        for (unsigned j = 0; j < 16; ++j) { const unsigned c = xb_ld(&bar[XB_XCNT(j)]); sum += c; cnt += (c > 0u) ? 1u : 0u; mine = (j == x) ? c : mine; }
        if (sum == G) break;
        __builtin_amdgcn_s_sleep(1);
        if ((++sp & 255u) == 0u) { if (xb_ld(&bar[XB_TMO])) break; if (sp > XB_SPIN_CAP) { atomicAdd(&bar[XB_TMO], 1u); break; } }
    }
    nloc = mine > 0u ? mine : 1u; nx = cnt > 0u ? cnt : 1u;
}

__device__ __forceinline__ void xcd_barrier(const XcdBarrier& b, int tid_in) {
    asm volatile("s_waitcnt vmcnt(0)" ::: "memory");
    __syncthreads();
    if (tid_in == 0) {
        unsigned* bar = b.bar;
        __builtin_amdgcn_s_waitcnt(0);
        unsigned nloc = b.st[0], nx = b.st[1];
        if (nloc == 0u) { xcd_barrier_complete(bar, b.x, nloc, nx); b.st[0] = nloc; b.st[1] = nx; }
        const unsigned old = xb_add(&bar[XB_XSUB(b.x)], 1u);
        const unsigned gen = old / nloc;
        if (old + 1u == (gen + 1u) * nloc) {
            __builtin_amdgcn_fence(__ATOMIC_RELEASE, "agent");
            asm volatile("s_waitcnt vmcnt(0)" ::: "memory");
            const unsigned og = xb_add(&bar[XB_TOP], 1u);
            const unsigned tg = og / nx;
            if (og + 1u == (tg + 1u) * nx) xb_add(&bar[XB_TOPGEN], 1u);
            else XB_SPIN(xb_ld(&bar[XB_TOPGEN]) == tg, bar);
            __builtin_amdgcn_fence(__ATOMIC_ACQUIRE, "agent");
            xb_add(&bar[XB_XGEN(b.x)], 1u);
            asm volatile("s_waitcnt vmcnt(0)" ::: "memory");
        } else {
            XB_SPIN(xb_ld(&bar[XB_XGEN(b.x)]) == gen, bar);
            __builtin_amdgcn_fence(__ATOMIC_ACQUIRE, "agent");
            asm volatile("s_waitcnt vmcnt(0)" ::: "memory");
        }
    }
    __syncthreads();
}


struct Args { const float* in[30]; float* out; unsigned char* ws; };
typedef const Args __attribute__((address_space(4))) Args_c;
__device__ __forceinline__ Args_c* kargs_ptr() { Args_c* p = (Args_c*)__builtin_amdgcn_kernarg_segment_ptr(); asm volatile("" : "+s"(p)); return p; }
#define GSYNC_CG() cg::this_grid().sync()
constexpr size_t WS_BAR = WS_END + 4096;
constexpr size_t WS_TOTAL = WS_BAR + (size_t)XCD_BAR_WORDS * 4;
static_assert(WS_TOTAL <= (size_t)512 * 1024 * 1024, "workspace");
constexpr int LDS_BARST = LDS_BYTES - 16;
#define GSYNC() do { XcdBarrier xb_; xb_.bar = (unsigned*)(kargs_ptr()->ws + WS_BAR); xb_.x = xb_xcc_id(); xb_.st = (volatile LAS unsigned*)(lds + LDS_BARST); xcd_barrier(xb_, TIDX()); } while (0)
#ifdef PROBE_A
#define TS(cat) do { if (blockIdx.x == 0 && TIDX() == 0) { unsigned long long* tsb = (unsigned long long*)(kargs_ptr()->ws + WS_END); const unsigned long long now = __builtin_amdgcn_s_memrealtime(); tsb[1 + (cat)] += now - tsb[0]; tsb[0] = now; } } while (0)
#else
#define TS(cat) do {} while (0)
#endif
__device__ __forceinline__ int tid_from(int wave_s) { int w_ = wave_s; unsigned z_ = 0u; asm volatile("" : "+s"(w_), "+s"(z_)); return w_ * 64 + (int)__builtin_amdgcn_mbcnt_hi(~0u, __builtin_amdgcn_mbcnt_lo(~0u, z_)); }
#define TIDX() tid_from(wave_s)
#define KA() int tid = TIDX(); asm volatile("" : "+v"(tid)); int G = gridDim.x, bid = blockIdx.x; asm volatile("" : "+s"(G), "+s"(bid)); \
    const int lane = tid & 63, wave = __builtin_amdgcn_readfirstlane(tid >> 6), gw = bid * 8 + wave, ngw = G * 8, gtid = bid * NTHR + tid, ngt = G * NTHR; \
    (void)lane; (void)wave; (void)gw; (void)ngw; (void)gtid; (void)ngt; \
    Args_c* ka = kargs_ptr(); unsigned char* ws = ka->ws; (void)ws

__global__ void __launch_bounds__(NTHR, 2) fwd_kernel(Args a_unused) {
    extern __shared__ __attribute__((aligned(16))) unsigned char lds_raw[];
    LAS unsigned char* lds = (LAS unsigned char*)lds_raw;
    const int wave_s = __builtin_amdgcn_readfirstlane((int)threadIdx.x >> 6);
    if (TIDX() < 4) ((volatile LAS unsigned*)(lds + LDS_BARST))[TIDX()] = 0u;
    __syncthreads();
    (void)xcd_barrier_post((unsigned*)(kargs_ptr()->ws + WS_BAR), (volatile LAS unsigned*)(lds + LDS_BARST), TIDX());
#ifdef PROBE_A
    if (blockIdx.x == 0 && TIDX() == 0) { unsigned long long* tsb = (unsigned long long*)(kargs_ptr()->ws + WS_END); for (int i = 1; i < 32; ++i) tsb[i] = 0; tsb[0] = __builtin_amdgcn_s_memrealtime(); }
#endif

#ifdef REP_INIT
#pragma unroll 1
    for (int rep_ = 0; rep_ < 2; ++rep_) {
#else
    {
#endif
    {
        KA();
        bf16_t* WB = (bf16_t*)(ws + WS_WB);
        LAS float* scr = (LAS float*)(lds + wave * 8448);
        constexpr int IT_L = 12416;
        for (int it = gw; it < 2 * IT_L; it += ngw) {
            const int l = it / IT_L; int r = it % IT_L;
            bf16_t* Wl = WB + (size_t)l * WL_TOTAL;
            if (r < 1408) { transpose_item(ka->in[9] + (size_t)l * 1024 * DFF, 1024, DFF, Wl + WL_UP1, 1, scr, r, lane); continue; } r -= 1408;
            if (r < 1408) { transpose_item(ka->in[10] + (size_t)l * 1024 * DFF, 1024, DFF, Wl + WL_UP1, 2, scr, r, lane); continue; } r -= 1408;
            if (r < 1408) { transpose_item(ka->in[11] + (size_t)l * DFF * 1024, DFF, 1024, Wl + WL_DN1, 0, scr, r, lane); continue; } r -= 1408;
            if (r < 1408) { transpose_item(ka->in[12] + (size_t)l * 1024 * DFF, 1024, DFF, Wl + WL_UP2, 1, scr, r, lane); continue; } r -= 1408;
            if (r < 1408) { transpose_item(ka->in[13] + (size_t)l * 1024 * DFF, 1024, DFF, Wl + WL_UP2, 2, scr, r, lane); continue; } r -= 1408;
            if (r < 1408) { transpose_item(ka->in[14] + (size_t)l * DFF * 1024, DFF, 1024, Wl + WL_DN2, 0, scr, r, lane); continue; } r -= 1408;
            if (r < 3072) { transpose_item(ka->in[15] + (size_t)l * 1024 * 6144, 1024, 6144, Wl + WL_IN, 3, scr, r, lane); continue; } r -= 3072;
            if (r < 256) { transpose_item(ka->in[25] + (size_t)l * 512 * 1024, 512, 1024, Wl + WL_PA, 0, scr, r, lane); continue; } r -= 256;
            if (r < 128) { transpose_item(ka->in[26] + (size_t)l * 256 * 1024, 256, 1024, Wl + WL_PH, 0, scr, r, lane); continue; } r -= 128;
            transpose_item(ka->in[28] + (size_t)l * 1024 * 1024, 1024, 1024, Wl + WL_O, 0, scr, r, lane);
        }
        __syncthreads();
    }
    {
        KA();
        float* MOD = (float*)(ws + WS_MOD);
        LAS float* sv = (LAS float*)lds;
        LAS float* part = (LAS float*)(lds + 12288);
        for (int i = tid; i < 3072; i += NTHR) { const int seg = i >> 10, k = i & 1023; const float x = (seg < 2) ? ka->in[1][seg * 1024 + k] : ka->in[3][k]; sv[i] = x / (1.f + __expf(-x)); }
        __syncthreads();
        for (int item = bid; item < 288; item += G) {
            const int l = item / 144, col = (item % 144) * 64 + lane;
            const float* W = ka->in[4] + (size_t)l * 1024 * 9216 + col;
            float a0 = 0.f, a1 = 0.f, a2 = 0.f;
            for (int k = wave * 128; k < wave * 128 + 128; ++k) { const float w = W[(size_t)k * 9216]; a0 = __builtin_fmaf(sv[k], w, a0); a1 = __builtin_fmaf(sv[1024 + k], w, a1); a2 = __builtin_fmaf(sv[2048 + k], w, a2); }
            part[(wave * 3 + 0) * 64 + lane] = a0; part[(wave * 3 + 1) * 64 + lane] = a1; part[(wave * 3 + 2) * 64 + lane] = a2;
            __syncthreads();
            if (tid < 192) { const int seg = tid >> 6, cl = tid & 63; float s = 0.f;
#pragma unroll
                for (int w = 0; w < 8; ++w) s += part[(w * 3 + seg) * 64 + cl];
                const int cc = (item % 144) * 64 + cl;
                MOD[(size_t)(l * 3 + seg) * 9216 + cc] = s + ka->in[5][l * 9216 + cc]; }
            __syncthreads();
        }
    }
    {
        KA();
        bf16_t* WB = (bf16_t*)(ws + WS_WB); float* CS = (float*)(ws + WS_CS); float* LBT = (float*)(ws + WS_LB); float* LAMV = (float*)(ws + WS_LAM);
        for (int idx = gtid; idx < 2 * 256 * 1024; idx += ngt) {
            const int n = idx & 1023, k = (idx >> 10) & 255, l = idx >> 18, g = k >> 6, c = k & 63;
            const float* pw = ka->in[23] + (size_t)l * 4 * 64 * 64 + (g * 64 + c) * 64;
            const float* psc = ka->in[24] + l * 256 + g * 64;
            const float* wp = ka->in[27] + (size_t)l * 256 * 1024 + (size_t)(g * 64) * 1024 + n;
            float s = 0.f;
            for (int d = 0; d < 64; ++d) s = __builtin_fmaf(pw[d] * psc[d], wp[(size_t)d * 1024], s);
            (WB + (size_t)l * WL_TOTAL + WL_PP)[(size_t)n * 256 + k] = (bf16_t)(pk2(s, 0.f) & 0xffffu);
        }
        for (int idx = gtid; idx < 4096; idx += ngt) {
            const int n = idx >> 4, j = idx & 15;
            const float invf = __builtin_exp2f(-(float)j * (13.287712379549449f / 16.f));
            const float ang = (float)n * invf;
            const double rev = (double)ang * 0.15915494309189535; const float fr = (float)(rev - __builtin_floor(rev));
            CS[n * 32 + j] = __builtin_amdgcn_cosf(fr); CS[n * 32 + 16 + j] = __builtin_amdgcn_sinf(fr);
        }
        for (int idx = gtid; idx < 1024; idx += ngt) {
            const int l = idx >> 9, dc = idx & 511;
            const float l0 = ka->in[21][dc], l1 = ka->in[21][512 + dc];
            LBT[idx] = (l == 0) ? 0.f : 1.f / (1.f + __expf(l0 - l1));
        }
        for (int idx = gtid; idx < NCTX * DM / 4; idx += ngt) ((f32x4*)(ws + WS_HC))[idx] = ((const f32x4*)ka->in[2])[idx];
        if (gtid < 2) {
            const int l = gtid; float s1 = 0.f, s2 = 0.f;
            for (int i = 0; i < 64; ++i) { s1 += ka->in[16][l * 64 + i] * ka->in[17][l * 64 + i]; s2 += ka->in[18][l * 64 + i] * ka->in[19][l * 64 + i]; }
            const float li = (l == 0) ? 0.2f : (0.8f - 0.6f * 0.7408182206817179f);
            LAMV[l * 2 + 0] = __expf(s1) - __expf(s2) + li; LAMV[l * 2 + 1] = 1.f - li;
        }
    }
    }
    GSYNC_CG();
    TS(0);

#pragma unroll 1
    for (int l = 0; l < 2; ++l) {
#ifdef REP_SYNC
#pragma unroll 1
        for (int rs_ = 0; rs_ < 10; ++rs_) { GSYNC(); }
#endif
#pragma unroll 1
        for (int f = 0; f < 2; ++f) {
            {   KA(); const bool first = (l == 0 && f == 0);
                const float* in_lat = first ? ka->in[0] : ka->out; const float* in_ctx = (const float*)(ws + WS_HC);
                norm_phase(in_lat, in_ctx, ka->in[f ? 8 : 6] + l * 1024, (const float*)(ws + WS_MOD) + (size_t)l * 3 * 9216, f ? 6 : 0, f ? 7 : 1, (bf16_t*)(ws + WS_XB), gw, ngw, lane,
                           (const float*)(ws + WS_O), first ? 0 : (f ? (l == 0 ? 4 : 0) : DFF / 256), (float*)(ws + WS_HC)); }
            GSYNC();
            TS(1);
            {   KA(); bf16_t* Wl = (bf16_t*)(ws + WS_WB) + (size_t)l * WL_TOTAL;
                const int Mr = (l == 1 && f == 1) ? NLAT : R;
                pg8::Gemm g{(bf16_t*)(ws + WS_XB), Wl + (f ? WL_UP2 : WL_UP1), Mr, 5632, 1024}; pg8::StaticOrder S; S.init(Mr, 5632, G, bid); EpiUp E{(bf16_t*)(ws + WS_Z)};
                pg8::gemm_phase<EpiUp, pg8::StaticOrder, true, true>(lds, g, S, E, tid); }
            GSYNC();
            TS(2);
            {   KA(); bf16_t* Wl = (bf16_t*)(ws + WS_WB) + (size_t)l * WL_TOTAL; const bool first = (l == 0 && f == 0);
                const float* in_lat = first ? ka->in[0] : ka->out;
                pg8::Gemm g{(bf16_t*)(ws + WS_Z), Wl + (f ? WL_DN2 : WL_DN1), NLAT, 1024, DFF}; pg8::StaticOrder S; S.init(NLAT, 1024, G, bid);
                EpiRes E{in_lat, (const float*)(ws + WS_HC), ka->out, (float*)(ws + WS_HC), (const float*)(ws + WS_MOD) + (size_t)l * 3 * 9216 + (f ? 8 : 2) * 1024, 0.5f};
                pg8::gemm_phase<EpiRes, pg8::StaticOrder, true, true>(lds, g, S, E, tid); }
            if (!(l == 1 && f == 1))
            {   KA(); bf16_t* Wl = (bf16_t*)(ws + WS_WB) + (size_t)l * WL_TOTAL;
                pg8::Gemm g{(bf16_t*)(ws + WS_Z) + (size_t)NLAT * DFF, Wl + (f ? WL_DN2 : WL_DN1), NCTX, 1024, 256, DFF}; SplitKOrder S; S.init(DFF / 256, 256, G, bid);
                EpiPart E{(float*)(ws + WS_O), (const float*)(ws + WS_MOD) + (size_t)l * 3 * 9216 + (f ? 8 : 2) * 1024, 0.5f};
                pg8::gemm_phase<EpiPart, SplitKOrder, true, true>(lds, g, S, E, tid); }
            GSYNC();
            TS(3);
            if (f == 1) break;
            {   KA();
                norm_phase(ka->out, (const float*)(ws + WS_HC), ka->in[7] + l * 1024, (const float*)(ws + WS_MOD) + (size_t)l * 3 * 9216, 3, 4, (bf16_t*)(ws + WS_XB), gw, ngw, lane,
                           (const float*)(ws + WS_O), DFF / 256, (float*)(ws + WS_HC)); }
            GSYNC();
            TS(1);
            {   KA(); bf16_t* Wl = (bf16_t*)(ws + WS_WB) + (size_t)l * WL_TOTAL;
                pg8::Gemm g{(bf16_t*)(ws + WS_XB), Wl + WL_IN, R, 3072, 1024}; pg8::StaticOrder S; S.init(R, 3072, G, bid);
                EpiWin E{ws + WS_Z, (const float*)(ws + WS_CS), (const float*)(ws + WS_LB) + l * 512, 0};
                pg8::gemm_phase<EpiWin, pg8::StaticOrder, true, true>(lds, g, S, E, tid); }
            GSYNC();
            TS(4);
            {   KA(); pool_phase((const bf16_t*)(ws + WS_Z + Z_ZP), (bf16_t*)(ws + WS_O + O_MX), gtid, ngt); }
#ifdef REP_ATTN
            for (int rep_ = 0; rep_ < 2; ++rep_)
#endif
            {   KA();
                const float* LAMV = (const float*)(ws + WS_LAM);
                const int nunits = 1024 + (l == 0 ? 16 : 0);
                for (int u = bid; u < nunits; u += G) {
                    int bh, qrow0, kt0, kt1;
                    if (u < 1024) { bh = u >> 7; qrow0 = (bh >> 2) * SEQ + (u & 127) * 128; kt0 = 0; kt1 = KEYS / 64; }
                    else { const int v = u - 1024; bh = v >> 1; qrow0 = NLAT + (bh >> 2) * CTXL + (v & 1) * 128; kt0 = SEQ / 64; kt1 = KEYS / 64; }
                    attn_unit(lds, (const bf16_t*)(ws + WS_Z + Z_Q), (const bf16_t*)(ws + WS_Z + Z_K), (const bf16_t*)(ws + WS_Z + Z_VT), (bf16_t*)(ws + WS_O + O_DA), ka->in[20] + l * 128,
                              bh >> 2, bh & 3, qrow0, kt0, kt1, LAMV[l * 2], LAMV[l * 2 + 1], tid, wave, lane);
                }
            }
            GSYNC();
            TS(5);
#ifdef REP_HG
#pragma unroll 1
            for (int rep_ = 0; rep_ < 2; ++rep_) {
#else
            {
#endif
            {   KA(); hg_passA_mfma(lds, (const float*)(ws + WS_Z + Z_FF), (const float*)(ws + WS_Z + Z_FB), (const bf16_t*)(ws + WS_Z + Z_HI),
                                      (float*)(ws + WS_CAR), (float*)(ws + WS_DK), wave, lane, G); }
            GSYNC();
            TS(6);
            {   KA(); hg_carry((float*)(ws + WS_CAR), (const float*)(ws + WS_DK), gtid, ngt); }
            GSYNC();
            TS(7);
            {   KA(); hg_passB_mfma(lds, (const float*)(ws + WS_Z + Z_HQ), (const float*)(ws + WS_Z + Z_FF), (const float*)(ws + WS_Z + Z_FB), (const bf16_t*)(ws + WS_Z + Z_HI),
                                      (const float*)(ws + WS_CAR), (bf16_t*)(ws + WS_Z + Z_K), wave, lane, G); }
            GSYNC();
            TS(8);
            {   KA(); hg_readout((const bf16_t*)(ws + WS_Z + Z_K), (const bf16_t*)(ws + WS_Z + Z_HG), ka->in[22] + l * 64, (bf16_t*)(ws + WS_O + O_HG), gw, ngw, lane); }
            GSYNC();
            TS(9);
            }
            {   KA(); bf16_t* Wl = (bf16_t*)(ws + WS_WB) + (size_t)l * WL_TOTAL;
                const int Mr = (l == 1) ? NLAT : R;
                pg8::Gemm g{(bf16_t*)(ws + WS_XB), Wl + WL_IN + (size_t)3072 * 1024, Mr, 3072, 1024}; pg8::StaticOrder S; S.init(Mr, 3072, G, bid); EpiG E{(bf16_t*)(ws + WS_Z)};
                pg8::gemm_phase<EpiG, pg8::StaticOrder, true, true>(lds, g, S, E, tid); }
            GSYNC();
            TS(10);
#pragma unroll 1
            for (int gi = 0; gi < 3; ++gi) {
                KA(); bf16_t* Wl = (bf16_t*)(ws + WS_WB) + (size_t)l * WL_TOTAL;
                const bf16_t* A = (const bf16_t*)(ws + WS_O + ((gi == 0) ? O_DA : (gi == 1 ? O_HG : O_MX))); const int K = (gi == 0) ? 512 : 256;
                const bf16_t* Bt = Wl + ((gi == 0) ? WL_PA : (gi == 1 ? WL_PH : WL_PP));
                const int Mr = (l == 1) ? NLAT : R;
                pg8::Gemm g{A, Bt, Mr, 1024, K}; pg8::StaticOrder S; S.init(Mr, 1024, G, bid); EpiProj E{(bf16_t*)(ws + WS_XB), (const bf16_t*)(ws + WS_Z), gi, gi == 0};
                pg8::gemm_phase<EpiProj, pg8::StaticOrder, true, true>(lds, g, S, E, tid);
            }
            GSYNC();
            TS(11);
            {   KA(); bf16_t* Wl = (bf16_t*)(ws + WS_WB) + (size_t)l * WL_TOTAL;
                pg8::Gemm g{(bf16_t*)(ws + WS_XB), Wl + WL_O, NLAT, 1024, 1024}; pg8::StaticOrder S; S.init(NLAT, 1024, G, bid);
                EpiRes E{ka->out, (const float*)(ws + WS_HC), ka->out, (float*)(ws + WS_HC), (const float*)(ws + WS_MOD) + (size_t)l * 3 * 9216 + 5 * 1024, 1.0f};
                pg8::gemm_phase<EpiRes, pg8::StaticOrder, true, true>(lds, g, S, E, tid); }
            if (l == 0)
            {   KA(); bf16_t* Wl = (bf16_t*)(ws + WS_WB) + (size_t)l * WL_TOTAL;
                pg8::Gemm g{(bf16_t*)(ws + WS_XB) + (size_t)NLAT * 1024, Wl + WL_O, NCTX, 1024, 256, 1024}; SplitKOrder S; S.init(4, 256, G, bid);
                EpiPart E{(float*)(ws + WS_O), (const float*)(ws + WS_MOD) + (size_t)l * 3 * 9216 + 5 * 1024, 1.0f};
                pg8::gemm_phase<EpiPart, SplitKOrder, true, true>(lds, g, S, E, tid); }
            GSYNC();
            TS(12);
        }
    }
    {   KA(); final_norm_phase(ka->out, ka->in[29], gw, ngw, lane); }
#ifdef PROBE_A
    GSYNC(); TS(1);
    if (blockIdx.x == 0) { KA(); const unsigned long long* tsb = (const unsigned long long*)(ws + WS_END);
        __syncthreads();
        const float va = (float)tsb[1 + PROBE_A] * 0.01f, vb = (float)tsb[1 + PROBE_B] * 0.01f;
        __syncthreads();
        if (tid == 0) ka->out[0] += va;
        for (int i = tid; i < 65536; i += NTHR) ka->out[(size_t)(i / 1024 + 8) * 1024 + (i & 1023)] += vb; }
#endif
}

extern "C" void kernel_launch(void* const* d_in, const int* in_sizes, int n_in, void* d_out, int out_size, void* d_ws, size_t ws_size, hipStream_t stream) {
    static int grid = 0;
    if (grid == 0) {
        if (n_in != 30 || out_size != NLAT * DM || ws_size < WS_TOTAL) { fprintf(stderr, "kernel_launch: unexpected shapes (n_in %d out %d ws %zu need %zu)\n", n_in, out_size, ws_size, (size_t)WS_TOTAL); grid = -1; return; }
        int dev = 0, cus = 0, per_cu = 0;
        (void)hipGetDevice(&dev);
        (void)hipDeviceGetAttribute(&cus, hipDeviceAttributeMultiprocessorCount, dev);
        if (hipFuncSetAttribute((const void*)fwd_kernel, hipFuncAttributeMaxDynamicSharedMemorySize, LDS_BYTES) != hipSuccess) { fprintf(stderr, "kernel_launch: hipFuncSetAttribute failed\n"); grid = -1; return; }
        if (hipOccupancyMaxActiveBlocksPerMultiprocessor(&per_cu, (const void*)fwd_kernel, NTHR, LDS_BYTES) != hipSuccess || per_cu < 1) { fprintf(stderr, "kernel_launch: occupancy query failed (%d)\n", per_cu); (void)hipGetLastError(); per_cu = 1; }
        if (per_cu > 1) per_cu = 1;
        grid = cus * per_cu;
    }
    if (grid < 0) return;
    if (hipMemsetAsync((unsigned char*)d_ws + WS_BAR, 0, (size_t)XCD_BAR_WORDS * 4, stream) != hipSuccess) { fprintf(stderr, "kernel_launch: memset failed\n"); return; }
    Args a{};
    for (int i = 0; i < 30; ++i) a.in[i] = (const float*)d_in[i];
    a.out = (float*)d_out; a.ws = (unsigned char*)d_ws;
    void* args[] = {&a};
    hipError_t e = hipLaunchCooperativeKernel((const void*)fwd_kernel, dim3(grid), dim3(NTHR), args, LDS_BYTES, stream);
    if (e != hipSuccess) fprintf(stderr, "cooperative launch failed: %s (grid %d)\n", hipGetErrorString(e), grid);
}
```

```cpp
#include <hip/hip_runtime.h>
#include <hip/hip_cooperative_groups.h>
#include <cstdio>
#include <cstdint>
namespace cg = cooperative_groups;
namespace pg8 {
#define PG8_LAS __attribute__((address_space(3)))
typedef unsigned short bf16_t;
typedef short bf16x8 __attribute__((ext_vector_type(8)));
typedef float f32x4 __attribute__((ext_vector_type(4)));
typedef unsigned u32x4 __attribute__((ext_vector_type(4)));
constexpr int BM = 256, BK = 64, HALF = 128, HTB = HALF * BK * 2  , STAGE_BYTES = 8 * HTB, NXCD = 8, WGM = 8;

__host__ __device__ __forceinline__ int lds_byte(int r, int c) { const int st = (r >> 4) * 2 + (c >> 5), rr = r & 15, cc = c & 31, ob = rr * 64 + cc * 2; return st * 1024 + (ob ^ (((ob >> 9) & 1) << 5)); }
__host__ __device__ __forceinline__ void stage_rc(int b, int& R, int& C) { const int st = b / 1024, sb = b % 1024, swz = sb ^ (((sb >> 9) & 1) << 5); R = (st >> 1) * 16 + swz / 64; C = (st & 1) * 32 + (swz % 64) / 2; }
__host__ __device__ __forceinline__ int perm32(int rho) { const int n = rho >> 4, i = rho & 15; return 8 * (i >> 2) + 4 * n + (i & 3); }

struct Unit { int pm, pn; int koff = 0; };
struct Gemm { const bf16_t* A; const bf16_t* Bt; int M, N, K; int ld = 0; };

struct StaticOrder {
    int nM, nN, nwg, G, c;
    __host__ __device__ void init(int M, int N, int G_, int c_) { nM = M / BM; nN = N / BM; nwg = nM * nN; G = G_; c = c_; }
    __host__ __device__ bool next(int i, Unit& u) const {
        const long L = (long)i * G + c; if (L >= nwg) return false;
        int wgid = (int)L; { const int q = nwg / NXCD, r = nwg % NXCD, xcd = wgid % NXCD, off = wgid / NXCD; wgid = (xcd < r ? xcd * (q + 1) : r * (q + 1) + (xcd - r) * q) + off; }
        const int nig = WGM * nN, gid = wgid / nig, fm = gid * WGM, gsz = (nM - fm) < WGM ? (nM - fm) : WGM;
        u.pm = fm + ((wgid % nig) % gsz); u.pn = (wgid % nig) / gsz; u.koff = 0; return true;
    }
    __device__ __forceinline__ void a_ready(const Unit&) const {}
    __device__ __forceinline__ void done(const Unit&) const {}
};

}
namespace pg8 {
template <class Epi, class Sched, bool ALIGN_EPI = false, bool SP2 = false>
__device__ __forceinline__ void gemm_phase(PG8_LAS unsigned char* lds, const Gemm g, const Sched& S, const Epi& E, int tid_in) {
    int tid_ = tid_in; asm volatile("" : "+v"(tid_)); const int tid = tid_, wid = __builtin_amdgcn_readfirstlane(tid >> 6), lane = tid & 63, wr = wid >> 2, wc = wid & 3, fr = lane & 15, fq = lane >> 4;
    const int K = g.ld ? g.ld : g.K, nt = g.K / BK;
    unsigned voffA[2], voffB[2];
#pragma unroll
    for (int i = 0; i < 2; ++i) { int R, C; stage_rc(tid * 16 + i * 8192, R, C); const int Rb = Epi::PERM ? ((R & ~31) + perm32(R & 31)) : R;
        voffA[i] = (unsigned)(R * K + C) * 2u; voffB[i] = (unsigned)(Rb * K + C) * 2u; }
    const size_t kstep = (size_t)(BK * 2);
    const size_t hstep = (size_t)HALF * K * 2;
    const size_t tstep = 2 * hstep;
    const unsigned ldsw = (unsigned)wid * 1024u;
    const int aoff = lds_byte(wr * 64 + fr, fq * 8), boff = lds_byte(wc * 32 + fr, fq * 8);
#define PG8_SA(b, h) (((b) * 2 + (h)) * HTB)
#define PG8_SB(b, h) ((4 + (b) * 2 + (h)) * HTB)
#define PG8_STAGE(bufoff, gbase, voff) do { _Pragma("unroll") for (int _i = 0; _i < 2; ++_i) \
        __builtin_amdgcn_global_load_lds((const unsigned*)((const char*)(gbase) + (voff)[_i]), (PG8_LAS unsigned*)(lds + (bufoff) + ldsw + _i * 8192), 16, 0, 0); } while (0)
#define PG8_LDA(dst, b, h) do { _Pragma("unroll") for (int m = 0; m < 4; ++m) _Pragma("unroll") for (int k = 0; k < 2; ++k) dst[m][k] = *(const PG8_LAS bf16x8*)(lds + PG8_SA(b, h) + aoff + m * 2048 + k * 1024); } while (0)
#define PG8_LDB(dst, b, h) do { _Pragma("unroll") for (int n = 0; n < 2; ++n) _Pragma("unroll") for (int k = 0; k < 2; ++k) dst[n][k] = *(const PG8_LAS bf16x8*)(lds + PG8_SB(b, h) + boff + n * 2048 + k * 1024); } while (0)
#define PG8_MMA(ai, bj, At, Bt) do { __builtin_amdgcn_s_setprio(1); _Pragma("unroll") for (int m = 0; m < 4; ++m) _Pragma("unroll") for (int n = 0; n < 2; ++n) _Pragma("unroll") for (int k = 0; k < 2; ++k) \
        acc[ai][bj][m][n] = __builtin_amdgcn_mfma_f32_16x16x32_bf16(Bt[n][k], At[m][k], acc[ai][bj][m][n], 0, 0, 0); __builtin_amdgcn_s_setprio(0); } while (0)
#define PG8_WAIT_V(n) asm volatile("s_waitcnt vmcnt(" #n ")" ::: "memory")
#define PG8_WAIT_L(n) asm volatile("s_waitcnt lgkmcnt(" #n ")" ::: "memory")
#define PG8_BAR __builtin_amdgcn_s_barrier()
#define PG8_SCHED __builtin_amdgcn_sched_barrier(0)
    Unit cur, nxt; int ui = 0;
    if (!S.next(0, cur)) return;
    f32x4 acc[2][2][4][2];
#pragma unroll
    for (int a = 0; a < 2; ++a)
#pragma unroll
        for (int b = 0; b < 2; ++b)
#pragma unroll
            for (int m = 0; m < 4; ++m)
#pragma unroll
                for (int n = 0; n < 2; ++n) acc[a][b][m][n] = (f32x4){0.f, 0.f, 0.f, 0.f};
    bf16x8 At[4][2], B0[2][2], B1[2][2];
    const char* cA = (const char*)g.A + (size_t)cur.pm * tstep + (size_t)cur.koff * 2; const char* cB = (const char*)g.Bt + (size_t)cur.pn * tstep + (size_t)cur.koff * 2;
    S.a_ready(cur);
    if constexpr (SP2) {
        PG8_STAGE(PG8_SB(0, 0), cB, voffB); PG8_STAGE(PG8_SB(0, 1), cB + hstep, voffB); PG8_STAGE(PG8_SA(0, 0), cA, voffA); PG8_STAGE(PG8_SA(0, 1), cA + hstep, voffA);
        if (wr == 1) PG8_BAR;
        PG8_WAIT_V(2); PG8_BAR;
        PG8_STAGE(PG8_SB(1, 0), cB + kstep, voffB); PG8_STAGE(PG8_SA(1, 0), cA + kstep, voffA); PG8_STAGE(PG8_SB(1, 1), cB + hstep + kstep, voffB);
        PG8_WAIT_V(6); PG8_BAR;
    } else {
        PG8_STAGE(PG8_SB(0, 0), cB, voffB); PG8_STAGE(PG8_SA(0, 0), cA, voffA); PG8_STAGE(PG8_SB(0, 1), cB + hstep, voffB); PG8_STAGE(PG8_SA(0, 1), cA + hstep, voffA);
        if (wr == 1) PG8_BAR;
        PG8_WAIT_V(4); PG8_BAR;
        PG8_STAGE(PG8_SB(1, 0), cB + kstep, voffB); PG8_STAGE(PG8_SA(1, 0), cA + kstep, voffA); PG8_STAGE(PG8_SB(1, 1), cB + hstep + kstep, voffB);
        PG8_WAIT_V(6); PG8_BAR;
    }
    for (;;) {
        const bool has_next = S.next(ui + 1, nxt);
        const char* nA = has_next ? (const char*)g.A + (size_t)nxt.pm * tstep + (size_t)nxt.koff * 2 : cA; const char* nB = has_next ? (const char*)g.Bt + (size_t)nxt.pn * tstep + (size_t)nxt.koff * 2 : cB;
        for (int t = 0; t < nt; t += 2) {
            const bool last = (t == nt - 2);
            const char* a1 = cA + (size_t)(t + 1) * kstep;
            const char* a2 = last ? nA : cA + (size_t)(t + 2) * kstep; const char* b2 = last ? nB : cB + (size_t)(t + 2) * kstep;
            const char* a3 = a2 + kstep; const char* b3 = b2 + kstep;
            if (last && has_next) S.a_ready(nxt);
            if constexpr (SP2) {
            PG8_LDB(B0, 0, 0); PG8_LDB(B1, 0, 1); PG8_SCHED; PG8_LDA(At, 0, 0); PG8_STAGE(PG8_SA(1, 1), a1 + hstep, voffA);
            PG8_WAIT_V(8); PG8_WAIT_L(0); PG8_BAR; PG8_MMA(0, 0, At, B0); PG8_MMA(0, 1, At, B1); PG8_BAR; PG8_SCHED;
            PG8_LDA(At, 0, 1); PG8_STAGE(PG8_SB(0, 0), b2, voffB); PG8_STAGE(PG8_SB(0, 1), b2 + hstep, voffB); PG8_STAGE(PG8_SA(0, 0), a2, voffA);
            PG8_WAIT_V(8); PG8_WAIT_L(0); PG8_BAR; PG8_MMA(1, 0, At, B0); PG8_MMA(1, 1, At, B1); PG8_BAR; PG8_SCHED;
            PG8_LDB(B0, 1, 0); PG8_LDB(B1, 1, 1); PG8_SCHED; PG8_LDA(At, 1, 0); PG8_STAGE(PG8_SA(0, 1), a2 + hstep, voffA);
            PG8_WAIT_V(8); PG8_WAIT_L(0); PG8_BAR; PG8_MMA(0, 0, At, B0); PG8_MMA(0, 1, At, B1); PG8_BAR; PG8_SCHED;
            PG8_LDA(At, 1, 1); PG8_STAGE(PG8_SB(1, 0), b3, voffB); PG8_STAGE(PG8_SB(1, 1), b3 + hstep, voffB); PG8_STAGE(PG8_SA(1, 0), a3, voffA);
            PG8_WAIT_V(8); PG8_WAIT_L(0); PG8_BAR; PG8_MMA(1, 0, At, B0); PG8_MMA(1, 1, At, B1); PG8_BAR; PG8_SCHED;
            } else {
            PG8_LDB(B0, 0, 0); PG8_SCHED; PG8_LDA(At, 0, 0); PG8_STAGE(PG8_SA(1, 1), a1 + hstep, voffA);
            PG8_WAIT_L(8); PG8_BAR; PG8_WAIT_L(0); PG8_MMA(0, 0, At, B0); PG8_BAR; PG8_SCHED;
            PG8_LDB(B1, 0, 1); PG8_STAGE(PG8_SB(0, 0), b2, voffB);
            PG8_BAR; PG8_WAIT_L(0); PG8_MMA(0, 1, At, B1); PG8_BAR;
            PG8_LDA(At, 0, 1); PG8_STAGE(PG8_SA(0, 0), a2, voffA);
            PG8_BAR; PG8_WAIT_L(0); PG8_MMA(1, 0, At, B0); PG8_BAR; PG8_SCHED;
            PG8_STAGE(PG8_SB(0, 1), b2 + hstep, voffB);
            PG8_WAIT_V(6); PG8_BAR; PG8_MMA(1, 1, At, B1); PG8_BAR;
            PG8_LDB(B0, 1, 0); PG8_SCHED; PG8_LDA(At, 1, 0); PG8_STAGE(PG8_SA(0, 1), a2 + hstep, voffA);
            PG8_WAIT_L(8); PG8_BAR; PG8_WAIT_L(0); PG8_MMA(0, 0, At, B0); PG8_BAR; PG8_SCHED;
            PG8_LDB(B1, 1, 1); PG8_STAGE(PG8_SB(1, 0), b3, voffB);
            PG8_BAR; PG8_WAIT_L(0); PG8_MMA(0, 1, At, B1); PG8_BAR;
            PG8_LDA(At, 1, 1); PG8_STAGE(PG8_SA(1, 0), a3, voffA);
            PG8_BAR; PG8_WAIT_L(0); PG8_MMA(1, 0, At, B0); PG8_BAR; PG8_SCHED;
            PG8_STAGE(PG8_SB(1, 1), b3 + hstep, voffB);
            PG8_WAIT_V(6); PG8_BAR; PG8_MMA(1, 1, At, B1); PG8_BAR;
            }
        }
        if constexpr (ALIGN_EPI) { if (wr == 0) PG8_BAR; }
        if constexpr (!Epi::AFTER_DRAIN) { E(acc, cur, wr, wc, fr, fq); S.done(cur); }
        if (!has_next) break;
#pragma unroll
        for (int a = 0; a < 2; ++a)
#pragma unroll
            for (int b = 0; b < 2; ++b)
#pragma unroll
                for (int m = 0; m < 4; ++m)
#pragma unroll
                    for (int n = 0; n < 2; ++n) acc[a][b][m][n] = (f32x4){0.f, 0.f, 0.f, 0.f};
        cur = nxt; cA = nA; cB = nB; ++ui;
        if constexpr (ALIGN_EPI) { if (wr == 1) PG8_BAR; }
    }
    PG8_WAIT_V(0);
    if constexpr (!ALIGN_EPI) { if (wr == 0) PG8_BAR; }
    PG8_BAR;
    if constexpr (Epi::AFTER_DRAIN) { E.fused(acc, cur, wr, wc, fr, fq, lds, wid, lane); S.done(cur); }
#undef PG8_SA
#undef PG8_SB
#undef PG8_STAGE
#undef PG8_LDA
#undef PG8_LDB
#undef PG8_MMA
#undef PG8_WAIT_V
#undef PG8_WAIT_L
#undef PG8_BAR
#undef PG8_SCHED
}
}

using pg8::bf16_t; using pg8::bf16x8; using pg8::f32x4; using pg8::u32x4; using pg8::Unit;
typedef float f32x16 __attribute__((ext_vector_type(16)));
typedef float f32x2v __attribute__((ext_vector_type(2)));
typedef __bf16 bf16x2v __attribute__((ext_vector_type(2)));
typedef unsigned u32x2 __attribute__((ext_vector_type(2)));
#define LAS __attribute__((address_space(3)))

constexpr int DM = 1024, NBATCH = 2, SEQ = 16384, CTXL = 256;
constexpr int NLAT = NBATCH * SEQ, NCTX = NBATCH * CTXL, R = NLAT + NCTX;
constexpr int DFF = 2816, KEYS = SEQ + CTXL;
constexpr float EPS = 1e-6f;
constexpr float C2 = 0.125f * 1.4426950408889634f;
constexpr int NTHR = 512;
constexpr int LDS_BYTES = 135168;
constexpr int HG_SEG = 128, HG_STEPS = KEYS / HG_SEG;

constexpr size_t WL_UP1 = 0, WL_DN1 = WL_UP1 + (size_t)5632 * 1024, WL_UP2 = WL_DN1 + (size_t)1024 * 2816, WL_DN2 = WL_UP2 + (size_t)5632 * 1024,
                 WL_IN = WL_DN2 + (size_t)1024 * 2816, WL_PA = WL_IN + (size_t)6144 * 1024, WL_PH = WL_PA + (size_t)1024 * 512, WL_PP = WL_PH + (size_t)1024 * 256,
                 WL_O = WL_PP + (size_t)1024 * 256, WL_TOTAL = WL_O + (size_t)1024 * 1024;
constexpr size_t WS_WB = 0;
constexpr size_t WS_XB = WS_WB + 2 * WL_TOTAL * 2;
constexpr size_t WS_Z = WS_XB + (size_t)R * 1024 * 2;
constexpr size_t Z_VT = 0, Z_HQ = Z_VT + (size_t)R * 512 * 2, Z_FF = Z_HQ + (size_t)R * 256 * 4, Z_FB = Z_FF + (size_t)R * 256 * 4, Z_HI = Z_FB + (size_t)R * 256 * 4,
                 Z_ZP = Z_HI + (size_t)R * 256 * 2, Z_Q = Z_ZP + (size_t)R * 256 * 2, Z_K = Z_Q + (size_t)R * 512 * 2, Z_HG = Z_K + (size_t)R * 512 * 2, Z_END = Z_HG + (size_t)R * 256 * 2;
static_assert((size_t)R * 3072 * 2 <= Z_K, "gate buffer must not reach k / odir / hgate");
static_assert((size_t)R * DFF * 2 <= Z_END, "act fits Z");
constexpr size_t WS_O = WS_Z + Z_END;
constexpr size_t O_DA = 0, O_HG = O_DA + (size_t)R * 512 * 2, O_MX = O_HG + (size_t)R * 256 * 2, O_END = O_MX + (size_t)R * 256 * 2;
constexpr size_t WS_CAR = WS_O + O_END;
constexpr size_t WS_DK = WS_CAR + (size_t)16 * HG_SEG * 4096 * 4;
constexpr size_t WS_HC = WS_DK + (size_t)16 * HG_SEG * 64 * 4;
constexpr size_t WS_MOD = WS_HC + (size_t)NCTX * 1024 * 4;
constexpr size_t WS_CS = WS_MOD + (size_t)2 * 3 * 9216 * 4;
constexpr size_t WS_LB = WS_CS + (size_t)256 * 32 * 4;
constexpr size_t WS_LAM = WS_LB + (size_t)2 * 2 * 256 * 4;
constexpr size_t WS_END = WS_LAM + 256;
static_assert(WS_END <= (size_t)512 * 1024 * 1024, "workspace");

__device__ __forceinline__ unsigned pk2(float lo, float hi) { f32x2v v = {lo, hi}; bf16x2v b = __builtin_convertvector(v, bf16x2v); return __builtin_bit_cast(unsigned, b); }
__device__ __forceinline__ float bf2f(unsigned short u) { return __builtin_bit_cast(float, (unsigned)u << 16); }
__device__ __forceinline__ float bflo(unsigned u) { return __builtin_bit_cast(float, u << 16); }
__device__ __forceinline__ float bfhi(unsigned u) { return __builtin_bit_cast(float, u & 0xffff0000u); }
__device__ __forceinline__ float ex2(float x) { return __builtin_amdgcn_exp2f(x); }
__device__ __forceinline__ float rcpf_(float x) { return __builtin_amdgcn_rcpf(x); }
__device__ __forceinline__ float sigm(float x) { return rcpf_(1.f + ex2(-1.4426950408889634f * x)); }
__device__ __forceinline__ float siluf(float x) { return x * sigm(x); }
__device__ __forceinline__ float shx(float v, int o, int lane) { return __builtin_bit_cast(float, __builtin_amdgcn_ds_bpermute((lane ^ o) << 2, __builtin_bit_cast(int, v))); }
__device__ __forceinline__ float swap32(float v) { auto rr = __builtin_amdgcn_permlane32_swap(__builtin_bit_cast(unsigned, v), __builtin_bit_cast(unsigned, v), false, false);
    const float a = __builtin_bit_cast(float, rr[0]), b = __builtin_bit_cast(float, rr[1]); return (a == v) ? b : a; }
__device__ __forceinline__ float wave_sum(float v, int lane) {
#pragma unroll
    for (int o = 1; o < 64; o <<= 1) v += shx(v, o, lane);
    return v;
}
#define LDS_WAIT() asm volatile("s_waitcnt lgkmcnt(0)" ::: "memory")

struct EpiUp {
    static constexpr bool PERM = true, AFTER_DRAIN = false;
    bf16_t* act;
    __device__ __forceinline__ void operator()(const f32x4 (&acc)[2][2][4][2], const Unit& u, int wr, int wc, int fr, int fq) const {
        const int row0 = u.pm * 256 + wr * 64 + fr, col0 = u.pn * 128 + wc * 32 + 8 * fq;
#pragma unroll
        for (int ai = 0; ai < 2; ++ai)
#pragma unroll
            for (int m = 0; m < 4; ++m) {
                const int row = row0 + ai * 128 + m * 16;
                const f32x4 a0 = acc[ai][0][m][0], a1 = acc[ai][0][m][1], b0 = acc[ai][1][m][0], b1 = acc[ai][1][m][1];
                u32x4 w;
                w.x = pk2(siluf(a0[0]) * b0[0], siluf(a0[1]) * b0[1]); w.y = pk2(siluf(a0[2]) * b0[2], siluf(a0[3]) * b0[3]);
                w.z = pk2(siluf(a1[0]) * b1[0], siluf(a1[1]) * b1[1]); w.w = pk2(siluf(a1[2]) * b1[2], siluf(a1[3]) * b1[3]);
                *(u32x4*)(act + (size_t)row * DFF + col0) = w;
            }
    }
};
struct EpiRes {
    static constexpr bool PERM = true, AFTER_DRAIN = false;
    const float* in_lat; const float* in_ctx; float* out_lat; float* out_ctx; const float* gate; float coef;
    __device__ __forceinline__ void operator()(const f32x4 (&acc)[2][2][4][2], const Unit& u, int wr, int wc, int fr, int fq) const {
        const int row0 = u.pm * 256 + wr * 64 + fr, col0 = u.pn * 256 + wc * 32 + 8 * fq;
        const int seg = (u.pm < 64) ? 0 : (u.pm < 128 ? 1 : 2);
        f32x4 gv[2][2];
#pragma unroll
        for (int bj = 0; bj < 2; ++bj)
#pragma unroll
            for (int n = 0; n < 2; ++n) gv[bj][n] = *(const f32x4*)(gate + seg * 9216 + col0 + bj * 128 + 4 * n) * coef;
#pragma unroll
        for (int ai = 0; ai < 2; ++ai)
#pragma unroll
            for (int m = 0; m < 4; ++m) {
                const int row = row0 + ai * 128 + m * 16;
                const float* ip; float* op;
                if (row < NLAT) { ip = in_lat + (size_t)row * DM; op = out_lat + (size_t)row * DM; }
                else { ip = in_ctx + (size_t)(row - NLAT) * DM; op = out_ctx + (size_t)(row - NLAT) * DM; }
#pragma unroll
                for (int bj = 0; bj < 2; ++bj)
#pragma unroll
                    for (int n = 0; n < 2; ++n) {
                        const int c = col0 + bj * 128 + 4 * n;
                        f32x4 v = *(const f32x4*)(ip + c);
                        v = v + gv[bj][n] * acc[ai][bj][m][n];
                        *(f32x4*)(op + c) = v;
                    }
            }
    }
};
struct SplitKOrder {
    int nunits, G, c, kc;
    __device__ void init(int nparts, int kc_, int G_, int c_) { nunits = nparts * 8; G = G_; c = c_; kc = kc_; }
    __device__ bool next(int i, Unit& u) const {
        const int L = i * G + c; if (L >= nunits) return false;
        const int part = L >> 3, r = L & 7; u.pm = r >> 2; u.pn = r & 3; u.koff = part * kc; return true;
    }
    __device__ __forceinline__ void a_ready(const Unit&) const {}
    __device__ __forceinline__ void done(const Unit&) const {}
};
struct EpiPart {
    static constexpr bool PERM = true, AFTER_DRAIN = false;
    float* P; const float* gate; float coef;
    __device__ __forceinline__ void operator()(const f32x4 (&acc)[2][2][4][2], const Unit& u, int wr, int wc, int fr, int fq) const {
        unsigned z_ = 0u; asm volatile("" : "+s"(z_));
        const int lane_ = (int)__builtin_amdgcn_mbcnt_hi(~0u, __builtin_amdgcn_mbcnt_lo(~0u, z_)), fr_ = lane_ & 15, fq_ = lane_ >> 4;
        const int row0 = u.pm * 256 + wr * 64 + fr_, col0 = u.pn * 256 + wc * 32 + 8 * fq_;
        float* Pp = P + (size_t)(u.koff >> 8) * NCTX * DM;
        f32x4 gv[2][2];
#pragma unroll
        for (int bj = 0; bj < 2; ++bj)
#pragma unroll
            for (int n = 0; n < 2; ++n) gv[bj][n] = *(const f32x4*)(gate + 2 * 9216 + col0 + bj * 128 + 4 * n) * coef;
#pragma unroll
        for (int ai = 0; ai < 2; ++ai)
#pragma unroll
            for (int m = 0; m < 4; ++m) {
                float* op = Pp + (size_t)(row0 + ai * 128 + m * 16) * DM;
#pragma unroll
                for (int bj = 0; bj < 2; ++bj)
#pragma unroll
                    for (int n = 0; n < 2; ++n) *(f32x4*)(op + col0 + bj * 128 + 4 * n) = gv[bj][n] * acc[ai][bj][m][n];
            }
    }
};
struct EpiWin {
    static constexpr bool PERM = true, AFTER_DRAIN = false;
    unsigned char* Z; const float* cs; const float* lb; int pn_off;
    __device__ __forceinline__ void operator()(const f32x4 (&acc)[2][2][4][2], const Unit& u, int wr, int wc, int fr, int fq) const {
        const int t = u.pn + pn_off;
        const int row0 = u.pm * 256 + wr * 64 + fr, cin = wc * 32 + 8 * fq;
        if (t < 4) {
            bf16_t* dst = (bf16_t*)(Z + ((t < 2) ? Z_Q : Z_K)); const float sc = (t < 2) ? C2 : 1.f; const int cb = (t & 1) * 256;
#pragma unroll
            for (int ai = 0; ai < 2; ++ai)
#pragma unroll
                for (int m = 0; m < 4; ++m) {
                    const int row = row0 + ai * 128 + m * 16;
                    f32x4 cv = {1.f, 1.f, 1.f, 1.f}, sv = {0.f, 0.f, 0.f, 0.f};
                    if (row < NLAT) { const int ts = row & (SEQ - 1); const int pos = (wc & 1) ? (ts & 63) : (ts >> 6);
                        cv = *(const f32x4*)(cs + pos * 32 + 4 * fq); sv = *(const f32x4*)(cs + pos * 32 + 16 + 4 * fq); }
#pragma unroll
                    for (int bj = 0; bj < 2; ++bj) {
                        const f32x4 x1 = acc[ai][bj][m][0], x2 = acc[ai][bj][m][1];
                        const f32x4 o1 = (x1 * cv - x2 * sv) * sc, o2 = (x1 * sv + x2 * cv) * sc;
                        u32x4 w; w.x = pk2(o1[0], o1[1]); w.y = pk2(o1[2], o1[3]); w.z = pk2(o2[0], o2[1]); w.w = pk2(o2[2], o2[3]);
                        *(u32x4*)(dst + (size_t)row * 512 + cb + bj * 128 + cin) = w;
                    }
                }
        } else if (t < 6) {
            bf16_t* vT = (bf16_t*)(Z + Z_VT);
#pragma unroll
            for (int ai = 0; ai < 2; ++ai)
#pragma unroll
                for (int m = 0; m < 4; ++m) {
                    const int row = row0 + ai * 128 + m * 16;
                    int b, key;
                    if (row < NLAT) { b = row >> 14; key = row & (SEQ - 1); } else { b = (row - NLAT) >> 8; key = SEQ + ((row - NLAT) & (CTXL - 1)); }
                    key = (key & ~15) + (key & 3) + ((key >> 3) & 1) * 4 + ((key >> 2) & 1) * 8;
#pragma unroll
                    for (int bj = 0; bj < 2; ++bj) {
                        bf16_t* dp = vT + (size_t)(b * 512 + (t - 4) * 256 + bj * 128 + cin) * KEYS + key;
#pragma unroll
                        for (int n = 0; n < 2; ++n)
#pragma unroll
                            for (int i = 0; i < 4; i += 2) {
                                const unsigned w = pk2(acc[ai][bj][m][n][i], acc[ai][bj][m][n][i + 1]);
                                dp[(size_t)(4 * n + i) * KEYS] = (bf16_t)(w & 0xffffu); dp[(size_t)(4 * n + i + 1) * KEYS] = (bf16_t)(w >> 16);
                            }
                    }
                }
        } else if (t <= 8) {
            float* dst = (float*)(Z + ((t == 6) ? Z_HQ : (t == 7 ? Z_FF : Z_FB)));
            const float* lbp = lb + ((t == 8) ? 256 : 0);
#pragma unroll
            for (int bj = 0; bj < 2; ++bj)
#pragma unroll
                for (int n = 0; n < 2; ++n) {
                    f32x4 lbv = *(const f32x4*)(lbp + bj * 128 + cin + 4 * n);
                    f32x4 om = 1.f - lbv;
#pragma unroll
                    for (int ai = 0; ai < 2; ++ai)
#pragma unroll
                        for (int m = 0; m < 4; ++m) {
                            const int row = row0 + ai * 128 + m * 16;
                            const f32x4 z = acc[ai][bj][m][n];
                            f32x4 sg; sg[0] = sigm(z[0]); sg[1] = sigm(z[1]); sg[2] = sigm(z[2]); sg[3] = sigm(z[3]);
                            const f32x4 o = (t == 6) ? z * sg : lbv + om * sg;
                            *(f32x4*)(dst + (size_t)row * 256 + bj * 128 + cin + 4 * n) = o;
                        }
                }
        } else {
            bf16_t* dst = (bf16_t*)(Z + ((t == 9) ? Z_HI : (t == 10 ? Z_HG : Z_ZP)));
#pragma unroll
            for (int ai = 0; ai < 2; ++ai)
#pragma unroll
                for (int m = 0; m < 4; ++m) {
                    const int row = row0 + ai * 128 + m * 16;
#pragma unroll
                    for (int bj = 0; bj < 2; ++bj) {
                        f32x4 v0 = acc[ai][bj][m][0], v1 = acc[ai][bj][m][1];
                        if (t == 10) { v0[0] = siluf(v0[0]); v0[1] = siluf(v0[1]); v0[2] = siluf(v0[2]); v0[3] = siluf(v0[3]); v1[0] = siluf(v1[0]); v1[1] = siluf(v1[1]); v1[2] = siluf(v1[2]); v1[3] = siluf(v1[3]); }
                        u32x4 w; w.x = pk2(v0[0], v0[1]); w.y = pk2(v0[2], v0[3]); w.z = pk2(v1[0], v1[1]); w.w = pk2(v1[2], v1[3]);
                        *(u32x4*)(dst + (size_t)row * 256 + bj * 128 + cin) = w;
                    }
                }
        }
    }
};
struct EpiVT {
    static constexpr bool PERM = true, AFTER_DRAIN = false;
    bf16_t* vT;
    __device__ __forceinline__ void operator()(const f32x4 (&acc)[2][2][4][2], const Unit& u, int wr, int wc, int fr, int fq) const {
        const int e0 = u.pm * 256 + wr * 64 + fr;
        int b, key0;
        if (u.pn < 64) { b = 0; key0 = u.pn * 256; } else if (u.pn < 128) { b = 1; key0 = (u.pn - 64) * 256; } else { b = u.pn - 128; key0 = SEQ; }
        const int kc = key0 + wc * 32 + 8 * fq;
#pragma unroll
        for (int ai = 0; ai < 2; ++ai)
#pragma unroll
            for (int m = 0; m < 4; ++m) {
                const int e = e0 + ai * 128 + m * 16;
#pragma unroll
                for (int bj = 0; bj < 2; ++bj) {
                    const f32x4 v0 = acc[ai][bj][m][0], v1 = acc[ai][bj][m][1];
                    u32x4 w; w.x = pk2(v0[0], v0[1]); w.y = pk2(v0[2], v0[3]); w.z = pk2(v1[0], v1[1]); w.w = pk2(v1[2], v1[3]);
                    *(u32x4*)(vT + (size_t)(b * 512 + e) * KEYS + kc + bj * 128) = w;
                }
            }
    }
};
struct EpiG {
    static constexpr bool PERM = true, AFTER_DRAIN = false;
    bf16_t* G;
    __device__ __forceinline__ void operator()(const f32x4 (&acc)[2][2][4][2], const Unit& u, int wr, int wc, int fr, int fq) const {
        const int row0 = u.pm * 256 + wr * 64 + fr, col0 = u.pn * 256 + wc * 32 + 8 * fq;
#pragma unroll
        for (int ai = 0; ai < 2; ++ai)
#pragma unroll
            for (int m = 0; m < 4; ++m) {
                const int row = row0 + ai * 128 + m * 16;
#pragma unroll
                for (int bj = 0; bj < 2; ++bj) {
                    const f32x4 v0 = acc[ai][bj][m][0], v1 = acc[ai][bj][m][1];
                    u32x4 w; w.x = pk2(sigm(v0[0]), sigm(v0[1])); w.y = pk2(sigm(v0[2]), sigm(v0[3])); w.z = pk2(sigm(v1[0]), sigm(v1[1])); w.w = pk2(sigm(v1[2]), sigm(v1[3]));
                    *(u32x4*)(G + (size_t)row * 3072 + col0 + bj * 128) = w;
                }
            }
    }
};
struct EpiProj {
    static constexpr bool PERM = true, AFTER_DRAIN = false;
    bf16_t* y; const bf16_t* G; int gi; int first;
    __device__ __forceinline__ void operator()(const f32x4 (&acc)[2][2][4][2], const Unit& u, int wr, int wc, int fr, int fq) const {
        const int row0 = u.pm * 256 + wr * 64 + fr, col0 = u.pn * 256 + wc * 32 + 8 * fq;
#pragma unroll
        for (int ai = 0; ai < 2; ++ai)
#pragma unroll
            for (int m = 0; m < 4; ++m) {
                const int row = row0 + ai * 128 + m * 16;
#pragma unroll
                for (int bj = 0; bj < 2; ++bj) {
                    const int c = col0 + bj * 128;
                    const u32x4 g = *(const u32x4*)(G + (size_t)row * 3072 + gi * 1024 + c);
                    u32x4 yo = {0u, 0u, 0u, 0u};
                    if (!first) yo = *(const u32x4*)(y + (size_t)row * 1024 + c);
                    const f32x4 v0 = acc[ai][bj][m][0], v1 = acc[ai][bj][m][1];
                    u32x4 w;
                    w.x = pk2(bflo(yo.x) + bflo(g.x) * v0[0], bfhi(yo.x) + bfhi(g.x) * v0[1]);
                    w.y = pk2(bflo(yo.y) + bflo(g.y) * v0[2], bfhi(yo.y) + bfhi(g.y) * v0[3]);
                    w.z = pk2(bflo(yo.z) + bflo(g.z) * v1[0], bfhi(yo.z) + bfhi(g.z) * v1[1]);
                    w.w = pk2(bflo(yo.w) + bflo(g.w) * v1[2], bfhi(yo.w) + bfhi(g.w) * v1[3]);
                    *(u32x4*)(y + (size_t)row * 1024 + c) = w;
                }
            }
    }
};

__device__ __forceinline__ int map_row(int mode, int n) {
    if (mode == 1) return 256 * (n >> 7) + (n & 127);
    if (mode == 2) return 256 * (n >> 7) + 128 + (n & 127);
    if (mode == 3) return (n < 1024) ? ((n & ~31) + 8 * ((n & 15) >> 2) + 4 * ((n >> 4) & 1) + (n & 3)) : n;
    return n;
}
__device__ __forceinline__ void transpose_item(const float* W, int K, int N, bf16_t* WT, int mode, LAS float* scr, int item, int lane) {
    const int nblk = N / 32, kb = item / nblk, nb = item % nblk, k0 = 64 * kb, n0 = 32 * nb;
#pragma unroll 8
    for (int i = 0; i < 32; ++i) { const int kk = 2 * i + (lane >> 5); scr[kk * 33 + (lane & 31)] = W[(size_t)(k0 + kk) * N + n0 + (lane & 31)]; }
    LDS_WAIT(); asm volatile("" ::: "memory");
    const int c = lane & 7;
#pragma unroll
    for (int j = 0; j < 4; ++j) { const int n = (lane >> 3) + 8 * j; const LAS float* s = scr + (8 * c) * 33 + n;
        u32x4 o; o.x = pk2(s[0 * 33], s[1 * 33]); o.y = pk2(s[2 * 33], s[3 * 33]); o.z = pk2(s[4 * 33], s[5 * 33]); o.w = pk2(s[6 * 33], s[7 * 33]);
        *(u32x4*)(WT + (size_t)map_row(mode, n0 + n) * K + k0 + 8 * c) = o; }
    LDS_WAIT(); asm volatile("" ::: "memory");
}

__device__ __forceinline__ void norm_phase(const float* in_lat, const float* in_ctx, const float* gain, const float* modl, int shi, int sci, bf16_t* outp, int gw, int ngw, int lane,
                                           const float* part, int nparts, float* hc_out) {
    f32x4 gv[4];
#pragma unroll
    for (int j = 0; j < 4; ++j) gv[j] = *(const f32x4*)(gain + 4 * lane + 256 * j);
    for (int row = gw; row < R; row += ngw) {
        const float* ip = (row < NLAT) ? in_lat + (size_t)row * DM : in_ctx + (size_t)(row - NLAT) * DM;
        const int seg = (row < SEQ) ? 0 : (row < NLAT ? 1 : 2);
        const float* sh = modl + seg * 9216 + shi * 1024; const float* sc = modl + seg * 9216 + sci * 1024;
        f32x4 v[4]; float ss = 0.f;
#pragma unroll
        for (int j = 0; j < 4; ++j) v[j] = *(const f32x4*)(ip + 4 * lane + 256 * j);
        if (row >= NLAT && nparts > 0) {
            for (int p = 0; p < nparts; ++p) {
                const float* pp = part + ((size_t)p * NCTX + (row - NLAT)) * DM;
#pragma unroll
                for (int j = 0; j < 4; ++j) v[j] = v[j] + *(const f32x4*)(pp + 4 * lane + 256 * j);
            }
#pragma unroll
            for (int j = 0; j < 4; ++j) *(f32x4*)(hc_out + (size_t)(row - NLAT) * DM + 4 * lane + 256 * j) = v[j];
        }
#pragma unroll
        for (int j = 0; j < 4; ++j) ss += (v[j][0] * v[j][0] + v[j][1] * v[j][1]) + (v[j][2] * v[j][2] + v[j][3] * v[j][3]);
        ss = wave_sum(ss, lane);
        const float rstd = 1.0f / sqrtf(ss * (1.f / DM) + EPS);
#pragma unroll
        for (int j = 0; j < 4; ++j) {
            const f32x4 s4 = *(const f32x4*)(sc + 4 * lane + 256 * j), h4 = *(const f32x4*)(sh + 4 * lane + 256 * j);
            const f32x4 y = v[j] * rstd * gv[j] * (s4 + 1.f) + h4;
            u32x2 w; w.x = pk2(y[0], y[1]); w.y = pk2(y[2], y[3]);
            *(u32x2*)(outp + (size_t)row * DM + 4 * lane + 256 * j) = w;
        }
    }
}
__device__ __forceinline__ void final_norm_phase(float* out, const float* gain, int gw, int ngw, int lane) {
    f32x4 gv[4];
#pragma unroll
    for (int j = 0; j < 4; ++j) gv[j] = *(const f32x4*)(gain + 4 * lane + 256 * j);
    for (int row = gw; row < NLAT; row += ngw) {
        float* ip = out + (size_t)row * DM;
        f32x4 v[4]; float ss = 0.f;
#pragma unroll
        for (int j = 0; j < 4; ++j) { v[j] = *(const f32x4*)(ip + 4 * lane + 256 * j); ss += (v[j][0] * v[j][0] + v[j][1] * v[j][1]) + (v[j][2] * v[j][2] + v[j][3] * v[j][3]); }
        ss = wave_sum(ss, lane);
        const float rstd = 1.0f / sqrtf(ss * (1.f / DM) + EPS);
#pragma unroll
        for (int j = 0; j < 4; ++j) *(f32x4*)(ip + 4 * lane + 256 * j) = v[j] * rstd * gv[j];
    }
}
__device__ __forceinline__ void pool_phase(const bf16_t* zp, bf16_t* mx, int gtid, int ngt) {
    for (int it = gtid; it < R * 32; it += ngt) {
        const int row = it >> 5, ch = (it & 31) * 8, g = ch >> 6, hw = 1 << g;
        int base, n;
        if (row < NLAT) { base = row & ~(SEQ - 1); n = SEQ; } else { base = NLAT + ((row - NLAT) & ~(CTXL - 1)); n = CTXL; }
        const int t = row - base, lo = (t - hw > 0) ? t - hw : 0, hi = (t + hw < n) ? t + hw : n;
        float s[8];
#pragma unroll
        for (int i = 0; i < 8; ++i) s[i] = 0.f;
        for (int j = lo; j < hi; ++j) {
            const u32x4 v = *(const u32x4*)(zp + (size_t)(base + j) * 256 + ch);
            s[0] += bflo(v.x); s[1] += bfhi(v.x); s[2] += bflo(v.y); s[3] += bfhi(v.y); s[4] += bflo(v.z); s[5] += bfhi(v.z); s[6] += bflo(v.w); s[7] += bfhi(v.w);
        }
        const float inv = 1.f / (float)(hi - lo);
        const u32x4 c = *(const u32x4*)(zp + (size_t)row * 256 + ch);
        u32x4 w;
        w.x = pk2(s[0] * inv - bflo(c.x), s[1] * inv - bfhi(c.x)); w.y = pk2(s[2] * inv - bflo(c.y), s[3] * inv - bfhi(c.y));
        w.z = pk2(s[4] * inv - bflo(c.z), s[5] * inv - bfhi(c.z)); w.w = pk2(s[6] * inv - bflo(c.w), s[7] * inv - bfhi(c.w));
        *(u32x4*)(mx + (size_t)row * 256 + ch) = w;
    }
}

__device__ __forceinline__ int hg_row(int dir, int b, int step) {
    if (step < CTXL) { const int t = dir ? (CTXL - 1 - step) : step; return NLAT + b * CTXL + t; }
    int t = step - CTXL; if (dir) t = SEQ - 1 - t; return b * SEQ + t;
}
template <bool OUT>
__device__ __forceinline__ void hg_pass(const float* hq, const float* ff, const float* fb, const bf16_t* hi, float* carry, float* dk, bf16_t* odir, int wave, int lane, int G) {
    for (int item = blockIdx.x + G * wave; item < 16 * HG_SEG; item += G * 8) {
        const int s = item / HG_SEG, j = item % HG_SEG, dir = s >> 3, b = (s >> 2) & 1, h = s & 3;
        const float* fbase = dir ? fb : ff;
        f32x2v S[32];
#pragma unroll
        for (int k = 0; k < 32; ++k) { S[k][0] = OUT ? carry[((size_t)item * 64 + 2 * k) * 64 + lane] : 0.f; S[k][1] = OUT ? carry[((size_t)item * 64 + 2 * k + 1) * 64 + lane] : 0.f; }
        float dl = 1.f;
        const int st0 = j * HG_STEPS, st1 = st0 + HG_STEPS;
        constexpr int HG_PF = 8;
        float ivb[HG_PF], fvb[HG_PF], qvb[HG_PF];
#pragma unroll
        for (int u = 0; u < HG_PF; ++u) {
            const int stl = (st0 + u < st1) ? st0 + u : st1 - 1;
            const size_t off = (size_t)hg_row(dir, b, stl) * 256 + h * 64 + lane;
            ivb[u] = bf2f(hi[off]); fvb[u] = fbase[off]; qvb[u] = OUT ? hq[off] : 0.f;
        }
        for (int sb = st0; sb < st1; sb += HG_PF) {
#pragma unroll
            for (int u = 0; u < HG_PF; ++u) {
                const int st = sb + u;
                if (st < st1) {
                    const float iv = ivb[u], fv = fvb[u], qv = qvb[u];
                    const size_t offc = (size_t)hg_row(dir, b, st) * 256 + h * 64 + lane;
                    { const int stn = (st + HG_PF < st1) ? st + HG_PF : st1 - 1;
                      const size_t off = (size_t)hg_row(dir, b, stn) * 256 + h * 64 + lane;
                      ivb[u] = bf2f(hi[off]); fvb[u] = fbase[off]; if (OUT) qvb[u] = hq[off]; }
                    if (!OUT) dl *= fv;
                    f32x2v o2 = {0.f, 0.f};
                    const f32x2v iv2 = {iv, iv};
                    const int fvi = __builtin_bit_cast(int, fv), qvi = __builtin_bit_cast(int, qv);
#pragma unroll
                    for (int k = 0; k < 32; ++k) {
                        f32x2v f2; f2[0] = __builtin_bit_cast(float, __builtin_amdgcn_readlane(fvi, 2 * k)); f2[1] = __builtin_bit_cast(float, __builtin_amdgcn_readlane(fvi, 2 * k + 1));
                        const f32x2v d2 = S[k] - iv2;
                        S[k] = __builtin_elementwise_fma(f2, d2, iv2);
                        if (OUT) { f32x2v q2; q2[0] = __builtin_bit_cast(float, __builtin_amdgcn_readlane(qvi, 2 * k)); q2[1] = __builtin_bit_cast(float, __builtin_amdgcn_readlane(qvi, 2 * k + 1));
                            o2 = __builtin_elementwise_fma(q2, S[k], o2); }
                    }
                    if (OUT) odir[(size_t)dir * R * 256 + offc] = (bf16_t)(pk2(o2[0] + o2[1], 0.f) & 0xffffu);
                }
            }
        }
        if (!OUT) {
#pragma unroll
            for (int k = 0; k < 32; ++k) { carry[((size_t)item * 64 + 2 * k) * 64 + lane] = S[k][0]; carry[((size_t)item * 64 + 2 * k + 1) * 64 + lane] = S[k][1]; }
            dk[item * 64 + lane] = dl;
        }
    }
}
constexpr int HGA_T = 48, HGA_STR = 112, HGA_MAT = 64 * HGA_STR, HGA_WAVE = 2 * HGA_MAT;
static_assert(8 * HGA_WAVE <= LDS_BYTES - 64 && 3 * HGA_T >= HG_STEPS, "hg pass A LDS");
__device__ __forceinline__ void hg_passA_mfma(LAS unsigned char* lds, const float* ff, const float* fb, const bf16_t* hi, float* carry, float* dk, int wave, int lane, int G) {
    LAS unsigned char* KT = lds + wave * HGA_WAVE; LAS unsigned char* VT = KT + HGA_MAT;
    const int n = lane & 31, gq = lane >> 5;
    for (int item = blockIdx.x + G * wave; item < 16 * HG_SEG; item += G * 8) {
        const int s = item / HG_SEG, j = item % HG_SEG, dir = s >> 3, b = (s >> 2) & 1, h = s & 3;
        const float* fbase = dir ? fb : ff;
        const int st0 = j * HG_STEPS, st1 = st0 + HG_STEPS;
        f32x16 acc[2][2];
#pragma unroll
        for (int kb = 0; kb < 2; ++kb)
#pragma unroll
            for (int vb = 0; vb < 2; ++vb)
#pragma unroll
                for (int r = 0; r < 16; ++r) acc[kb][vb][r] = 0.f;
        float P = 1.f;
        for (int third = 2; third >= 0; --third) {
            const int sb = st0 + third * HGA_T;
            for (int s0 = HGA_T - 8; s0 >= 0; s0 -= 8) {
                float fv[8]; unsigned short iv[8];
#pragma unroll
                for (int u = 0; u < 8; ++u) {
                    const int st = sb + s0 + u;
                    const int stc = (st < st1) ? st : st1 - 1;
                    const size_t off = (size_t)hg_row(dir, b, stc) * 256 + h * 64 + lane;
                    fv[u] = fbase[off]; iv[u] = hi[off];
                }
#pragma unroll
                for (int u = 7; u >= 0; --u) {
                    const int st = sb + s0 + u;
                    const bool ok = (st < st1);
                    const float f = ok ? fv[u] : 1.f;
                    const float kh = ok ? (1.f - f) * P : 0.f;
                    P *= f;
                    *(LAS unsigned short*)(KT + lane * HGA_STR + (s0 + u) * 2) = (unsigned short)(pk2(kh, 0.f) & 0xffffu);
                    *(LAS unsigned short*)(VT + lane * HGA_STR + (s0 + u) * 2) = ok ? iv[u] : (unsigned short)0;
                }
            }
            LDS_WAIT(); asm volatile("" ::: "memory");
#pragma unroll
            for (int q = 0; q < HGA_T / 16; ++q) {
                bf16x8 af[2], bfr[2];
#pragma unroll
                for (int kb = 0; kb < 2; ++kb) af[kb] = *(LAS bf16x8*)(KT + (kb * 32 + n) * HGA_STR + (16 * q + 8 * gq) * 2);
#pragma unroll
                for (int vb = 0; vb < 2; ++vb) bfr[vb] = *(LAS bf16x8*)(VT + (vb * 32 + n) * HGA_STR + (16 * q + 8 * gq) * 2);
#pragma unroll
                for (int kb = 0; kb < 2; ++kb)
#pragma unroll
                    for (int vb = 0; vb < 2; ++vb) acc[kb][vb] = __builtin_amdgcn_mfma_f32_32x32x16_bf16(af[kb], bfr[vb], acc[kb][vb], 0, 0, 0);
            }
            LDS_WAIT(); asm volatile("" ::: "memory");
        }
#pragma unroll
        for (int kb = 0; kb < 2; ++kb)
#pragma unroll
            for (int vb = 0; vb < 2; ++vb)
#pragma unroll
                for (int r = 0; r < 16; ++r) {
                    const int k = kb * 32 + 8 * (r >> 2) + 4 * gq + (r & 3), v = vb * 32 + n;
                    carry[((size_t)item * 64 + k) * 64 + v] = acc[kb][vb][r];
                }
        dk[item * 64 + lane] = P;
    }
}
constexpr int HGB_QSTR = 144, HGB_TSTR = 48, HGB_Q = 0, HGB_K = HGB_Q + 16 * HGB_QSTR, HGB_KH = HGB_K + 16 * HGB_QSTR, HGB_IT = HGB_KH + 64 * HGB_TSTR, HGB_DC = HGB_IT + 64 * HGB_TSTR, HGB_WAVE = HGB_DC + 256;
static_assert(8 * HGB_WAVE <= LDS_BYTES - 64, "hg pass B LDS");
__device__ __forceinline__ bf16x8 hgb_pack8(const f32x16& t, int r0) {
    u32x4 w; w.x = pk2(t[r0 + 0], t[r0 + 1]); w.y = pk2(t[r0 + 2], t[r0 + 3]); w.z = pk2(t[r0 + 4], t[r0 + 5]); w.w = pk2(t[r0 + 6], t[r0 + 7]); return __builtin_bit_cast(bf16x8, w);
}
__device__ __forceinline__ void hg_passB_mfma(LAS unsigned char* lds, const float* hq, const float* ff, const float* fb, const bf16_t* hi, const float* carry, bf16_t* odir, int wave, int lane, int G) {
    LAS unsigned char* W = lds + wave * HGB_WAVE;
    const int n = lane & 31, gq = lane >> 5, n16 = n & 15;
    const int kpos = (lane & ~15) + (lane & 3) + ((lane >> 3) & 1) * 4 + ((lane >> 2) & 1) * 8;
    for (int item = blockIdx.x + G * wave; item < 16 * HG_SEG; item += G * 8) {
        const int s = item / HG_SEG, j = item % HG_SEG, dir = s >> 3, b = (s >> 2) & 1, h = s & 3;
        const float* fbase = dir ? fb : ff;
        const int st0 = j * HG_STEPS, st1 = st0 + HG_STEPS;
        f32x16 S[2][2];
#pragma unroll
        for (int kb = 0; kb < 2; ++kb)
#pragma unroll
            for (int vb = 0; vb < 2; ++vb)
#pragma unroll
                for (int r = 0; r < 16; ++r) S[kb][vb][r] = carry[((size_t)item * 64 + kb * 32 + 8 * (r >> 2) + 4 * gq + (r & 3)) * 64 + vb * 32 + n];
        for (int c0 = st0; c0 < st1; c0 += 16) {
            float fv[16], qv[16]; unsigned short iv[16];
#pragma unroll
            for (int t = 0; t < 16; ++t) {
                const int st = c0 + t; const int stc = (st < st1) ? st : st1 - 1;
                const size_t off = (size_t)hg_row(dir, b, stc) * 256 + h * 64 + lane;
                fv[t] = fbase[off]; qv[t] = hq[off]; iv[t] = hi[off];
            }
            float P = 1.f; float kt[16];
#pragma unroll
            for (int t = 0; t < 16; ++t) {
                const bool ok = (c0 + t < st1);
                const float f = ok ? fv[t] : 1.f, q = ok ? qv[t] : 0.f;
                P *= f;
                const float Pc = fmaxf(P, 1e-30f);
                kt[t] = ok ? (1.f - f) * rcpf_(Pc) : 0.f;
                *(LAS unsigned short*)(W + HGB_Q + t * HGB_QSTR + kpos * 2) = (unsigned short)(pk2(q * Pc, 0.f) & 0xffffu);
                *(LAS unsigned short*)(W + HGB_K + t * HGB_QSTR + kpos * 2) = (unsigned short)(pk2(kt[t], 0.f) & 0xffffu);
                *(LAS unsigned short*)(W + HGB_IT + lane * HGB_TSTR + t * 2) = ok ? iv[t] : (unsigned short)0;
            }
            const float P15 = fmaxf(P, 1e-30f);
#pragma unroll
            for (int t = 0; t < 16; ++t) *(LAS unsigned short*)(W + HGB_KH + lane * HGB_TSTR + t * 2) = (unsigned short)(pk2(kt[t] * P15, 0.f) & 0xffffu);
            *(LAS float*)(W + HGB_DC + lane * 4) = P;
            LDS_WAIT(); asm volatile("" ::: "memory");
            bf16x8 qb[4];
#pragma unroll
            for (int u = 0; u < 4; ++u) qb[u] = *(LAS bf16x8*)(W + HGB_Q + n16 * HGB_QSTR + (16 * u + 8 * gq) * 2);
            f32x16 OT[2], AT;
#pragma unroll
            for (int r = 0; r < 16; ++r) { OT[0][r] = 0.f; OT[1][r] = 0.f; AT[r] = 0.f; }
#pragma unroll
            for (int u = 0; u < 4; ++u) {
                const bf16x8 ka = *(LAS bf16x8*)(W + HGB_K + n16 * HGB_QSTR + (16 * u + 8 * gq) * 2);
                AT = __builtin_amdgcn_mfma_f32_32x32x16_bf16(ka, qb[u], AT, 0, 0, 0);
#pragma unroll
                for (int vb = 0; vb < 2; ++vb)
                    OT[vb] = __builtin_amdgcn_mfma_f32_32x32x16_bf16(hgb_pack8(S[u >> 1][vb], 8 * (u & 1)), qb[u], OT[vb], 0, 0, 0);
            }
#pragma unroll
            for (int r = 0; r < 8; ++r) { const int srow = 8 * (r >> 2) + 4 * gq + (r & 3); if (srow > n) AT[r] = 0.f; }
            const bf16x8 ab = hgb_pack8(AT, 0);
#pragma unroll
            for (int vb = 0; vb < 2; ++vb) {
                const u32x2 lo = *(LAS u32x2*)(W + HGB_IT + (vb * 32 + n) * HGB_TSTR + (4 * gq) * 2), hi2 = *(LAS u32x2*)(W + HGB_IT + (vb * 32 + n) * HGB_TSTR + (8 + 4 * gq) * 2);
                const bf16x8 ia = __builtin_bit_cast(bf16x8, ((u32x4){lo.x, lo.y, hi2.x, hi2.y}));
                OT[vb] = __builtin_amdgcn_mfma_f32_32x32x16_bf16(ia, ab, OT[vb], 0, 0, 0);
            }
            if (n < 16 && c0 + n < st1) {
                bf16_t* op = odir + (size_t)dir * R * 256 + (size_t)hg_row(dir, b, c0 + n) * 256 + h * 64;
#pragma unroll
                for (int vb = 0; vb < 2; ++vb)
#pragma unroll
                    for (int r4 = 0; r4 < 4; ++r4) {
                        u32x2 w; w.x = pk2(OT[vb][4 * r4 + 0], OT[vb][4 * r4 + 1]); w.y = pk2(OT[vb][4 * r4 + 2], OT[vb][4 * r4 + 3]);
                        *(u32x2*)(op + vb * 32 + 8 * r4 + 4 * gq) = w;
                    }
            }
#pragma unroll
            for (int kb = 0; kb < 2; ++kb) {
                f32x4 dc[4];
#pragma unroll
                for (int r4 = 0; r4 < 4; ++r4) dc[r4] = *(LAS f32x4*)(W + HGB_DC + (kb * 32 + 8 * r4 + 4 * gq) * 4);
                const bf16x8 kh = *(LAS bf16x8*)(W + HGB_KH + (kb * 32 + n) * HGB_TSTR + (8 * gq) * 2);
#pragma unroll
                for (int vb = 0; vb < 2; ++vb) {
#pragma unroll
                    for (int r = 0; r < 16; ++r) S[kb][vb][r] *= dc[r >> 2][r & 3];
                    const bf16x8 ib = *(LAS bf16x8*)(W + HGB_IT + (vb * 32 + n) * HGB_TSTR + (8 * gq) * 2);
                    S[kb][vb] = __builtin_amdgcn_mfma_f32_32x32x16_bf16(kh, ib, S[kb][vb], 0, 0, 0);
                }
            }
            LDS_WAIT(); asm volatile("" ::: "memory");
        }
    }
}
__device__ __forceinline__ void hg_carry(float* carry, const float* dk, int gtid, int ngt) {
    for (int e = gtid; e < 16 * 4096; e += ngt) {
        const int s = e >> 12, idx = e & 4095, k = idx >> 6;
        float run = 0.f;
        for (int j0 = 0; j0 < HG_SEG; j0 += 8) {
            float t[8], d[8];
#pragma unroll
            for (int u = 0; u < 8; ++u) { t[u] = carry[(size_t)(s * HG_SEG + j0 + u) * 4096 + idx]; d[u] = dk[(s * HG_SEG + j0 + u) * 64 + k]; }
#pragma unroll
            for (int u = 0; u < 8; ++u) { carry[(size_t)(s * HG_SEG + j0 + u) * 4096 + idx] = run; run = __builtin_fmaf(d[u], run, t[u]); }
        }
    }
}
__device__ __forceinline__ void hg_readout(const bf16_t* odir, const bf16_t* hgs, const float* gain, bf16_t* ohg, int gw, int ngw, int lane) {
    const f32x4 gv = *(const f32x4*)(gain + ((4 * lane) & 63));
    for (int row = gw; row < R; row += ngw) {
        const size_t off = (size_t)row * 256 + 4 * lane;
        const u32x2 a = *(const u32x2*)(odir + off), bq = *(const u32x2*)(odir + (size_t)R * 256 + off), hg = *(const u32x2*)(hgs + off);
        const float o0 = bflo(a.x) + bflo(bq.x), o1 = bfhi(a.x) + bfhi(bq.x), o2 = bflo(a.y) + bflo(bq.y), o3 = bfhi(a.y) + bfhi(bq.y);
        float ss = (o0 * o0 + o1 * o1) + (o2 * o2 + o3 * o3);
        ss += shx(ss, 1, lane); ss += shx(ss, 2, lane); ss += shx(ss, 4, lane); ss += shx(ss, 8, lane);
        const float rstd = 1.0f / sqrtf(ss * (1.f / 64.f) + EPS);
        u32x2 w;
        w.x = pk2(o0 * rstd * gv[0] * bflo(hg.x), o1 * rstd * gv[1] * bfhi(hg.x));
        w.y = pk2(o2 * rstd * gv[2] * bflo(hg.y), o3 * rstd * gv[3] * bfhi(hg.y));
        *(u32x2*)(ohg + off) = w;
    }
}

constexpr int AT_KSTR = 256, AT_VSTR = 128, AT_KBYTES = 64 * AT_KSTR, AT_VBYTES = 128 * AT_VSTR, AT_STAGE = AT_KBYTES + AT_VBYTES;
static_assert(2 * AT_STAGE <= LDS_BYTES && 65536 <= 2 * AT_STAGE, "attention LDS");
__device__ __forceinline__ void attn_unit(LAS unsigned char* lds, const bf16_t* qbuf, const bf16_t* kbuf, const bf16_t* vT, bf16_t* oda, const float* gain,
                                          int b, int h, int qrow0, int kt0, int kt1, float lam, float post, int tid, int wave, int lane) {
    const int c = wave & 1, g = wave >> 1, n = lane & 31, gq = lane >> 5;
    bf16x8 qf[4];
    { const bf16_t* qp = qbuf + (size_t)(qrow0 + 32 * g + n) * 512 + h * 128 + c * 64 + 8 * gq;
#pragma unroll
      for (int s = 0; s < 4; ++s) qf[s] = *(const bf16x8*)(qp + 16 * s); }
    f32x16 O[4];
#pragma unroll
    for (int e = 0; e < 4; ++e)
#pragma unroll
        for (int r = 0; r < 16; ++r) O[e][r] = 0.f;
    float l = 0.f;
    const int kr_ = lane >> 4, kpos_ = lane & 15;
    const int vr_ = lane >> 3, vpos_ = lane & 7;
    const unsigned char* kbase = (const unsigned char*)(kbuf + h * 128);
    const unsigned char* vbase = (const unsigned char*)(vT + (size_t)(b * 512 + h * 128) * KEYS);
#define AT_KROW0(kt) (((kt) * 64 < SEQ) ? (size_t)b * SEQ + (kt) * 64 : (size_t)NLAT + b * CTXL + ((kt) * 64 - SEQ))
#define AT_DMA(kt, buf) do { const unsigned char* kb_ = kbase + AT_KROW0(kt) * 1024; const unsigned char* vb_ = vbase + (size_t)(kt) * 128; \
        _Pragma("unroll") for (int pp = 0; pp < 2; ++pp) { const int p_ = wave + 8 * pp; \
            { const int r_ = 4 * p_ + kr_; \
              __builtin_amdgcn_global_load_lds((const unsigned*)(kb_ + (size_t)r_ * 1024 + ((kpos_ ^ (r_ & 15)) * 16)), (LAS unsigned*)(lds + (buf) * AT_KBYTES + p_ * 1024), 16, 0, 0); } \
            { const int e_ = 8 * p_ + vr_; \
              __builtin_amdgcn_global_load_lds((const unsigned*)(vb_ + (size_t)e_ * (KEYS * 2) + ((vpos_ ^ ((e_ >> 1) & 7)) * 16)), (LAS unsigned*)(lds + 2 * AT_KBYTES + (buf) * AT_VBYTES + p_ * 1024), 16, 0, 0); } } } while (0)
#define AT_QK(Sa, Sb, buf) do { LAS unsigned char* kp = lds + (buf) * AT_KBYTES + n * AT_KSTR; \
        _Pragma("unroll") for (int s = 0; s < 4; ++s) { \
            const bf16x8 a0 = *(LAS bf16x8*)(kp + (((c * 8 + 2 * s + gq) ^ (n & 15)) * 16)), a1 = *(LAS bf16x8*)(kp + 32 * AT_KSTR + (((c * 8 + 2 * s + gq) ^ (n & 15)) * 16)); \
            Sa = __builtin_amdgcn_mfma_f32_32x32x16_bf16(a0, qf[s], Sa, 0, 0, 0); \
            Sb = __builtin_amdgcn_mfma_f32_32x32x16_bf16(a1, qf[s], Sb, 0, 0, 0); } } while (0)
#define AT_BAR() do { asm volatile("s_waitcnt vmcnt(0) lgkmcnt(0)" ::: "memory"); __builtin_amdgcn_s_barrier(); asm volatile("" ::: "memory"); } while (0)
    const int nt = kt1 - kt0;
    AT_DMA(kt0, 0);
    AT_BAR();
    f32x16 negm;
    {
        f32x16 S0, S1;
#pragma unroll
        for (int r = 0; r < 16; ++r) { S0[r] = 0.f; S1[r] = 0.f; }
        AT_QK(S0, S1, 0);
        float mx = fmaxf(S0[0], S1[0]);
#pragma unroll
        for (int r = 1; r < 16; ++r) mx = fmaxf(fmaxf(mx, S0[r]), S1[r]);
        { auto rr = __builtin_amdgcn_permlane32_swap(__builtin_bit_cast(unsigned, mx), __builtin_bit_cast(unsigned, mx), false, false);
          mx = fmaxf(__builtin_bit_cast(float, rr[0]), __builtin_bit_cast(float, rr[1])); }
#pragma unroll
        for (int r = 0; r < 16; ++r) negm[r] = -mx;
    }
    constexpr float THR = 8.f;
    for (int i = 0; i < nt; ++i) {
        const int cur = i & 1;
        bf16x8 kf[8];
        { LAS unsigned char* kp = lds + cur * AT_KBYTES + n * AT_KSTR;
#pragma unroll
          for (int s = 0; s < 4; ++s) { const int po = ((c * 8 + 2 * s + gq) ^ (n & 15)) * 16; kf[2 * s] = *(LAS bf16x8*)(kp + po); kf[2 * s + 1] = *(LAS bf16x8*)(kp + 32 * AT_KSTR + po); } }
        LAS unsigned char* vp = lds + 2 * AT_KBYTES + cur * AT_VBYTES + n * AT_VSTR;
        const int vsw = (n >> 1) & 7;
        bf16x8 va[8];
#pragma unroll
        for (int ks = 0; ks < 2; ++ks)
#pragma unroll
            for (int e = 0; e < 4; ++e) va[ks * 4 + e] = *(LAS bf16x8*)(vp + e * 32 * AT_VSTR + (((2 * ks + gq) ^ vsw) * 16));
        __builtin_amdgcn_sched_barrier(0);
        if (i + 1 < nt) AT_DMA(kt0 + i + 1, cur ^ 1);
        __builtin_amdgcn_sched_barrier(0);
        f32x16 S0 = negm, S1 = negm;
#pragma unroll
        for (int s = 0; s < 4; ++s) {
            S0 = __builtin_amdgcn_mfma_f32_32x32x16_bf16(kf[2 * s], qf[s], S0, 0, 0, 0);
            S1 = __builtin_amdgcn_mfma_f32_32x32x16_bf16(kf[2 * s + 1], qf[s], S1, 0, 0, 0);
        }
        __builtin_amdgcn_sched_barrier(0);
        bf16x8 vb[8];
#pragma unroll
        for (int ks = 0; ks < 2; ++ks)
#pragma unroll
            for (int e = 0; e < 4; ++e) vb[ks * 4 + e] = *(LAS bf16x8*)(vp + e * 32 * AT_VSTR + (((2 * (ks + 2) + gq) ^ vsw) * 16));
        __builtin_amdgcn_sched_barrier(0);
        float mx = fmaxf(S0[0], S1[0]);
#pragma unroll
        for (int r = 1; r < 16; ++r) mx = fmaxf(fmaxf(mx, S0[r]), S1[r]);
        { auto rr = __builtin_amdgcn_permlane32_swap(__builtin_bit_cast(unsigned, mx), __builtin_bit_cast(unsigned, mx), false, false);
          mx = fmaxf(__builtin_bit_cast(float, rr[0]), __builtin_bit_cast(float, rr[1])); }
        if (__builtin_amdgcn_ballot_w64(mx > THR) != 0ull) {
            const float delta = fmaxf(mx, 0.f), alpha = ex2(-delta);
            l *= alpha;
#pragma unroll
            for (int r = 0; r < 16; ++r) { S0[r] -= delta; S1[r] -= delta; negm[r] -= delta; }
#pragma unroll
            for (int e = 0; e < 4; ++e) O[e] = O[e] * alpha;
        }
        float ps = 0.f;
#define AT_QTR(Sx, r0, va_, ksl) do { \
        _Pragma("unroll") for (int r = 0; r < 8; ++r) { Sx[(r0) + r] = ex2(Sx[(r0) + r]); ps += Sx[(r0) + r]; } \
        u32x4 pw; pw.x = pk2(Sx[(r0) + 0], Sx[(r0) + 1]); pw.y = pk2(Sx[(r0) + 2], Sx[(r0) + 3]); pw.z = pk2(Sx[(r0) + 4], Sx[(r0) + 5]); pw.w = pk2(Sx[(r0) + 6], Sx[(r0) + 7]); \
        const bf16x8 pq = __builtin_bit_cast(bf16x8, pw); \
        __builtin_amdgcn_sched_barrier(0); \
        _Pragma("unroll") for (int e = 0; e < 4; ++e) O[e] = __builtin_amdgcn_mfma_f32_32x32x16_bf16(va_[(ksl) * 4 + e], pq, O[e], 0, 0, 0); } while (0)
        AT_QTR(S0, 0, va, 0);
        AT_QTR(S0, 8, va, 1);
        AT_QTR(S1, 0, vb, 0);
        AT_QTR(S1, 8, vb, 1);
#undef AT_QTR
        l += ps;
        AT_BAR();
    }
#undef AT_BAR
#undef AT_KROW0
#undef AT_DMA
#undef AT_QK
    l += shx(l, 32, lane);
    const float inv = 1.f / l;
    LAS float* xch = (LAS float*)lds;
    if (c == 1) {
#pragma unroll
        for (int e = 0; e < 4; ++e)
#pragma unroll
            for (int r = 0; r < 16; ++r) xch[(g * 64 + e * 16 + r) * 64 + lane] = O[e][r] * inv;
    }
    __syncthreads();
    if (c == 0) {
        float ss = 0.f;
#pragma unroll
        for (int e = 0; e < 4; ++e)
#pragma unroll
            for (int r = 0; r < 16; ++r) { const float o = O[e][r] * inv - lam * xch[(g * 64 + e * 16 + r) * 64 + lane]; O[e][r] = o; ss += o * o; }
        ss += shx(ss, 32, lane);
        const float rs = post / sqrtf(ss * (1.f / 128.f) + EPS);
        bf16_t* op = oda + (size_t)(qrow0 + 32 * g + n) * 512 + h * 128;
#pragma unroll
        for (int e = 0; e < 4; ++e)
#pragma unroll
            for (int r4 = 0; r4 < 4; ++r4) {
                const int e0 = e * 32 + 8 * r4 + 4 * gq;
                const f32x4 gv = *(const f32x4*)(gain + e0);
                u32x2 w; w.x = pk2(O[e][4 * r4 + 0] * rs * gv[0], O[e][4 * r4 + 1] * rs * gv[1]); w.y = pk2(O[e][4 * r4 + 2] * rs * gv[2], O[e][4 * r4 + 3] * rs * gv[3]);
                *(u32x2*)(op + e0) = w;
            }
    }
    __syncthreads();
}
#define XB_TMO      128
#define XB_XCNT(j)  (256  + 64 * (j))
#define XB_XSUB(j)  (1280 + 64 * (j))
#define XB_XGEN(j)  (2304 + 64 * (j))
#define XB_TOP      3328
#define XB_TOPGEN   3392
#define XCD_BAR_WORDS 3456
#define XB_SPIN_CAP (1u << 18)

__device__ __forceinline__ unsigned xb_ld(unsigned* p)              { return __hip_atomic_load(p, __ATOMIC_RELAXED, __HIP_MEMORY_SCOPE_AGENT); }
__device__ __forceinline__ unsigned xb_add(unsigned* p, unsigned v) { return __hip_atomic_fetch_add(p, v, __ATOMIC_RELAXED, __HIP_MEMORY_SCOPE_AGENT); }
__device__ __forceinline__ unsigned xb_xcc_id() { return (unsigned)__builtin_amdgcn_s_getreg((3 << 11) | 20) & 0xFu; }
#define XB_SPIN(cond, bar) do { unsigned _sp = 0; while (cond) { __builtin_amdgcn_s_sleep(1); \
    if ((++_sp & 255u) == 0u) { if (xb_ld(&(bar)[XB_TMO])) break; if (_sp > XB_SPIN_CAP) { atomicAdd(&(bar)[XB_TMO], 1u); break; } } } } while (0)

struct XcdBarrier {
    unsigned* bar; unsigned x;
    volatile LAS unsigned* st;
};

__device__ __forceinline__ XcdBarrier xcd_barrier_post(unsigned* bar, volatile LAS unsigned* st, int tid_in) {
    XcdBarrier b; b.bar = bar; b.x = xb_xcc_id(); b.st = st;
    if (tid_in == 0) (void)xb_add(&bar[XB_XCNT(b.x)], 1u);
    return b;
}
__device__ __forceinline__ void xcd_barrier_complete(unsigned* bar, unsigned x, unsigned& nloc, unsigned& nx) {
    const unsigned G = gridDim.x * gridDim.y * gridDim.z;
    unsigned sum, cnt, mine, sp = 0u;
    for (;;) {
        sum = 0u; cnt = 0u; mine = 0u;
#pragma unroll
        for (unsigned j = 0; j < 16; ++j) { const unsigned c = xb_ld(&bar[XB_XCNT(j)]); sum += c; cnt += (c > 0u) ? 1u : 0u; mine = (j == x) ? c : mine; }
        if (sum == G) break;
        __builtin_amdgcn_s_sleep(1);
        if ((++sp & 255u) == 0u) { if (xb_ld(&bar[XB_TMO])) break; if (sp > XB_SPIN_CAP) { atomicAdd(&bar[XB_TMO], 1u); break; } }
    }
    nloc = mine > 0u ? mine : 1u; nx = cnt > 0u ? cnt : 1u;
}

__device__ __forceinline__ void xcd_barrier(const XcdBarrier& b, int tid_in) {
    asm volatile("s_waitcnt vmcnt(0)" ::: "memory");
    __syncthreads();
    if (tid_in == 0) {
        unsigned* bar = b.bar;
        __builtin_amdgcn_s_waitcnt(0);
        unsigned nloc = b.st[0], nx = b.st[1];
        if (nloc == 0u) { xcd_barrier_complete(bar, b.x, nloc, nx); b.st[0] = nloc; b.st[1] = nx; }
        const unsigned old = xb_add(&bar[XB_XSUB(b.x)], 1u);
        const unsigned gen = old / nloc;
        if (old + 1u == (gen + 1u) * nloc) {
            __builtin_amdgcn_fence(__ATOMIC_RELEASE, "agent");
            asm volatile("s_waitcnt vmcnt(0)" ::: "memory");
            const unsigned og = xb_add(&bar[XB_TOP], 1u);
            const unsigned tg = og / nx;
            if (og + 1u == (tg + 1u) * nx) xb_add(&bar[XB_TOPGEN], 1u);
            else XB_SPIN(xb_ld(&bar[XB_TOPGEN]) == tg, bar);
            __builtin_amdgcn_fence(__ATOMIC_ACQUIRE, "agent");
            xb_add(&bar[XB_XGEN(b.x)], 1u);
            asm volatile("s_waitcnt vmcnt(0)" ::: "memory");
        } else {
            XB_SPIN(xb_ld(&bar[XB_XGEN(b.x)]) == gen, bar);
            __builtin_amdgcn_fence(__ATOMIC_ACQUIRE, "agent");
            asm volatile("s_waitcnt vmcnt(0)" ::: "memory");
        }
    }
    __syncthreads();
}


struct Args { const float* in[30]; float* out; unsigned char* ws; };
typedef const Args __attribute__((address_space(4))) Args_c;
__device__ __forceinline__ Args_c* kargs_ptr() { Args_c* p = (Args_c*)__builtin_amdgcn_kernarg_segment_ptr(); asm volatile("" : "+s"(p)); return p; }
#define GSYNC_CG() cg::this_grid().sync()
constexpr size_t WS_BAR = WS_END + 4096;
constexpr size_t WS_TOTAL = WS_BAR + (size_t)XCD_BAR_WORDS * 4;
static_assert(WS_TOTAL <= (size_t)512 * 1024 * 1024, "workspace");
constexpr int LDS_BARST = LDS_BYTES - 16;
#define GSYNC() do { XcdBarrier xb_; xb_.bar = (unsigned*)(kargs_ptr()->ws + WS_BAR); xb_.x = xb_xcc_id(); xb_.st = (volatile LAS unsigned*)(lds + LDS_BARST); xcd_barrier(xb_, TIDX()); } while (0)
#ifdef PROBE_A
#define TS(cat) do { if (blockIdx.x == 0 && TIDX() == 0) { unsigned long long* tsb = (unsigned long long*)(kargs_ptr()->ws + WS_END); const unsigned long long now = __builtin_amdgcn_s_memrealtime(); tsb[1 + (cat)] += now - tsb[0]; tsb[0] = now; } } while (0)
#else
#define TS(cat) do {} while (0)
#endif
__device__ __forceinline__ int tid_from(int wave_s) { int w_ = wave_s; unsigned z_ = 0u; asm volatile("" : "+s"(w_), "+s"(z_)); return w_ * 64 + (int)__builtin_amdgcn_mbcnt_hi(~0u, __builtin_amdgcn_mbcnt_lo(~0u, z_)); }
#define TIDX() tid_from(wave_s)
#define KA() int tid = TIDX(); asm volatile("" : "+v"(tid)); int G = gridDim.x, bid = blockIdx.x; asm volatile("" : "+s"(G), "+s"(bid)); \
    const int lane = tid & 63, wave = __builtin_amdgcn_readfirstlane(tid >> 6), gw = bid * 8 + wave, ngw = G * 8, gtid = bid * NTHR + tid, ngt = G * NTHR; \
    (void)lane; (void)wave; (void)gw; (void)ngw; (void)gtid; (void)ngt; \
    Args_c* ka = kargs_ptr(); unsigned char* ws = ka->ws; (void)ws

__global__ void __launch_bounds__(NTHR, 2) fwd_kernel(Args a_unused) {
    extern __shared__ __attribute__((aligned(16))) unsigned char lds_raw[];
    LAS unsigned char* lds = (LAS unsigned char*)lds_raw;
    const int wave_s = __builtin_amdgcn_readfirstlane((int)threadIdx.x >> 6);
    if (TIDX() < 4) ((volatile LAS unsigned*)(lds + LDS_BARST))[TIDX()] = 0u;
    __syncthreads();
    (void)xcd_barrier_post((unsigned*)(kargs_ptr()->ws + WS_BAR), (volatile LAS unsigned*)(lds + LDS_BARST), TIDX());
#ifdef PROBE_A
    if (blockIdx.x == 0 && TIDX() == 0) { unsigned long long* tsb = (unsigned long long*)(kargs_ptr()->ws + WS_END); for (int i = 1; i < 32; ++i) tsb[i] = 0; tsb[0] = __builtin_amdgcn_s_memrealtime(); }
#endif

#ifdef REP_INIT
#pragma unroll 1
    for (int rep_ = 0; rep_ < 2; ++rep_) {
#else
    {
#endif
    {
        KA();
        bf16_t* WB = (bf16_t*)(ws + WS_WB);
        LAS float* scr = (LAS float*)(lds + wave * 8448);
        constexpr int IT_L = 12416;
        for (int it = gw; it < 2 * IT_L; it += ngw) {
            const int l = it / IT_L; int r = it % IT_L;
            bf16_t* Wl = WB + (size_t)l * WL_TOTAL;
            if (r < 1408) { transpose_item(ka->in[9] + (size_t)l * 1024 * DFF, 1024, DFF, Wl + WL_UP1, 1, scr, r, lane); continue; } r -= 1408;
            if (r < 1408) { transpose_item(ka->in[10] + (size_t)l * 1024 * DFF, 1024, DFF, Wl + WL_UP1, 2, scr, r, lane); continue; } r -= 1408;
            if (r < 1408) { transpose_item(ka->in[11] + (size_t)l * DFF * 1024, DFF, 1024, Wl + WL_DN1, 0, scr, r, lane); continue; } r -= 1408;
            if (r < 1408) { transpose_item(ka->in[12] + (size_t)l * 1024 * DFF, 1024, DFF, Wl + WL_UP2, 1, scr, r, lane); continue; } r -= 1408;
            if (r < 1408) { transpose_item(ka->in[13] + (size_t)l * 1024 * DFF, 1024, DFF, Wl + WL_UP2, 2, scr, r, lane); continue; } r -= 1408;
            if (r < 1408) { transpose_item(ka->in[14] + (size_t)l * DFF * 1024, DFF, 1024, Wl + WL_DN2, 0, scr, r, lane); continue; } r -= 1408;
            if (r < 3072) { transpose_item(ka->in[15] + (size_t)l * 1024 * 6144, 1024, 6144, Wl + WL_IN, 3, scr, r, lane); continue; } r -= 3072;
            if (r < 256) { transpose_item(ka->in[25] + (size_t)l * 512 * 1024, 512, 1024, Wl + WL_PA, 0, scr, r, lane); continue; } r -= 256;
            if (r < 128) { transpose_item(ka->in[26] + (size_t)l * 256 * 1024, 256, 1024, Wl + WL_PH, 0, scr, r, lane); continue; } r -= 128;
            transpose_item(ka->in[28] + (size_t)l * 1024 * 1024, 1024, 1024, Wl + WL_O, 0, scr, r, lane);
        }
        __syncthreads();
    }
    {
        KA();
        float* MOD = (float*)(ws + WS_MOD);
        LAS float* sv = (LAS float*)lds;
        LAS float* part = (LAS float*)(lds + 12288);
        for (int i = tid; i < 3072; i += NTHR) { const int seg = i >> 10, k = i & 1023; const float x = (seg < 2) ? ka->in[1][seg * 1024 + k] : ka->in[3][k]; sv[i] = x / (1.f + __expf(-x)); }
        __syncthreads();
        for (int item = bid; item < 288; item += G) {
            const int l = item / 144, col = (item % 144) * 64 + lane;
            const float* W = ka->in[4] + (size_t)l * 1024 * 9216 + col;
            float a0 = 0.f, a1 = 0.f, a2 = 0.f;
            for (int k = wave * 128; k < wave * 128 + 128; ++k) { const float w = W[(size_t)k * 9216]; a0 = __builtin_fmaf(sv[k], w, a0); a1 = __builtin_fmaf(sv[1024 + k], w, a1); a2 = __builtin_fmaf(sv[2048 + k], w, a2); }
            part[(wave * 3 + 0) * 64 + lane] = a0; part[(wave * 3 + 1) * 64 + lane] = a1; part[(wave * 3 + 2) * 64 + lane] = a2;
            __syncthreads();
            if (tid < 192) { const int seg = tid >> 6, cl = tid & 63; float s = 0.f;
#pragma unroll
                for (int w = 0; w < 8; ++w) s += part[(w * 3 + seg) * 64 + cl];
                const int cc = (item % 144) * 64 + cl;
                MOD[(size_t)(l * 3 + seg) * 9216 + cc] = s + ka->in[5][l * 9216 + cc]; }
            __syncthreads();
        }
    }
    {
        KA();
        bf16_t* WB = (bf16_t*)(ws + WS_WB); float* CS = (float*)(ws + WS_CS); float* LBT = (float*)(ws + WS_LB); float* LAMV = (float*)(ws + WS_LAM);
        for (int idx = gtid; idx < 2 * 256 * 1024; idx += ngt) {
            const int n = idx & 1023, k = (idx >> 10) & 255, l = idx >> 18, g = k >> 6, c = k & 63;
            const float* pw = ka->in[23] + (size_t)l * 4 * 64 * 64 + (g * 64 + c) * 64;
            const float* psc = ka->in[24] + l * 256 + g * 64;
            const float* wp = ka->in[27] + (size_t)l * 256 * 1024 + (size_t)(g * 64) * 1024 + n;
            float s = 0.f;
            for (int d = 0; d < 64; ++d) s = __builtin_fmaf(pw[d] * psc[d], wp[(size_t)d * 1024], s);
            (WB + (size_t)l * WL_TOTAL + WL_PP)[(size_t)n * 256 + k] = (bf16_t)(pk2(s, 0.f) & 0xffffu);
        }
        for (int idx = gtid; idx < 4096; idx += ngt) {
            const int n = idx >> 4, j = idx & 15;
            const float invf = __builtin_exp2f(-(float)j * (13.287712379549449f / 16.f));
            const float ang = (float)n * invf;
            const double rev = (double)ang * 0.15915494309189535; const float fr = (float)(rev - __builtin_floor(rev));
            CS[n * 32 + j] = __builtin_amdgcn_cosf(fr); CS[n * 32 + 16 + j] = __builtin_amdgcn_sinf(fr);
        }
        for (int idx = gtid; idx < 1024; idx += ngt) {
            const int l = idx >> 9, dc = idx & 511;
            const float l0 = ka->in[21][dc], l1 = ka->in[21][512 + dc];
            LBT[idx] = (l == 0) ? 0.f : 1.f / (1.f + __expf(l0 - l1));
        }
        for (int idx = gtid; idx < NCTX * DM / 4; idx += ngt) ((f32x4*)(ws + WS_HC))[idx] = ((const f32x4*)ka->in[2])[idx];
        if (gtid < 2) {
            const int l = gtid; float s1 = 0.f, s2 = 0.f;
            for (int i = 0; i < 64; ++i) { s1 += ka->in[16][l * 64 + i] * ka->in[17][l * 64 + i]; s2 += ka->in[18][l * 64 + i] * ka->in[19][l * 64 + i]; }
            const float li = (l == 0) ? 0.2f : (0.8f - 0.6f * 0.7408182206817179f);
            LAMV[l * 2 + 0] = __expf(s1) - __expf(s2) + li; LAMV[l * 2 + 1] = 1.f - li;
        }
    }
    }
    GSYNC_CG();
    TS(0);

#pragma unroll 1
    for (int l = 0; l < 2; ++l) {
#ifdef REP_SYNC
#pragma unroll 1
        for (int rs_ = 0; rs_ < 10; ++rs_) { GSYNC(); }
#endif
#pragma unroll 1
        for (int f = 0; f < 2; ++f) {
            {   KA(); const bool first = (l == 0 && f == 0);
                const float* in_lat = first ? ka->in[0] : ka->out; const float* in_ctx = (const float*)(ws + WS_HC);
                norm_phase(in_lat, in_ctx, ka->in[f ? 8 : 6] + l * 1024, (const float*)(ws + WS_MOD) + (size_t)l * 3 * 9216, f ? 6 : 0, f ? 7 : 1, (bf16_t*)(ws + WS_XB), gw, ngw, lane,
                           (const float*)(ws + WS_O), first ? 0 : (f ? (l == 0 ? 4 : 0) : DFF / 256), (float*)(ws + WS_HC)); }
            GSYNC();
            TS(1);
            {   KA(); bf16_t* Wl = (bf16_t*)(ws + WS_WB) + (size_t)l * WL_TOTAL;
                const int Mr = (l == 1 && f == 1) ? NLAT : R;
                pg8::Gemm g{(bf16_t*)(ws + WS_XB), Wl + (f ? WL_UP2 : WL_UP1), Mr, 5632, 1024}; pg8::StaticOrder S; S.init(Mr, 5632, G, bid); EpiUp E{(bf16_t*)(ws + WS_Z)};
                pg8::gemm_phase<EpiUp, pg8::StaticOrder, true, true>(lds, g, S, E, tid); }
            GSYNC();
            TS(2);
            {   KA(); bf16_t* Wl = (bf16_t*)(ws + WS_WB) + (size_t)l * WL_TOTAL; const bool first = (l == 0 && f == 0);
                const float* in_lat = first ? ka->in[0] : ka->out;
                pg8::Gemm g{(bf16_t*)(ws + WS_Z), Wl + (f ? WL_DN2 : WL_DN1), NLAT, 1024, DFF}; pg8::StaticOrder S; S.init(NLAT, 1024, G, bid);
                EpiRes E{in_lat, (const float*)(ws + WS_HC), ka->out, (float*)(ws + WS_HC), (const float*)(ws + WS_MOD) + (size_t)l * 3 * 9216 + (f ? 8 : 2) * 1024, 0.5f};
                pg8::gemm_phase<EpiRes, pg8::StaticOrder, true, true>(lds, g, S, E, tid); }
            if (!(l == 1 && f == 1))
            {   KA(); bf16_t* Wl = (bf16_t*)(ws + WS_WB) + (size_t)l * WL_TOTAL;
                pg8::Gemm g{(bf16_t*)(ws + WS_Z) + (size_t)NLAT * DFF, Wl + (f ? WL_DN2 : WL_DN1), NCTX, 1024, 256, DFF}; SplitKOrder S; S.init(DFF / 256, 256, G, bid);
                EpiPart E{(float*)(ws + WS_O), (const float*)(ws + WS_MOD) + (size_t)l * 3 * 9216 + (f ? 8 : 2) * 1024, 0.5f};
                pg8::gemm_phase<EpiPart, SplitKOrder, true, true>(lds, g, S, E, tid); }
            GSYNC();
            TS(3);
            if (f == 1) break;
            {   KA();
                norm_phase(ka->out, (const float*)(ws + WS_HC), ka->in[7] + l * 1024, (const float*)(ws + WS_MOD) + (size_t)l * 3 * 9216, 3, 4, (bf16_t*)(ws + WS_XB), gw, ngw, lane,
                           (const float*)(ws + WS_O), DFF / 256, (float*)(ws + WS_HC)); }
            GSYNC();
            TS(1);
            {   KA(); bf16_t* Wl = (bf16_t*)(ws + WS_WB) + (size_t)l * WL_TOTAL;
                pg8::Gemm g{(bf16_t*)(ws + WS_XB), Wl + WL_IN, R, 3072, 1024}; pg8::StaticOrder S; S.init(R, 3072, G, bid);
                EpiWin E{ws + WS_Z, (const float*)(ws + WS_CS), (const float*)(ws + WS_LB) + l * 512, 0};
                pg8::gemm_phase<EpiWin, pg8::StaticOrder, true, true>(lds, g, S, E, tid); }
            GSYNC();
            TS(4);
            {   KA(); pool_phase((const bf16_t*)(ws + WS_Z + Z_ZP), (bf16_t*)(ws + WS_O + O_MX), gtid, ngt); }
#ifdef REP_ATTN
            for (int rep_ = 0; rep_ < 2; ++rep_)
#endif
            {   KA();
                const float* LAMV = (const float*)(ws + WS_LAM);
                const int nunits = 1024 + (l == 0 ? 16 : 0);
                for (int u = bid; u < nunits; u += G) {
                    int bh, qrow0, kt0, kt1;
                    if (u < 1024) { bh = u >> 7; qrow0 = (bh >> 2) * SEQ + (u & 127) * 128; kt0 = 0; kt1 = KEYS / 64; }
                    else { const int v = u - 1024; bh = v >> 1; qrow0 = NLAT + (bh >> 2) * CTXL + (v & 1) * 128; kt0 = SEQ / 64; kt1 = KEYS / 64; }
                    attn_unit(lds, (const bf16_t*)(ws + WS_Z + Z_Q), (const bf16_t*)(ws + WS_Z + Z_K), (const bf16_t*)(ws + WS_Z + Z_VT), (bf16_t*)(ws + WS_O + O_DA), ka->in[20] + l * 128,
                              bh >> 2, bh & 3, qrow0, kt0, kt1, LAMV[l * 2], LAMV[l * 2 + 1], tid, wave, lane);
                }
            }
            GSYNC();
            TS(5);
#ifdef REP_HG
#pragma unroll 1
            for (int rep_ = 0; rep_ < 2; ++rep_) {
#else
            {
#endif
            {   KA(); hg_passA_mfma(lds, (const float*)(ws + WS_Z + Z_FF), (const float*)(ws + WS_Z + Z_FB), (const bf16_t*)(ws + WS_Z + Z_HI),
                                      (float*)(ws + WS_CAR), (float*)(ws + WS_DK), wave, lane, G); }
            GSYNC();
            TS(6);
            {   KA(); hg_carry((float*)(ws + WS_CAR), (const float*)(ws + WS_DK), gtid, ngt); }
            GSYNC();
            TS(7);
            {   KA(); hg_passB_mfma(lds, (const float*)(ws + WS_Z + Z_HQ), (const float*)(ws + WS_Z + Z_FF), (const float*)(ws + WS_Z + Z_FB), (const bf16_t*)(ws + WS_Z + Z_HI),
                                      (const float*)(ws + WS_CAR), (bf16_t*)(ws + WS_Z + Z_K), wave, lane, G); }
            GSYNC();
            TS(8);
            {   KA(); hg_readout((const bf16_t*)(ws + WS_Z + Z_K), (const bf16_t*)(ws + WS_Z + Z_HG), ka->in[22] + l * 64, (bf16_t*)(ws + WS_O + O_HG), gw, ngw, lane); }
            GSYNC();
            TS(9);
            }
            {   KA(); bf16_t* Wl = (bf16_t*)(ws + WS_WB) + (size_t)l * WL_TOTAL;
                const int Mr = (l == 1) ? NLAT : R;
                pg8::Gemm g{(bf16_t*)(ws + WS_XB), Wl + WL_IN + (size_t)3072 * 1024, Mr, 3072, 1024}; pg8::StaticOrder S; S.init(Mr, 3072, G, bid); EpiG E{(bf16_t*)(ws + WS_Z)};
                pg8::gemm_phase<EpiG, pg8::StaticOrder, true, true>(lds, g, S, E, tid); }
            GSYNC();
            TS(10);
#pragma unroll 1
            for (int gi = 0; gi < 3; ++gi) {
                KA(); bf16_t* Wl = (bf16_t*)(ws + WS_WB) + (size_t)l * WL_TOTAL;
                const bf16_t* A = (const bf16_t*)(ws + WS_O + ((gi == 0) ? O_DA : (gi == 1 ? O_HG : O_MX))); const int K = (gi == 0) ? 512 : 256;
                const bf16_t* Bt = Wl + ((gi == 0) ? WL_PA : (gi == 1 ? WL_PH : WL_PP));
                const int Mr = (l == 1) ? NLAT : R;
                pg8::Gemm g{A, Bt, Mr, 1024, K}; pg8::StaticOrder S; S.init(Mr, 1024, G, bid); EpiProj E{(bf16_t*)(ws + WS_XB), (const bf16_t*)(ws + WS_Z), gi, gi == 0};
                pg8::gemm_phase<EpiProj, pg8::StaticOrder, true, true>(lds, g, S, E, tid);
            }
            GSYNC();
            TS(11);
            {   KA(); bf16_t* Wl = (bf16_t*)(ws + WS_WB) + (size_t)l * WL_TOTAL;
                pg8::Gemm g{(bf16_t*)(ws + WS_XB), Wl + WL_O, NLAT, 1024, 1024}; pg8::StaticOrder S; S.init(NLAT, 1024, G, bid);
                EpiRes E{ka->out, (const float*)(ws + WS_HC), ka->out, (float*)(ws + WS_HC), (const float*)(ws + WS_MOD) + (size_t)l * 3 * 9216 + 5 * 1024, 1.0f};
                pg8::gemm_phase<EpiRes, pg8::StaticOrder, true, true>(lds, g, S, E, tid); }
            if (l == 0)
            {   KA(); bf16_t* Wl = (bf16_t*)(ws + WS_WB) + (size_t)l * WL_TOTAL;
                pg8::Gemm g{(bf16_t*)(ws + WS_XB) + (size_t)NLAT * 1024, Wl + WL_O, NCTX, 1024, 256, 1024}; SplitKOrder S; S.init(4, 256, G, bid);
                EpiPart E{(float*)(ws + WS_O), (const float*)(ws + WS_MOD) + (size_t)l * 3 * 9216 + 5 * 1024, 1.0f};
                pg8::gemm_phase<EpiPart, SplitKOrder, true, true>(lds, g, S, E, tid); }
            GSYNC();
            TS(12);
        }
    }
    {   KA(); final_norm_phase(ka->out, ka->in[29], gw, ngw, lane); }
#ifdef PROBE_A
    GSYNC(); TS(1);
    if (blockIdx.x == 0) { KA(); const unsigned long long* tsb = (const unsigned long long*)(ws + WS_END);
        __syncthreads();
        const float va = (float)tsb[1 + PROBE_A] * 0.01f, vb = (float)tsb[1 + PROBE_B] * 0.01f;
        __syncthreads();
        if (tid == 0) ka->out[0] += va;
        for (int i = tid; i < 65536; i += NTHR) ka->out[(size_t)(i / 1024 + 8) * 1024 + (i & 1023)] += vb; }
#endif
}

extern "C" void kernel_launch(void* const* d_in, const int* in_sizes, int n_in, void* d_out, int out_size, void* d_ws, size_t ws_size, hipStream_t stream) {
    static int grid = 0;
    if (grid == 0) {
        if (n_in != 30 || out_size != NLAT * DM || ws_size < WS_TOTAL) { fprintf(stderr, "kernel_launch: unexpected shapes (n_in %d out %d ws %zu need %zu)\n", n_in, out_size, ws_size, (size_t)WS_TOTAL); grid = -1; return; }
        int dev = 0, cus = 0, per_cu = 0;
        (void)hipGetDevice(&dev);
        (void)hipDeviceGetAttribute(&cus, hipDeviceAttributeMultiprocessorCount, dev);
        if (hipFuncSetAttribute((const void*)fwd_kernel, hipFuncAttributeMaxDynamicSharedMemorySize, LDS_BYTES) != hipSuccess) { fprintf(stderr, "kernel_launch: hipFuncSetAttribute failed\n"); grid = -1; return; }
        if (hipOccupancyMaxActiveBlocksPerMultiprocessor(&per_cu, (const void*)fwd_kernel, NTHR, LDS_BYTES) != hipSuccess || per_cu < 1) { fprintf(stderr, "kernel_launch: occupancy query failed (%d)\n", per_cu); (void)hipGetLastError(); per_cu = 1; }
        if (per_cu > 1) per_cu = 1;
        grid = cus * per_cu;
    }
    if (grid < 0) return;
    if (hipMemsetAsync((unsigned char*)d_ws + WS_BAR, 0, (size_t)XCD_BAR_WORDS * 4, stream) != hipSuccess) { fprintf(stderr, "kernel_launch: memset failed\n"); return; }
    Args a{};
    for (int i = 0; i < 30; ++i) a.in[i] = (const float*)d_in[i];
    a.out = (float*)d_out; a.ws = (unsigned char*)d_ws;
    void* args[] = {&a};
    hipError_t e = hipLaunchCooperativeKernel((const void*)fwd_kernel, dim3(grid), dim3(NTHR), args, LDS_BYTES, stream);
    if (e != hipSuccess) fprintf(stderr, "cooperative launch failed: %s (grid %d)\n", hipGetErrorString(e), grid);
}
```
